# Optimizing an MI355X kernel written in HIP

```python
import math
import jax, jax.numpy as jnp
from jax import lax
import numpy as np

D_MODEL = 1024
BATCH = 8
SEQ = 2048
DEPTH = 1
DEC_BATCH = 32
DEC_SEQ = 1
PAST_LEN = 16384
PAGE_SIZE = 128

N_META = 16
A_HEADS = 8
A_NOPE = 64
A_ROPE = 32
A_QK = A_NOPE + A_ROPE
A_V = 64
A_WIDTH = A_HEADS * A_V
Q_LORA = 384
KV_LORA = 256
ROPE_THETA = 10000.0
Q_BLOCK = 128
B_HEADS = 4
B_DK = 128
B_DV = 128
B_FDIM = B_HEADS * B_DK
B_WIDTH = B_HEADS * B_DV
CHUNK = 64
EPS = 1e-6
SPLIT_SIZES = (Q_LORA, KV_LORA, A_ROPE, B_FDIM, B_FDIM, B_WIDTH, A_WIDTH, B_WIDTH, D_MODEL, D_MODEL)
SPLIT_IDX = tuple(int(c) for c in np.cumsum(SPLIT_SIZES)[:-1])
IN_COLS = sum(SPLIT_SIZES)

kernel_name = 'mla_hgrn2_gated_hybrid_step'


def rmsnorm(x, g):
    xf = x.astype(jnp.float32)
    r = lax.rsqrt(jnp.mean(xf * xf, axis=-1, keepdims=True) + EPS)
    return (xf * r).astype(x.dtype) * g


def rope(x, pos):
    half = A_ROPE // 2
    inv = ROPE_THETA ** (-jnp.arange(half, dtype=jnp.float32) / half)
    ang = pos.astype(jnp.float32)[:, None] * inv
    ang = ang.reshape(ang.shape[0], *([1] * (x.ndim - 3)), half)
    cos, sin = jnp.cos(ang).astype(x.dtype), jnp.sin(ang).astype(x.dtype)
    x1, x2 = x[..., :half], x[..., half:]
    return jnp.concatenate([x1 * cos - x2 * sin, x1 * sin + x2 * cos], axis=-1)


def mla_queries(cq, pos, g_cq, w_uq, g_qn):
    q = (rmsnorm(cq, g_cq) @ w_uq).reshape(*cq.shape[:-1], A_HEADS, A_QK)
    q = jnp.concatenate([q[..., :A_NOPE], rope(q[..., A_NOPE:], pos)], axis=-1)
    return rmsnorm(q, g_qn)


def mla_keys(ckv, kr, w_uk, g_kn):
    kn = jnp.einsum('bkc,chd->bkhd', ckv, w_uk)
    kr = jnp.broadcast_to(kr[:, :, None, :], kn.shape[:-1] + (A_ROPE,))
    return rmsnorm(jnp.concatenate([kn, kr], axis=-1), g_kn)


def mla_prompt(q, k, v, with_meta):
    b = q.shape[0]
    scale = A_QK ** -0.5
    kpos = jnp.arange(k.shape[1])

    def attend(qb, qpos, kk, vv, kp):
        s = jnp.einsum('bqhd,bkhd->bhqk', qb, kk).astype(jnp.float32) * scale
        s = jnp.where(kp[None, :] <= qpos[:, None], s, -jnp.inf)
        p = jax.nn.softmax(s, axis=-1).astype(vv.dtype)
        return jnp.einsum('bhqk,bkhd->bqhd', p, vv)

    nb = SEQ // Q_BLOCK
    qr = q[:, -SEQ:].reshape(b, nb, Q_BLOCK, A_HEADS, A_QK).swapaxes(0, 1)

    def block(args):
        qb, j = args
        return attend(qb, N_META + j * Q_BLOCK + jnp.arange(Q_BLOCK), k, v, kpos)

    o = lax.map(block, (qr, jnp.arange(nb)))
    o = o.swapaxes(0, 1).reshape(b, SEQ, A_HEADS, A_V)
    if with_meta:
        mpos = jnp.arange(N_META)
        om = attend(q[:, :N_META], mpos, k[:, :N_META], v[:, :N_META], mpos)
        o = jnp.concatenate([om, o], axis=1)
    return o


def online_update(carry, s, c):
    m, l_, acc = carry
    m_new = jnp.maximum(m, s.max(-1))
    a = jnp.exp(m - m_new)
    p = jnp.exp(s - m_new[..., None])
    acc = acc * a[..., None] + jnp.einsum('bhqk,bkc->bhqc', p, c.astype(jnp.float32))
    return (m_new, l_ * a + p.sum(-1), acc)


def mla_sample(q, ckv, kr, cache_lat, cache_kr, page_table, w_uk, w_uv, g_kn):
    db, t = q.shape[:2]
    scale = A_QK ** -0.5

    def scores(c, r):
        return jnp.einsum('bqhd,bkhd->bhqk', q, mla_keys(c, r, w_uk, g_kn)).astype(jnp.float32) * scale

    def page_step(carry, pt):
        c = cache_lat[pt]
        r = cache_kr[pt]
        return online_update(carry, scores(c, r), c), None

    init = (jnp.full((db, A_HEADS, t), -jnp.inf, jnp.float32),
            jnp.zeros((db, A_HEADS, t), jnp.float32),
            jnp.zeros((db, A_HEADS, t, KV_LORA), jnp.float32))
    carry, _ = lax.scan(page_step, init, page_table.T)
    causal = jnp.tril(jnp.ones((t, t), bool))
    s_new = jnp.where(causal, scores(ckv, kr), -jnp.inf)
    _, l_, acc = online_update(carry, s_new, ckv)
    o_lat = (acc / l_[..., None]).astype(w_uv.dtype)
    return jnp.einsum('bhqc,chd->bqhd', o_lat, w_uv)


def hgrn2_inputs(bq, bf, bi, lb):
    z = bf.astype(jnp.float32)
    logf = jnp.log(lb + (1.0 - lb) * jax.nn.sigmoid(z))
    k = (1.0 - lb) * jax.nn.sigmoid(-z)
    q = jax.nn.silu(bq.astype(jnp.float32))
    heads = lambda a: a.reshape(*a.shape[:-1], B_HEADS, -1)
    return heads(q), heads(k), heads(bi.astype(jnp.float32)), heads(logf)


def hgrn2_chunked(q, k, v, logf, s0, chunk):
    b, L = q.shape[:2]
    n = L // chunk
    chunks = lambda a: a.reshape(b, n, chunk, *a.shape[2:]).swapaxes(0, 1)
    causal = jnp.tril(jnp.ones((chunk, chunk), bool))[None, :, :, None, None]

    def step(S, xs):
        qc, kc, vc, gc = xs
        cum = jnp.cumsum(gc, axis=1)
        decay = jnp.exp(jnp.where(causal, cum[:, :, None] - cum[:, None, :], -jnp.inf))
        attn = jnp.einsum('bthk,bshk,btshk->bhts', qc, kc, decay)
        o = jnp.einsum('bhts,bshv->bthv', attn, vc) + jnp.einsum('bthk,bhkv->bthv', qc * jnp.exp(cum), S)
        last = cum[:, -1]
        S = jnp.exp(last)[..., None] * S + jnp.einsum('bshk,bshv->bhkv', kc * jnp.exp(last[:, None] - cum), vc)
        return S, o

    S, o = lax.scan(step, s0, (chunks(q), chunks(k), chunks(v), chunks(logf)))
    return o.swapaxes(0, 1).reshape(b, L, *o.shape[3:]), S


def merge(h, oa, ob, ga, gb, ma, mb, g_bn, w_oa, w_ob, w_o):
    ya = (oa.reshape(*oa.shape[:2], A_WIDTH) * jax.nn.silu(ga)) @ w_oa
    obn = rmsnorm(ob.astype(h.dtype), g_bn).reshape(*ob.shape[:2], B_WIDTH)
    yb = (obn * jax.nn.silu(gb)) @ w_ob
    return h + (jax.nn.sigmoid(ma) * ya + jax.nn.sigmoid(mb) * yb) @ w_o


def setup_inputs(seed: int = 0) -> dict:
    key = jax.random.key(seed)
    ks = jax.random.split(key, 24)
    f32 = jnp.float32
    n_pages = PAST_LEN // PAGE_SIZE
    n_used = DEC_BATCH * n_pages
    n_pool = n_used + max(1, n_used // 4)
    nrm = lambda k, shape, s=1.0: s * jax.random.normal(k, shape, f32)
    gain = lambda k, n: 1.0 + 0.01 * jax.random.normal(k, (DEPTH, n), f32)
    page_table = jax.random.permutation(ks[5], n_pool)[:n_used].reshape(DEC_BATCH, n_pages).astype(jnp.int32)
    return {
        'x_prompt': nrm(ks[0], (BATCH, SEQ, D_MODEL)),
        'x_sample': nrm(ks[1], (DEC_BATCH, DEC_SEQ, D_MODEL)),
        'cache_latent': nrm(ks[2], (DEPTH, n_pool, PAGE_SIZE, KV_LORA)),
        'cache_krope': nrm(ks[3], (DEPTH, n_pool, PAGE_SIZE, A_ROPE)),
        'state_hgrn': nrm(ks[4], (DEPTH, DEC_BATCH, B_HEADS, B_DK, B_DV), 0.3),
        'page_table': page_table,
        'meta_tokens': nrm(ks[6], (N_META, D_MODEL)),
        'norm_g': gain(ks[7], D_MODEL),
        'w_in': nrm(ks[8], (DEPTH, D_MODEL, IN_COLS), D_MODEL ** -0.5),
        'g_cq': gain(ks[9], Q_LORA),
        'w_uq': nrm(ks[10], (DEPTH, Q_LORA, A_HEADS * A_QK), Q_LORA ** -0.5),
        'g_ckv': gain(ks[11], KV_LORA),
        'w_uk': nrm(ks[12], (DEPTH, KV_LORA, A_HEADS, A_NOPE), KV_LORA ** -0.5),
        'w_uv': nrm(ks[13], (DEPTH, KV_LORA, A_HEADS, A_V), KV_LORA ** -0.5),
        'g_qn': gain(ks[14], A_QK),
        'g_kn': gain(ks[15], A_QK),
        'lb_logits': nrm(ks[16], (DEPTH + 1, B_FDIM), 0.5),
        'g_bn': gain(ks[17], B_DV),
        'w_oa': nrm(ks[18], (DEPTH, A_WIDTH, D_MODEL), A_WIDTH ** -0.5),
        'w_ob': nrm(ks[19], (DEPTH, B_WIDTH, D_MODEL), B_WIDTH ** -0.5),
        'w_o': nrm(ks[20], (DEPTH, D_MODEL, D_MODEL), D_MODEL ** -0.5),
    }


def reference(x_prompt, x_sample, cache_latent, cache_krope, state_hgrn, page_table, meta_tokens,
              norm_g, w_in, g_cq, w_uq, g_ckv, w_uk, w_uv, g_qn, g_kn, lb_logits, g_bn, w_oa, w_ob, w_o):
    f32 = jnp.float32
    lb_all = jnp.cumsum(jax.nn.softmax(lb_logits.astype(f32), axis=0), axis=0)
    b = x_prompt.shape[0]
    hp = jnp.concatenate([jnp.broadcast_to(meta_tokens[None].astype(x_prompt.dtype), (b, N_META, D_MODEL)), x_prompt], axis=1)
    hs = x_sample
    pos_p = jnp.arange(N_META + SEQ)
    pos_s = PAST_LEN + jnp.arange(DEC_SEQ)
    lat_p, kr_p, st_p, lat_s, kr_s, st_s = [], [], [], [], [], []
    for l in range(DEPTH):
        last = l == DEPTH - 1
        r0 = N_META if last else 0
        xn = rmsnorm(hp, norm_g[l])
        cq, ckv, kr, bq, bf, bi, ga, gb, ma, mb = jnp.split(xn @ w_in[l], SPLIT_IDX, axis=-1)
        ckv = rmsnorm(ckv, g_ckv[l])
        kr = rope(kr, pos_p)
        k = mla_keys(ckv, kr, w_uk[l], g_kn[l])
        v = jnp.einsum('bkc,chd->bkhd', ckv, w_uv[l])
        q = mla_queries(cq[:, r0:], pos_p[r0:], g_cq[l], w_uq[l], g_qn[l])
        oa = mla_prompt(q, k, v, not last)
        hq, hk, hv, hf = hgrn2_inputs(bq, bf, bi, lb_all[l])
        s0 = jnp.zeros((b, B_HEADS, B_DK, B_DV), f32)
        om, s_meta = hgrn2_chunked(hq[:, :N_META], hk[:, :N_META], hv[:, :N_META], hf[:, :N_META], s0, N_META)
        orl, s_fin = hgrn2_chunked(hq[:, N_META:], hk[:, N_META:], hv[:, N_META:], hf[:, N_META:], s_meta, CHUNK)
        ob = orl if last else jnp.concatenate([om, orl], axis=1)
        hp = merge(hp[:, r0:], oa, ob, ga[:, r0:], gb[:, r0:], ma[:, r0:], mb[:, r0:], g_bn[l], w_oa[l], w_ob[l], w_o[l])
        lat_p.append(ckv)
        kr_p.append(kr)
        st_p.append(s_fin.astype(state_hgrn.dtype))
        xn = rmsnorm(hs, norm_g[l])
        cq, ckv, kr, bq, bf, bi, ga, gb, ma, mb = jnp.split(xn @ w_in[l], SPLIT_IDX, axis=-1)
        ckv = rmsnorm(ckv, g_ckv[l])
        kr = rope(kr, pos_s)
        q = mla_queries(cq, pos_s, g_cq[l], w_uq[l], g_qn[l])
        oa = mla_sample(q, ckv, kr, cache_latent[l], cache_krope[l], page_table, w_uk[l], w_uv[l], g_kn[l])
        hq, hk, hv, hf = hgrn2_inputs(bq, bf, bi, lb_all[l])
        ob, s_new = hgrn2_chunked(hq, hk, hv, hf, state_hgrn[l].astype(f32), math.gcd(DEC_SEQ, CHUNK))
        hs = merge(hs, oa, ob, ga, gb, ma, mb, g_bn[l], w_oa[l], w_ob[l], w_o[l])
        lat_s.append(ckv)
        kr_s.append(kr)
        st_s.append(s_new.astype(state_hgrn.dtype))
    return (hp, hs, jnp.stack(lat_p), jnp.stack(kr_p), jnp.stack(st_p), jnp.stack(lat_s), jnp.stack(kr_s), jnp.stack(st_s))
```

```cpp
#include <hip/hip_runtime.h>
#include <stdint.h>

#define D_MODEL 1024
#define BATCH 8
#define SEQ 2048
#define NMETA 16
#define LTOT 2064
#define DEC_BATCH 32
#define PAST_LEN 16384
#define PAGE 128
#define NPAGES 128
#define A_HEADS 8
#define A_NOPE 64
#define A_ROPE 32
#define A_QK 96
#define A_V 64
#define Q_LORA 384
#define KV_LORA 256
#define B_HEADS 4
#define B_DK 128
#define B_DV 128
#define IN_COLS 5280
#define IN_COLS_PAD 5376
#define EPSF 1e-6f

#define C_CQ 0
#define C_CKV 384
#define C_KR 640
#define C_BQ 672
#define C_BF 1184
#define C_BI 1696
#define C_GA 2208
#define C_GB 2720
#define C_MA 3232
#define C_MB 4256
#define C_END 5280

#define R_PROMPT 16512
#define R_ALL 16544
#define R_PAD 16640
#define NQ 16384
#define MROWS 16416
#define MROWS_PAD 16512

#define OFF_Y_P 0
#define OFF_Y_S 16777216
#define OFF_LAT_P 16809984
#define OFF_KR_P 21037056
#define OFF_HG_P 21565440
#define OFF_LAT_S 22089728
#define OFF_KR_S 22097920
#define OFF_HG_S 22098944
#define OUT_TOTAL 24196096

#define NTHREADS 512
#define NCHUNK 33

typedef unsigned short bf16_t;
typedef short bf16x8 __attribute__((ext_vector_type(8)));
typedef float f32x4 __attribute__((ext_vector_type(4)));
typedef float f32x2 __attribute__((ext_vector_type(2)));
typedef unsigned u32x4 __attribute__((ext_vector_type(4)));
typedef unsigned u32x2 __attribute__((ext_vector_type(2)));
typedef __bf16 bf16x2_t __attribute__((ext_vector_type(2)));

__device__ __forceinline__ unsigned cvtpk(float lo, float hi) {
    f32x2 v = {lo, hi};
    bf16x2_t b = __builtin_convertvector(v, bf16x2_t);
    return __builtin_bit_cast(unsigned, b);
}
__device__ __forceinline__ bf16_t f2bf(float x) { return (bf16_t)(cvtpk(x, 0.f) & 0xffffu); }
__device__ __forceinline__ float bf2f(bf16_t u) { return __uint_as_float(((unsigned)u) << 16); }
__device__ __forceinline__ float bflo(unsigned w) { return __uint_as_float(w << 16); }
__device__ __forceinline__ float bfhi(unsigned w) { return __uint_as_float(w & 0xffff0000u); }
__device__ __forceinline__ float sigmoidf_(float x) { return 1.0f / (1.0f + __expf(-x)); }
__device__ __forceinline__ float siluf_(float x) { return x / (1.0f + __expf(-x)); }
__device__ __forceinline__ float wave_sum(float v) {
    v += __shfl_xor(v, 32); v += __shfl_xor(v, 16); v += __shfl_xor(v, 8);
    v += __shfl_xor(v, 4);  v += __shfl_xor(v, 2);  v += __shfl_xor(v, 1);
    return v;
}

struct Params {
    const float* x_prompt; const float* x_sample; const float* cache_latent; const float* cache_krope;
    const float* state_hgrn; const int* page_table; const float* meta; const float* norm_g;
    const float* w_in; const float* g_cq; const float* w_uq; const float* g_ckv; const float* w_uk; const float* w_uv;
    const float* g_qn; const float* g_kn; const float* lb_logits; const float* g_bn;
    const float* w_oa; const float* w_ob; const float* w_o;
    float* out;
    bf16_t* XN;
    bf16_t* WIN_T;
    bf16_t* PBUF;
    float*  F32A;
    float*  GLOG;
    bf16_t* CQN;
    bf16_t* CKVN;
    float*  KRR;
    bf16_t* WUQ_T;
    bf16_t* WUKV_T;
    bf16_t* WOA_T;
    bf16_t* WOB_T;
    bf16_t* WO_T;
    bf16_t* QRAW;
    bf16_t* KVRAW;
    bf16_t* QA;
    bf16_t* KA;
    float*  QS;
    float*  KSRAW;
    bf16_t* AM;
    bf16_t* MM;
    float*  UT;
    bf16_t* ST;
    float*  DEC;
    float*  LB;
    float*  INV;
    float*  SCAL;
    float*  PART;
    float*  PL;
    float*  OLAT;
    unsigned* bar;
};

__device__ __forceinline__ f32x4 mfma16(bf16x8 w, bf16x8 x, f32x4 acc) {
    return __builtin_amdgcn_mfma_f32_16x16x32_bf16(w, x, acc, 0, 0, 0);
}

#define GT_LD 144
#define GT_BUF (128 * GT_LD)
#define GT_LDS_BYTES (4 * GT_BUF)

__device__ __forceinline__ void gemm_tile_accum(f32x4 (&acc)[4][2], const bf16_t* __restrict__ X, int ldx, const bf16_t* __restrict__ W, int ldw,
                                                int K, char* lds) {
    const int tid = threadIdx.x, lane = tid & 63, wid = tid >> 6, wm = wid >> 2, wn = wid & 3;
    const int lr = lane & 15, lg = lane >> 4;
    const int r0 = tid >> 3, kc = tid & 7;
    const bf16_t* xp0 = X + (size_t)r0 * ldx + kc * 8;
    const bf16_t* xp1 = X + (size_t)(r0 + 64) * ldx + kc * 8;
    const bf16_t* wp0 = W + (size_t)r0 * ldw + kc * 8;
    const bf16_t* wp1 = W + (size_t)(r0 + 64) * ldw + kc * 8;
    const int so0 = r0 * GT_LD + kc * 16, so1 = (r0 + 64) * GT_LD + kc * 16;
    char* Xs = lds; char* Ws = lds + 2 * GT_BUF;
    const int nk = K >> 6;
    u32x4 a0 = *(const u32x4*)xp0, a1 = *(const u32x4*)xp1, b0 = *(const u32x4*)wp0, b1 = *(const u32x4*)wp1;
    *(u32x4*)(Xs + so0) = a0; *(u32x4*)(Xs + so1) = a1; *(u32x4*)(Ws + so0) = b0; *(u32x4*)(Ws + so1) = b1;
    __syncthreads();
    const int xoff = (wm * 64 + lr) * GT_LD + lg * 16;
    const int woff = (wn * 32 + lr) * GT_LD + lg * 16;
    for (int kt = 0; kt < nk; ++kt) {
        const int cur = kt & 1;
        if (kt + 1 < nk) {
            const int ko = (kt + 1) * 64;
            a0 = *(const u32x4*)(xp0 + ko); a1 = *(const u32x4*)(xp1 + ko); b0 = *(const u32x4*)(wp0 + ko); b1 = *(const u32x4*)(wp1 + ko);
        }
        const char* xs = Xs + cur * GT_BUF + xoff;
        const char* ws = Ws + cur * GT_BUF + woff;
#pragma unroll
        for (int ks = 0; ks < 2; ++ks) {
            bf16x8 xf[4], wf[2];
#pragma unroll
            for (int mt = 0; mt < 4; ++mt) xf[mt] = *(const bf16x8*)(xs + mt * 16 * GT_LD + ks * 64);
#pragma unroll
            for (int nt = 0; nt < 2; ++nt) wf[nt] = *(const bf16x8*)(ws + nt * 16 * GT_LD + ks * 64);
#pragma unroll
            for (int mt = 0; mt < 4; ++mt)
#pragma unroll
                for (int nt = 0; nt < 2; ++nt) acc[mt][nt] = mfma16(wf[nt], xf[mt], acc[mt][nt]);
        }
        if (kt + 1 < nk) {
            char* xd = Xs + (cur ^ 1) * GT_BUF; char* wd = Ws + (cur ^ 1) * GT_BUF;
            *(u32x4*)(xd + so0) = a0; *(u32x4*)(xd + so1) = a1; *(u32x4*)(wd + so0) = b0; *(u32x4*)(wd + so1) = b1;
        }
        __syncthreads();
    }
}

__device__ __forceinline__ void transpose_tile(const float* __restrict__ src, int src_ld, int nvalid, int k0, int n0,
                                               bf16_t* __restrict__ dst, int dst_ld, float* tile  ) {
    const int tid = threadIdx.x;
#pragma unroll
    for (int i = 0; i < 2; ++i) {
        const int kk = (tid >> 4) + 32 * i, nn = (tid & 15) * 4;
        f32x4 v = {0.f, 0.f, 0.f, 0.f};
        if (n0 + nn < nvalid) v = *(const f32x4*)(src + (size_t)(k0 + kk) * src_ld + n0 + nn);
        tile[kk * 65 + nn + 0] = v[0]; tile[kk * 65 + nn + 1] = v[1]; tile[kk * 65 + nn + 2] = v[2]; tile[kk * 65 + nn + 3] = v[3];
    }
    __syncthreads();
    {
        const int n = tid >> 3, kq = (tid & 7) * 8;
        u32x4 w;
        w[0] = cvtpk(tile[(kq + 0) * 65 + n], tile[(kq + 1) * 65 + n]);
        w[1] = cvtpk(tile[(kq + 2) * 65 + n], tile[(kq + 3) * 65 + n]);
        w[2] = cvtpk(tile[(kq + 4) * 65 + n], tile[(kq + 5) * 65 + n]);
        w[3] = cvtpk(tile[(kq + 6) * 65 + n], tile[(kq + 7) * 65 + n]);
        *(u32x4*)(dst + (size_t)(n0 + n) * dst_ld + k0 + kq) = w;
    }
    __syncthreads();
}

__device__ __forceinline__ void phase0(const Params& p, char* lds) {
    const int tid = threadIdx.x, lane = tid & 63, wid = tid >> 6;
    const int nb = gridDim.x, bid = blockIdx.x;
    {
        float* tile = (float*)lds;
        const int c0 = 16 * 84;
        const int c1 = c0 + 6 * 12;
        const int c2 = c1 + 4 * 8;
        const int c3 = c2 + 4 * 8;
        const int c4 = c3 + 8 * 16;
        const int c5 = c4 + 8 * 16;
        const int c6 = c5 + 16 * 16;
        for (int j = bid; j < c6; j += nb) {
            const float* src; int sld, nval, ntn, loc; bf16_t* dst; int dld;
            if (j < c0)      { loc = j;      src = p.w_in; sld = IN_COLS; nval = IN_COLS; ntn = 84; dst = p.WIN_T; dld = 1024; }
            else if (j < c1) { loc = j - c0; src = p.w_uq; sld = 768;  nval = 768;  ntn = 12; dst = p.WUQ_T; dld = 384; }
            else if (j < c2) { loc = j - c1; src = p.w_uk; sld = 512;  nval = 512;  ntn = 8;  dst = p.WUKV_T; dld = 256; }
            else if (j < c3) { loc = j - c2; src = p.w_uv; sld = 512;  nval = 512;  ntn = 8;  dst = p.WUKV_T + (size_t)512 * 256; dld = 256; }
            else if (j < c4) { loc = j - c3; src = p.w_oa; sld = 1024; nval = 1024; ntn = 16; dst = p.WOA_T; dld = 512; }
            else if (j < c5) { loc = j - c4; src = p.w_ob; sld = 1024; nval = 1024; ntn = 16; dst = p.WOB_T; dld = 512; }
            else             { loc = j - c5; src = p.w_o;  sld = 1024; nval = 1024; ntn = 16; dst = p.WO_T; dld = 1024; }
            const int kt = loc / ntn, nt = loc % ntn;
            transpose_tile(src, sld, nval, kt * 64, nt * 64, dst, dld, tile);
        }
    }
    for (int r = bid * 8 + wid; r < R_PAD; r += nb * 8) {
        bf16_t* dst = p.XN + (size_t)r * 1024;
        if (r >= R_ALL) {
#pragma unroll
            for (int i = 0; i < 4; ++i) *(u32x2*)(dst + lane * 4 + 256 * i) = (u32x2){0u, 0u};
            continue;
        }
        const float* src;
        if (r < R_PROMPT) { const int b = r / LTOT, t = r - b * LTOT; src = (t < NMETA) ? p.meta + (size_t)t * 1024 : p.x_prompt + ((size_t)b * SEQ + (t - NMETA)) * 1024; }
        else src = p.x_sample + (size_t)(r - R_PROMPT) * 1024;
        f32x4 v[4]; float ss = 0.f;
#pragma unroll
        for (int i = 0; i < 4; ++i) { v[i] = *(const f32x4*)(src + lane * 4 + 256 * i); ss += v[i][0] * v[i][0] + v[i][1] * v[i][1] + v[i][2] * v[i][2] + v[i][3] * v[i][3]; }
        ss = wave_sum(ss);
        const float rs = 1.0f / sqrtf(ss * (1.0f / 1024.0f) + EPSF);
#pragma unroll
        for (int i = 0; i < 4; ++i) {
            const f32x4 g = *(const f32x4*)(p.norm_g + lane * 4 + 256 * i);
            u32x2 w; w[0] = cvtpk(v[i][0] * rs * g[0], v[i][1] * rs * g[1]); w[1] = cvtpk(v[i][2] * rs * g[2], v[i][3] * rs * g[3]);
            *(u32x2*)(dst + lane * 4 + 256 * i) = w;
        }
    }
    if (bid == 0) {
        if (tid < 512) { const float l0 = p.lb_logits[tid], l1 = p.lb_logits[512 + tid]; p.LB[tid] = 1.0f / (1.0f + expf(l1 - l0)); }
        if (tid < 16) p.INV[tid] = (float)exp(-(double)tid / 16.0 * log(10000.0));
        if (wid == 0) {
            float gq = 0.f, gk = 0.f;
            for (int i = lane; i < A_QK; i += 64) { gq = fmaxf(gq, fabsf(p.g_qn[i])); gk = fmaxf(gk, fabsf(p.g_kn[i])); }
#pragma unroll
            for (int o = 32; o >= 1; o >>= 1) { gq = fmaxf(gq, __shfl_xor(gq, o)); gk = fmaxf(gk, __shfl_xor(gk, o)); }
            if (lane == 0) p.SCAL[0] = sqrtf((float)A_QK) * gq * gk;
        }
    }
    for (int i = bid * NTHREADS + tid; i < (MROWS_PAD - MROWS) * 1024 / 8; i += nb * NTHREADS) *(u32x4*)(p.AM + (size_t)MROWS * 1024 + (size_t)i * 8) = (u32x4){0u, 0u, 0u, 0u};
}

__device__ __forceinline__ void phase1(const Params& p, char* lds) {
    const int tid = threadIdx.x, lane = tid & 63, wid = tid >> 6, wm = wid >> 2, wn = wid & 3, lr = lane & 15, lg = lane >> 4;
    const int NT_M = R_PAD / 128, NT_N = IN_COLS_PAD / 128;
    for (int t = blockIdx.x; t < NT_M * NT_N; t += gridDim.x) {
        const int grp = t / (8 * NT_N), rem = t % (8 * NT_N);
        const int gsz = (NT_M - grp * 8) < 8 ? (NT_M - grp * 8) : 8;
        const int mt_ = grp * 8 + rem % gsz, nt_ = rem / gsz;
        const int m0 = mt_ * 128, n0 = nt_ * 128;
        f32x4 acc[4][2];
#pragma unroll
        for (int a = 0; a < 4; ++a)
#pragma unroll
            for (int b = 0; b < 2; ++b) acc[a][b] = (f32x4){0.f, 0.f, 0.f, 0.f};
        gemm_tile_accum(acc, p.XN + (size_t)m0 * 1024, 1024, p.WIN_T + (size_t)n0 * 1024, 1024, 1024, lds);
#pragma unroll
        for (int nt = 0; nt < 2; ++nt) {
            const int n = n0 + 32 * wn + 16 * nt + 4 * lg;
            const int nseg = n0 + 32 * wn + 16 * nt;
#pragma unroll
            for (int mt = 0; mt < 4; ++mt) {
                const int m = m0 + 64 * wm + 16 * mt + lr;
                const f32x4 v = acc[mt][nt];
                if (nseg < C_BQ) {
                    *(f32x4*)(p.F32A + (size_t)m * 672 + n) = v;
                } else if (nseg >= C_END) {
                } else {
                    f32x4 o;
                    if (nseg < C_BF) {
#pragma unroll
                        for (int e = 0; e < 4; ++e) o[e] = siluf_(v[e]);
                    } else if (nseg < C_BI) {
                        const int j = n - C_BF;
                        const f32x4 lb = *(const f32x4*)(p.LB + j);
                        f32x4 lg4;
#pragma unroll
                        for (int e = 0; e < 4; ++e) {
                            const float sg = 1.0f / (1.0f + expf(-v[e]));
                            const float f = lb[e] + (1.0f - lb[e]) * sg;
                            lg4[e] = logf(f);
                            o[e] = (1.0f - lb[e]) * (1.0f - sg);
                        }
                        *(f32x4*)(p.GLOG + (size_t)m * 512 + j) = lg4;
                    } else if (nseg < C_GA) {
                        o = v;
                    } else if (nseg < C_MA) {
#pragma unroll
                        for (int e = 0; e < 4; ++e) o[e] = siluf_(v[e]);
                    } else {
#pragma unroll
                        for (int e = 0; e < 4; ++e) o[e] = sigmoidf_(v[e]);
                    }
                    u32x2 w; w[0] = cvtpk(o[0], o[1]); w[1] = cvtpk(o[2], o[3]);
                    *(u32x2*)(p.PBUF + (size_t)m * IN_COLS_PAD + n) = w;
                }
            }
        }
    }
}

__device__ __forceinline__ void fin1_rows(const Params& p) {
    const int tid = threadIdx.x, lane = tid & 63, wid = tid >> 6;
    for (int r = blockIdx.x * 8 + wid; r < R_ALL; r += gridDim.x * 8) {
        const float* src = p.F32A + (size_t)r * 672;
        int pos; float* o_lat; float* o_kr;
        if (r < R_PROMPT) { const int t = r % LTOT; pos = t; o_lat = p.out + OFF_LAT_P + (size_t)r * 256; o_kr = p.out + OFF_KR_P + (size_t)r * 32; }
        else { const int i = r - R_PROMPT; pos = PAST_LEN; o_lat = p.out + OFF_LAT_S + (size_t)i * 256; o_kr = p.out + OFF_KR_S + (size_t)i * 32; }
        {
            f32x2 v[3]; float ss = 0.f;
#pragma unroll
            for (int i = 0; i < 3; ++i) { v[i] = *(const f32x2*)(src + C_CQ + lane * 2 + 128 * i); ss += v[i][0] * v[i][0] + v[i][1] * v[i][1]; }
            ss = wave_sum(ss);
            const float rs = 1.0f / sqrtf(ss * (1.0f / 384.0f) + EPSF);
#pragma unroll
            for (int i = 0; i < 3; ++i) {
                const f32x2 g = *(const f32x2*)(p.g_cq + lane * 2 + 128 * i);
                *(unsigned*)(p.CQN + (size_t)r * 384 + lane * 2 + 128 * i) = cvtpk(v[i][0] * rs * g[0], v[i][1] * rs * g[1]);
            }
        }
        {
            const f32x4 v = *(const f32x4*)(src + C_CKV + lane * 4);
            float ss = v[0] * v[0] + v[1] * v[1] + v[2] * v[2] + v[3] * v[3];
            ss = wave_sum(ss);
            const float rs = 1.0f / sqrtf(ss * (1.0f / 256.0f) + EPSF);
            const f32x4 g = *(const f32x4*)(p.g_ckv + lane * 4);
            f32x4 o; o[0] = v[0] * rs * g[0]; o[1] = v[1] * rs * g[1]; o[2] = v[2] * rs * g[2]; o[3] = v[3] * rs * g[3];
            *(f32x4*)(o_lat + lane * 4) = o;
            u32x2 w; w[0] = cvtpk(o[0], o[1]); w[1] = cvtpk(o[2], o[3]);
            *(u32x2*)(p.CKVN + (size_t)r * 256 + lane * 4) = w;
        }
        if (lane < 16) {
            const float x1 = src[C_KR + lane], x2 = src[C_KR + 16 + lane];
            const float ang = (float)pos * p.INV[lane];
            const float c = cosf(ang), s = sinf(ang);
            const float y1 = x1 * c - x2 * s, y2 = x1 * s + x2 * c;
            o_kr[lane] = y1; o_kr[16 + lane] = y2;
            p.KRR[(size_t)r * 32 + lane] = y1; p.KRR[(size_t)r * 32 + 16 + lane] = y2;
        }
    }
}

#define HA_LD 144
__device__ __forceinline__ void hgrn_passA(const Params& p, char* lds) {
    const int tid = threadIdx.x, lane = tid & 63, wid = tid >> 6, lr = lane & 15, lg = lane >> 4;
    float* cumL = (float*)lds;
    float* tot = (float*)(lds + 32768);
    char* KT = lds + 32768 + 2048;
    char* VT = KT + 128 * HA_LD;
    for (int u = blockIdx.x; u < BATCH * B_HEADS * NCHUNK; u += gridDim.x) {
        const int c = u % NCHUNK, bh = u / NCHUNK, h = bh % B_HEADS, b = bh / B_HEADS;
        const int nvalid = (c == 0) ? NMETA : 64;
        const int t0 = (c == 0) ? 0 : NMETA + 64 * (c - 1);
        const size_t rowbase = (size_t)b * LTOT + t0;
        const int d = tid & 127, part = tid >> 7;
        float run = 0.f;
#pragma unroll 4
        for (int i = 0; i < 16; ++i) {
            const int s = part * 16 + i;
            const float g = (s < nvalid) ? p.GLOG[(rowbase + s) * 512 + h * 128 + d] : 0.f;
            run += g; cumL[s * 128 + d] = run;
        }
        tot[part * 128 + d] = run;
        __syncthreads();
        {
            float off = 0.f, last = 0.f;
#pragma unroll
            for (int q = 0; q < 4; ++q) { const float tq = tot[q * 128 + d]; last += tq; if (q < part) off += tq; }
            if (part == 0) p.DEC[(size_t)u * 128 + d] = expf(last);
#pragma unroll 4
            for (int i = 0; i < 16; ++i) {
                const int s = part * 16 + i;
                const float cum = cumL[s * 128 + d] + off;
                const float kv = (s < nvalid) ? bf2f(p.PBUF[(rowbase + s) * IN_COLS_PAD + C_BF + h * 128 + d]) : 0.f;
                *(bf16_t*)(KT + d * HA_LD + s * 2) = f2bf(kv * expf(last - cum));
            }
#pragma unroll
            for (int i = 0; i < 2; ++i) {
                const int id = tid + 512 * i, s = id >> 4, vc = id & 15;
                u32x4 w = {0u, 0u, 0u, 0u};
                if (s < nvalid) w = *(const u32x4*)(p.PBUF + (rowbase + s) * IN_COLS_PAD + C_BI + h * 128 + vc * 8);
#pragma unroll
                for (int e = 0; e < 4; ++e) {
                    *(bf16_t*)(VT + (vc * 8 + 2 * e) * HA_LD + s * 2) = (bf16_t)(w[e] & 0xffffu);
                    *(bf16_t*)(VT + (vc * 8 + 2 * e + 1) * HA_LD + s * 2) = (bf16_t)(w[e] >> 16);
                }
            }
        }
        __syncthreads();
        {
            const char* xs = VT + (wid * 16 + lr) * HA_LD + lg * 16;
            bf16x8 xf0 = *(const bf16x8*)(xs), xf1 = *(const bf16x8*)(xs + 64);
            float* dst = p.UT + (size_t)u * 16384 + (size_t)(wid * 16 + lr) * 128;
#pragma unroll
            for (int nt = 0; nt < 8; ++nt) {
                const char* ws = KT + (nt * 16 + lr) * HA_LD + lg * 16;
                f32x4 acc = {0.f, 0.f, 0.f, 0.f};
                acc = mfma16(*(const bf16x8*)(ws), xf0, acc);
                acc = mfma16(*(const bf16x8*)(ws + 64), xf1, acc);
                *(f32x4*)(dst + nt * 16 + 4 * lg) = acc;
            }
        }
        __syncthreads();
    }
}

__device__ __forceinline__ void hgrn_sample_step(const Params& p, char* lds) {
    const int tid = threadIdx.x;
    float* part = (float*)lds;
    float* red = (float*)(lds + 8192);
    for (int u = blockIdx.x; u < DEC_BATCH * B_HEADS; u += gridDim.x) {
        const int i = u / B_HEADS, h = u % B_HEADS;
        const size_t r = R_PROMPT + i;
        const int v4 = (tid & 31) * 4, dp = tid >> 5;
        const float* S0 = p.state_hgrn + (size_t)u * 16384;
        float* S1 = p.out + OFF_HG_S + (size_t)u * 16384;
        const u32x2 vw = *(const u32x2*)(p.PBUF + r * IN_COLS_PAD + C_BI + h * 128 + v4);
        const float vv[4] = {bflo(vw[0]), bfhi(vw[0]), bflo(vw[1]), bfhi(vw[1])};
        float o[4] = {0.f, 0.f, 0.f, 0.f};
#pragma unroll
        for (int e = 0; e < 8; ++e) {
            const int d = dp * 8 + e;
            const float q = bf2f(p.PBUF[r * IN_COLS_PAD + C_BQ + h * 128 + d]);
            const float k = bf2f(p.PBUF[r * IN_COLS_PAD + C_BF + h * 128 + d]);
            const float f = expf(p.GLOG[r * 512 + h * 128 + d]);
            const f32x4 s0 = *(const f32x4*)(S0 + d * 128 + v4);
            f32x4 s1;
#pragma unroll
            for (int j = 0; j < 4; ++j) { s1[j] = f * s0[j] + k * vv[j]; o[j] += q * s1[j]; }
            *(f32x4*)(S1 + d * 128 + v4) = s1;
        }
#pragma unroll
        for (int j = 0; j < 4; ++j) part[dp * 128 + v4 + j] = o[j];
        __syncthreads();
        float osum = 0.f;
        if (tid < 128) {
#pragma unroll
            for (int q = 0; q < 16; ++q) osum += part[q * 128 + tid];
            float ss = wave_sum(osum * osum);
            if ((tid & 63) == 0) red[tid >> 6] = ss;
        }
        __syncthreads();
        if (tid < 128) {
            const float ss = red[0] + red[1];
            const float rs = 1.0f / sqrtf(ss * (1.0f / 128.0f) + EPSF);
            const float gb = bf2f(p.PBUF[r * IN_COLS_PAD + C_GB + h * 128 + tid]);
            p.AM[(size_t)(NQ + i) * 1024 + 512 + h * 128 + tid] = f2bf(osum * rs * p.g_bn[tid] * gb);
        }
        __syncthreads();
    }
}

__device__ __forceinline__ void phase2(const Params& p, char* lds) {
    fin1_rows(p);
    hgrn_sample_step(p, lds);
    hgrn_passA(p, lds);
}

__device__ __forceinline__ void hgrn_passB(const Params& p) {
    for (int g = blockIdx.x * NTHREADS + threadIdx.x; g < 32 * 128 * 32; g += gridDim.x * NTHREADS) {
        const int d4 = (g & 31) * 4, v = (g >> 5) & 127, bh = g >> 12;
        f32x4 S = {0.f, 0.f, 0.f, 0.f};
        for (int c = 0; c < NCHUNK; ++c) {
            const size_t u = (size_t)bh * NCHUNK + c;
            u32x2 w; w[0] = cvtpk(S[0], S[1]); w[1] = cvtpk(S[2], S[3]);
            *(u32x2*)(p.ST + u * 16384 + v * 128 + d4) = w;
            const f32x4 dec = *(const f32x4*)(p.DEC + u * 128 + d4);
            const f32x4 ut = *(const f32x4*)(p.UT + u * 16384 + v * 128 + d4);
#pragma unroll
            for (int j = 0; j < 4; ++j) S[j] = dec[j] * S[j] + ut[j];
        }
        float* o = p.out + OFF_HG_P + (size_t)bh * 16384;
#pragma unroll
        for (int j = 0; j < 4; ++j) o[(d4 + j) * 128 + v] = S[j];
    }
}

__device__ __forceinline__ void upproj_gemms(const Params& p, char* lds) {
    const int tid = threadIdx.x, lane = tid & 63, wid = tid >> 6, wm = wid >> 2, wn = wid & 3, lr = lane & 15, lg = lane >> 4;
    const int NT_M = R_PAD / 128;
    const int nq_tiles = NT_M * 6, nkv_tiles = NT_M * 8;
    for (int t = blockIdx.x; t < nq_tiles + nkv_tiles; t += gridDim.x) {
        const bool isq = t < nq_tiles;
        const int tt = isq ? t : t - nq_tiles;
        const int ntn = isq ? 6 : 8;
        const int m0 = (tt / ntn) * 128, n0 = (tt % ntn) * 128;
        const int K = isq ? 384 : 256;
        const bf16_t* X = isq ? p.CQN + (size_t)m0 * 384 : p.CKVN + (size_t)m0 * 256;
        const bf16_t* W = isq ? p.WUQ_T + (size_t)n0 * 384 : p.WUKV_T + (size_t)n0 * 256;
        bf16_t* O = isq ? p.QRAW : p.KVRAW;
        const int ldo = isq ? 768 : 1024;
        f32x4 acc[4][2];
#pragma unroll
        for (int a = 0; a < 4; ++a)
#pragma unroll
            for (int b = 0; b < 2; ++b) acc[a][b] = (f32x4){0.f, 0.f, 0.f, 0.f};
        gemm_tile_accum(acc, X, K, W, K, K, lds);
#pragma unroll
        for (int nt = 0; nt < 2; ++nt) {
            const int n = n0 + 32 * wn + 16 * nt + 4 * lg;
#pragma unroll
            for (int mt = 0; mt < 4; ++mt) {
                const int m = m0 + 64 * wm + 16 * mt + lr;
                const f32x4 v = acc[mt][nt];
                u32x2 w; w[0] = cvtpk(v[0], v[1]); w[1] = cvtpk(v[2], v[3]);
                *(u32x2*)(O + (size_t)m * ldo + n) = w;
            }
        }
    }
}

__device__ __forceinline__ void phase3(const Params& p, char* lds) {
    hgrn_passB(p);
    upproj_gemms(p, lds);
}

#define LOG2E 1.4426950408889634f
__device__ __forceinline__ void phase4(const Params& p, char* lds) {
    const int gtid = blockIdx.x * NTHREADS + threadIdx.x, gsz = gridDim.x * NTHREADS;
    const float qk_scale = 0.10206207261596577f;
    for (int idx = gtid; idx < MROWS * 8; idx += gsz) {
        const int qi = idx >> 3, h = idx & 7;
        size_t r; int pos;
        if (qi < NQ) { const int b = qi >> 11, tq = qi & 2047; r = (size_t)b * LTOT + NMETA + tq; pos = NMETA + tq; }
        else { r = R_PROMPT + (qi - NQ); pos = PAST_LEN; }
        float q[96];
        const bf16_t* src = p.QRAW + r * 768 + h * 96;
#pragma unroll
        for (int c = 0; c < 12; ++c) {
            const u32x4 w = *(const u32x4*)(src + c * 8);
#pragma unroll
            for (int e = 0; e < 4; ++e) { q[c * 8 + 2 * e] = bflo(w[e]); q[c * 8 + 2 * e + 1] = bfhi(w[e]); }
        }
#pragma unroll
        for (int i = 0; i < 16; ++i) {
            const float ang = (float)pos * p.INV[i];
            const float c = cosf(ang), s = sinf(ang);
            const float x1 = q[64 + i], x2 = q[80 + i];
            q[64 + i] = x1 * c - x2 * s; q[80 + i] = x1 * s + x2 * c;
        }
        float ss = 0.f;
#pragma unroll
        for (int d = 0; d < 96; ++d) ss += q[d] * q[d];
        const float rs = 1.0f / sqrtf(ss * (1.0f / 96.0f) + EPSF);
        if (qi < NQ) {
            const int b = qi >> 11, tq = qi & 2047;
            bf16_t* dst = p.QA + ((size_t)(b * 8 + h) * 2048 + tq) * 96;
            const float sc = rs * qk_scale * LOG2E;
#pragma unroll
            for (int c = 0; c < 12; ++c) {
                u32x4 w;
#pragma unroll
                for (int e = 0; e < 4; ++e) w[e] = cvtpk(q[c * 8 + 2 * e] * sc * p.g_qn[c * 8 + 2 * e], q[c * 8 + 2 * e + 1] * sc * p.g_qn[c * 8 + 2 * e + 1]);
                *(u32x4*)(dst + c * 8) = w;
            }
        } else {
            float* dst = p.QS + ((size_t)(qi - NQ) * 8 + h) * 96;
            const float sc = rs * qk_scale;
#pragma unroll
            for (int d = 0; d < 96; ++d) dst[d] = q[d] * sc * p.g_qn[d] * p.g_kn[d];
        }
    }
    for (int idx = gtid; idx < R_ALL * 8; idx += gsz) {
        const int r = idx >> 3, h = idx & 7;
        float k[96];
        const bf16_t* src = p.KVRAW + (size_t)r * 1024 + h * 64;
#pragma unroll
        for (int c = 0; c < 8; ++c) {
            const u32x4 w = *(const u32x4*)(src + c * 8);
#pragma unroll
            for (int e = 0; e < 4; ++e) { k[c * 8 + 2 * e] = bflo(w[e]); k[c * 8 + 2 * e + 1] = bfhi(w[e]); }
        }
        const float* kr = p.KRR + (size_t)r * 32;
#pragma unroll
        for (int c = 0; c < 8; ++c) { const f32x4 v = *(const f32x4*)(kr + c * 4); k[64 + c * 4] = v[0]; k[65 + c * 4] = v[1]; k[66 + c * 4] = v[2]; k[67 + c * 4] = v[3]; }
        if (r < R_PROMPT) {
            float ss = 0.f;
#pragma unroll
            for (int d = 0; d < 96; ++d) ss += k[d] * k[d];
            const float rs = 1.0f / sqrtf(ss * (1.0f / 96.0f) + EPSF);
            const int b = r / LTOT, t = r - b * LTOT;
            bf16_t* dst = p.KA + ((size_t)(b * 8 + h) * LTOT + t) * 96;
#pragma unroll
            for (int c = 0; c < 12; ++c) {
                u32x4 w;
#pragma unroll
                for (int e = 0; e < 4; ++e) w[e] = cvtpk(k[c * 8 + 2 * e] * rs * p.g_kn[c * 8 + 2 * e], k[c * 8 + 2 * e + 1] * rs * p.g_kn[c * 8 + 2 * e + 1]);
                *(u32x4*)(dst + c * 8) = w;
            }
        } else {
            float* dst = p.KSRAW + ((size_t)(r - R_PROMPT) * 8 + h) * 96;
#pragma unroll
            for (int d = 0; d < 96; ++d) dst[d] = k[d];
        }
    }
}

#define AK_LD 208
#define AV_LD 144
#define AP_LD 144
#define AK_BUF (64 * AK_LD)
#define AV_BUF (64 * AV_LD)
__device__ __forceinline__ void attn_unit(const Params& p, char* lds, int b, int h, int qb) {
    const int tid = threadIdx.x, lane = tid & 63, wid = tid >> 6, lr = lane & 15, lg = lane >> 4;
    char* Ks = lds;
    char* VTs = lds + 2 * AK_BUF;
    char* Ps = VTs + 2 * AV_BUF + wid * 16 * AP_LD;
    const int tq0 = qb * 128;
    const int ntile = 2 * qb + 3;
    const float Mb = p.SCAL[0] * LOG2E;
    const bf16_t* qsrc = p.QA + ((size_t)(b * 8 + h) * 2048 + tq0 + 16 * wid + lr) * 96 + lg * 8;
    bf16x8 qf[3];
#pragma unroll
    for (int ks = 0; ks < 3; ++ks) qf[ks] = *(const bf16x8*)(qsrc + ks * 32);
    const int qpos = NMETA + tq0 + 16 * wid + lr;
    const int wq_max = NMETA + tq0 + 16 * wid + 15;
    const bf16_t* kbase = p.KA + (size_t)(b * 8 + h) * LTOT * 96;
    const bf16_t* vbase = p.KVRAW + (size_t)b * LTOT * 1024 + 512 + h * 64;
    const int kkey0 = tid / 12, kpart0 = tid % 12;
    const int kkey1 = (512 + tid) / 12, kpart1 = (512 + tid) % 12;
    const int vkey = tid >> 3, vdc = tid & 7;
    u32x4 kr0, kr1 = {0u, 0u, 0u, 0u}, vr;
    auto load_tile = [&](int ti) {
        const int key0 = ti * 64;
        int ka = key0 + kkey0; ka = ka < LTOT ? ka : LTOT - 1;
        kr0 = *(const u32x4*)(kbase + (size_t)ka * 96 + kpart0 * 8);
        if (tid < 256) { int kb = key0 + kkey1; kb = kb < LTOT ? kb : LTOT - 1; kr1 = *(const u32x4*)(kbase + (size_t)kb * 96 + kpart1 * 8); }
        int kv = key0 + vkey; kv = kv < LTOT ? kv : LTOT - 1;
        vr = *(const u32x4*)(vbase + (size_t)kv * 1024 + vdc * 8);
    };
    auto store_tile = [&](int buf) {
        *(u32x4*)(Ks + buf * AK_BUF + kkey0 * AK_LD + kpart0 * 16) = kr0;
        if (tid < 256) *(u32x4*)(Ks + buf * AK_BUF + kkey1 * AK_LD + kpart1 * 16) = kr1;
        char* vt = VTs + buf * AV_BUF + vkey * 2;
#pragma unroll
        for (int e = 0; e < 4; ++e) {
            *(bf16_t*)(vt + (vdc * 8 + 2 * e) * AV_LD) = (bf16_t)(vr[e] & 0xffffu);
            *(bf16_t*)(vt + (vdc * 8 + 2 * e + 1) * AV_LD) = (bf16_t)(vr[e] >> 16);
        }
    };
    f32x4 o[4];
#pragma unroll
    for (int i = 0; i < 4; ++i) o[i] = (f32x4){0.f, 0.f, 0.f, 0.f};
    float lsum = 0.f;
    load_tile(0); store_tile(0);
    __syncthreads();
    for (int ti = 0; ti < ntile; ++ti) {
        const int cur = ti & 1;
        if (ti + 1 < ntile) load_tile(ti + 1);
        if (ti * 64 <= wq_max) {
            const char* kb_ = Ks + cur * AK_BUF + lr * AK_LD + lg * 16;
#pragma unroll
            for (int nt = 0; nt < 4; ++nt) {
                f32x4 s = {0.f, 0.f, 0.f, 0.f};
#pragma unroll
                for (int ks = 0; ks < 3; ++ks) s = mfma16(*(const bf16x8*)(kb_ + nt * 16 * AK_LD + ks * 64), qf[ks], s);
                const int key = ti * 64 + nt * 16 + 4 * lg;
                float pe[4];
#pragma unroll
                for (int j = 0; j < 4; ++j) { pe[j] = (key + j <= qpos) ? exp2f(s[j] - Mb) : 0.f; lsum += pe[j]; }
                u32x2 w; w[0] = cvtpk(pe[0], pe[1]); w[1] = cvtpk(pe[2], pe[3]);
                *(u32x2*)(Ps + lr * AP_LD + (nt * 16 + 4 * lg) * 2) = w;
            }
            asm volatile("s_waitcnt lgkmcnt(0)" ::: "memory");
            __builtin_amdgcn_wave_barrier();
            const bf16x8 pf0 = *(const bf16x8*)(Ps + lr * AP_LD + lg * 16);
            const bf16x8 pf1 = *(const bf16x8*)(Ps + lr * AP_LD + 64 + lg * 16);
            const char* vb_ = VTs + cur * AV_BUF + lr * AV_LD + lg * 16;
#pragma unroll
            for (int nt = 0; nt < 4; ++nt) {
                o[nt] = mfma16(*(const bf16x8*)(vb_ + nt * 16 * AV_LD), pf0, o[nt]);
                o[nt] = mfma16(*(const bf16x8*)(vb_ + nt * 16 * AV_LD + 64), pf1, o[nt]);
            }
            asm volatile("s_waitcnt lgkmcnt(0)" ::: "memory");
            __builtin_amdgcn_wave_barrier();
        }
        if (ti + 1 < ntile) store_tile(cur ^ 1);
        __syncthreads();
    }
    lsum += __shfl_xor(lsum, 16); lsum += __shfl_xor(lsum, 32);
    const float inv = 1.0f / lsum;
    const int tq = tq0 + 16 * wid + lr;
    const size_t r = (size_t)b * LTOT + NMETA + tq;
    const size_t mrow = (size_t)b * 2048 + tq;
#pragma unroll
    for (int nt = 0; nt < 4; ++nt) {
        const int dv = nt * 16 + 4 * lg;
        const u32x2 gw = *(const u32x2*)(p.PBUF + r * IN_COLS_PAD + C_GA + h * 64 + dv);
        u32x2 w; w[0] = cvtpk(o[nt][0] * inv * bflo(gw[0]), o[nt][1] * inv * bfhi(gw[0])); w[1] = cvtpk(o[nt][2] * inv * bflo(gw[1]), o[nt][3] * inv * bfhi(gw[1]));
        *(u32x2*)(p.AM + mrow * 1024 + h * 64 + dv) = w;
    }
}

__device__ __forceinline__ void attn_phase(const Params& p, char* lds) {
    for (int round = 0; round < 4; ++round) {
        const int i = blockIdx.x;
        if (i >= 256) break;
        const int k = (round & 1) ? (round * 256 + (255 - i)) : (round * 256 + i);
        const int qb = 15 - (k >> 6), bh = k & 63;
        attn_unit(p, lds, bh >> 3, bh & 7, qb);
    }
    if (gridDim.x < 256) {
    }
}

#define HC_LD 272
__device__ __forceinline__ void hgrn_passC(const Params& p, char* lds) {
    const int tid = threadIdx.x, lane = tid & 63, wid = tid >> 6, lr = lane & 15, lg = lane >> 4;
    float* cumL = (float*)lds;
    float* tot = (float*)(lds + 32768);
    char* QT = lds + 34816;
    char* KN = QT + 64 * HC_LD;
    char* QH = KN + 64 * HC_LD;
    char* VT = QH + 64 * HC_LD;
    char* AT = VT + 128 * HA_LD;
    char* STl = AT + 64 * HA_LD;
    for (int uu = blockIdx.x; uu < 32 * 32; uu += gridDim.x) {
        const int c = 1 + (uu & 31), bh = uu >> 5, h = bh & 3, b = bh >> 2;
        const size_t u = (size_t)bh * NCHUNK + c;
        const int t0 = NMETA + 64 * (c - 1);
        const size_t rowbase = (size_t)b * LTOT + t0;
        const int d = tid & 127, part = tid >> 7;
        float run = 0.f;
#pragma unroll 4
        for (int i = 0; i < 16; ++i) {
            const int s = part * 16 + i;
            run += p.GLOG[(rowbase + s) * 512 + h * 128 + d];
            cumL[s * 128 + d] = run;
        }
        tot[part * 128 + d] = run;
        __syncthreads();
        {
            float off = 0.f;
#pragma unroll
            for (int q = 0; q < 4; ++q) { const float tq = tot[q * 128 + d]; if (q < part) off += tq; }
            const float ref = tot[d] + tot[128 + d];
#pragma unroll 4
            for (int i = 0; i < 16; ++i) {
                const int s = part * 16 + i;
                const float cum = cumL[s * 128 + d] + off;
                const float qv = bf2f(p.PBUF[(rowbase + s) * IN_COLS_PAD + C_BQ + h * 128 + d]);
                const float kv = bf2f(p.PBUF[(rowbase + s) * IN_COLS_PAD + C_BF + h * 128 + d]);
                *(bf16_t*)(QT + s * HC_LD + d * 2) = f2bf(qv * expf(cum - ref));
                *(bf16_t*)(KN + s * HC_LD + d * 2) = f2bf(kv * expf(ref - cum));
                *(bf16_t*)(QH + s * HC_LD + d * 2) = f2bf(qv * expf(cum));
            }
#pragma unroll
            for (int i = 0; i < 2; ++i) {
                const int id = tid + 512 * i, s = id >> 4, vc = id & 15;
                const u32x4 w = *(const u32x4*)(p.PBUF + (rowbase + s) * IN_COLS_PAD + C_BI + h * 128 + vc * 8);
#pragma unroll
                for (int e = 0; e < 4; ++e) {
                    *(bf16_t*)(VT + (vc * 8 + 2 * e) * HA_LD + s * 2) = (bf16_t)(w[e] & 0xffffu);
                    *(bf16_t*)(VT + (vc * 8 + 2 * e + 1) * HA_LD + s * 2) = (bf16_t)(w[e] >> 16);
                }
            }
#pragma unroll
            for (int i = 0; i < 4; ++i) {
                const int id = tid + 512 * i, v = id >> 4, dc = id & 15;
                *(u32x4*)(STl + v * HC_LD + dc * 16) = *(const u32x4*)(p.ST + u * 16384 + v * 128 + dc * 8);
            }
        }
        __syncthreads();
        {
            const int mt = wid >> 1;
            const char* xs = QT + (mt * 16 + lr) * HC_LD + lg * 16;
            bf16x8 xf[4];
#pragma unroll
            for (int ks = 0; ks < 4; ++ks) xf[ks] = *(const bf16x8*)(xs + ks * 64);
#pragma unroll
            for (int q = 0; q < 2; ++q) {
                const int nt = 2 * (wid & 1) + q;
                const char* ws = KN + (nt * 16 + lr) * HC_LD + lg * 16;
                f32x4 a = {0.f, 0.f, 0.f, 0.f};
#pragma unroll
                for (int ks = 0; ks < 4; ++ks) a = mfma16(*(const bf16x8*)(ws + ks * 64), xf[ks], a);
                const int t = mt * 16 + lr, s0 = nt * 16 + 4 * lg;
                float m[4];
#pragma unroll
                for (int j = 0; j < 4; ++j) m[j] = (s0 + j <= t) ? a[j] : 0.f;
                u32x2 w; w[0] = cvtpk(m[0], m[1]); w[1] = cvtpk(m[2], m[3]);
                *(u32x2*)(AT + t * HA_LD + s0 * 2) = w;
            }
        }
        __syncthreads();
        {
            const int mt = wid >> 1;
            const char* xa = AT + (mt * 16 + lr) * HA_LD + lg * 16;
            const char* xq = QH + (mt * 16 + lr) * HC_LD + lg * 16;
            bf16x8 af[2], qf[4];
#pragma unroll
            for (int ks = 0; ks < 2; ++ks) af[ks] = *(const bf16x8*)(xa + ks * 64);
#pragma unroll
            for (int ks = 0; ks < 4; ++ks) qf[ks] = *(const bf16x8*)(xq + ks * 64);
#pragma unroll
            for (int q = 0; q < 4; ++q) {
                const int nt = 4 * (wid & 1) + q;
                const char* wv = VT + (nt * 16 + lr) * HA_LD + lg * 16;
                const char* wsx = STl + (nt * 16 + lr) * HC_LD + lg * 16;
                f32x4 a = {0.f, 0.f, 0.f, 0.f};
#pragma unroll
                for (int ks = 0; ks < 2; ++ks) a = mfma16(*(const bf16x8*)(wv + ks * 64), af[ks], a);
#pragma unroll
                for (int ks = 0; ks < 4; ++ks) a = mfma16(*(const bf16x8*)(wsx + ks * 64), qf[ks], a);
                *(f32x4*)(cumL + (mt * 16 + lr) * 128 + nt * 16 + 4 * lg) = a;
            }
        }
        __syncthreads();
        {
#pragma unroll
            for (int i = 0; i < 8; ++i) {
                const int t = wid * 8 + i;
                const f32x2 ov = *(const f32x2*)(cumL + t * 128 + 2 * lane);
                const float ss = wave_sum(ov[0] * ov[0] + ov[1] * ov[1]);
                const float rs = 1.0f / sqrtf(ss * (1.0f / 128.0f) + EPSF);
                const unsigned gw = *(const unsigned*)(p.PBUF + (rowbase + t) * IN_COLS_PAD + C_GB + h * 128 + 2 * lane);
                const f32x2 gbn = *(const f32x2*)(p.g_bn + 2 * lane);
                const size_t mrow = (size_t)b * 2048 + 64 * (c - 1) + t;
                *(unsigned*)(p.AM + mrow * 1024 + 512 + h * 128 + 2 * lane) = cvtpk(ov[0] * rs * gbn[0] * bflo(gw), ov[1] * rs * gbn[1] * bfhi(gw));
            }
        }
        __syncthreads();
    }
}

#define SC_LD 528
#define SP_LD 272
__device__ __forceinline__ void sample_attn(const Params& p, char* lds) {
    const int tid = threadIdx.x, lane = tid & 63, wid = tid >> 6, lr = lane & 15, lg = lane >> 4;
    char* Cs = lds;
    float* Rs = (float*)(lds + 128 * SC_LD);
    char* Pl = lds + 128 * SC_LD + 128 * 33 * 4;
    float* Qsl = (float*)(Pl + 16 * SP_LD);
    for (int blk = blockIdx.x; blk < DEC_BATCH * 8; blk += gridDim.x) {
        const int b = blk >> 3, split = blk & 7, h = wid;
        for (int i = tid; i < 16 * SP_LD / 4; i += NTHREADS) ((unsigned*)Pl)[i] = 0u;
        bf16x8 wf[4][8];
#pragma unroll
        for (int nt = 0; nt < 4; ++nt)
#pragma unroll
            for (int ks = 0; ks < 8; ++ks) wf[nt][ks] = *(const bf16x8*)(p.WUKV_T + (size_t)(64 * h + 16 * nt + lr) * 256 + 32 * ks + 8 * lg);
        for (int i = tid; i < 8 * 96; i += NTHREADS) Qsl[i] = p.QS[(size_t)b * 768 + i];
        const float* qsl = Qsl + h * 96;
        const float M = p.SCAL[0];
        f32x4 accl[2] = {{0.f, 0.f, 0.f, 0.f}, {0.f, 0.f, 0.f, 0.f}};
        float lacc = 0.f;
        __syncthreads();
        for (int pi = 0; pi < 16; ++pi) {
            const int pg = p.page_table[b * NPAGES + split * 16 + pi];
            const float* csrc = p.cache_latent + (size_t)pg * PAGE * KV_LORA;
            const float* rsrc = p.cache_krope + (size_t)pg * PAGE * A_ROPE;
#pragma unroll 2
            for (int it = 0; it < 16; ++it) {
                const int row = (tid >> 6) + 8 * it, c4 = (tid & 63) * 4;
                const f32x4 v = *(const f32x4*)(csrc + row * 256 + c4);
                u32x2 w; w[0] = cvtpk(v[0], v[1]); w[1] = cvtpk(v[2], v[3]);
                *(u32x2*)(Cs + row * SC_LD + c4 * 2) = w;
            }
#pragma unroll
            for (int it = 0; it < 8; ++it) { const int idx = tid + 512 * it; Rs[(idx >> 5) * 33 + (idx & 31)] = rsrc[idx]; }
            __syncthreads();
#pragma unroll 1
            for (int mt = 0; mt < 8; ++mt) {
                f32x4 a[4];
#pragma unroll
                for (int nt = 0; nt < 4; ++nt) a[nt] = (f32x4){0.f, 0.f, 0.f, 0.f};
                const char* xs = Cs + (16 * mt + lr) * SC_LD + lg * 16;
#pragma unroll
                for (int ks = 0; ks < 8; ++ks) {
                    const bf16x8 xf = *(const bf16x8*)(xs + ks * 64);
#pragma unroll
                    for (int nt = 0; nt < 4; ++nt) a[nt] = mfma16(wf[nt][ks], xf, a[nt]);
                }
                float ss = 0.f, sq = 0.f;
#pragma unroll
                for (int nt = 0; nt < 4; ++nt) {
                    const f32x4 qg = *(const f32x4*)(qsl + 16 * nt + 4 * lg);
#pragma unroll
                    for (int j = 0; j < 4; ++j) { ss += a[nt][j] * a[nt][j]; sq += a[nt][j] * qg[j]; }
                }
                const float* rr = Rs + (16 * mt + lr) * 33 + 8 * lg;
#pragma unroll
                for (int e = 0; e < 8; ++e) { const float rv = rr[e]; ss += rv * rv; sq += rv * qsl[64 + 8 * lg + e]; }
                ss += __shfl_xor(ss, 16); ss += __shfl_xor(ss, 32);
                sq += __shfl_xor(sq, 16); sq += __shfl_xor(sq, 32);
                const float s = sq / sqrtf(ss * (1.0f / 96.0f) + EPSF);
                const float pe = __expf(s - M);
                lacc += pe;
                if (lg == 0) *(bf16_t*)(Pl + h * SP_LD + (16 * mt + lr) * 2) = f2bf(pe);
            }
            __syncthreads();
            {
                const char* xp = Pl + lr * SP_LD + lg * 16;
#pragma unroll
                for (int q = 0; q < 2; ++q) {
                    const int n0 = 32 * wid + 16 * q;
#pragma unroll 1
                    for (int ks = 0; ks < 4; ++ks) {
                        const bf16x8 xf = *(const bf16x8*)(xp + ks * 64);
                        const char* cc = Cs + (32 * ks + 8 * lg) * SC_LD + (n0 + lr) * 2;
                        bf16x8 wfr;
#pragma unroll
                        for (int e = 0; e < 8; ++e) wfr[e] = (short)*(const bf16_t*)(cc + e * SC_LD);
                        accl[q] = mfma16(wfr, xf, accl[q]);
                    }
                }
            }
            __syncthreads();
        }
        if (lr < 8) {
#pragma unroll
            for (int q = 0; q < 2; ++q) *(f32x4*)(p.PART + ((size_t)(b * 8 + split) * 8 + lr) * 256 + 32 * wid + 16 * q + 4 * lg) = accl[q];
        }
        lacc += __shfl_xor(lacc, 8); lacc += __shfl_xor(lacc, 4); lacc += __shfl_xor(lacc, 2); lacc += __shfl_xor(lacc, 1);
        if (lane == 0) p.PL[(b * 8 + split) * 8 + h] = lacc;
        __syncthreads();
    }
}

__device__ __forceinline__ void phase5(const Params& p, char* lds) {
    sample_attn(p, lds);
    attn_phase(p, lds);
    hgrn_passC(p, lds);
}

__device__ __forceinline__ void sample_combine(const Params& p, char* lds) {
    const int tid = threadIdx.x;
    float* ol = (float*)lds;
    float* sc = (float*)(lds + 8192);
    for (int b = blockIdx.x; b < DEC_BATCH; b += gridDim.x) {
        if (tid < 8) {
            const int h = tid;
            const float* kraw = p.KSRAW + (size_t)(b * 8 + h) * 96;
            const float* qs = p.QS + (size_t)(b * 8 + h) * 96;
            float ss = 0.f, sq = 0.f;
            for (int d = 0; d < 96; ++d) { ss += kraw[d] * kraw[d]; sq += kraw[d] * qs[d]; }
            const float s = sq / sqrtf(ss * (1.0f / 96.0f) + EPSF);
            const float pn = __expf(s - p.SCAL[0]);
            float l = pn;
            for (int sp = 0; sp < 8; ++sp) l += p.PL[(b * 8 + sp) * 8 + h];
            sc[h] = pn; sc[8 + h] = 1.0f / l;
        }
        __syncthreads();
#pragma unroll
        for (int i = 0; i < 4; ++i) {
            const int id = tid + 512 * i, h = id >> 8, c = id & 255;
            float a = sc[h] * p.out[OFF_LAT_S + b * 256 + c];
            for (int sp = 0; sp < 8; ++sp) a += p.PART[((size_t)(b * 8 + sp) * 8 + h) * 256 + c];
            ol[h * 256 + c] = a * sc[8 + h];
        }
        __syncthreads();
        {
            const int h = tid >> 6, d = tid & 63;
            float a = 0.f;
            for (int c = 0; c < 256; ++c) a += ol[h * 256 + c] * p.w_uv[((size_t)c * 8 + h) * 64 + d];
            const float ga = bf2f(p.PBUF[(size_t)(R_PROMPT + b) * IN_COLS_PAD + C_GA + h * 64 + d]);
            p.AM[(size_t)(NQ + b) * 1024 + h * 64 + d] = f2bf(a * ga);
        }
        __syncthreads();
    }
}

__device__ __forceinline__ void merge_m_gemm(const Params& p, char* lds) {
    const int tid = threadIdx.x, lane = tid & 63, wid = tid >> 6, wm = wid >> 2, wn = wid & 3, lr = lane & 15, lg = lane >> 4;
    for (int t = blockIdx.x; t < 128 * 8; t += gridDim.x) {
        const int m0 = (t >> 3) * 128, n0 = (t & 7) * 128;
        f32x4 acc1[4][2], acc2[4][2];
#pragma unroll
        for (int a = 0; a < 4; ++a)
#pragma unroll
            for (int b = 0; b < 2; ++b) { acc1[a][b] = (f32x4){0.f, 0.f, 0.f, 0.f}; acc2[a][b] = (f32x4){0.f, 0.f, 0.f, 0.f}; }
        gemm_tile_accum(acc1, p.AM + (size_t)m0 * 1024, 1024, p.WOA_T + (size_t)n0 * 512, 512, 512, lds);
        gemm_tile_accum(acc2, p.AM + (size_t)m0 * 1024 + 512, 1024, p.WOB_T + (size_t)n0 * 512, 512, 512, lds);
#pragma unroll
        for (int nt = 0; nt < 2; ++nt) {
            const int n = n0 + 32 * wn + 16 * nt + 4 * lg;
#pragma unroll
            for (int mt = 0; mt < 4; ++mt) {
                const int m = m0 + 64 * wm + 16 * mt + lr;
                const size_t r = (size_t)(m >> 11) * LTOT + NMETA + (m & 2047);
                const u32x2 ga = *(const u32x2*)(p.PBUF + r * IN_COLS_PAD + C_MA + n);
                const u32x2 gb = *(const u32x2*)(p.PBUF + r * IN_COLS_PAD + C_MB + n);
                const f32x4 a = acc1[mt][nt], c = acc2[mt][nt];
                u32x2 w;
                w[0] = cvtpk(bflo(ga[0]) * a[0] + bflo(gb[0]) * c[0], bfhi(ga[0]) * a[1] + bfhi(gb[0]) * c[1]);
                w[1] = cvtpk(bflo(ga[1]) * a[2] + bflo(gb[1]) * c[2], bfhi(ga[1]) * a[3] + bfhi(gb[1]) * c[3]);
                *(u32x2*)(p.MM + (size_t)m * 1024 + n) = w;
            }
        }
    }
}

__device__ __forceinline__ void phase6(const Params& p, char* lds) {
    sample_combine(p, lds);
    merge_m_gemm(p, lds);
}

__device__ __forceinline__ float dot_bf16_row(const bf16_t* a, const bf16_t* w, int K) {
    float s = 0.f;
    for (int k = 0; k < K; k += 8) {
        const u32x4 x = *(const u32x4*)(a + k), y = *(const u32x4*)(w + k);
#pragma unroll
        for (int e = 0; e < 4; ++e) s += bflo(x[e]) * bflo(y[e]) + bfhi(x[e]) * bfhi(y[e]);
    }
    return s;
}
__device__ __forceinline__ void sample_m(const Params& p) {
    for (int idx = blockIdx.x * NTHREADS + threadIdx.x; idx < DEC_BATCH * 1024; idx += gridDim.x * NTHREADS) {
        const int i = idx & 31, n = idx >> 5;
        const bf16_t* a = p.AM + (size_t)(NQ + i) * 1024;
        const float ya = dot_bf16_row(a, p.WOA_T + (size_t)n * 512, 512);
        const float yb = dot_bf16_row(a + 512, p.WOB_T + (size_t)n * 512, 512);
        const size_t r = R_PROMPT + i;
        const float ga = bf2f(p.PBUF[r * IN_COLS_PAD + C_MA + n]), gb = bf2f(p.PBUF[r * IN_COLS_PAD + C_MB + n]);
        p.MM[(size_t)(NQ + i) * 1024 + n] = f2bf(ga * ya + gb * yb);
    }
}
__device__ __forceinline__ void final_gemm(const Params& p, char* lds) {
    const int tid = threadIdx.x, lane = tid & 63, wid = tid >> 6, wm = wid >> 2, wn = wid & 3, lr = lane & 15, lg = lane >> 4;
    for (int t = blockIdx.x; t < 128 * 8; t += gridDim.x) {
        const int m0 = (t >> 3) * 128, n0 = (t & 7) * 128;
        f32x4 acc[4][2];
#pragma unroll
        for (int a = 0; a < 4; ++a)
#pragma unroll
            for (int b = 0; b < 2; ++b) acc[a][b] = (f32x4){0.f, 0.f, 0.f, 0.f};
        gemm_tile_accum(acc, p.MM + (size_t)m0 * 1024, 1024, p.WO_T + (size_t)n0 * 1024, 1024, 1024, lds);
#pragma unroll
        for (int nt = 0; nt < 2; ++nt) {
            const int n = n0 + 32 * wn + 16 * nt + 4 * lg;
#pragma unroll
            for (int mt = 0; mt < 4; ++mt) {
                const int m = m0 + 64 * wm + 16 * mt + lr;
                const f32x4 x = *(const f32x4*)(p.x_prompt + (size_t)m * 1024 + n);
                *(f32x4*)(p.out + OFF_Y_P + (size_t)m * 1024 + n) = x + acc[mt][nt];
            }
        }
    }
}
__device__ __forceinline__ void phase7(const Params& p, char* lds) {
    sample_m(p);
    final_gemm(p, lds);
}
__device__ __forceinline__ void phase8(const Params& p, char* lds) {
    for (int idx = blockIdx.x * NTHREADS + threadIdx.x; idx < DEC_BATCH * 1024; idx += gridDim.x * NTHREADS) {
        const int i = idx & 31, n = idx >> 5;
        const float y = dot_bf16_row(p.MM + (size_t)(NQ + i) * 1024, p.WO_T + (size_t)n * 1024, 1024);
        p.out[OFF_Y_S + i * 1024 + n] = p.x_sample[i * 1024 + n] + y;
    }
}

#define LDS_BYTES 155648
extern __shared__ __attribute__((aligned(16))) char smem[];
#define NPHASES 9

__global__ void __launch_bounds__(NTHREADS) mega(Params p, int ph0, int ph1) {
#define RUN_PHASE(k) if (ph0 <= k && k < ph1) { phase##k(p, smem); }
    RUN_PHASE(0)
    RUN_PHASE(1)
    RUN_PHASE(2)
    RUN_PHASE(3)
    RUN_PHASE(4)
    RUN_PHASE(5)
    RUN_PHASE(6)
    RUN_PHASE(7)
    RUN_PHASE(8)
}

static inline size_t align_up(size_t x, size_t a) { return (x + a - 1) / a * a; }

extern "C" void kernel_launch(void* const* d_in, const int* in_sizes, int n_in,
                              void* d_out, int out_size, void* d_ws, size_t ws_size,
                              hipStream_t stream) {
    Params p{};
    p.x_prompt = (const float*)d_in[0]; p.x_sample = (const float*)d_in[1]; p.cache_latent = (const float*)d_in[2]; p.cache_krope = (const float*)d_in[3];
    p.state_hgrn = (const float*)d_in[4]; p.page_table = (const int*)d_in[5]; p.meta = (const float*)d_in[6]; p.norm_g = (const float*)d_in[7];
    p.w_in = (const float*)d_in[8]; p.g_cq = (const float*)d_in[9]; p.w_uq = (const float*)d_in[10]; p.g_ckv = (const float*)d_in[11];
    p.w_uk = (const float*)d_in[12]; p.w_uv = (const float*)d_in[13]; p.g_qn = (const float*)d_in[14]; p.g_kn = (const float*)d_in[15];
    p.lb_logits = (const float*)d_in[16]; p.g_bn = (const float*)d_in[17]; p.w_oa = (const float*)d_in[18]; p.w_ob = (const float*)d_in[19]; p.w_o = (const float*)d_in[20];
    p.out = (float*)d_out;
    char* w = (char*)d_ws; size_t off = 0;
    auto take = [&](size_t bytes) { char* r = w + off; off = align_up(off + bytes, 256); return r; };
    p.bar    = (unsigned*)take(16384);
    p.XN     = (bf16_t*)take((size_t)R_PAD * 1024 * 2);
    p.WIN_T  = (bf16_t*)take((size_t)IN_COLS_PAD * 1024 * 2);
    p.PBUF   = (bf16_t*)take((size_t)R_PAD * IN_COLS_PAD * 2);
    p.F32A   = (float*)take((size_t)R_PAD * 672 * 4);
    p.GLOG   = (float*)take((size_t)R_PAD * 512 * 4);
    p.CQN    = (bf16_t*)take((size_t)R_PAD * 384 * 2);
    p.CKVN   = (bf16_t*)take((size_t)R_PAD * 256 * 2);
    p.KRR    = (float*)take((size_t)R_PAD * 32 * 4);
    p.WUQ_T  = (bf16_t*)take((size_t)768 * 384 * 2);
    p.WUKV_T = (bf16_t*)take((size_t)1024 * 256 * 2);
    p.WOA_T  = (bf16_t*)take((size_t)1024 * 512 * 2);
    p.WOB_T  = (bf16_t*)take((size_t)1024 * 512 * 2);
    p.WO_T   = (bf16_t*)take((size_t)1024 * 1024 * 2);
    p.QRAW   = (bf16_t*)take((size_t)R_PAD * 768 * 2);
    p.KVRAW  = (bf16_t*)take((size_t)R_PAD * 1024 * 2);
    p.QA     = (bf16_t*)take((size_t)8 * 8 * 2048 * 96 * 2);
    p.KA     = (bf16_t*)take((size_t)8 * 8 * 2064 * 96 * 2 + 65536);
    p.QS     = (float*)take((size_t)32 * 8 * 96 * 4);
    p.KSRAW  = (float*)take((size_t)32 * 8 * 96 * 4);
    p.AM     = (bf16_t*)take((size_t)MROWS_PAD * 1024 * 2);
    p.MM     = (bf16_t*)take((size_t)MROWS_PAD * 1024 * 2);
    p.UT     = (float*)take((size_t)32 * NCHUNK * 16384 * 4);
    p.ST     = (bf16_t*)take((size_t)32 * NCHUNK * 16384 * 2);
    p.DEC    = (float*)take((size_t)32 * NCHUNK * 128 * 4);
    p.LB     = (float*)take(512 * 4);
    p.INV    = (float*)take(64);
    p.SCAL   = (float*)take(64);
    p.PART   = (float*)take((size_t)32 * 8 * 8 * 256 * 4);
    p.PL     = (float*)take((size_t)32 * 8 * 8 * 4);
    p.OLAT   = (float*)take((size_t)32 * 8 * 256 * 4);
    (void)ws_size; (void)in_sizes; (void)n_in; (void)out_size;
    static bool attr_set = false;
    if (!attr_set) { hipFuncSetAttribute((const void*)mega, hipFuncAttributeMaxDynamicSharedMemorySize, LDS_BYTES); attr_set = true; }
    const int NPH = NPHASES;
    for (int ph = 0; ph < NPH; ++ph) mega<<<dim3(256), dim3(NTHREADS), LDS_BYTES, stream>>>(p, ph, ph + 1);
}
```

```cpp
#include <hip/hip_runtime.h>
#include <stdint.h>

#define D_MODEL 1024
#define BATCH 8
#define SEQ 2048
#define NMETA 16
#define LTOT 2064
#define DEC_BATCH 32
#define PAST_LEN 16384
#define PAGE 128
#define NPAGES 128
#define A_HEADS 8
#define A_NOPE 64
#define A_ROPE 32
#define A_QK 96
#define A_V 64
#define Q_LORA 384
#define KV_LORA 256
#define B_HEADS 4
#define B_DK 128
#define B_DV 128
#define IN_COLS 5280
#define IN_COLS_PAD 5376
#define EPSF 1e-6f

#define C_CQ 0
#define C_CKV 384
#define C_KR 640
#define C_BQ 672
#define C_BF 1184
#define C_BI 1696
#define C_GA 2208
#define C_GB 2720
#define C_MA 3232
#define C_MB 4256
#define C_END 5280

#define R_PROMPT 16512
#define R_ALL 16544
#define R_PAD 16640
#define NQ 16384
#define MROWS 16416
#define MROWS_PAD 16512

#define OFF_Y_P 0
#define OFF_Y_S 16777216
#define OFF_LAT_P 16809984
#define OFF_KR_P 21037056
#define OFF_HG_P 21565440
#define OFF_LAT_S 22089728
#define OFF_KR_S 22097920
#define OFF_HG_S 22098944
#define OUT_TOTAL 24196096

#define NTHREADS 512
#define NCHUNK 33

typedef unsigned short bf16_t;
typedef short bf16x8 __attribute__((ext_vector_type(8)));
typedef float f32x4 __attribute__((ext_vector_type(4)));
typedef float f32x2 __attribute__((ext_vector_type(2)));
typedef unsigned u32x4 __attribute__((ext_vector_type(4)));
typedef unsigned u32x2 __attribute__((ext_vector_type(2)));
typedef __bf16 bf16x2_t __attribute__((ext_vector_type(2)));

__device__ __forceinline__ unsigned cvtpk(float lo, float hi) {
    f32x2 v = {lo, hi};
    bf16x2_t b = __builtin_convertvector(v, bf16x2_t);
    return __builtin_bit_cast(unsigned, b);
}
__device__ __forceinline__ bf16_t f2bf(float x) { return (bf16_t)(cvtpk(x, 0.f) & 0xffffu); }
__device__ __forceinline__ float bf2f(bf16_t u) { return __uint_as_float(((unsigned)u) << 16); }
__device__ __forceinline__ float bflo(unsigned w) { return __uint_as_float(w << 16); }
__device__ __forceinline__ float bfhi(unsigned w) { return __uint_as_float(w & 0xffff0000u); }
__device__ __forceinline__ float sigmoidf_(float x) { return 1.0f / (1.0f + __expf(-x)); }
__device__ __forceinline__ float siluf_(float x) { return x / (1.0f + __expf(-x)); }
__device__ __forceinline__ float wave_sum(float v) {
    v += __shfl_xor(v, 32); v += __shfl_xor(v, 16); v += __shfl_xor(v, 8);
    v += __shfl_xor(v, 4);  v += __shfl_xor(v, 2);  v += __shfl_xor(v, 1);
    return v;
}

struct Params {
    const float* x_prompt; const float* x_sample; const float* cache_latent; const float* cache_krope;
    const float* state_hgrn; const int* page_table; const float* meta; const float* norm_g;
    const float* w_in; const float* g_cq; const float* w_uq; const float* g_ckv; const float* w_uk; const float* w_uv;
    const float* g_qn; const float* g_kn; const float* lb_logits; const float* g_bn;
    const float* w_oa; const float* w_ob; const float* w_o;
    float* out;
    bf16_t* XN;
    bf16_t* WIN_T;
    bf16_t* PBUF;
    float*  F32A;
    float*  GLOG;
    bf16_t* CQN;
    bf16_t* CKVN;
    float*  KRR;
    bf16_t* WUQ_T;
    bf16_t* WUKV_T;
    bf16_t* WOA_T;
    bf16_t* WOB_T;
    bf16_t* WO_T;
    bf16_t* QRAW;
    bf16_t* KVRAW;
    bf16_t* QA;
    bf16_t* KA;
    float*  QS;
    float*  KSRAW;
    bf16_t* AMA;
    bf16_t* AMB;
    bf16_t* MM;
    float*  TMP;
    float*  UT;
    bf16_t* ST;
    float*  DEC;
    float*  LB;
    float*  INV;
    float*  SCAL;
    float*  PART;
    float*  PL;
    float*  OLAT;
    unsigned* bar;
};

__device__ __forceinline__ f32x4 mfma16(bf16x8 w, bf16x8 x, f32x4 acc) {
    return __builtin_amdgcn_mfma_f32_16x16x32_bf16(w, x, acc, 0, 0, 0);
}

#define GT_LD 144
#define GT_BUF (128 * GT_LD)
#define GT_LDS_BYTES (4 * GT_BUF)

__device__ __forceinline__ void gemm_tile_accum(f32x4 (&acc)[4][2], const bf16_t* __restrict__ X, int ldx, const bf16_t* __restrict__ W, int ldw,
                                                int K, char* lds) {
    const int tid = threadIdx.x, lane = tid & 63, wid = tid >> 6, wm = wid >> 2, wn = wid & 3;
    const int lr = lane & 15, lg = lane >> 4;
    const int r0 = tid >> 3, kc = tid & 7;
    const bf16_t* xp0 = X + (size_t)r0 * ldx + kc * 8;
    const bf16_t* xp1 = X + (size_t)(r0 + 64) * ldx + kc * 8;
    const bf16_t* wp0 = W + (size_t)r0 * ldw + kc * 8;
    const bf16_t* wp1 = W + (size_t)(r0 + 64) * ldw + kc * 8;
    const int so0 = r0 * GT_LD + kc * 16, so1 = (r0 + 64) * GT_LD + kc * 16;
    char* Xs = lds; char* Ws = lds + 2 * GT_BUF;
    const int nk = K >> 6;
    u32x4 a0 = *(const u32x4*)xp0, a1 = *(const u32x4*)xp1, b0 = *(const u32x4*)wp0, b1 = *(const u32x4*)wp1;
    *(u32x4*)(Xs + so0) = a0; *(u32x4*)(Xs + so1) = a1; *(u32x4*)(Ws + so0) = b0; *(u32x4*)(Ws + so1) = b1;
    __syncthreads();
    const int xoff = (wm * 64 + lr) * GT_LD + lg * 16;
    const int woff = (wn * 32 + lr) * GT_LD + lg * 16;
    for (int kt = 0; kt < nk; ++kt) {
        const int cur = kt & 1;
        if (kt + 1 < nk) {
            const int ko = (kt + 1) * 64;
            a0 = *(const u32x4*)(xp0 + ko); a1 = *(const u32x4*)(xp1 + ko); b0 = *(const u32x4*)(wp0 + ko); b1 = *(const u32x4*)(wp1 + ko);
        }
        const char* xs = Xs + cur * GT_BUF + xoff;
        const char* ws = Ws + cur * GT_BUF + woff;
#pragma unroll
        for (int ks = 0; ks < 2; ++ks) {
            bf16x8 xf[4], wf[2];
#pragma unroll
            for (int mt = 0; mt < 4; ++mt) xf[mt] = *(const bf16x8*)(xs + mt * 16 * GT_LD + ks * 64);
#pragma unroll
            for (int nt = 0; nt < 2; ++nt) wf[nt] = *(const bf16x8*)(ws + nt * 16 * GT_LD + ks * 64);
#pragma unroll
            for (int mt = 0; mt < 4; ++mt)
#pragma unroll
                for (int nt = 0; nt < 2; ++nt) acc[mt][nt] = mfma16(wf[nt], xf[mt], acc[mt][nt]);
        }
        if (kt + 1 < nk) {
            char* xd = Xs + (cur ^ 1) * GT_BUF; char* wd = Ws + (cur ^ 1) * GT_BUF;
            *(u32x4*)(xd + so0) = a0; *(u32x4*)(xd + so1) = a1; *(u32x4*)(wd + so0) = b0; *(u32x4*)(wd + so1) = b1;
        }
        __syncthreads();
    }
}

namespace pg8 {
#define PG8_LAS __attribute__((address_space(3)))
constexpr int BM = 256, BK = 64, HALF = 128, HTB = HALF * BK * 2  , STAGE_BYTES = 8 * HTB, NXCD = 8, WGM = 8;

__host__ __device__ __forceinline__ int lds_byte(int r, int c) { const int st = (r >> 4) * 2 + (c >> 5), rr = r & 15, cc = c & 31, ob = rr * 64 + cc * 2; return st * 1024 + (ob ^ (((ob >> 9) & 1) << 5)); }
__host__ __device__ __forceinline__ void stage_rc(int b, int& R, int& C) { const int st = b / 1024, sb = b % 1024, swz = sb ^ (((sb >> 9) & 1) << 5); R = (st >> 1) * 16 + swz / 64; C = (st & 1) * 32 + (swz % 64) / 2; }
__host__ __device__ __forceinline__ int perm32(int rho) { const int n = rho >> 4, i = rho & 15; return 8 * (i >> 2) + 4 * n + (i & 3); }

struct Unit { int pm, pn, sel; };
struct Gemm { const bf16_t* A; const bf16_t* Bt; int M, N, K; const bf16_t* A1; const bf16_t* Bt1; };

struct StaticOrder {
    int nM, nN, nwg, G, c;
    __host__ __device__ void init(int M, int N, int G_, int c_) { nM = M / BM; nN = N / BM; nwg = nM * nN; G = G_; c = c_; }
    __host__ __device__ bool next(int i, Unit& u) const {
        const long L = (long)i * G + c; if (L >= nwg) return false;
        int wgid = (int)L; { const int q = nwg / NXCD, r = nwg % NXCD, xcd = wgid % NXCD, off = wgid / NXCD; wgid = (xcd < r ? xcd * (q + 1) : r * (q + 1) + (xcd - r) * q) + off; }
        const int nig = WGM * nN, gid = wgid / nig, fm = gid * WGM, gsz = (nM - fm) < WGM ? (nM - fm) : WGM;
        u.pm = fm + ((wgid % nig) % gsz); u.pn = (wgid % nig) / gsz; u.sel = 0; return true;
    }
    __device__ __forceinline__ void a_ready(const Unit&) const {}
    __device__ __forceinline__ void done(const Unit&) const {}
};


template <class Epi, class Sched, bool ALIGN_EPI = false, bool SP2 = false>
__device__ __forceinline__ void gemm_phase(PG8_LAS unsigned char* lds, const Gemm g, const Sched& S, const Epi& E) {
    const int tid = threadIdx.x, wid = __builtin_amdgcn_readfirstlane(tid >> 6), lane = tid & 63, wr = wid >> 2, wc = wid & 3, fr = lane & 15, fq = lane >> 4;
    const int K = g.K, nt = K / BK;
    unsigned voffA[2], voffB[2];
#pragma unroll
    for (int i = 0; i < 2; ++i) { int R, C; stage_rc(tid * 16 + i * 8192, R, C); const int Rb = Epi::PERM ? ((R & ~31) + perm32(R & 31)) : R;
        voffA[i] = (unsigned)(R * K + C) * 2u; voffB[i] = (unsigned)(Rb * K + C) * 2u; }
    const size_t kstep = (size_t)(BK * 2);
    const size_t hstep = (size_t)HALF * K * 2;
    const size_t tstep = 2 * hstep;
    const unsigned ldsw = (unsigned)wid * 1024u;
    const int aoff = lds_byte(wr * 64 + fr, fq * 8), boff = lds_byte(wc * 32 + fr, fq * 8);
#define PG8_SA(b, h) (((b) * 2 + (h)) * HTB)
#define PG8_SB(b, h) ((4 + (b) * 2 + (h)) * HTB)
#define PG8_STAGE(bufoff, gbase, voff) do { _Pragma("unroll") for (int _i = 0; _i < 2; ++_i) \
        __builtin_amdgcn_global_load_lds((const unsigned*)((const char*)(gbase) + (voff)[_i]), (PG8_LAS unsigned*)(lds + (bufoff) + ldsw + _i * 8192), 16, 0, 0); } while (0)
#define PG8_LDA(dst, b, h) do { _Pragma("unroll") for (int m = 0; m < 4; ++m) _Pragma("unroll") for (int k = 0; k < 2; ++k) dst[m][k] = *(const PG8_LAS bf16x8*)(lds + PG8_SA(b, h) + aoff + m * 2048 + k * 1024); } while (0)
#define PG8_LDB(dst, b, h) do { _Pragma("unroll") for (int n = 0; n < 2; ++n) _Pragma("unroll") for (int k = 0; k < 2; ++k) dst[n][k] = *(const PG8_LAS bf16x8*)(lds + PG8_SB(b, h) + boff + n * 2048 + k * 1024); } while (0)
#define PG8_MMA(ai, bj, At, Bt) do { __builtin_amdgcn_s_setprio(1); _Pragma("unroll") for (int m = 0; m < 4; ++m) _Pragma("unroll") for (int n = 0; n < 2; ++n) _Pragma("unroll") for (int k = 0; k < 2; ++k) \
        acc[ai][bj][m][n] = __builtin_amdgcn_mfma_f32_16x16x32_bf16(Bt[n][k], At[m][k], acc[ai][bj][m][n], 0, 0, 0); __builtin_amdgcn_s_setprio(0); } while (0)
#define PG8_WAIT_V(n) asm volatile("s_waitcnt vmcnt(" #n ")" ::: "memory")
#define PG8_WAIT_L(n) asm volatile("s_waitcnt lgkmcnt(" #n ")" ::: "memory")
#define PG8_BAR __builtin_amdgcn_s_barrier()
#define PG8_SCHED __builtin_amdgcn_sched_barrier(0)
    Unit cur, nxt; int ui = 0;
    if (!S.next(0, cur)) return;
    f32x4 acc[2][2][4][2];
#pragma unroll
    for (int a = 0; a < 2; ++a)
#pragma unroll
        for (int b = 0; b < 2; ++b)
#pragma unroll
            for (int m = 0; m < 4; ++m)
#pragma unroll
                for (int n = 0; n < 2; ++n) acc[a][b][m][n] = (f32x4){0.f, 0.f, 0.f, 0.f};
    bf16x8 At[4][2], B0[2][2], B1[2][2];
    const char* cA = (const char*)(cur.sel ? g.A1 : g.A) + (size_t)cur.pm * tstep; const char* cB = (const char*)(cur.sel ? g.Bt1 : g.Bt) + (size_t)cur.pn * tstep;
    S.a_ready(cur);
    if constexpr (SP2) {
        PG8_STAGE(PG8_SB(0, 0), cB, voffB); PG8_STAGE(PG8_SB(0, 1), cB + hstep, voffB); PG8_STAGE(PG8_SA(0, 0), cA, voffA); PG8_STAGE(PG8_SA(0, 1), cA + hstep, voffA);
        if (wr == 1) PG8_BAR;
        PG8_WAIT_V(2); PG8_BAR;
        PG8_STAGE(PG8_SB(1, 0), cB + kstep, voffB); PG8_STAGE(PG8_SA(1, 0), cA + kstep, voffA); PG8_STAGE(PG8_SB(1, 1), cB + hstep + kstep, voffB);
        PG8_WAIT_V(6); PG8_BAR;
    } else {
        PG8_STAGE(PG8_SB(0, 0), cB, voffB); PG8_STAGE(PG8_SA(0, 0), cA, voffA); PG8_STAGE(PG8_SB(0, 1), cB + hstep, voffB); PG8_STAGE(PG8_SA(0, 1), cA + hstep, voffA);
        if (wr == 1) PG8_BAR;
        PG8_WAIT_V(4); PG8_BAR;
        PG8_STAGE(PG8_SB(1, 0), cB + kstep, voffB); PG8_STAGE(PG8_SA(1, 0), cA + kstep, voffA); PG8_STAGE(PG8_SB(1, 1), cB + hstep + kstep, voffB);
        PG8_WAIT_V(6); PG8_BAR;
    }
    for (;;) {
        const bool has_next = S.next(ui + 1, nxt);
        const char* nA = has_next ? (const char*)(nxt.sel ? g.A1 : g.A) + (size_t)nxt.pm * tstep : cA; const char* nB = has_next ? (const char*)(nxt.sel ? g.Bt1 : g.Bt) + (size_t)nxt.pn * tstep : cB;
        for (int t = 0; t < nt; t += 2) {
            const bool last = (t == nt - 2);
            const char* a1 = cA + (size_t)(t + 1) * kstep;
            const char* a2 = last ? nA : cA + (size_t)(t + 2) * kstep; const char* b2 = last ? nB : cB + (size_t)(t + 2) * kstep;
            const char* a3 = a2 + kstep; const char* b3 = b2 + kstep;
            if (last && has_next) S.a_ready(nxt);
            if constexpr (SP2) {
            PG8_LDB(B0, 0, 0); PG8_LDB(B1, 0, 1); PG8_SCHED; PG8_LDA(At, 0, 0); PG8_STAGE(PG8_SA(1, 1), a1 + hstep, voffA);
            PG8_WAIT_V(8); PG8_WAIT_L(0); PG8_BAR; PG8_MMA(0, 0, At, B0); PG8_MMA(0, 1, At, B1); PG8_BAR; PG8_SCHED;
            PG8_LDA(At, 0, 1); PG8_STAGE(PG8_SB(0, 0), b2, voffB); PG8_STAGE(PG8_SB(0, 1), b2 + hstep, voffB); PG8_STAGE(PG8_SA(0, 0), a2, voffA);
            PG8_WAIT_V(8); PG8_WAIT_L(0); PG8_BAR; PG8_MMA(1, 0, At, B0); PG8_MMA(1, 1, At, B1); PG8_BAR; PG8_SCHED;
            PG8_LDB(B0, 1, 0); PG8_LDB(B1, 1, 1); PG8_SCHED; PG8_LDA(At, 1, 0); PG8_STAGE(PG8_SA(0, 1), a2 + hstep, voffA);
            PG8_WAIT_V(8); PG8_WAIT_L(0); PG8_BAR; PG8_MMA(0, 0, At, B0); PG8_MMA(0, 1, At, B1); PG8_BAR; PG8_SCHED;
            PG8_LDA(At, 1, 1); PG8_STAGE(PG8_SB(1, 0), b3, voffB); PG8_STAGE(PG8_SB(1, 1), b3 + hstep, voffB); PG8_STAGE(PG8_SA(1, 0), a3, voffA);
            PG8_WAIT_V(8); PG8_WAIT_L(0); PG8_BAR; PG8_MMA(1, 0, At, B0); PG8_MMA(1, 1, At, B1); PG8_BAR; PG8_SCHED;
            } else {
            PG8_LDB(B0, 0, 0); PG8_SCHED; PG8_LDA(At, 0, 0); PG8_STAGE(PG8_SA(1, 1), a1 + hstep, voffA);
            PG8_WAIT_L(8); PG8_BAR; PG8_WAIT_L(0); PG8_MMA(0, 0, At, B0); PG8_BAR; PG8_SCHED;
            PG8_LDB(B1, 0, 1); PG8_STAGE(PG8_SB(0, 0), b2, voffB);
            PG8_BAR; PG8_WAIT_L(0); PG8_MMA(0, 1, At, B1); PG8_BAR;
            PG8_LDA(At, 0, 1); PG8_STAGE(PG8_SA(0, 0), a2, voffA);
            PG8_BAR; PG8_WAIT_L(0); PG8_MMA(1, 0, At, B0); PG8_BAR; PG8_SCHED;
            PG8_STAGE(PG8_SB(0, 1), b2 + hstep, voffB);
            PG8_WAIT_V(6); PG8_BAR; PG8_MMA(1, 1, At, B1); PG8_BAR;
            PG8_LDB(B0, 1, 0); PG8_SCHED; PG8_LDA(At, 1, 0); PG8_STAGE(PG8_SA(0, 1), a2 + hstep, voffA);
            PG8_WAIT_L(8); PG8_BAR; PG8_WAIT_L(0); PG8_MMA(0, 0, At, B0); PG8_BAR; PG8_SCHED;
            PG8_LDB(B1, 1, 1); PG8_STAGE(PG8_SB(1, 0), b3, voffB);
            PG8_BAR; PG8_WAIT_L(0); PG8_MMA(0, 1, At, B1); PG8_BAR;
            PG8_LDA(At, 1, 1); PG8_STAGE(PG8_SA(1, 0), a3, voffA);
            PG8_BAR; PG8_WAIT_L(0); PG8_MMA(1, 0, At, B0); PG8_BAR; PG8_SCHED;
            PG8_STAGE(PG8_SB(1, 1), b3 + hstep, voffB);
            PG8_WAIT_V(6); PG8_BAR; PG8_MMA(1, 1, At, B1); PG8_BAR;
            }
        }
        if constexpr (ALIGN_EPI) { if (wr == 0) PG8_BAR; }
        if constexpr (!Epi::AFTER_DRAIN) { E(acc, cur, wr, wc, fr, fq); S.done(cur); }
        if (!has_next) break;
        if (!Epi::keep(cur)) {
#pragma unroll
        for (int a = 0; a < 2; ++a)
#pragma unroll
            for (int b = 0; b < 2; ++b)
#pragma unroll
                for (int m = 0; m < 4; ++m)
#pragma unroll
                    for (int n = 0; n < 2; ++n) acc[a][b][m][n] = (f32x4){0.f, 0.f, 0.f, 0.f};
        }
        cur = nxt; cA = nA; cB = nB; ++ui;
        if constexpr (ALIGN_EPI) { if (wr == 1) PG8_BAR; }
    }
    PG8_WAIT_V(0);
    if constexpr (!ALIGN_EPI) { if (wr == 0) PG8_BAR; }
    PG8_BAR;
    if constexpr (Epi::AFTER_DRAIN) { E.fused(acc, cur, wr, wc, fr, fq, lds, wid, lane); S.done(cur); }
#undef PG8_SA
#undef PG8_SB
#undef PG8_STAGE
#undef PG8_LDA
#undef PG8_LDB
#undef PG8_MMA
#undef PG8_WAIT_V
#undef PG8_WAIT_L
#undef PG8_BAR
#undef PG8_SCHED
}
}

struct EpiInProj {
    static constexpr bool PERM = true, AFTER_DRAIN = false;
    static __device__ __forceinline__ bool keep(const pg8::Unit&) { return false; }
    float* F32A; float* GLOG; bf16_t* PBUF; const float* LB;
    __device__ __forceinline__ void operator()(f32x4 (&acc)[2][2][4][2], const pg8::Unit& u, int wr, int wc, int fr, int fq) const {
#pragma unroll
        for (int bj = 0; bj < 2; ++bj) {
            const int nseg = u.pn * 256 + bj * 128 + wc * 32;
            if (nseg >= C_END) continue;
            const int c = nseg + 8 * fq;
            f32x4 lb0 = {0.f, 0.f, 0.f, 0.f}, lb1 = {0.f, 0.f, 0.f, 0.f};
            if (nseg >= C_BF && nseg < C_BI) { lb0 = *(const f32x4*)(LB + (c - C_BF)); lb1 = *(const f32x4*)(LB + (c - C_BF) + 4); }
#pragma unroll
            for (int ai = 0; ai < 2; ++ai)
#pragma unroll
                for (int m = 0; m < 4; ++m) {
                    const size_t r = (size_t)u.pm * 256 + ai * 128 + wr * 64 + m * 16 + fr;
                    const f32x4 v0 = acc[ai][bj][m][0], v1 = acc[ai][bj][m][1];
                    if (nseg < C_BQ) { *(f32x4*)(F32A + r * 672 + c) = v0; *(f32x4*)(F32A + r * 672 + c + 4) = v1; continue; }
                    f32x4 o0, o1;
                    if (nseg < C_BF) {
#pragma unroll
                        for (int e = 0; e < 4; ++e) { o0[e] = siluf_(v0[e]); o1[e] = siluf_(v1[e]); }
                    } else if (nseg < C_BI) {
                        f32x4 l0, l1;
#pragma unroll
                        for (int e = 0; e < 4; ++e) {
                            const float sg0 = 1.0f / (1.0f + expf(-v0[e])), sg1 = 1.0f / (1.0f + expf(-v1[e]));
                            l0[e] = logf(lb0[e] + (1.0f - lb0[e]) * sg0); l1[e] = logf(lb1[e] + (1.0f - lb1[e]) * sg1);
                            o0[e] = (1.0f - lb0[e]) * (1.0f - sg0); o1[e] = (1.0f - lb1[e]) * (1.0f - sg1);
                        }
                        *(f32x4*)(GLOG + r * 512 + (c - C_BF)) = l0; *(f32x4*)(GLOG + r * 512 + (c - C_BF) + 4) = l1;
                    } else if (nseg < C_GA) {
                        o0 = v0; o1 = v1;
                    } else if (nseg < C_MA) {
#pragma unroll
                        for (int e = 0; e < 4; ++e) { o0[e] = siluf_(v0[e]); o1[e] = siluf_(v1[e]); }
                    } else {
#pragma unroll
                        for (int e = 0; e < 4; ++e) { o0[e] = sigmoidf_(v0[e]); o1[e] = sigmoidf_(v1[e]); }
                    }
                    u32x4 w; w[0] = cvtpk(o0[0], o0[1]); w[1] = cvtpk(o0[2], o0[3]); w[2] = cvtpk(o1[0], o1[1]); w[3] = cvtpk(o1[2], o1[3]);
                    *(u32x4*)(PBUF + r * IN_COLS_PAD + c) = w;
                }
        }
    }
};
template <int STAGE> struct EpiMerge {
    static constexpr bool PERM = true, AFTER_DRAIN = false;
    static __device__ __forceinline__ bool keep(const pg8::Unit&) { return false; }
    const bf16_t* PBUF; float* TMP; bf16_t* MM;
    __device__ __forceinline__ void operator()(f32x4 (&acc)[2][2][4][2], const pg8::Unit& u, int wr, int wc, int fr, int fq) const {
#pragma unroll
        for (int ai = 0; ai < 2; ++ai)
#pragma unroll
            for (int m = 0; m < 4; ++m) {
                const int mq = u.pm * 256 + ai * 128 + wr * 64 + m * 16 + fr;
                const size_t r = (size_t)(mq >> 11) * LTOT + NMETA + (mq & 2047);
#pragma unroll
                for (int bj = 0; bj < 2; ++bj) {
                    const int c = u.pn * 256 + bj * 128 + wc * 32 + 8 * fq;
                    const u32x4 g = *(const u32x4*)(PBUF + r * IN_COLS_PAD + (STAGE == 0 ? C_MA : C_MB) + c);
                    const f32x4 v0 = acc[ai][bj][m][0], v1 = acc[ai][bj][m][1];
                    f32x4 o0, o1;
                    o0[0] = v0[0] * bflo(g[0]); o0[1] = v0[1] * bfhi(g[0]); o0[2] = v0[2] * bflo(g[1]); o0[3] = v0[3] * bfhi(g[1]);
                    o1[0] = v1[0] * bflo(g[2]); o1[1] = v1[1] * bfhi(g[2]); o1[2] = v1[2] * bflo(g[3]); o1[3] = v1[3] * bfhi(g[3]);
                    if (STAGE == 0) { *(f32x4*)(TMP + (size_t)mq * 1024 + c) = o0; *(f32x4*)(TMP + (size_t)mq * 1024 + c + 4) = o1; }
                    else {
                        const f32x4 t0 = *(const f32x4*)(TMP + (size_t)mq * 1024 + c), t1 = *(const f32x4*)(TMP + (size_t)mq * 1024 + c + 4);
                        u32x4 w; w[0] = cvtpk(o0[0] + t0[0], o0[1] + t0[1]); w[1] = cvtpk(o0[2] + t0[2], o0[3] + t0[3]);
                        w[2] = cvtpk(o1[0] + t1[0], o1[1] + t1[1]); w[3] = cvtpk(o1[2] + t1[2], o1[3] + t1[3]);
                        *(u32x4*)(MM + (size_t)mq * 1024 + c) = w;
                    }
                }
                asm volatile("" ::: "memory");
            }
    }
};
struct EpiFinal {
    static constexpr bool PERM = true, AFTER_DRAIN = false;
    static __device__ __forceinline__ bool keep(const pg8::Unit&) { return false; }
    const float* X; float* Y;
    __device__ __forceinline__ void operator()(f32x4 (&acc)[2][2][4][2], const pg8::Unit& u, int wr, int wc, int fr, int fq) const {
#pragma unroll
        for (int ai = 0; ai < 2; ++ai)
#pragma unroll
            for (int m = 0; m < 4; ++m) {
                const size_t mq = (size_t)u.pm * 256 + ai * 128 + wr * 64 + m * 16 + fr;
#pragma unroll
                for (int bj = 0; bj < 2; ++bj) {
                    const int c = u.pn * 256 + bj * 128 + wc * 32 + 8 * fq;
                    const f32x4 x0 = *(const f32x4*)(X + mq * 1024 + c), x1 = *(const f32x4*)(X + mq * 1024 + c + 4);
                    *(f32x4*)(Y + mq * 1024 + c) = x0 + acc[ai][bj][m][0];
                    *(f32x4*)(Y + mq * 1024 + c + 4) = x1 + acc[ai][bj][m][1];
                }
            }
    }
};
struct OneTileOrder {
    int tile, nsel;
    __device__ __forceinline__ bool next(int i, pg8::Unit& u) const { if (i >= nsel) return false; u.pm = tile >> 2; u.pn = tile & 3; u.sel = i; return true; }
    __device__ __forceinline__ void a_ready(const pg8::Unit&) const {}
    __device__ __forceinline__ void done(const pg8::Unit&) const {}
};

__device__ __forceinline__ void transpose_tile(const float* __restrict__ src, int src_ld, int nvalid, int k0, int n0,
                                               bf16_t* __restrict__ dst, int dst_ld, float* tile  ) {
    const int tid = threadIdx.x;
#pragma unroll
    for (int i = 0; i < 2; ++i) {
        const int kk = (tid >> 4) + 32 * i, nn = (tid & 15) * 4;
        f32x4 v = {0.f, 0.f, 0.f, 0.f};
        if (n0 + nn < nvalid) v = *(const f32x4*)(src + (size_t)(k0 + kk) * src_ld + n0 + nn);
        tile[kk * 65 + nn + 0] = v[0]; tile[kk * 65 + nn + 1] = v[1]; tile[kk * 65 + nn + 2] = v[2]; tile[kk * 65 + nn + 3] = v[3];
    }
    __syncthreads();
    {
        const int n = tid >> 3, kq = (tid & 7) * 8;
        u32x4 w;
        w[0] = cvtpk(tile[(kq + 0) * 65 + n], tile[(kq + 1) * 65 + n]);
        w[1] = cvtpk(tile[(kq + 2) * 65 + n], tile[(kq + 3) * 65 + n]);
        w[2] = cvtpk(tile[(kq + 4) * 65 + n], tile[(kq + 5) * 65 + n]);
        w[3] = cvtpk(tile[(kq + 6) * 65 + n], tile[(kq + 7) * 65 + n]);
        *(u32x4*)(dst + (size_t)(n0 + n) * dst_ld + k0 + kq) = w;
    }
    __syncthreads();
}

__device__ __forceinline__ void phase0(const Params& p, char* lds) {
    const int tid = threadIdx.x, lane = tid & 63, wid = tid >> 6;
    const int nb = gridDim.x, bid = blockIdx.x;
    {
        float* tile = (float*)lds;
        const int c0 = 16 * 84;
        const int c1 = c0 + 6 * 12;
        const int c2 = c1 + 4 * 8;
        const int c3 = c2 + 4 * 8;
        const int c4 = c3 + 8 * 16;
        const int c5 = c4 + 8 * 16;
        const int c6 = c5 + 16 * 16;
        for (int j = bid; j < c6; j += nb) {
            const float* src; int sld, nval, ntn, loc; bf16_t* dst; int dld;
            if (j < c0)      { loc = j;      src = p.w_in; sld = IN_COLS; nval = IN_COLS; ntn = 84; dst = p.WIN_T; dld = 1024; }
            else if (j < c1) { loc = j - c0; src = p.w_uq; sld = 768;  nval = 768;  ntn = 12; dst = p.WUQ_T; dld = 384; }
            else if (j < c2) { loc = j - c1; src = p.w_uk; sld = 512;  nval = 512;  ntn = 8;  dst = p.WUKV_T; dld = 256; }
            else if (j < c3) { loc = j - c2; src = p.w_uv; sld = 512;  nval = 512;  ntn = 8;  dst = p.WUKV_T + (size_t)512 * 256; dld = 256; }
            else if (j < c4) { loc = j - c3; src = p.w_oa; sld = 1024; nval = 1024; ntn = 16; dst = p.WOA_T; dld = 512; }
            else if (j < c5) { loc = j - c4; src = p.w_ob; sld = 1024; nval = 1024; ntn = 16; dst = p.WOB_T; dld = 512; }
            else             { loc = j - c5; src = p.w_o;  sld = 1024; nval = 1024; ntn = 16; dst = p.WO_T; dld = 1024; }
            const int kt = loc / ntn, nt = loc % ntn;
            transpose_tile(src, sld, nval, kt * 64, nt * 64, dst, dld, tile);
        }
    }
    for (int r = bid * 8 + wid; r < R_PAD; r += nb * 8) {
        bf16_t* dst = p.XN + (size_t)r * 1024;
        if (r >= R_ALL) {
#pragma unroll
            for (int i = 0; i < 4; ++i) *(u32x2*)(dst + lane * 4 + 256 * i) = (u32x2){0u, 0u};
            continue;
        }
        const float* src;
        if (r < R_PROMPT) { const int b = r / LTOT, t = r - b * LTOT; src = (t < NMETA) ? p.meta + (size_t)t * 1024 : p.x_prompt + ((size_t)b * SEQ + (t - NMETA)) * 1024; }
        else src = p.x_sample + (size_t)(r - R_PROMPT) * 1024;
        f32x4 v[4]; float ss = 0.f;
#pragma unroll
        for (int i = 0; i < 4; ++i) { v[i] = *(const f32x4*)(src + lane * 4 + 256 * i); ss += v[i][0] * v[i][0] + v[i][1] * v[i][1] + v[i][2] * v[i][2] + v[i][3] * v[i][3]; }
        ss = wave_sum(ss);
        const float rs = 1.0f / sqrtf(ss * (1.0f / 1024.0f) + EPSF);
#pragma unroll
        for (int i = 0; i < 4; ++i) {
            const f32x4 g = *(const f32x4*)(p.norm_g + lane * 4 + 256 * i);
            u32x2 w; w[0] = cvtpk(v[i][0] * rs * g[0], v[i][1] * rs * g[1]); w[1] = cvtpk(v[i][2] * rs * g[2], v[i][3] * rs * g[3]);
            *(u32x2*)(dst + lane * 4 + 256 * i) = w;
        }
    }
    if (bid == 0) {
        if (tid < 512) { const float l0 = p.lb_logits[tid], l1 = p.lb_logits[512 + tid]; p.LB[tid] = 1.0f / (1.0f + expf(l1 - l0)); }
        if (tid < 16) p.INV[tid] = (float)exp(-(double)tid / 16.0 * log(10000.0));
        if (wid == 0) {
            float gq = 0.f, gk = 0.f;
            for (int i = lane; i < A_QK; i += 64) { gq = fmaxf(gq, fabsf(p.g_qn[i])); gk = fmaxf(gk, fabsf(p.g_kn[i])); }
#pragma unroll
            for (int o = 32; o >= 1; o >>= 1) { gq = fmaxf(gq, __shfl_xor(gq, o)); gk = fmaxf(gk, __shfl_xor(gk, o)); }
            if (lane == 0) p.SCAL[0] = sqrtf((float)A_QK) * gq * gk;
        }
    }
}

__device__ __forceinline__ void phase1(const Params& p, char* lds) {
    pg8::Gemm g{p.XN, p.WIN_T, R_PAD, IN_COLS_PAD, 1024, p.XN, p.WIN_T};
    pg8::StaticOrder S; S.init(R_PAD, IN_COLS_PAD, (int)gridDim.x, (int)blockIdx.x);
    EpiInProj E{p.F32A, p.GLOG, p.PBUF, p.LB};
    pg8::gemm_phase<EpiInProj, pg8::StaticOrder, true, true>((PG8_LAS unsigned char*)lds, g, S, E);
}

__device__ __forceinline__ void fin1_rows(const Params& p) {
    const int tid = threadIdx.x, lane = tid & 63, wid = tid >> 6;
    for (int r = blockIdx.x * 8 + wid; r < R_ALL; r += gridDim.x * 8) {
        const float* src = p.F32A + (size_t)r * 672;
        int pos; float* o_lat; float* o_kr;
        if (r < R_PROMPT) { const int t = r % LTOT; pos = t; o_lat = p.out + OFF_LAT_P + (size_t)r * 256; o_kr = p.out + OFF_KR_P + (size_t)r * 32; }
        else { const int i = r - R_PROMPT; pos = PAST_LEN; o_lat = p.out + OFF_LAT_S + (size_t)i * 256; o_kr = p.out + OFF_KR_S + (size_t)i * 32; }
        {
            f32x2 v[3]; float ss = 0.f;
#pragma unroll
            for (int i = 0; i < 3; ++i) { v[i] = *(const f32x2*)(src + C_CQ + lane * 2 + 128 * i); ss += v[i][0] * v[i][0] + v[i][1] * v[i][1]; }
            ss = wave_sum(ss);
            const float rs = 1.0f / sqrtf(ss * (1.0f / 384.0f) + EPSF);
#pragma unroll
            for (int i = 0; i < 3; ++i) {
                const f32x2 g = *(const f32x2*)(p.g_cq + lane * 2 + 128 * i);
                *(unsigned*)(p.CQN + (size_t)r * 384 + lane * 2 + 128 * i) = cvtpk(v[i][0] * rs * g[0], v[i][1] * rs * g[1]);
            }
        }
        {
            const f32x4 v = *(const f32x4*)(src + C_CKV + lane * 4);
            float ss = v[0] * v[0] + v[1] * v[1] + v[2] * v[2] + v[3] * v[3];
            ss = wave_sum(ss);
            const float rs = 1.0f / sqrtf(ss * (1.0f / 256.0f) + EPSF);
            const f32x4 g = *(const f32x4*)(p.g_ckv + lane * 4);
            f32x4 o; o[0] = v[0] * rs * g[0]; o[1] = v[1] * rs * g[1]; o[2] = v[2] * rs * g[2]; o[3] = v[3] * rs * g[3];
            *(f32x4*)(o_lat + lane * 4) = o;
            u32x2 w; w[0] = cvtpk(o[0], o[1]); w[1] = cvtpk(o[2], o[3]);
            *(u32x2*)(p.CKVN + (size_t)r * 256 + lane * 4) = w;
        }
        if (lane < 16) {
            const float x1 = src[C_KR + lane], x2 = src[C_KR + 16 + lane];
            const float ang = (float)pos * p.INV[lane];
            const float c = cosf(ang), s = sinf(ang);
            const float y1 = x1 * c - x2 * s, y2 = x1 * s + x2 * c;
            o_kr[lane] = y1; o_kr[16 + lane] = y2;
            p.KRR[(size_t)r * 32 + lane] = y1; p.KRR[(size_t)r * 32 + 16 + lane] = y2;
        }
    }
}

#define HA_LD 144
__device__ __forceinline__ void hgrn_passA(const Params& p, char* lds) {
    const int tid = threadIdx.x, lane = tid & 63, wid = tid >> 6, lr = lane & 15, lg = lane >> 4;
    float* cumL = (float*)lds;
    float* tot = (float*)(lds + 32768);
    char* KT = lds + 32768 + 2048;
    char* VT = KT + 128 * HA_LD;
    for (int u = blockIdx.x; u < BATCH * B_HEADS * NCHUNK; u += gridDim.x) {
        const int c = u % NCHUNK, bh = u / NCHUNK, h = bh % B_HEADS, b = bh / B_HEADS;
        const int nvalid = (c == 0) ? NMETA : 64;
        const int t0 = (c == 0) ? 0 : NMETA + 64 * (c - 1);
        const size_t rowbase = (size_t)b * LTOT + t0;
        const int d = tid & 127, part = tid >> 7;
        float run = 0.f;
#pragma unroll 4
        for (int i = 0; i < 16; ++i) {
            const int s = part * 16 + i;
            const float g = (s < nvalid) ? p.GLOG[(rowbase + s) * 512 + h * 128 + d] : 0.f;
            run += g; cumL[s * 128 + d] = run;
        }
        tot[part * 128 + d] = run;
        __syncthreads();
        {
            float off = 0.f, last = 0.f;
#pragma unroll
            for (int q = 0; q < 4; ++q) { const float tq = tot[q * 128 + d]; last += tq; if (q < part) off += tq; }
            if (part == 0) p.DEC[(size_t)u * 128 + d] = expf(last);
#pragma unroll 4
            for (int i = 0; i < 16; ++i) {
                const int s = part * 16 + i;
                const float cum = cumL[s * 128 + d] + off;
                const float kv = (s < nvalid) ? bf2f(p.PBUF[(rowbase + s) * IN_COLS_PAD + C_BF + h * 128 + d]) : 0.f;
                *(bf16_t*)(KT + d * HA_LD + s * 2) = f2bf(kv * expf(last - cum));
            }
#pragma unroll
            for (int i = 0; i < 2; ++i) {
                const int id = tid + 512 * i, s = id >> 4, vc = id & 15;
                u32x4 w = {0u, 0u, 0u, 0u};
                if (s < nvalid) w = *(const u32x4*)(p.PBUF + (rowbase + s) * IN_COLS_PAD + C_BI + h * 128 + vc * 8);
#pragma unroll
                for (int e = 0; e < 4; ++e) {
                    *(bf16_t*)(VT + (vc * 8 + 2 * e) * HA_LD + s * 2) = (bf16_t)(w[e] & 0xffffu);
                    *(bf16_t*)(VT + (vc * 8 + 2 * e + 1) * HA_LD + s * 2) = (bf16_t)(w[e] >> 16);
                }
            }
        }
        __syncthreads();
        {
            const char* xs = VT + (wid * 16 + lr) * HA_LD + lg * 16;
            bf16x8 xf0 = *(const bf16x8*)(xs), xf1 = *(const bf16x8*)(xs + 64);
            float* dst = p.UT + (size_t)u * 16384 + (size_t)(wid * 16 + lr) * 128;
#pragma unroll
            for (int nt = 0; nt < 8; ++nt) {
                const char* ws = KT + (nt * 16 + lr) * HA_LD + lg * 16;
                f32x4 acc = {0.f, 0.f, 0.f, 0.f};
                acc = mfma16(*(const bf16x8*)(ws), xf0, acc);
                acc = mfma16(*(const bf16x8*)(ws + 64), xf1, acc);
                *(f32x4*)(dst + nt * 16 + 4 * lg) = acc;
            }
        }
        __syncthreads();
    }
}

__device__ __forceinline__ void hgrn_sample_step(const Params& p, char* lds) {
    const int tid = threadIdx.x;
    float* part = (float*)lds;
    float* red = (float*)(lds + 8192);
    for (int u = blockIdx.x; u < DEC_BATCH * B_HEADS; u += gridDim.x) {
        const int i = u / B_HEADS, h = u % B_HEADS;
        const size_t r = R_PROMPT + i;
        const int v4 = (tid & 31) * 4, dp = tid >> 5;
        const float* S0 = p.state_hgrn + (size_t)u * 16384;
        float* S1 = p.out + OFF_HG_S + (size_t)u * 16384;
        const u32x2 vw = *(const u32x2*)(p.PBUF + r * IN_COLS_PAD + C_BI + h * 128 + v4);
        const float vv[4] = {bflo(vw[0]), bfhi(vw[0]), bflo(vw[1]), bfhi(vw[1])};
        float o[4] = {0.f, 0.f, 0.f, 0.f};
#pragma unroll
        for (int e = 0; e < 8; ++e) {
            const int d = dp * 8 + e;
            const float q = bf2f(p.PBUF[r * IN_COLS_PAD + C_BQ + h * 128 + d]);
            const float k = bf2f(p.PBUF[r * IN_COLS_PAD + C_BF + h * 128 + d]);
            const float f = expf(p.GLOG[r * 512 + h * 128 + d]);
            const f32x4 s0 = *(const f32x4*)(S0 + d * 128 + v4);
            f32x4 s1;
#pragma unroll
            for (int j = 0; j < 4; ++j) { s1[j] = f * s0[j] + k * vv[j]; o[j] += q * s1[j]; }
            *(f32x4*)(S1 + d * 128 + v4) = s1;
        }
#pragma unroll
        for (int j = 0; j < 4; ++j) part[dp * 128 + v4 + j] = o[j];
        __syncthreads();
        float osum = 0.f;
        if (tid < 128) {
#pragma unroll
            for (int q = 0; q < 16; ++q) osum += part[q * 128 + tid];
            float ss = wave_sum(osum * osum);
            if ((tid & 63) == 0) red[tid >> 6] = ss;
        }
        __syncthreads();
        if (tid < 128) {
            const float ss = red[0] + red[1];
            const float rs = 1.0f / sqrtf(ss * (1.0f / 128.0f) + EPSF);
            const float gb = bf2f(p.PBUF[r * IN_COLS_PAD + C_GB + h * 128 + tid]);
            p.AMB[(size_t)(NQ + i) * 512 + h * 128 + tid] = f2bf(osum * rs * p.g_bn[tid] * gb);
        }
        __syncthreads();
    }
}

__device__ __forceinline__ void phase2(const Params& p, char* lds) {
    fin1_rows(p);
    hgrn_sample_step(p, lds);
    hgrn_passA(p, lds);
}

__device__ __forceinline__ void hgrn_passB(const Params& p) {
    for (int g = blockIdx.x * NTHREADS + threadIdx.x; g < 32 * 128 * 32; g += gridDim.x * NTHREADS) {
        const int d4 = (g & 31) * 4, v = (g >> 5) & 127, bh = g >> 12;
        f32x4 S = {0.f, 0.f, 0.f, 0.f};
        for (int c = 0; c < NCHUNK; ++c) {
            const size_t u = (size_t)bh * NCHUNK + c;
            u32x2 w; w[0] = cvtpk(S[0], S[1]); w[1] = cvtpk(S[2], S[3]);
            *(u32x2*)(p.ST + u * 16384 + v * 128 + d4) = w;
            const f32x4 dec = *(const f32x4*)(p.DEC + u * 128 + d4);
            const f32x4 ut = *(const f32x4*)(p.UT + u * 16384 + v * 128 + d4);
#pragma unroll
            for (int j = 0; j < 4; ++j) S[j] = dec[j] * S[j] + ut[j];
        }
        float* o = p.out + OFF_HG_P + (size_t)bh * 16384;
#pragma unroll
        for (int j = 0; j < 4; ++j) o[(d4 + j) * 128 + v] = S[j];
    }
}

__device__ __forceinline__ void upproj_gemms(const Params& p, char* lds) {
    const int tid = threadIdx.x, lane = tid & 63, wid = tid >> 6, wm = wid >> 2, wn = wid & 3, lr = lane & 15, lg = lane >> 4;
    const int NT_M = R_PAD / 128;
    const int nq_tiles = NT_M * 6, nkv_tiles = NT_M * 8;
    for (int t = blockIdx.x; t < nq_tiles + nkv_tiles; t += gridDim.x) {
        const bool isq = t < nq_tiles;
        const int tt = isq ? t : t - nq_tiles;
        const int ntn = isq ? 6 : 8;
        const int m0 = (tt / ntn) * 128, n0 = (tt % ntn) * 128;
        const int K = isq ? 384 : 256;
        const bf16_t* X = isq ? p.CQN + (size_t)m0 * 384 : p.CKVN + (size_t)m0 * 256;
        const bf16_t* W = isq ? p.WUQ_T + (size_t)n0 * 384 : p.WUKV_T + (size_t)n0 * 256;
        bf16_t* O = isq ? p.QRAW : p.KVRAW;
        const int ldo = isq ? 768 : 1024;
        f32x4 acc[4][2];
#pragma unroll
        for (int a = 0; a < 4; ++a)
#pragma unroll
            for (int b = 0; b < 2; ++b) acc[a][b] = (f32x4){0.f, 0.f, 0.f, 0.f};
        gemm_tile_accum(acc, X, K, W, K, K, lds);
#pragma unroll
        for (int nt = 0; nt < 2; ++nt) {
            const int n = n0 + 32 * wn + 16 * nt + 4 * lg;
#pragma unroll
            for (int mt = 0; mt < 4; ++mt) {
                const int m = m0 + 64 * wm + 16 * mt + lr;
                const f32x4 v = acc[mt][nt];
                u32x2 w; w[0] = cvtpk(v[0], v[1]); w[1] = cvtpk(v[2], v[3]);
                *(u32x2*)(O + (size_t)m * ldo + n) = w;
            }
        }
    }
}

__device__ __forceinline__ void phase3(const Params& p, char* lds) {
    hgrn_passB(p);
    upproj_gemms(p, lds);
}

#define LOG2E 1.4426950408889634f
__device__ __forceinline__ void phase4(const Params& p, char* lds) {
    const int gtid = blockIdx.x * NTHREADS + threadIdx.x, gsz = gridDim.x * NTHREADS;
    const float qk_scale = 0.10206207261596577f;
    for (int idx = gtid; idx < MROWS * 8; idx += gsz) {
        const int qi = idx >> 3, h = idx & 7;
        size_t r; int pos;
        if (qi < NQ) { const int b = qi >> 11, tq = qi & 2047; r = (size_t)b * LTOT + NMETA + tq; pos = NMETA + tq; }
        else { r = R_PROMPT + (qi - NQ); pos = PAST_LEN; }
        float q[96];
        const bf16_t* src = p.QRAW + r * 768 + h * 96;
#pragma unroll
        for (int c = 0; c < 12; ++c) {
            const u32x4 w = *(const u32x4*)(src + c * 8);
#pragma unroll
            for (int e = 0; e < 4; ++e) { q[c * 8 + 2 * e] = bflo(w[e]); q[c * 8 + 2 * e + 1] = bfhi(w[e]); }
        }
#pragma unroll
        for (int i = 0; i < 16; ++i) {
            const float ang = (float)pos * p.INV[i];
            const float c = cosf(ang), s = sinf(ang);
            const float x1 = q[64 + i], x2 = q[80 + i];
            q[64 + i] = x1 * c - x2 * s; q[80 + i] = x1 * s + x2 * c;
        }
        float ss = 0.f;
#pragma unroll
        for (int d = 0; d < 96; ++d) ss += q[d] * q[d];
        const float rs = 1.0f / sqrtf(ss * (1.0f / 96.0f) + EPSF);
        if (qi < NQ) {
            const int b = qi >> 11, tq = qi & 2047;
            bf16_t* dst = p.QA + ((size_t)(b * 8 + h) * 2048 + tq) * 96;
            const float sc = rs * qk_scale * LOG2E;
#pragma unroll
            for (int c = 0; c < 12; ++c) {
                u32x4 w;
#pragma unroll
                for (int e = 0; e < 4; ++e) w[e] = cvtpk(q[c * 8 + 2 * e] * sc * p.g_qn[c * 8 + 2 * e], q[c * 8 + 2 * e + 1] * sc * p.g_qn[c * 8 + 2 * e + 1]);
                *(u32x4*)(dst + c * 8) = w;
            }
        } else {
            float* dst = p.QS + ((size_t)(qi - NQ) * 8 + h) * 96;
            const float sc = rs * qk_scale;
#pragma unroll
            for (int d = 0; d < 96; ++d) dst[d] = q[d] * sc * p.g_qn[d] * p.g_kn[d];
        }
    }
    for (int idx = gtid; idx < R_ALL * 8; idx += gsz) {
        const int r = idx >> 3, h = idx & 7;
        float k[96];
        const bf16_t* src = p.KVRAW + (size_t)r * 1024 + h * 64;
#pragma unroll
        for (int c = 0; c < 8; ++c) {
            const u32x4 w = *(const u32x4*)(src + c * 8);
#pragma unroll
            for (int e = 0; e < 4; ++e) { k[c * 8 + 2 * e] = bflo(w[e]); k[c * 8 + 2 * e + 1] = bfhi(w[e]); }
        }
        const float* kr = p.KRR + (size_t)r * 32;
#pragma unroll
        for (int c = 0; c < 8; ++c) { const f32x4 v = *(const f32x4*)(kr + c * 4); k[64 + c * 4] = v[0]; k[65 + c * 4] = v[1]; k[66 + c * 4] = v[2]; k[67 + c * 4] = v[3]; }
        if (r < R_PROMPT) {
            float ss = 0.f;
#pragma unroll
            for (int d = 0; d < 96; ++d) ss += k[d] * k[d];
            const float rs = 1.0f / sqrtf(ss * (1.0f / 96.0f) + EPSF);
            const int b = r / LTOT, t = r - b * LTOT;
            bf16_t* dst = p.KA + ((size_t)(b * 8 + h) * LTOT + t) * 96;
#pragma unroll
            for (int c = 0; c < 12; ++c) {
                u32x4 w;
#pragma unroll
                for (int e = 0; e < 4; ++e) w[e] = cvtpk(k[c * 8 + 2 * e] * rs * p.g_kn[c * 8 + 2 * e], k[c * 8 + 2 * e + 1] * rs * p.g_kn[c * 8 + 2 * e + 1]);
                *(u32x4*)(dst + c * 8) = w;
            }
        } else {
            float* dst = p.KSRAW + ((size_t)(r - R_PROMPT) * 8 + h) * 96;
#pragma unroll
            for (int d = 0; d < 96; ++d) dst[d] = k[d];
        }
    }
}

#define AK_LD 208
#define AV_LD 144
#define AP_LD 144
#define AK_BUF (64 * AK_LD)
#define AV_BUF (64 * AV_LD)
__device__ __forceinline__ void attn_unit(const Params& p, char* lds, int b, int h, int qb) {
    const int tid = threadIdx.x, lane = tid & 63, wid = tid >> 6, lr = lane & 15, lg = lane >> 4;
    char* Ks = lds;
    char* VTs = lds + 2 * AK_BUF;
    char* Ps = VTs + 2 * AV_BUF + wid * 16 * AP_LD;
    const int tq0 = qb * 128;
    const int ntile = 2 * qb + 3;
    const float Mb = p.SCAL[0] * LOG2E;
    const bf16_t* qsrc = p.QA + ((size_t)(b * 8 + h) * 2048 + tq0 + 16 * wid + lr) * 96 + lg * 8;
    bf16x8 qf[3];
#pragma unroll
    for (int ks = 0; ks < 3; ++ks) qf[ks] = *(const bf16x8*)(qsrc + ks * 32);
    const int qpos = NMETA + tq0 + 16 * wid + lr;
    const int wq_max = NMETA + tq0 + 16 * wid + 15;
    const bf16_t* kbase = p.KA + (size_t)(b * 8 + h) * LTOT * 96;
    const bf16_t* vbase = p.KVRAW + (size_t)b * LTOT * 1024 + 512 + h * 64;
    const int kkey0 = tid / 12, kpart0 = tid % 12;
    const int kkey1 = (512 + tid) / 12, kpart1 = (512 + tid) % 12;
    const int vkey = tid >> 3, vdc = tid & 7;
    u32x4 kr0, kr1 = {0u, 0u, 0u, 0u}, vr;
    auto load_tile = [&](int ti) {
        const int key0 = ti * 64;
        int ka = key0 + kkey0; ka = ka < LTOT ? ka : LTOT - 1;
        kr0 = *(const u32x4*)(kbase + (size_t)ka * 96 + kpart0 * 8);
        if (tid < 256) { int kb = key0 + kkey1; kb = kb < LTOT ? kb : LTOT - 1; kr1 = *(const u32x4*)(kbase + (size_t)kb * 96 + kpart1 * 8); }
        int kv = key0 + vkey; kv = kv < LTOT ? kv : LTOT - 1;
        vr = *(const u32x4*)(vbase + (size_t)kv * 1024 + vdc * 8);
    };
    auto store_tile = [&](int buf) {
        *(u32x4*)(Ks + buf * AK_BUF + kkey0 * AK_LD + kpart0 * 16) = kr0;
        if (tid < 256) *(u32x4*)(Ks + buf * AK_BUF + kkey1 * AK_LD + kpart1 * 16) = kr1;
        char* vt = VTs + buf * AV_BUF + vkey * 2;
#pragma unroll
        for (int e = 0; e < 4; ++e) {
            *(bf16_t*)(vt + (vdc * 8 + 2 * e) * AV_LD) = (bf16_t)(vr[e] & 0xffffu);
            *(bf16_t*)(vt + (vdc * 8 + 2 * e + 1) * AV_LD) = (bf16_t)(vr[e] >> 16);
        }
    };
    f32x4 o[4];
#pragma unroll
    for (int i = 0; i < 4; ++i) o[i] = (f32x4){0.f, 0.f, 0.f, 0.f};
    float lsum = 0.f;
    load_tile(0); store_tile(0);
    __syncthreads();
    for (int ti = 0; ti < ntile; ++ti) {
        const int cur = ti & 1;
        if (ti + 1 < ntile) load_tile(ti + 1);
        if (ti * 64 <= wq_max) {
            const char* kb_ = Ks + cur * AK_BUF + lr * AK_LD + lg * 16;
#pragma unroll
            for (int nt = 0; nt < 4; ++nt) {
                f32x4 s = {0.f, 0.f, 0.f, 0.f};
#pragma unroll
                for (int ks = 0; ks < 3; ++ks) s = mfma16(*(const bf16x8*)(kb_ + nt * 16 * AK_LD + ks * 64), qf[ks], s);
                const int key = ti * 64 + nt * 16 + 4 * lg;
                float pe[4];
#pragma unroll
                for (int j = 0; j < 4; ++j) { pe[j] = (key + j <= qpos) ? exp2f(s[j] - Mb) : 0.f; lsum += pe[j]; }
                u32x2 w; w[0] = cvtpk(pe[0], pe[1]); w[1] = cvtpk(pe[2], pe[3]);
                *(u32x2*)(Ps + lr * AP_LD + (nt * 16 + 4 * lg) * 2) = w;
            }
            asm volatile("s_waitcnt lgkmcnt(0)" ::: "memory");
            __builtin_amdgcn_wave_barrier();
            const bf16x8 pf0 = *(const bf16x8*)(Ps + lr * AP_LD + lg * 16);
            const bf16x8 pf1 = *(const bf16x8*)(Ps + lr * AP_LD + 64 + lg * 16);
            const char* vb_ = VTs + cur * AV_BUF + lr * AV_LD + lg * 16;
#pragma unroll
            for (int nt = 0; nt < 4; ++nt) {
                o[nt] = mfma16(*(const bf16x8*)(vb_ + nt * 16 * AV_LD), pf0, o[nt]);
                o[nt] = mfma16(*(const bf16x8*)(vb_ + nt * 16 * AV_LD + 64), pf1, o[nt]);
            }
            asm volatile("s_waitcnt lgkmcnt(0)" ::: "memory");
            __builtin_amdgcn_wave_barrier();
        }
        if (ti + 1 < ntile) store_tile(cur ^ 1);
        __syncthreads();
    }
    lsum += __shfl_xor(lsum, 16); lsum += __shfl_xor(lsum, 32);
    const float inv = 1.0f / lsum;
    const int tq = tq0 + 16 * wid + lr;
    const size_t r = (size_t)b * LTOT + NMETA + tq;
    const size_t mrow = (size_t)b * 2048 + tq;
#pragma unroll
    for (int nt = 0; nt < 4; ++nt) {
        const int dv = nt * 16 + 4 * lg;
        const u32x2 gw = *(const u32x2*)(p.PBUF + r * IN_COLS_PAD + C_GA + h * 64 + dv);
        u32x2 w; w[0] = cvtpk(o[nt][0] * inv * bflo(gw[0]), o[nt][1] * inv * bfhi(gw[0])); w[1] = cvtpk(o[nt][2] * inv * bflo(gw[1]), o[nt][3] * inv * bfhi(gw[1]));
        *(u32x2*)(p.AMA + mrow * 512 + h * 64 + dv) = w;
    }
}

__device__ __forceinline__ void attn_phase(const Params& p, char* lds) {
    for (int round = 0; round < 4; ++round) {
        const int i = blockIdx.x;
        if (i >= 256) break;
        const int k = (round & 1) ? (round * 256 + (255 - i)) : (round * 256 + i);
        const int qb = 15 - (k >> 6), bh = k & 63;
        attn_unit(p, lds, bh >> 3, bh & 7, qb);
    }
    if (gridDim.x < 256) {
    }
}

#define HC_LD 272
__device__ __forceinline__ void hgrn_passC(const Params& p, char* lds) {
    const int tid = threadIdx.x, lane = tid & 63, wid = tid >> 6, lr = lane & 15, lg = lane >> 4;
    float* cumL = (float*)lds;
    float* tot = (float*)(lds + 32768);
    char* QT = lds + 34816;
    char* KN = QT + 64 * HC_LD;
    char* QH = KN + 64 * HC_LD;
    char* VT = QH + 64 * HC_LD;
    char* AT = VT + 128 * HA_LD;
    char* STl = AT + 64 * HA_LD;
    for (int uu = blockIdx.x; uu < 32 * 32; uu += gridDim.x) {
        const int c = 1 + (uu & 31), bh = uu >> 5, h = bh & 3, b = bh >> 2;
        const size_t u = (size_t)bh * NCHUNK + c;
        const int t0 = NMETA + 64 * (c - 1);
        const size_t rowbase = (size_t)b * LTOT + t0;
        const int d = tid & 127, part = tid >> 7;
        float run = 0.f;
#pragma unroll 4
        for (int i = 0; i < 16; ++i) {
            const int s = part * 16 + i;
            run += p.GLOG[(rowbase + s) * 512 + h * 128 + d];
            cumL[s * 128 + d] = run;
        }
        tot[part * 128 + d] = run;
        __syncthreads();
        {
            float off = 0.f;
#pragma unroll
            for (int q = 0; q < 4; ++q) { const float tq = tot[q * 128 + d]; if (q < part) off += tq; }
            const float ref = tot[d] + tot[128 + d];
#pragma unroll 4
            for (int i = 0; i < 16; ++i) {
                const int s = part * 16 + i;
                const float cum = cumL[s * 128 + d] + off;
                const float qv = bf2f(p.PBUF[(rowbase + s) * IN_COLS_PAD + C_BQ + h * 128 + d]);
                const float kv = bf2f(p.PBUF[(rowbase + s) * IN_COLS_PAD + C_BF + h * 128 + d]);
                *(bf16_t*)(QT + s * HC_LD + d * 2) = f2bf(qv * expf(cum - ref));
                *(bf16_t*)(KN + s * HC_LD + d * 2) = f2bf(kv * expf(ref - cum));
                *(bf16_t*)(QH + s * HC_LD + d * 2) = f2bf(qv * expf(cum));
            }
#pragma unroll
            for (int i = 0; i < 2; ++i) {
                const int id = tid + 512 * i, s = id >> 4, vc = id & 15;
                const u32x4 w = *(const u32x4*)(p.PBUF + (rowbase + s) * IN_COLS_PAD + C_BI + h * 128 + vc * 8);
#pragma unroll
                for (int e = 0; e < 4; ++e) {
                    *(bf16_t*)(VT + (vc * 8 + 2 * e) * HA_LD + s * 2) = (bf16_t)(w[e] & 0xffffu);
                    *(bf16_t*)(VT + (vc * 8 + 2 * e + 1) * HA_LD + s * 2) = (bf16_t)(w[e] >> 16);
                }
            }
#pragma unroll
            for (int i = 0; i < 4; ++i) {
                const int id = tid + 512 * i, v = id >> 4, dc = id & 15;
                *(u32x4*)(STl + v * HC_LD + dc * 16) = *(const u32x4*)(p.ST + u * 16384 + v * 128 + dc * 8);
            }
        }
        __syncthreads();
        {
            const int mt = wid >> 1;
            const char* xs = QT + (mt * 16 + lr) * HC_LD + lg * 16;
            bf16x8 xf[4];
#pragma unroll
            for (int ks = 0; ks < 4; ++ks) xf[ks] = *(const bf16x8*)(xs + ks * 64);
#pragma unroll
            for (int q = 0; q < 2; ++q) {
                const int nt = 2 * (wid & 1) + q;
                const char* ws = KN + (nt * 16 + lr) * HC_LD + lg * 16;
                f32x4 a = {0.f, 0.f, 0.f, 0.f};
#pragma unroll
                for (int ks = 0; ks < 4; ++ks) a = mfma16(*(const bf16x8*)(ws + ks * 64), xf[ks], a);
                const int t = mt * 16 + lr, s0 = nt * 16 + 4 * lg;
                float m[4];
#pragma unroll
                for (int j = 0; j < 4; ++j) m[j] = (s0 + j <= t) ? a[j] : 0.f;
                u32x2 w; w[0] = cvtpk(m[0], m[1]); w[1] = cvtpk(m[2], m[3]);
                *(u32x2*)(AT + t * HA_LD + s0 * 2) = w;
            }
        }
        __syncthreads();
        {
            const int mt = wid >> 1;
            const char* xa = AT + (mt * 16 + lr) * HA_LD + lg * 16;
            const char* xq = QH + (mt * 16 + lr) * HC_LD + lg * 16;
            bf16x8 af[2], qf[4];
#pragma unroll
            for (int ks = 0; ks < 2; ++ks) af[ks] = *(const bf16x8*)(xa + ks * 64);
#pragma unroll
            for (int ks = 0; ks < 4; ++ks) qf[ks] = *(const bf16x8*)(xq + ks * 64);
#pragma unroll
            for (int q = 0; q < 4; ++q) {
                const int nt = 4 * (wid & 1) + q;
                const char* wv = VT + (nt * 16 + lr) * HA_LD + lg * 16;
                const char* wsx = STl + (nt * 16 + lr) * HC_LD + lg * 16;
                f32x4 a = {0.f, 0.f, 0.f, 0.f};
#pragma unroll
                for (int ks = 0; ks < 2; ++ks) a = mfma16(*(const bf16x8*)(wv + ks * 64), af[ks], a);
#pragma unroll
                for (int ks = 0; ks < 4; ++ks) a = mfma16(*(const bf16x8*)(wsx + ks * 64), qf[ks], a);
                *(f32x4*)(cumL + (mt * 16 + lr) * 128 + nt * 16 + 4 * lg) = a;
            }
        }
        __syncthreads();
        {
#pragma unroll
            for (int i = 0; i < 8; ++i) {
                const int t = wid * 8 + i;
                const f32x2 ov = *(const f32x2*)(cumL + t * 128 + 2 * lane);
                const float ss = wave_sum(ov[0] * ov[0] + ov[1] * ov[1]);
                const float rs = 1.0f / sqrtf(ss * (1.0f / 128.0f) + EPSF);
                const unsigned gw = *(const unsigned*)(p.PBUF + (rowbase + t) * IN_COLS_PAD + C_GB + h * 128 + 2 * lane);
                const f32x2 gbn = *(const f32x2*)(p.g_bn + 2 * lane);
                const size_t mrow = (size_t)b * 2048 + 64 * (c - 1) + t;
                *(unsigned*)(p.AMB + mrow * 512 + h * 128 + 2 * lane) = cvtpk(ov[0] * rs * gbn[0] * bflo(gw), ov[1] * rs * gbn[1] * bfhi(gw));
            }
        }
        __syncthreads();
    }
}

#define SC_LD 528
#define SP_LD 272
#define SC_BUF (128 * SC_LD)
__device__ __forceinline__ void sample_attn(const Params& p, char* lds) {
    const int tid = threadIdx.x, lane = tid & 63, wid = tid >> 6, lr = lane & 15, lg = lane >> 4;
    char* Cs = lds;
    float* RS = (float*)(lds + 2 * SC_BUF);
    char* Pl = lds + 2 * SC_BUF + 2 * 9 * 128 * 4;
    float* Qsl = (float*)(Pl + 16 * SP_LD);
    for (int blk = blockIdx.x; blk < DEC_BATCH * 8; blk += gridDim.x) {
        const int b = blk >> 3, split = blk & 7, h = wid;
        for (int i = tid; i < 16 * SP_LD / 4; i += NTHREADS) ((unsigned*)Pl)[i] = 0u;
        for (int i = tid; i < 8 * 96; i += NTHREADS) Qsl[i] = p.QS[(size_t)b * 768 + i];
        bf16x8 wf[4][8];
        {
            const bf16_t* wb = p.WUKV_T + (size_t)(64 * h + lr) * 256 + 8 * lg;
#pragma unroll
            for (int nt = 0; nt < 4; ++nt) {
                asm volatile("" : "+v"(wb));
#pragma unroll
                for (int ks = 0; ks < 8; ++ks) wf[nt][ks] = *(const bf16x8*)(wb + 32 * ks);
                wb += 16 * 256;
            }
        }
        const float* qsl = Qsl + h * 96;
        const float M = p.SCAL[0];
        f32x4 accl[2] = {{0.f, 0.f, 0.f, 0.f}, {0.f, 0.f, 0.f, 0.f}};
        float lacc = 0.f;
        __syncthreads();
        f32x4 pre[4], rpre[2];
        const int crow = tid >> 6, cc4 = (tid & 63) * 4;
        const int rrow = tid >> 2, rq = tid & 3;
        const int* ptab = p.page_table + b * NPAGES + split * 16;
        auto issue_c = [&](const float* csrc, int qt) {
#pragma unroll
            for (int it = 0; it < 4; ++it) pre[it] = *(const f32x4*)(csrc + (qt * 32 + crow + 8 * it) * 256 + cc4);
        };
        auto write_c = [&](int buf, int qt) {
#pragma unroll
            for (int it = 0; it < 4; ++it) {
                u32x2 w; w[0] = cvtpk(pre[it][0], pre[it][1]); w[1] = cvtpk(pre[it][2], pre[it][3]);
                *(u32x2*)(Cs + buf * SC_BUF + (qt * 32 + crow + 8 * it) * SC_LD + cc4 * 2) = w;
            }
        };
        auto issue_r = [&](const float* rsrc) {
            rpre[0] = *(const f32x4*)(rsrc + rrow * 32 + rq * 8); rpre[1] = *(const f32x4*)(rsrc + rrow * 32 + rq * 8 + 4);
        };
        auto write_r = [&](int buf) {
            float v[9];
            v[0] = rpre[0][0] * rpre[0][0] + rpre[0][1] * rpre[0][1] + rpre[0][2] * rpre[0][2] + rpre[0][3] * rpre[0][3]
                 + rpre[1][0] * rpre[1][0] + rpre[1][1] * rpre[1][1] + rpre[1][2] * rpre[1][2] + rpre[1][3] * rpre[1][3];
#pragma unroll
            for (int hh = 0; hh < 8; ++hh) {
                const f32x4 q0 = *(const f32x4*)(Qsl + hh * 96 + 64 + rq * 8), q1 = *(const f32x4*)(Qsl + hh * 96 + 64 + rq * 8 + 4);
                v[1 + hh] = rpre[0][0] * q0[0] + rpre[0][1] * q0[1] + rpre[0][2] * q0[2] + rpre[0][3] * q0[3]
                          + rpre[1][0] * q1[0] + rpre[1][1] * q1[1] + rpre[1][2] * q1[2] + rpre[1][3] * q1[3];
            }
#pragma unroll
            for (int k = 0; k < 9; ++k) { v[k] += __shfl_xor(v[k], 1); v[k] += __shfl_xor(v[k], 2); }
            if (rq == 0) {
#pragma unroll
                for (int k = 0; k < 9; ++k) RS[(buf * 9 + k) * 128 + rrow] = v[k];
            }
        };
        auto compute_mt = [&](int cur, int mt) {
            f32x4 a[4];
#pragma unroll
            for (int nt = 0; nt < 4; ++nt) a[nt] = (f32x4){0.f, 0.f, 0.f, 0.f};
            const char* xs = Cs + cur * SC_BUF + (16 * mt + lr) * SC_LD + lg * 16;
#pragma unroll
            for (int ks = 0; ks < 8; ++ks) {
                const bf16x8 xf = *(const bf16x8*)(xs + ks * 64);
#pragma unroll
                for (int nt = 0; nt < 4; ++nt) a[nt] = mfma16(wf[nt][ks], xf, a[nt]);
            }
            float ss = 0.f, sq = 0.f;
#pragma unroll
            for (int nt = 0; nt < 4; ++nt) {
                const f32x4 qg = *(const f32x4*)(qsl + 16 * nt + 4 * lg);
#pragma unroll
                for (int j = 0; j < 4; ++j) { ss += a[nt][j] * a[nt][j]; sq += a[nt][j] * qg[j]; }
            }
            ss += __shfl_xor(ss, 16); ss += __shfl_xor(ss, 32);
            sq += __shfl_xor(sq, 16); sq += __shfl_xor(sq, 32);
            ss += RS[(cur * 9) * 128 + 16 * mt + lr];
            sq += RS[(cur * 9 + 1 + h) * 128 + 16 * mt + lr];
            const float sc = sq / sqrtf(ss * (1.0f / 96.0f) + EPSF);
            const float pe = __expf(sc - M);
            lacc += pe;
            if (lg == 0) *(bf16_t*)(Pl + h * SP_LD + (16 * mt + lr) * 2) = f2bf(pe);
        };
        {
            const int pg = ptab[0];
            const float* csrc = p.cache_latent + (size_t)pg * PAGE * KV_LORA;
            issue_r(p.cache_krope + (size_t)pg * PAGE * A_ROPE);
            issue_c(csrc, 0); write_c(0, 0); write_r(0);
            issue_c(csrc, 1); write_c(0, 1);
            issue_c(csrc, 2); write_c(0, 2);
            issue_c(csrc, 3); write_c(0, 3);
        }
        __syncthreads();
#pragma unroll 1
        for (int pi = 0; pi < 16; ++pi) {
            const int cur = pi & 1;
            const bool has_next = pi + 1 < 16;
            const int pgn = has_next ? ptab[pi + 1] : ptab[pi];
            const float* csrc = p.cache_latent + (size_t)pgn * PAGE * KV_LORA;
            if (has_next) { issue_r(p.cache_krope + (size_t)pgn * PAGE * A_ROPE); issue_c(csrc, 0); }
#pragma unroll 1
            for (int qt = 0; qt < 4; ++qt) {
                compute_mt(cur, 2 * qt); compute_mt(cur, 2 * qt + 1);
                if (has_next) { write_c(cur ^ 1, qt); if (qt == 0) write_r(cur ^ 1); if (qt < 3) issue_c(csrc, qt + 1); }
            }
            __syncthreads();
            {
                const char* xp = Pl + lr * SP_LD + lg * 16;
#pragma unroll
                for (int q = 0; q < 2; ++q) {
                    const int n0 = 32 * wid + 16 * q;
#pragma unroll 1
                    for (int ks = 0; ks < 4; ++ks) {
                        const bf16x8 xf = *(const bf16x8*)(xp + ks * 64);
                        const char* cc = Cs + cur * SC_BUF + (32 * ks + 8 * lg) * SC_LD + (n0 + lr) * 2;
                        bf16x8 wfr;
#pragma unroll
                        for (int e = 0; e < 8; ++e) wfr[e] = (short)*(const bf16_t*)(cc + e * SC_LD);
                        accl[q] = mfma16(wfr, xf, accl[q]);
                    }
                }
            }
            __syncthreads();
        }
        if (lr < 8) {
#pragma unroll
            for (int q = 0; q < 2; ++q) *(f32x4*)(p.PART + ((size_t)(b * 8 + split) * 8 + lr) * 256 + 32 * wid + 16 * q + 4 * lg) = accl[q];
        }
        lacc += __shfl_xor(lacc, 8); lacc += __shfl_xor(lacc, 4); lacc += __shfl_xor(lacc, 2); lacc += __shfl_xor(lacc, 1);
        if (lane == 0) p.PL[(b * 8 + split) * 8 + h] = lacc;
        __syncthreads();
    }
}

#define SA_D 6
#define SA_STG (SA_D * 16384)
#define SA_RSTG (SA_D * 2048)
#define SA_CB_SLOT (16 * SC_LD)
#define SA_NG 128
typedef __attribute__((address_space(3))) unsigned las_u32;
__device__ __forceinline__ void sample_attn2(const Params& p, char* lds) {
    const int tid = threadIdx.x, lane = tid & 63, lr = lane & 15, lg = lane >> 4;
    const int wid = __builtin_amdgcn_readfirstlane(tid >> 6);
    char* stg = lds;
    char* rstg = lds + SA_STG;
    char* cb = rstg + SA_RSTG;
    char* pl = cb + 3 * SA_CB_SLOT;
    float* rs = (float*)(pl + 1024);
    float* Qsl = (float*)((char*)rs + 1152);
    for (int blk = blockIdx.x; blk < DEC_BATCH * 8; blk += gridDim.x) {
        const int b = blk >> 3, split = blk & 7, h = wid;
        if (tid < 256) ((unsigned*)pl)[tid] = 0u;
        for (int i = tid; i < 8 * 96; i += NTHREADS) Qsl[i] = p.QS[(size_t)b * 768 + i];
        bf16x8 wf[4][8];
        {
            const bf16_t* wb = p.WUKV_T + (size_t)(64 * h + lr) * 256 + 8 * lg;
#pragma unroll
            for (int nt = 0; nt < 4; ++nt) {
                asm volatile("" : "+v"(wb));
#pragma unroll
                for (int ks = 0; ks < 8; ++ks) wf[nt][ks] = *(const bf16x8*)(wb + 32 * ks);
                wb += 16 * 256;
            }
        }
        const int pgid = p.page_table[b * NPAGES + split * 16 + (lane & 15)];
        const float* qsl = Qsl + h * 96;
        const float M = p.SCAL[0];
        f32x4 accl[2] = {{0.f, 0.f, 0.f, 0.f}, {0.f, 0.f, 0.f, 0.f}};
        float lacc = 0.f;
        asm volatile("s_waitcnt vmcnt(0) lgkmcnt(0)" ::: "memory");
        __syncthreads();
        auto issue = [&](int gi, int slot) {
            const int pg = __builtin_amdgcn_readlane(pgid, gi >> 3);
            const size_t row0 = (size_t)pg * PAGE + 16 * (gi & 7) + 2 * wid;
            const float* src = p.cache_latent + row0 * KV_LORA + lane * 4;
            las_u32* d0 = (las_u32*)(stg + slot * 16384 + (2 * wid) * 1024);
            __builtin_amdgcn_global_load_lds((const unsigned*)src, d0, 16, 0, 0);
            __builtin_amdgcn_global_load_lds((const unsigned*)(src + KV_LORA), (las_u32*)((char __attribute__((address_space(3)))*)d0 + 1024), 16, 0, 0);
            const float* rsrc = p.cache_krope + row0 * A_ROPE + lane;
            __builtin_amdgcn_global_load_lds((const unsigned*)rsrc, (las_u32*)(rstg + slot * 2048 + wid * 256), 4, 0, 0);
        };
#pragma unroll 1
        for (int gi = 0; gi < SA_D; ++gi) issue(gi, gi);
        int c3_g = 2, d_g1 = 0;
#pragma unroll 1
        for (int g = -1; g <= SA_NG; ++g) {
            const int c3_g1 = (c3_g == 2) ? 0 : c3_g + 1;
            const int c3_gm1 = (c3_g == 0) ? 2 : c3_g - 1;
            if (g + 1 < SA_NG) {
                if (g + SA_D <= SA_NG - 1) asm volatile("s_waitcnt vmcnt(%0)" :: "n"(3 * (SA_D - 1)) : "memory");
                else asm volatile("s_waitcnt vmcnt(0)" ::: "memory");
            }
            asm volatile("s_waitcnt lgkmcnt(0)" ::: "memory");
            __builtin_amdgcn_s_barrier();
            asm volatile("" ::: "memory");
            if (g + 1 < SA_NG) {
                const int gc = g + 1;
#pragma unroll
                for (int i = 0; i < 2; ++i) {
                    const f32x4 v = *(const f32x4*)(stg + d_g1 * 16384 + (2 * wid + i) * 1024 + lane * 16);
                    u32x2 w; w[0] = cvtpk(v[0], v[1]); w[1] = cvtpk(v[2], v[3]);
                    *(u32x2*)(cb + c3_g1 * SA_CB_SLOT + (2 * wid + i) * SC_LD + lane * 8) = w;
                }
                {
                    const int rrow = 2 * wid + (lane >> 5), hh = (lane >> 2) & 7, part = lane & 3;
                    const f32x4 r0 = *(const f32x4*)(rstg + d_g1 * 2048 + rrow * 128 + part * 32);
                    const f32x4 r1 = *(const f32x4*)(rstg + d_g1 * 2048 + rrow * 128 + part * 32 + 16);
                    const f32x4 q0 = *(const f32x4*)(Qsl + hh * 96 + 64 + part * 8), q1 = *(const f32x4*)(Qsl + hh * 96 + 64 + part * 8 + 4);
                    float dot = r0[0] * q0[0] + r0[1] * q0[1] + r0[2] * q0[2] + r0[3] * q0[3] + r1[0] * q1[0] + r1[1] * q1[1] + r1[2] * q1[2] + r1[3] * q1[3];
                    float rr = r0[0] * r0[0] + r0[1] * r0[1] + r0[2] * r0[2] + r0[3] * r0[3] + r1[0] * r1[0] + r1[1] * r1[1] + r1[2] * r1[2] + r1[3] * r1[3];
                    dot += __shfl_xor(dot, 1); dot += __shfl_xor(dot, 2);
                    rr += __shfl_xor(rr, 1); rr += __shfl_xor(rr, 2);
                    if (part == 0) {
                        rs[((gc & 1) * 9 + 1 + hh) * 16 + rrow] = dot;
                        if (hh == 0) rs[((gc & 1) * 9) * 16 + rrow] = rr;
                    }
                }
                asm volatile("s_waitcnt lgkmcnt(0)" ::: "memory");
                if (gc + SA_D < SA_NG) issue(gc + SA_D, d_g1);
            }
            if (g >= 0 && g < SA_NG) {
                f32x4 a[4];
#pragma unroll
                for (int nt = 0; nt < 4; ++nt) a[nt] = (f32x4){0.f, 0.f, 0.f, 0.f};
                const char* xs = cb + c3_g * SA_CB_SLOT + lr * SC_LD + lg * 16;
#pragma unroll
                for (int ks = 0; ks < 8; ++ks) {
                    const bf16x8 xf = *(const bf16x8*)(xs + ks * 64);
#pragma unroll
                    for (int nt = 0; nt < 4; ++nt) a[nt] = mfma16(wf[nt][ks], xf, a[nt]);
                }
                float ss = 0.f, sq = 0.f;
#pragma unroll
                for (int nt = 0; nt < 4; ++nt) {
                    const f32x4 qg = *(const f32x4*)(qsl + 16 * nt + 4 * lg);
#pragma unroll
                    for (int j = 0; j < 4; ++j) { ss += a[nt][j] * a[nt][j]; sq += a[nt][j] * qg[j]; }
                }
                ss += __shfl_xor(ss, 16); ss += __shfl_xor(ss, 32);
                sq += __shfl_xor(sq, 16); sq += __shfl_xor(sq, 32);
                ss += rs[((g & 1) * 9) * 16 + lr];
                sq += rs[((g & 1) * 9 + 1 + h) * 16 + lr];
                const float sc = sq / sqrtf(ss * (1.0f / 96.0f) + EPSF);
                const float pe = __expf(sc - M);
                lacc += pe;
                if (lg == 0) *(bf16_t*)(pl + (g & 1) * 512 + h * 32 + lr * 2) = f2bf(pe);
            }
            if (g >= 1) {
                bf16x8 xf = {0, 0, 0, 0, 0, 0, 0, 0};
                if (lg < 2) xf = *(const bf16x8*)(pl + ((g - 1) & 1) * 512 + lr * 32 + lg * 16);
#pragma unroll
                for (int q = 0; q < 2; ++q) {
                    const char* cc = cb + c3_gm1 * SA_CB_SLOT + ((8 * lg) & 15) * SC_LD + (32 * wid + 16 * q + lr) * 2;
                    bf16x8 wfr;
#pragma unroll
                    for (int e = 0; e < 8; ++e) wfr[e] = (short)*(const bf16_t*)(cc + e * SC_LD);
                    accl[q] = mfma16(wfr, xf, accl[q]);
                }
            }
            c3_g = c3_g1;
            d_g1 = (d_g1 + 1 == SA_D) ? 0 : d_g1 + 1;
        }
        if (lr < 8) {
#pragma unroll
            for (int q = 0; q < 2; ++q) *(f32x4*)(p.PART + ((size_t)(b * 8 + split) * 8 + lr) * 256 + 32 * wid + 16 * q + 4 * lg) = accl[q];
        }
        lacc += __shfl_xor(lacc, 8); lacc += __shfl_xor(lacc, 4); lacc += __shfl_xor(lacc, 2); lacc += __shfl_xor(lacc, 1);
        if (lane == 0) p.PL[(b * 8 + split) * 8 + h] = lacc;
        __syncthreads();
    }
}

#define SB_D 2
#define SB_STG (SB_D * 32768)
#define SB_RSTG (SB_D * 4096)
#define SB_CB_SLOT (32 * SC_LD)
#define SB_NG 64
__device__ __forceinline__ void sample_attn3(const Params& p, char* lds) {
    const int tid = threadIdx.x, lane = tid & 63, lr = lane & 15, lg = lane >> 4;
    const int wid = __builtin_amdgcn_readfirstlane(tid >> 6);
    char* stg = lds;
    char* rstg = lds + SB_STG;
    char* cb = rstg + SB_RSTG;
    char* pl = cb + 3 * SB_CB_SLOT;
    float* rs = (float*)(pl + 2048);
    float* Qsl = (float*)((char*)rs + 2304);
    for (int blk = blockIdx.x; blk < DEC_BATCH * 8; blk += gridDim.x) {
        const int b = blk >> 3, split = blk & 7, h = wid;
        ((unsigned*)pl)[tid] = 0u;
        for (int i = tid; i < 8 * 96; i += NTHREADS) Qsl[i] = p.QS[(size_t)b * 768 + i];
        bf16x8 wf[4][8];
        {
            const bf16_t* wb = p.WUKV_T + (size_t)(64 * h + lr) * 256 + 8 * lg;
#pragma unroll
            for (int nt = 0; nt < 4; ++nt) {
                asm volatile("" : "+v"(wb));
#pragma unroll
                for (int ks = 0; ks < 8; ++ks) wf[nt][ks] = *(const bf16x8*)(wb + 32 * ks);
                wb += 16 * 256;
            }
        }
        const int pgid = p.page_table[b * NPAGES + split * 16 + (lane & 15)];
        const float* qsl = Qsl + h * 96;
        const float M = p.SCAL[0];
        f32x4 accl[2] = {{0.f, 0.f, 0.f, 0.f}, {0.f, 0.f, 0.f, 0.f}};
        float lacc = 0.f;
        asm volatile("s_waitcnt vmcnt(0) lgkmcnt(0)" ::: "memory");
        __syncthreads();
        auto issue = [&](int gi, int slot) {
            const int pg = __builtin_amdgcn_readlane(pgid, gi >> 2);
            const size_t row0 = (size_t)pg * PAGE + 32 * (gi & 3) + 4 * wid;
            const float* src = p.cache_latent + row0 * KV_LORA + lane * 4;
            char __attribute__((address_space(3)))* d0 = (char __attribute__((address_space(3)))*)(stg + slot * 32768 + (4 * wid) * 1024);
            __builtin_amdgcn_global_load_lds((const unsigned*)src, (las_u32*)d0, 16, 0, 0);
            __builtin_amdgcn_global_load_lds((const unsigned*)(src + KV_LORA), (las_u32*)(d0 + 1024), 16, 0, 0);
            __builtin_amdgcn_global_load_lds((const unsigned*)(src + 2 * KV_LORA), (las_u32*)(d0 + 2048), 16, 0, 0);
            __builtin_amdgcn_global_load_lds((const unsigned*)(src + 3 * KV_LORA), (las_u32*)(d0 + 3072), 16, 0, 0);
            const float* rsrc = p.cache_krope + row0 * A_ROPE + lane;
            char __attribute__((address_space(3)))* r0 = (char __attribute__((address_space(3)))*)(rstg + slot * 4096 + wid * 512);
            __builtin_amdgcn_global_load_lds((const unsigned*)rsrc, (las_u32*)r0, 4, 0, 0);
            __builtin_amdgcn_global_load_lds((const unsigned*)(rsrc + 64), (las_u32*)(r0 + 256), 4, 0, 0);
        };
#pragma unroll 1
        for (int gi = 0; gi < SB_D; ++gi) issue(gi, gi);
        int c3_g = 2, d_g1 = 0;
#pragma unroll 1
        for (int g = -1; g <= SB_NG; ++g) {
            const int c3_g1 = (c3_g == 2) ? 0 : c3_g + 1;
            const int c3_gm1 = (c3_g == 0) ? 2 : c3_g - 1;
            if (g + 1 < SB_NG) {
                if (g + SB_D <= SB_NG - 1) asm volatile("s_waitcnt vmcnt(%0)" :: "n"(6 * (SB_D - 1)) : "memory");
                else asm volatile("s_waitcnt vmcnt(0)" ::: "memory");
            }
            asm volatile("s_waitcnt lgkmcnt(0)" ::: "memory");
            __builtin_amdgcn_s_barrier();
            asm volatile("" ::: "memory");
            if (g + 1 < SB_NG) {
                const int gc = g + 1;
#pragma unroll
                for (int i = 0; i < 4; ++i) {
                    const f32x4 v = *(const f32x4*)(stg + d_g1 * 32768 + (4 * wid + i) * 1024 + lane * 16);
                    u32x2 w; w[0] = cvtpk(v[0], v[1]); w[1] = cvtpk(v[2], v[3]);
                    *(u32x2*)(cb + c3_g1 * SB_CB_SLOT + (4 * wid + i) * SC_LD + lane * 8) = w;
                }
                {
                    const int hh = (lane >> 2) & 7, part = lane & 3;
                    const f32x4 q0 = *(const f32x4*)(Qsl + hh * 96 + 64 + part * 8), q1 = *(const f32x4*)(Qsl + hh * 96 + 64 + part * 8 + 4);
#pragma unroll
                    for (int i = 0; i < 2; ++i) {
                        const int rrow = 4 * wid + 2 * i + (lane >> 5);
                        const f32x4 r0 = *(const f32x4*)(rstg + d_g1 * 4096 + rrow * 128 + part * 32);
                        const f32x4 r1 = *(const f32x4*)(rstg + d_g1 * 4096 + rrow * 128 + part * 32 + 16);
                        float dot = r0[0] * q0[0] + r0[1] * q0[1] + r0[2] * q0[2] + r0[3] * q0[3] + r1[0] * q1[0] + r1[1] * q1[1] + r1[2] * q1[2] + r1[3] * q1[3];
                        float rr = r0[0] * r0[0] + r0[1] * r0[1] + r0[2] * r0[2] + r0[3] * r0[3] + r1[0] * r1[0] + r1[1] * r1[1] + r1[2] * r1[2] + r1[3] * r1[3];
                        dot += __shfl_xor(dot, 1); dot += __shfl_xor(dot, 2);
                        rr += __shfl_xor(rr, 1); rr += __shfl_xor(rr, 2);
                        if (part == 0) {
                            rs[((gc & 1) * 9 + 1 + hh) * 32 + rrow] = dot;
                            if (hh == 0) rs[((gc & 1) * 9) * 32 + rrow] = rr;
                        }
                    }
                }
                asm volatile("s_waitcnt lgkmcnt(0)" ::: "memory");
                if (gc + SB_D < SB_NG) issue(gc + SB_D, d_g1);
            }
            if (g >= 0 && g < SB_NG) {
#pragma unroll
                for (int mt2 = 0; mt2 < 2; ++mt2) {
                    f32x4 a[4];
#pragma unroll
                    for (int nt = 0; nt < 4; ++nt) a[nt] = (f32x4){0.f, 0.f, 0.f, 0.f};
                    const char* xs = cb + c3_g * SB_CB_SLOT + (16 * mt2 + lr) * SC_LD + lg * 16;
#pragma unroll
                    for (int ks = 0; ks < 8; ++ks) {
                        const bf16x8 xf = *(const bf16x8*)(xs + ks * 64);
#pragma unroll
                        for (int nt = 0; nt < 4; ++nt) a[nt] = mfma16(wf[nt][ks], xf, a[nt]);
                    }
                    float ss = 0.f, sq = 0.f;
#pragma unroll
                    for (int nt = 0; nt < 4; ++nt) {
                        const f32x4 qg = *(const f32x4*)(qsl + 16 * nt + 4 * lg);
#pragma unroll
                        for (int j = 0; j < 4; ++j) { ss += a[nt][j] * a[nt][j]; sq += a[nt][j] * qg[j]; }
                    }
                    ss += __shfl_xor(ss, 16); ss += __shfl_xor(ss, 32);
                    sq += __shfl_xor(sq, 16); sq += __shfl_xor(sq, 32);
                    ss += rs[((g & 1) * 9) * 32 + 16 * mt2 + lr];
                    sq += rs[((g & 1) * 9 + 1 + h) * 32 + 16 * mt2 + lr];
                    const float sc = sq * __builtin_amdgcn_rsqf(ss * (1.0f / 96.0f) + EPSF);
                    const float pe = __expf(sc - M);
                    lacc += pe;
                    if (lg == 0) *(bf16_t*)(pl + (g & 1) * 1024 + h * 64 + (16 * mt2 + lr) * 2) = f2bf(pe);
                }
            }
            if (g >= 1) {
                const bf16x8 xf = *(const bf16x8*)(pl + ((g - 1) & 1) * 1024 + lr * 64 + lg * 16);
#pragma unroll
                for (int q = 0; q < 2; ++q) {
                    const char* cc = cb + c3_gm1 * SB_CB_SLOT + (8 * lg) * SC_LD + (32 * wid + 16 * q + lr) * 2;
                    bf16x8 wfr;
#pragma unroll
                    for (int e = 0; e < 8; ++e) wfr[e] = (short)*(const bf16_t*)(cc + e * SC_LD);
                    accl[q] = mfma16(wfr, xf, accl[q]);
                }
            }
            c3_g = c3_g1;
            d_g1 = (d_g1 + 1 == SB_D) ? 0 : d_g1 + 1;
        }
        if (lr < 8) {
#pragma unroll
            for (int q = 0; q < 2; ++q) *(f32x4*)(p.PART + ((size_t)(b * 8 + split) * 8 + lr) * 256 + 32 * wid + 16 * q + 4 * lg) = accl[q];
        }
        lacc += __shfl_xor(lacc, 8); lacc += __shfl_xor(lacc, 4); lacc += __shfl_xor(lacc, 2); lacc += __shfl_xor(lacc, 1);
        if (lane == 0) p.PL[(b * 8 + split) * 8 + h] = lacc;
        __syncthreads();
    }
}

__device__ __forceinline__ void phase5(const Params& p, char* lds) {
    sample_attn3(p, lds);
    attn_phase(p, lds);
    hgrn_passC(p, lds);
}

__device__ __forceinline__ void sample_combine(const Params& p, char* lds) {
    const int tid = threadIdx.x;
    float* ol = (float*)lds;
    float* sc = (float*)(lds + 8192);
    for (int b = blockIdx.x; b < DEC_BATCH; b += gridDim.x) {
        if (tid < 8) {
            const int h = tid;
            const float* kraw = p.KSRAW + (size_t)(b * 8 + h) * 96;
            const float* qs = p.QS + (size_t)(b * 8 + h) * 96;
            float ss = 0.f, sq = 0.f;
            for (int d = 0; d < 96; ++d) { ss += kraw[d] * kraw[d]; sq += kraw[d] * qs[d]; }
            const float s = sq / sqrtf(ss * (1.0f / 96.0f) + EPSF);
            const float pn = __expf(s - p.SCAL[0]);
            float l = pn;
            for (int sp = 0; sp < 8; ++sp) l += p.PL[(b * 8 + sp) * 8 + h];
            sc[h] = pn; sc[8 + h] = 1.0f / l;
        }
        __syncthreads();
#pragma unroll
        for (int i = 0; i < 4; ++i) {
            const int id = tid + 512 * i, h = id >> 8, c = id & 255;
            float a = sc[h] * p.out[OFF_LAT_S + b * 256 + c];
            for (int sp = 0; sp < 8; ++sp) a += p.PART[((size_t)(b * 8 + sp) * 8 + h) * 256 + c];
            ol[h * 256 + c] = a * sc[8 + h];
        }
        __syncthreads();
        {
            const int h = tid >> 6, d = tid & 63;
            float a = 0.f;
            const bf16_t* wrow = p.WUKV_T + (size_t)(512 + h * 64 + d) * 256;
#pragma unroll 8
            for (int c = 0; c < 256; c += 8) {
                const u32x4 w = *(const u32x4*)(wrow + c);
                const f32x4 o0 = *(const f32x4*)(ol + h * 256 + c), o1 = *(const f32x4*)(ol + h * 256 + c + 4);
                a += o0[0] * bflo(w[0]) + o0[1] * bfhi(w[0]) + o0[2] * bflo(w[1]) + o0[3] * bfhi(w[1]) + o1[0] * bflo(w[2]) + o1[1] * bfhi(w[2]) + o1[2] * bflo(w[3]) + o1[3] * bfhi(w[3]);
            }
            const float ga = bf2f(p.PBUF[(size_t)(R_PROMPT + b) * IN_COLS_PAD + C_GA + h * 64 + d]);
            p.AMA[(size_t)(NQ + b) * 512 + h * 64 + d] = f2bf(a * ga);
        }
        __syncthreads();
    }
}

__device__ __forceinline__ void merge_m_gemm(const Params& p, char* lds) {
    const int bx = blockIdx.x, vcu = (bx & 7) * 32 + (bx >> 3);
    OneTileOrder S{vcu, 1};
    {
        pg8::Gemm g{p.AMA, p.WOA_T, NQ, 1024, 512, p.AMA, p.WOA_T};
        EpiMerge<0> E{p.PBUF, p.TMP, p.MM};
        pg8::gemm_phase<EpiMerge<0>, OneTileOrder, false, true>((PG8_LAS unsigned char*)lds, g, S, E);
    }
    {
        pg8::Gemm g{p.AMB, p.WOB_T, NQ, 1024, 512, p.AMB, p.WOB_T};
        EpiMerge<1> E{p.PBUF, p.TMP, p.MM};
        pg8::gemm_phase<EpiMerge<1>, OneTileOrder, false, true>((PG8_LAS unsigned char*)lds, g, S, E);
    }
}

__device__ __forceinline__ void phase6(const Params& p, char* lds) {
    sample_combine(p, lds);
    merge_m_gemm(p, lds);
}

__device__ __forceinline__ float dot_bf16_row(const bf16_t* a, const bf16_t* w, int K) {
    float s = 0.f;
    for (int k = 0; k < K; k += 8) {
        const u32x4 x = *(const u32x4*)(a + k), y = *(const u32x4*)(w + k);
#pragma unroll
        for (int e = 0; e < 4; ++e) s += bflo(x[e]) * bflo(y[e]) + bfhi(x[e]) * bfhi(y[e]);
    }
    return s;
}
__device__ __forceinline__ void rows32_tile(f32x4 (&acc)[2], const bf16_t* __restrict__ X, int ldx, const bf16_t* __restrict__ W, int K, int nt) {
    const int lane = threadIdx.x & 63, lr = lane & 15, lg = lane >> 4;
    const bf16_t* x0 = X + (size_t)lr * ldx + lg * 8;
    const bf16_t* x1 = X + (size_t)(16 + lr) * ldx + lg * 8;
    const bf16_t* w = W + (size_t)(nt * 16 + lr) * K + lg * 8;
#pragma unroll 8
    for (int ks = 0; ks < (K >> 5); ++ks) {
        const bf16x8 wf = *(const bf16x8*)(w + ks * 32);
        acc[0] = mfma16(wf, *(const bf16x8*)(x0 + ks * 32), acc[0]);
        acc[1] = mfma16(wf, *(const bf16x8*)(x1 + ks * 32), acc[1]);
    }
}
__device__ __forceinline__ void sample_m(const Params& p) {
    const int lane = threadIdx.x & 63, lr = lane & 15, lg = lane >> 4;
    for (int nt = blockIdx.x * 8 + (threadIdx.x >> 6); nt < 64; nt += gridDim.x * 8) {
        f32x4 ya[2] = {{0.f, 0.f, 0.f, 0.f}, {0.f, 0.f, 0.f, 0.f}}, yb[2] = {{0.f, 0.f, 0.f, 0.f}, {0.f, 0.f, 0.f, 0.f}};
        rows32_tile(ya, p.AMA + (size_t)NQ * 512, 512, p.WOA_T, 512, nt);
        rows32_tile(yb, p.AMB + (size_t)NQ * 512, 512, p.WOB_T, 512, nt);
#pragma unroll
        for (int mt = 0; mt < 2; ++mt) {
            const int i = 16 * mt + lr, n = 16 * nt + 4 * lg;
            const size_t r = R_PROMPT + i;
            const u32x2 ga = *(const u32x2*)(p.PBUF + r * IN_COLS_PAD + C_MA + n);
            const u32x2 gb = *(const u32x2*)(p.PBUF + r * IN_COLS_PAD + C_MB + n);
            u32x2 w;
            w[0] = cvtpk(bflo(ga[0]) * ya[mt][0] + bflo(gb[0]) * yb[mt][0], bfhi(ga[0]) * ya[mt][1] + bfhi(gb[0]) * yb[mt][1]);
            w[1] = cvtpk(bflo(ga[1]) * ya[mt][2] + bflo(gb[1]) * yb[mt][2], bfhi(ga[1]) * ya[mt][3] + bfhi(gb[1]) * yb[mt][3]);
            *(u32x2*)(p.MM + (size_t)(NQ + i) * 1024 + n) = w;
        }
    }
}
__device__ __forceinline__ void final_gemm(const Params& p, char* lds) {
    const int bx = blockIdx.x, vcu = (bx & 7) * 32 + (bx >> 3);
    pg8::Gemm g{p.MM, p.WO_T, NQ, 1024, 1024, p.MM, p.WO_T};
    OneTileOrder S{vcu, 1};
    EpiFinal E{p.x_prompt, p.out + OFF_Y_P};
    pg8::gemm_phase<EpiFinal, OneTileOrder, false, true>((PG8_LAS unsigned char*)lds, g, S, E);
}

__device__ __forceinline__ void phase7(const Params& p, char* lds) {
    sample_m(p);
    final_gemm(p, lds);
}
__device__ __forceinline__ void phase8(const Params& p, char* lds) {
    const int lane = threadIdx.x & 63, lr = lane & 15, lg = lane >> 4;
    for (int nt = blockIdx.x * 8 + (threadIdx.x >> 6); nt < 64; nt += gridDim.x * 8) {
        f32x4 y[2] = {{0.f, 0.f, 0.f, 0.f}, {0.f, 0.f, 0.f, 0.f}};
        rows32_tile(y, p.MM + (size_t)NQ * 1024, 1024, p.WO_T, 1024, nt);
#pragma unroll
        for (int mt = 0; mt < 2; ++mt) {
            const int i = 16 * mt + lr, n = 16 * nt + 4 * lg;
            const f32x4 x = *(const f32x4*)(p.x_sample + (size_t)i * 1024 + n);
            *(f32x4*)(p.out + OFF_Y_S + (size_t)i * 1024 + n) = x + y[mt];
        }
    }
}

#define XB_TMO      128
#define XB_XCNT(j)  (256  + 64 * (j))
#define XB_XSUB(j)  (1280 + 64 * (j))
#define XB_XGEN(j)  (2304 + 64 * (j))
#define XB_TOP      3328
#define XB_TOPGEN   3392
#define XCD_BAR_WORDS 3456
#define XB_SPIN_CAP (1u << 22)
#define LAS __attribute__((address_space(3)))
__device__ __forceinline__ unsigned xb_ld(unsigned* p)              { return __hip_atomic_load(p, __ATOMIC_RELAXED, __HIP_MEMORY_SCOPE_AGENT); }
__device__ __forceinline__ unsigned xb_add(unsigned* p, unsigned v) { return __hip_atomic_fetch_add(p, v, __ATOMIC_RELAXED, __HIP_MEMORY_SCOPE_AGENT); }
__device__ __forceinline__ unsigned xb_xcc_id() { return (unsigned)__builtin_amdgcn_s_getreg((3 << 11) | 20) & 0xFu; }
#define XB_SPIN(cond, bar) do { unsigned _sp = 0; while (cond) { __builtin_amdgcn_s_sleep(1); \
    if ((++_sp & 255u) == 0u) { if (xb_ld(&(bar)[XB_TMO])) break; if (_sp > XB_SPIN_CAP) { atomicAdd(&(bar)[XB_TMO], 1u); break; } } } } while (0)
struct XcdBarrier { unsigned* bar; unsigned x; volatile LAS unsigned* st; };
__device__ __forceinline__ XcdBarrier xcd_barrier_post(unsigned* bar, volatile LAS unsigned* st) {
    XcdBarrier b; b.bar = bar; b.x = xb_xcc_id(); b.st = st;
    if (threadIdx.x == 0) (void)xb_add(&bar[XB_XCNT(b.x)], 1u);
    return b;
}
__device__ __forceinline__ void xcd_barrier_complete(unsigned* bar, unsigned x, unsigned& nloc, unsigned& nx) {
    const unsigned G = gridDim.x * gridDim.y * gridDim.z;
    unsigned sum, cnt, mine, sp = 0u;
    for (;;) {
        sum = 0u; cnt = 0u; mine = 0u;
#pragma unroll
        for (unsigned j = 0; j < 16; ++j) { const unsigned c = xb_ld(&bar[XB_XCNT(j)]); sum += c; cnt += (c > 0u) ? 1u : 0u; mine = (j == x) ? c : mine; }
        if (sum == G) break;
        __builtin_amdgcn_s_sleep(1);
        if ((++sp & 255u) == 0u) { if (xb_ld(&bar[XB_TMO])) break; if (sp > XB_SPIN_CAP) { atomicAdd(&bar[XB_TMO], 1u); break; } }
    }
    nloc = mine > 0u ? mine : 1u; nx = cnt > 0u ? cnt : 1u;
}
__device__ __forceinline__ void xcd_barrier(const XcdBarrier& b) {
    asm volatile("s_waitcnt vmcnt(0)" ::: "memory");
    __syncthreads();
    if (threadIdx.x == 0) {
        unsigned* bar = b.bar;
        __builtin_amdgcn_s_waitcnt(0);
        unsigned nloc = b.st[0], nx = b.st[1];
        if (nloc == 0u) { xcd_barrier_complete(bar, b.x, nloc, nx); b.st[0] = nloc; b.st[1] = nx; }
        const unsigned old = xb_add(&bar[XB_XSUB(b.x)], 1u);
        const unsigned gen = old / nloc;
        if (old + 1u == (gen + 1u) * nloc) {
            __builtin_amdgcn_fence(__ATOMIC_RELEASE, "agent");
            asm volatile("s_waitcnt vmcnt(0)" ::: "memory");
            const unsigned og = xb_add(&bar[XB_TOP], 1u);
            const unsigned tg = og / nx;
            if (og + 1u == (tg + 1u) * nx) xb_add(&bar[XB_TOPGEN], 1u);
            else XB_SPIN(xb_ld(&bar[XB_TOPGEN]) == tg, bar);
            __builtin_amdgcn_fence(__ATOMIC_ACQUIRE, "agent");
            xb_add(&bar[XB_XGEN(b.x)], 1u);
            asm volatile("s_waitcnt vmcnt(0)" ::: "memory");
        } else {
            XB_SPIN(xb_ld(&bar[XB_XGEN(b.x)]) == gen, bar);
            __builtin_amdgcn_fence(__ATOMIC_ACQUIRE, "agent");
            asm volatile("s_waitcnt vmcnt(0)" ::: "memory");
        }
    }
    __syncthreads();
}

#define LDS_BYTES 155648
extern __shared__ __attribute__((aligned(16))) char smem[];
#define NPHASES 9

#define XB_LDS_OFF (LDS_BYTES - 16)
__global__ void __launch_bounds__(NTHREADS) mega(Params p, int ph0, int ph1) {
    XcdBarrier xb;
    const bool multi = (ph1 - ph0) > 1;
    if (multi) {
        if (threadIdx.x == 0) *(u32x4*)(smem + XB_LDS_OFF) = (u32x4){0u, 0u, 0u, 0u};
        __syncthreads();
        xb = xcd_barrier_post(p.bar, (volatile LAS unsigned*)(smem + XB_LDS_OFF));
    }
#define RUN_PHASE(k) if (ph0 <= k && k < ph1) { phase##k(p, smem); if (k + 1 < ph1) xcd_barrier(xb); }
    RUN_PHASE(0)
    RUN_PHASE(1)
    RUN_PHASE(2)
    RUN_PHASE(3)
    RUN_PHASE(4)
    RUN_PHASE(5)
    RUN_PHASE(6)
    RUN_PHASE(7)
    RUN_PHASE(8)
}

static inline size_t align_up(size_t x, size_t a) { return (x + a - 1) / a * a; }

extern "C" void kernel_launch(void* const* d_in, const int* in_sizes, int n_in,
                              void* d_out, int out_size, void* d_ws, size_t ws_size,
                              hipStream_t stream) {
    Params p{};
    p.x_prompt = (const float*)d_in[0]; p.x_sample = (const float*)d_in[1]; p.cache_latent = (const float*)d_in[2]; p.cache_krope = (const float*)d_in[3];
    p.state_hgrn = (const float*)d_in[4]; p.page_table = (const int*)d_in[5]; p.meta = (const float*)d_in[6]; p.norm_g = (const float*)d_in[7];
    p.w_in = (const float*)d_in[8]; p.g_cq = (const float*)d_in[9]; p.w_uq = (const float*)d_in[10]; p.g_ckv = (const float*)d_in[11];
    p.w_uk = (const float*)d_in[12]; p.w_uv = (const float*)d_in[13]; p.g_qn = (const float*)d_in[14]; p.g_kn = (const float*)d_in[15];
    p.lb_logits = (const float*)d_in[16]; p.g_bn = (const float*)d_in[17]; p.w_oa = (const float*)d_in[18]; p.w_ob = (const float*)d_in[19]; p.w_o = (const float*)d_in[20];
    p.out = (float*)d_out;
    char* w = (char*)d_ws; size_t off = 0;
    auto take = [&](size_t bytes) { char* r = w + off; off = align_up(off + bytes, 256); return r; };
    p.bar    = (unsigned*)take(16384);
    p.XN     = (bf16_t*)take((size_t)R_PAD * 1024 * 2);
    p.WIN_T  = (bf16_t*)take((size_t)IN_COLS_PAD * 1024 * 2);
    p.PBUF   = (bf16_t*)take((size_t)R_PAD * IN_COLS_PAD * 2);
    p.F32A   = (float*)take((size_t)R_PAD * 672 * 4);
    p.GLOG   = (float*)take((size_t)R_PAD * 512 * 4);
    p.CQN    = (bf16_t*)take((size_t)R_PAD * 384 * 2);
    p.CKVN   = (bf16_t*)take((size_t)R_PAD * 256 * 2);
    p.KRR    = (float*)take((size_t)R_PAD * 32 * 4);
    p.WUQ_T  = (bf16_t*)take((size_t)768 * 384 * 2);
    p.WUKV_T = (bf16_t*)take((size_t)1024 * 256 * 2);
    p.WOA_T  = (bf16_t*)take((size_t)1024 * 512 * 2);
    p.WOB_T  = (bf16_t*)take((size_t)1024 * 512 * 2);
    p.WO_T   = (bf16_t*)take((size_t)1024 * 1024 * 2);
    p.QRAW   = (bf16_t*)take((size_t)R_PAD * 768 * 2);
    p.KVRAW  = (bf16_t*)take((size_t)R_PAD * 1024 * 2);
    p.QA     = (bf16_t*)take((size_t)8 * 8 * 2048 * 96 * 2);
    p.KA     = (bf16_t*)take((size_t)8 * 8 * 2064 * 96 * 2 + 65536);
    p.QS     = (float*)take((size_t)32 * 8 * 96 * 4);
    p.KSRAW  = (float*)take((size_t)32 * 8 * 96 * 4);
    p.AMA    = (bf16_t*)take((size_t)MROWS_PAD * 512 * 2);
    p.AMB    = (bf16_t*)take((size_t)MROWS_PAD * 512 * 2);
    p.MM     = (bf16_t*)take((size_t)MROWS_PAD * 1024 * 2);
    p.TMP    = (float*)take((size_t)NQ * 1024 * 4);
    p.UT     = (float*)take((size_t)32 * NCHUNK * 16384 * 4);
    p.ST     = (bf16_t*)take((size_t)32 * NCHUNK * 16384 * 2);
    p.DEC    = (float*)take((size_t)32 * NCHUNK * 128 * 4);
    p.LB     = (float*)take(512 * 4);
    p.INV    = (float*)take(64);
    p.SCAL   = (float*)take(64);
    p.PART   = (float*)take((size_t)32 * 8 * 8 * 256 * 4);
    p.PL     = (float*)take((size_t)32 * 8 * 8 * 4);
    p.OLAT   = (float*)take((size_t)32 * 8 * 256 * 4);
    (void)ws_size; (void)in_sizes; (void)n_in; (void)out_size;
    static int mode = -1;
    if (mode < 0) {
        (void)hipFuncSetAttribute((const void*)mega, hipFuncAttributeMaxDynamicSharedMemorySize, LDS_BYTES);
        int dev = 0, cus = 0, per_cu = 0;
        (void)hipGetDevice(&dev);
        (void)hipDeviceGetAttribute(&cus, hipDeviceAttributeMultiprocessorCount, dev);
        (void)hipOccupancyMaxActiveBlocksPerMultiprocessor(&per_cu, (const void*)mega, NTHREADS, LDS_BYTES);
        mode = (cus * per_cu >= 256) ? 1 : 0;
    }
    if (mode == 1) {
        (void)hipMemsetAsync(p.bar, 0, 16384, stream);
        mega<<<dim3(256), dim3(NTHREADS), LDS_BYTES, stream>>>(p, 0, NPHASES);
    } else {
        for (int ph = 0; ph < NPHASES; ++ph) mega<<<dim3(256), dim3(NTHREADS), LDS_BYTES, stream>>>(p, ph, ph + 1);
    }
}
```

```cpp
#include <hip/hip_runtime.h>
#include <stdint.h>

#define D_MODEL 1024
#define BATCH 8
#define SEQ 2048
#define NMETA 16
#define LTOT 2064
#define DEC_BATCH 32
#define PAST_LEN 16384
#define PAGE 128
#define NPAGES 128
#define A_HEADS 8
#define A_NOPE 64
#define A_ROPE 32
#define A_QK 96
#define A_V 64
#define Q_LORA 384
#define KV_LORA 256
#define B_HEADS 4
#define B_DK 128
#define B_DV 128
#define IN_COLS 5280
#define IN_COLS_PAD 5376
#define EPSF 1e-6f

#define C_CQ 0
#define C_CKV 384
#define C_KR 640
#define C_BQ 672
#define C_BF 1184
#define C_BI 1696
#define C_GA 2208
#define C_GB 2720
#define C_MA 3232
#define C_MB 4256
#define C_END 5280

#define R_PROMPT 16512
#define R_ALL 16544
#define R_PAD 16640
#define NQ 16384
#define MROWS 16416
#define MROWS_PAD 16512

#define OFF_Y_P 0
#define OFF_Y_S 16777216
#define OFF_LAT_P 16809984
#define OFF_KR_P 21037056
#define OFF_HG_P 21565440
#define OFF_LAT_S 22089728
#define OFF_KR_S 22097920
#define OFF_HG_S 22098944
#define OUT_TOTAL 24196096

#define NTHREADS 512
#define LDS_BYTES 155648
#define LDS_ITEM_OFF (LDS_BYTES - 32)
#define NCHUNK 33

typedef unsigned short bf16_t;
typedef short bf16x8 __attribute__((ext_vector_type(8)));
typedef float f32x4 __attribute__((ext_vector_type(4)));
typedef float f32x2 __attribute__((ext_vector_type(2)));
typedef unsigned u32x4 __attribute__((ext_vector_type(4)));
typedef unsigned u32x2 __attribute__((ext_vector_type(2)));
typedef __bf16 bf16x2_t __attribute__((ext_vector_type(2)));

__device__ __forceinline__ unsigned cvtpk(float lo, float hi) {
    f32x2 v = {lo, hi};
    bf16x2_t b = __builtin_convertvector(v, bf16x2_t);
    return __builtin_bit_cast(unsigned, b);
}
__device__ __forceinline__ bf16_t f2bf(float x) { return (bf16_t)(cvtpk(x, 0.f) & 0xffffu); }
__device__ __forceinline__ float bf2f(bf16_t u) { return __uint_as_float(((unsigned)u) << 16); }
__device__ __forceinline__ float bflo(unsigned w) { return __uint_as_float(w << 16); }
__device__ __forceinline__ float bfhi(unsigned w) { return __uint_as_float(w & 0xffff0000u); }
__device__ __forceinline__ float sigmoidf_(float x) { return 1.0f / (1.0f + __expf(-x)); }
__device__ __forceinline__ float siluf_(float x) { return x / (1.0f + __expf(-x)); }
__device__ __forceinline__ float wave_sum(float v) {
    v += __shfl_xor(v, 32); v += __shfl_xor(v, 16); v += __shfl_xor(v, 8);
    v += __shfl_xor(v, 4);  v += __shfl_xor(v, 2);  v += __shfl_xor(v, 1);
    return v;
}

struct Params {
    const float* x_prompt; const float* x_sample; const float* cache_latent; const float* cache_krope;
    const float* state_hgrn; const int* page_table; const float* meta; const float* norm_g;
    const float* w_in; const float* g_cq; const float* w_uq; const float* g_ckv; const float* w_uk; const float* w_uv;
    const float* g_qn; const float* g_kn; const float* lb_logits; const float* g_bn;
    const float* w_oa; const float* w_ob; const float* w_o;
    float* out;
    bf16_t* XN;
    bf16_t* WIN_T;
    bf16_t* PBUF;
    float*  F32A;
    float*  GLOG;
    bf16_t* CQN;
    bf16_t* CKVN;
    float*  KRR;
    bf16_t* WUQ_T;
    bf16_t* WUKV_T;
    bf16_t* WUKVG_T;
    float*  F32B;
    bf16_t* WOA_T;
    bf16_t* WOB_T;
    bf16_t* WO_T;
    bf16_t* QRAW;
    bf16_t* KVRAW;
    bf16_t* QA;
    bf16_t* KA;
    bf16_t* VTG;
    float*  QS;
    float*  KSRAW;
    bf16_t* AMA;
    bf16_t* AMB;
    bf16_t* MM;
    float*  TMP;
    bf16_t* UT;
    bf16_t* ST;
    float*  DEC;
    float*  LB;
    float*  INV;
    float*  ROPE;
    float*  SCAL;
    float*  PART;
    float*  PL;
    float*  OLAT;
    unsigned* bar;
};

__device__ __forceinline__ f32x4 mfma16(bf16x8 w, bf16x8 x, f32x4 acc) {
    return __builtin_amdgcn_mfma_f32_16x16x32_bf16(w, x, acc, 0, 0, 0);
}

#define GT_LD 144
#define GT_BUF (128 * GT_LD)
#define GT_LDS_BYTES (4 * GT_BUF)

__device__ __forceinline__ void gemm_tile_accum(f32x4 (&acc)[4][2], const bf16_t* __restrict__ X, int ldx, const bf16_t* __restrict__ W, int ldw,
                                                int K, char* lds) {
    const int tid = threadIdx.x, lane = tid & 63, wid = tid >> 6, wm = wid >> 2, wn = wid & 3;
    const int lr = lane & 15, lg = lane >> 4;
    const int r0 = tid >> 3, kc = tid & 7;
    const bf16_t* xp0 = X + (size_t)r0 * ldx + kc * 8;
    const bf16_t* xp1 = X + (size_t)(r0 + 64) * ldx + kc * 8;
    const bf16_t* wp0 = W + (size_t)r0 * ldw + kc * 8;
    const bf16_t* wp1 = W + (size_t)(r0 + 64) * ldw + kc * 8;
    const int so0 = r0 * GT_LD + kc * 16, so1 = (r0 + 64) * GT_LD + kc * 16;
    char* Xs = lds; char* Ws = lds + 2 * GT_BUF;
    const int nk = K >> 6;
    u32x4 a0 = *(const u32x4*)xp0, a1 = *(const u32x4*)xp1, b0 = *(const u32x4*)wp0, b1 = *(const u32x4*)wp1;
    *(u32x4*)(Xs + so0) = a0; *(u32x4*)(Xs + so1) = a1; *(u32x4*)(Ws + so0) = b0; *(u32x4*)(Ws + so1) = b1;
    __syncthreads();
    const int xoff = (wm * 64 + lr) * GT_LD + lg * 16;
    const int woff = (wn * 32 + lr) * GT_LD + lg * 16;
    for (int kt = 0; kt < nk; ++kt) {
        const int cur = kt & 1;
        if (kt + 1 < nk) {
            const int ko = (kt + 1) * 64;
            a0 = *(const u32x4*)(xp0 + ko); a1 = *(const u32x4*)(xp1 + ko); b0 = *(const u32x4*)(wp0 + ko); b1 = *(const u32x4*)(wp1 + ko);
        }
        const char* xs = Xs + cur * GT_BUF + xoff;
        const char* ws = Ws + cur * GT_BUF + woff;
#pragma unroll
        for (int ks = 0; ks < 2; ++ks) {
            bf16x8 xf[4], wf[2];
#pragma unroll
            for (int mt = 0; mt < 4; ++mt) xf[mt] = *(const bf16x8*)(xs + mt * 16 * GT_LD + ks * 64);
#pragma unroll
            for (int nt = 0; nt < 2; ++nt) wf[nt] = *(const bf16x8*)(ws + nt * 16 * GT_LD + ks * 64);
#pragma unroll
            for (int mt = 0; mt < 4; ++mt)
#pragma unroll
                for (int nt = 0; nt < 2; ++nt) acc[mt][nt] = mfma16(wf[nt], xf[mt], acc[mt][nt]);
        }
        if (kt + 1 < nk) {
            char* xd = Xs + (cur ^ 1) * GT_BUF; char* wd = Ws + (cur ^ 1) * GT_BUF;
            *(u32x4*)(xd + so0) = a0; *(u32x4*)(xd + so1) = a1; *(u32x4*)(wd + so0) = b0; *(u32x4*)(wd + so1) = b1;
        }
        __syncthreads();
    }
}

namespace pg8 {
#define PG8_LAS __attribute__((address_space(3)))
constexpr int BM = 256, BK = 64, HALF = 128, HTB = HALF * BK * 2  , STAGE_BYTES = 8 * HTB, NXCD = 8, WGM = 8;

__host__ __device__ __forceinline__ int lds_byte(int r, int c) { const int st = (r >> 4) * 2 + (c >> 5), rr = r & 15, cc = c & 31, ob = rr * 64 + cc * 2; return st * 1024 + (ob ^ (((ob >> 9) & 1) << 5)); }
__host__ __device__ __forceinline__ void stage_rc(int b, int& R, int& C) { const int st = b / 1024, sb = b % 1024, swz = sb ^ (((sb >> 9) & 1) << 5); R = (st >> 1) * 16 + swz / 64; C = (st & 1) * 32 + (swz % 64) / 2; }
__host__ __device__ __forceinline__ int perm32(int rho) { const int n = rho >> 4, i = rho & 15; return 8 * (i >> 2) + 4 * n + (i & 3); }

struct Unit { int pm, pn, sel; };
struct Gemm { const bf16_t* A; const bf16_t* Bt; int M, N, K; const bf16_t* A1; const bf16_t* Bt1; };

struct StaticOrder {
    int nM, nN, nwg, G, c;
    __host__ __device__ void init(int M, int N, int G_, int c_) { nM = M / BM; nN = N / BM; nwg = nM * nN; G = G_; c = c_; }
    __host__ __device__ bool next(int i, Unit& u) const {
        const long L = (long)i * G + c; if (L >= nwg) return false;
        int wgid = (int)L; { const int q = nwg / NXCD, r = nwg % NXCD, xcd = wgid % NXCD, off = wgid / NXCD; wgid = (xcd < r ? xcd * (q + 1) : r * (q + 1) + (xcd - r) * q) + off; }
        const int nig = WGM * nN, gid = wgid / nig, fm = gid * WGM, gsz = (nM - fm) < WGM ? (nM - fm) : WGM;
        u.pm = fm + ((wgid % nig) % gsz); u.pn = (wgid % nig) / gsz; u.sel = 0; return true;
    }
    __device__ __forceinline__ void a_ready(const Unit&) const {}
    __device__ __forceinline__ void done(const Unit&) const {}
};


template <class Epi, class Sched, bool ALIGN_EPI = false, bool SP2 = false>
__device__ __forceinline__ void gemm_phase(PG8_LAS unsigned char* lds, const Gemm g, const Sched& S, const Epi& E) {
    const int tid = threadIdx.x, wid = __builtin_amdgcn_readfirstlane(tid >> 6), lane = tid & 63, wr = wid >> 2, wc = wid & 3, fr = lane & 15, fq = lane >> 4;
    const int K = g.K, nt = K / BK;
    unsigned voffA[2], voffB[2];
#pragma unroll
    for (int i = 0; i < 2; ++i) { int R, C; stage_rc(tid * 16 + i * 8192, R, C); const int Rb = Epi::PERM ? ((R & ~31) + perm32(R & 31)) : R;
        voffA[i] = (unsigned)(R * K + C) * 2u; voffB[i] = (unsigned)(Rb * K + C) * 2u; }
    const size_t kstep = (size_t)(BK * 2);
    const size_t hstep = (size_t)HALF * K * 2;
    const size_t tstep = 2 * hstep;
    const unsigned ldsw = (unsigned)wid * 1024u;
    const int aoff = lds_byte(wr * 64 + fr, fq * 8), boff = lds_byte(wc * 32 + fr, fq * 8);
#define PG8_SA(b, h) (((b) * 2 + (h)) * HTB)
#define PG8_SB(b, h) ((4 + (b) * 2 + (h)) * HTB)
#define PG8_STAGE(bufoff, gbase, voff) do { _Pragma("unroll") for (int _i = 0; _i < 2; ++_i) \
        __builtin_amdgcn_global_load_lds((const unsigned*)((const char*)(gbase) + (voff)[_i]), (PG8_LAS unsigned*)(lds + (bufoff) + ldsw + _i * 8192), 16, 0, 0); } while (0)
#define PG8_LDA(dst, b, h) do { _Pragma("unroll") for (int m = 0; m < 4; ++m) _Pragma("unroll") for (int k = 0; k < 2; ++k) dst[m][k] = *(const PG8_LAS bf16x8*)(lds + PG8_SA(b, h) + aoff + m * 2048 + k * 1024); } while (0)
#define PG8_LDB(dst, b, h) do { _Pragma("unroll") for (int n = 0; n < 2; ++n) _Pragma("unroll") for (int k = 0; k < 2; ++k) dst[n][k] = *(const PG8_LAS bf16x8*)(lds + PG8_SB(b, h) + boff + n * 2048 + k * 1024); } while (0)
#define PG8_MMA(ai, bj, At, Bt) do { __builtin_amdgcn_s_setprio(1); _Pragma("unroll") for (int m = 0; m < 4; ++m) _Pragma("unroll") for (int n = 0; n < 2; ++n) _Pragma("unroll") for (int k = 0; k < 2; ++k) \
        acc[ai][bj][m][n] = __builtin_amdgcn_mfma_f32_16x16x32_bf16(Bt[n][k], At[m][k], acc[ai][bj][m][n], 0, 0, 0); __builtin_amdgcn_s_setprio(0); } while (0)
#define PG8_WAIT_V(n) asm volatile("s_waitcnt vmcnt(" #n ")" ::: "memory")
#define PG8_WAIT_L(n) asm volatile("s_waitcnt lgkmcnt(" #n ")" ::: "memory")
#define PG8_BAR __builtin_amdgcn_s_barrier()
#define PG8_SCHED __builtin_amdgcn_sched_barrier(0)
    Unit cur, nxt; int ui = 0;
    if (!S.next(0, cur)) return;
    f32x4 acc[2][2][4][2];
#pragma unroll
    for (int a = 0; a < 2; ++a)
#pragma unroll
        for (int b = 0; b < 2; ++b)
#pragma unroll
            for (int m = 0; m < 4; ++m)
#pragma unroll
                for (int n = 0; n < 2; ++n) acc[a][b][m][n] = (f32x4){0.f, 0.f, 0.f, 0.f};
    bf16x8 At[4][2], B0[2][2], B1[2][2];
    const char* cA = (const char*)(cur.sel ? g.A1 : g.A) + (size_t)cur.pm * tstep; const char* cB = (const char*)(cur.sel ? g.Bt1 : g.Bt) + (size_t)cur.pn * tstep;
    S.a_ready(cur);
    if constexpr (SP2) {
        PG8_STAGE(PG8_SB(0, 0), cB, voffB); PG8_STAGE(PG8_SB(0, 1), cB + hstep, voffB); PG8_STAGE(PG8_SA(0, 0), cA, voffA); PG8_STAGE(PG8_SA(0, 1), cA + hstep, voffA);
        if (wr == 1) PG8_BAR;
        PG8_WAIT_V(2); PG8_BAR;
        PG8_STAGE(PG8_SB(1, 0), cB + kstep, voffB); PG8_STAGE(PG8_SA(1, 0), cA + kstep, voffA); PG8_STAGE(PG8_SB(1, 1), cB + hstep + kstep, voffB);
        PG8_WAIT_V(6); PG8_BAR;
    } else {
        PG8_STAGE(PG8_SB(0, 0), cB, voffB); PG8_STAGE(PG8_SA(0, 0), cA, voffA); PG8_STAGE(PG8_SB(0, 1), cB + hstep, voffB); PG8_STAGE(PG8_SA(0, 1), cA + hstep, voffA);
        if (wr == 1) PG8_BAR;
        PG8_WAIT_V(4); PG8_BAR;
        PG8_STAGE(PG8_SB(1, 0), cB + kstep, voffB); PG8_STAGE(PG8_SA(1, 0), cA + kstep, voffA); PG8_STAGE(PG8_SB(1, 1), cB + hstep + kstep, voffB);
        PG8_WAIT_V(6); PG8_BAR;
    }
    for (;;) {
        const bool has_next = S.next(ui + 1, nxt);
        const char* nA = has_next ? (const char*)(nxt.sel ? g.A1 : g.A) + (size_t)nxt.pm * tstep : cA; const char* nB = has_next ? (const char*)(nxt.sel ? g.Bt1 : g.Bt) + (size_t)nxt.pn * tstep : cB;
        for (int t = 0; t < nt; t += 2) {
            const bool last = (t == nt - 2);
            const char* a1 = cA + (size_t)(t + 1) * kstep;
            const char* a2 = last ? nA : cA + (size_t)(t + 2) * kstep; const char* b2 = last ? nB : cB + (size_t)(t + 2) * kstep;
            const char* a3 = a2 + kstep; const char* b3 = b2 + kstep;
            if (last && has_next) S.a_ready(nxt);
            if constexpr (SP2) {
            PG8_LDB(B0, 0, 0); PG8_LDB(B1, 0, 1); PG8_SCHED; PG8_LDA(At, 0, 0); PG8_STAGE(PG8_SA(1, 1), a1 + hstep, voffA);
            PG8_WAIT_V(8); PG8_WAIT_L(0); PG8_BAR; PG8_MMA(0, 0, At, B0); PG8_MMA(0, 1, At, B1); PG8_BAR; PG8_SCHED;
            PG8_LDA(At, 0, 1); PG8_STAGE(PG8_SB(0, 0), b2, voffB); PG8_STAGE(PG8_SB(0, 1), b2 + hstep, voffB); PG8_STAGE(PG8_SA(0, 0), a2, voffA);
            PG8_WAIT_V(8); PG8_WAIT_L(0); PG8_BAR; PG8_MMA(1, 0, At, B0); PG8_MMA(1, 1, At, B1); PG8_BAR; PG8_SCHED;
            PG8_LDB(B0, 1, 0); PG8_LDB(B1, 1, 1); PG8_SCHED; PG8_LDA(At, 1, 0); PG8_STAGE(PG8_SA(0, 1), a2 + hstep, voffA);
            PG8_WAIT_V(8); PG8_WAIT_L(0); PG8_BAR; PG8_MMA(0, 0, At, B0); PG8_MMA(0, 1, At, B1); PG8_BAR; PG8_SCHED;
            PG8_LDA(At, 1, 1); PG8_STAGE(PG8_SB(1, 0), b3, voffB); PG8_STAGE(PG8_SB(1, 1), b3 + hstep, voffB); PG8_STAGE(PG8_SA(1, 0), a3, voffA);
            PG8_WAIT_V(8); PG8_WAIT_L(0); PG8_BAR; PG8_MMA(1, 0, At, B0); PG8_MMA(1, 1, At, B1); PG8_BAR; PG8_SCHED;
            } else {
            PG8_LDB(B0, 0, 0); PG8_SCHED; PG8_LDA(At, 0, 0); PG8_STAGE(PG8_SA(1, 1), a1 + hstep, voffA);
            PG8_WAIT_L(8); PG8_BAR; PG8_WAIT_L(0); PG8_MMA(0, 0, At, B0); PG8_BAR; PG8_SCHED;
            PG8_LDB(B1, 0, 1); PG8_STAGE(PG8_SB(0, 0), b2, voffB);
            PG8_BAR; PG8_WAIT_L(0); PG8_MMA(0, 1, At, B1); PG8_BAR;
            PG8_LDA(At, 0, 1); PG8_STAGE(PG8_SA(0, 0), a2, voffA);
            PG8_BAR; PG8_WAIT_L(0); PG8_MMA(1, 0, At, B0); PG8_BAR; PG8_SCHED;
            PG8_STAGE(PG8_SB(0, 1), b2 + hstep, voffB);
            PG8_WAIT_V(6); PG8_BAR; PG8_MMA(1, 1, At, B1); PG8_BAR;
            PG8_LDB(B0, 1, 0); PG8_SCHED; PG8_LDA(At, 1, 0); PG8_STAGE(PG8_SA(0, 1), a2 + hstep, voffA);
            PG8_WAIT_L(8); PG8_BAR; PG8_WAIT_L(0); PG8_MMA(0, 0, At, B0); PG8_BAR; PG8_SCHED;
            PG8_LDB(B1, 1, 1); PG8_STAGE(PG8_SB(1, 0), b3, voffB);
            PG8_BAR; PG8_WAIT_L(0); PG8_MMA(0, 1, At, B1); PG8_BAR;
            PG8_LDA(At, 1, 1); PG8_STAGE(PG8_SA(1, 0), a3, voffA);
            PG8_BAR; PG8_WAIT_L(0); PG8_MMA(1, 0, At, B0); PG8_BAR; PG8_SCHED;
            PG8_STAGE(PG8_SB(1, 1), b3 + hstep, voffB);
            PG8_WAIT_V(6); PG8_BAR; PG8_MMA(1, 1, At, B1); PG8_BAR;
            }
        }
        if constexpr (ALIGN_EPI) { if (wr == 0) PG8_BAR; }
        if constexpr (!Epi::AFTER_DRAIN) { E(acc, cur, wr, wc, fr, fq); S.done(cur); }
        if (!has_next) break;
        if (!Epi::keep(cur)) {
#pragma unroll
        for (int a = 0; a < 2; ++a)
#pragma unroll
            for (int b = 0; b < 2; ++b)
#pragma unroll
                for (int m = 0; m < 4; ++m)
#pragma unroll
                    for (int n = 0; n < 2; ++n) acc[a][b][m][n] = (f32x4){0.f, 0.f, 0.f, 0.f};
        }
        cur = nxt; cA = nA; cB = nB; ++ui;
        if constexpr (ALIGN_EPI) { if (wr == 1) PG8_BAR; }
    }
    PG8_WAIT_V(0);
    if constexpr (!ALIGN_EPI) { if (wr == 0) PG8_BAR; }
    PG8_BAR;
    if constexpr (Epi::AFTER_DRAIN) { E.fused(acc, cur, wr, wc, fr, fq, lds, wid, lane); S.done(cur); }
#undef PG8_SA
#undef PG8_SB
#undef PG8_STAGE
#undef PG8_LDA
#undef PG8_LDB
#undef PG8_MMA
#undef PG8_WAIT_V
#undef PG8_WAIT_L
#undef PG8_BAR
#undef PG8_SCHED
}
}

struct EpiInProj {
    static constexpr bool PERM = true, AFTER_DRAIN = false;
    static __device__ __forceinline__ bool keep(const pg8::Unit&) { return false; }
    float* F32B; float* GLOG; bf16_t* PBUF; const float* LB; bf16_t* CQN; bf16_t* CKVN;
    __device__ __forceinline__ void operator()(f32x4 (&acc)[2][2][4][2], const pg8::Unit& u, int wr, int wc, int fr, int fq) const {
#pragma unroll
        for (int bj = 0; bj < 2; ++bj) {
            const int nseg = u.pn * 256 + bj * 128 + wc * 32;
            if (nseg >= C_END) continue;
            const int c = nseg + 8 * fq;
            f32x4 lb0 = {0.f, 0.f, 0.f, 0.f}, lb1 = {0.f, 0.f, 0.f, 0.f};
            if (nseg >= C_BF && nseg < C_BI) { lb0 = *(const f32x4*)(LB + (c - C_BF)); lb1 = *(const f32x4*)(LB + (c - C_BF) + 4); }
#pragma unroll
            for (int ai = 0; ai < 2; ++ai)
#pragma unroll
                for (int m = 0; m < 4; ++m) {
                    const size_t r = (size_t)u.pm * 256 + ai * 128 + wr * 64 + m * 16 + fr;
                    const f32x4 v0 = acc[ai][bj][m][0], v1 = acc[ai][bj][m][1];
                    if (nseg < C_BQ) {
                        if (nseg >= C_CKV) { *(f32x4*)(F32B + r * 288 + (c - C_CKV)) = v0; *(f32x4*)(F32B + r * 288 + (c - C_CKV) + 4) = v1; }
                        if (nseg < C_KR) {
                            u32x4 w; w[0] = cvtpk(v0[0], v0[1]); w[1] = cvtpk(v0[2], v0[3]); w[2] = cvtpk(v1[0], v1[1]); w[3] = cvtpk(v1[2], v1[3]);
                            if (nseg < C_CKV) *(u32x4*)(CQN + r * 384 + c) = w; else *(u32x4*)(CKVN + r * 256 + (c - C_CKV)) = w;
                        }
                        continue;
                    }
                    f32x4 o0, o1;
                    if (nseg < C_BF) {
#pragma unroll
                        for (int e = 0; e < 4; ++e) { o0[e] = siluf_(v0[e]); o1[e] = siluf_(v1[e]); }
                    } else if (nseg < C_BI) {
                        f32x4 l0, l1;
#pragma unroll
                        for (int e = 0; e < 4; ++e) {
                            const float sg0 = 1.0f / (1.0f + expf(-v0[e])), sg1 = 1.0f / (1.0f + expf(-v1[e]));
                            l0[e] = logf(lb0[e] + (1.0f - lb0[e]) * sg0); l1[e] = logf(lb1[e] + (1.0f - lb1[e]) * sg1);
                            o0[e] = (1.0f - lb0[e]) * (1.0f - sg0); o1[e] = (1.0f - lb1[e]) * (1.0f - sg1);
                        }
                        *(f32x4*)(GLOG + r * 512 + (c - C_BF)) = l0; *(f32x4*)(GLOG + r * 512 + (c - C_BF) + 4) = l1;
                    } else if (nseg < C_GA) {
                        o0 = v0; o1 = v1;
                    } else if (nseg < C_MA) {
#pragma unroll
                        for (int e = 0; e < 4; ++e) { o0[e] = siluf_(v0[e]); o1[e] = siluf_(v1[e]); }
                    } else {
#pragma unroll
                        for (int e = 0; e < 4; ++e) { o0[e] = sigmoidf_(v0[e]); o1[e] = sigmoidf_(v1[e]); }
                    }
                    u32x4 w; w[0] = cvtpk(o0[0], o0[1]); w[1] = cvtpk(o0[2], o0[3]); w[2] = cvtpk(o1[0], o1[1]); w[3] = cvtpk(o1[2], o1[3]);
                    *(u32x4*)(PBUF + r * IN_COLS_PAD + c) = w;
                    asm volatile("" ::: "memory");
                }
        }
    }
};
template <int STAGE> struct EpiMerge {
    static constexpr bool PERM = true, AFTER_DRAIN = false;
    static __device__ __forceinline__ bool keep(const pg8::Unit&) { return false; }
    const bf16_t* PBUF; float* TMP; bf16_t* MM;
    __device__ __forceinline__ void operator()(f32x4 (&acc)[2][2][4][2], const pg8::Unit& u, int wr, int wc, int fr, int fq) const {
#pragma unroll
        for (int ai = 0; ai < 2; ++ai)
#pragma unroll
            for (int m = 0; m < 4; ++m) {
                const int mq = u.pm * 256 + ai * 128 + wr * 64 + m * 16 + fr;
                const size_t r = (size_t)(mq >> 11) * LTOT + NMETA + (mq & 2047);
#pragma unroll
                for (int bj = 0; bj < 2; ++bj) {
                    const int c = u.pn * 256 + bj * 128 + wc * 32 + 8 * fq;
                    const u32x4 g = *(const u32x4*)(PBUF + r * IN_COLS_PAD + (STAGE == 0 ? C_MA : C_MB) + c);
                    const f32x4 v0 = acc[ai][bj][m][0], v1 = acc[ai][bj][m][1];
                    f32x4 o0, o1;
                    o0[0] = v0[0] * bflo(g[0]); o0[1] = v0[1] * bfhi(g[0]); o0[2] = v0[2] * bflo(g[1]); o0[3] = v0[3] * bfhi(g[1]);
                    o1[0] = v1[0] * bflo(g[2]); o1[1] = v1[1] * bfhi(g[2]); o1[2] = v1[2] * bflo(g[3]); o1[3] = v1[3] * bfhi(g[3]);
                    if (STAGE == 0) {
                        u32x4 w; w[0] = cvtpk(o0[0], o0[1]); w[1] = cvtpk(o0[2], o0[3]); w[2] = cvtpk(o1[0], o1[1]); w[3] = cvtpk(o1[2], o1[3]);
                        *(u32x4*)(MM + (size_t)mq * 1024 + c) = w;
                    }
                    else {
                        const u32x4 tw = *(const u32x4*)(MM + (size_t)mq * 1024 + c);
                        f32x4 t0, t1;
                        t0[0] = bflo(tw[0]); t0[1] = bfhi(tw[0]); t0[2] = bflo(tw[1]); t0[3] = bfhi(tw[1]);
                        t1[0] = bflo(tw[2]); t1[1] = bfhi(tw[2]); t1[2] = bflo(tw[3]); t1[3] = bfhi(tw[3]);
                        u32x4 w; w[0] = cvtpk(o0[0] + t0[0], o0[1] + t0[1]); w[1] = cvtpk(o0[2] + t0[2], o0[3] + t0[3]);
                        w[2] = cvtpk(o1[0] + t1[0], o1[1] + t1[1]); w[3] = cvtpk(o1[2] + t1[2], o1[3] + t1[3]);
                        *(u32x4*)(MM + (size_t)mq * 1024 + c) = w;
                    }
                }
                asm volatile("" ::: "memory");
            }
    }
};
struct EpiFinal {
    static constexpr bool PERM = true, AFTER_DRAIN = false;
    static __device__ __forceinline__ bool keep(const pg8::Unit&) { return false; }
    const float* X; float* Y;
    __device__ __forceinline__ void operator()(f32x4 (&acc)[2][2][4][2], const pg8::Unit& u, int wr, int wc, int fr, int fq) const {
#pragma unroll
        for (int ai = 0; ai < 2; ++ai)
#pragma unroll
            for (int m = 0; m < 4; ++m) {
                const size_t mq = (size_t)u.pm * 256 + ai * 128 + wr * 64 + m * 16 + fr;
#pragma unroll
                for (int bj = 0; bj < 2; ++bj) {
                    const int c = u.pn * 256 + bj * 128 + wc * 32 + 8 * fq;
                    const f32x4 x0 = *(const f32x4*)(X + mq * 1024 + c), x1 = *(const f32x4*)(X + mq * 1024 + c + 4);
                    *(f32x4*)(Y + mq * 1024 + c) = x0 + acc[ai][bj][m][0];
                    *(f32x4*)(Y + mq * 1024 + c + 4) = x1 + acc[ai][bj][m][1];
                }
            }
    }
};
struct OneTileOrder {
    int tile, nsel;
    __device__ __forceinline__ bool next(int i, pg8::Unit& u) const { if (i >= nsel) return false; u.pm = tile >> 2; u.pn = tile & 3; u.sel = i; return true; }
    __device__ __forceinline__ void a_ready(const pg8::Unit&) const {}
    __device__ __forceinline__ void done(const pg8::Unit&) const {}
};

__device__ __forceinline__ void transpose_tile(const float* __restrict__ src, int src_ld, int nvalid, int k0, int n0,
                                               bf16_t* __restrict__ dst, int dst_ld, float* tile  , const float* __restrict__ kscale) {
    const int tid = threadIdx.x;
#pragma unroll
    for (int i = 0; i < 2; ++i) {
        const int kk = (tid >> 4) + 32 * i, nn = (tid & 15) * 4;
        f32x4 v = {0.f, 0.f, 0.f, 0.f};
        if (n0 + nn < nvalid) v = *(const f32x4*)(src + (size_t)(k0 + kk) * src_ld + n0 + nn);
        if (kscale) v = v * kscale[k0 + kk];
        tile[kk * 65 + nn + 0] = v[0]; tile[kk * 65 + nn + 1] = v[1]; tile[kk * 65 + nn + 2] = v[2]; tile[kk * 65 + nn + 3] = v[3];
    }
    __syncthreads();
    {
        const int n = tid >> 3, kq = (tid & 7) * 8;
        u32x4 w;
        w[0] = cvtpk(tile[(kq + 0) * 65 + n], tile[(kq + 1) * 65 + n]);
        w[1] = cvtpk(tile[(kq + 2) * 65 + n], tile[(kq + 3) * 65 + n]);
        w[2] = cvtpk(tile[(kq + 4) * 65 + n], tile[(kq + 5) * 65 + n]);
        w[3] = cvtpk(tile[(kq + 6) * 65 + n], tile[(kq + 7) * 65 + n]);
        *(u32x4*)(dst + (size_t)(n0 + n) * dst_ld + k0 + kq) = w;
    }
    __syncthreads();
}

__device__ __forceinline__ void phase0(const Params& p, char* lds) {
    const int tid = threadIdx.x, lane = tid & 63, wid = tid >> 6;
    const int nb = gridDim.x, bid = blockIdx.x;
    {
        float* tile = (float*)lds;
        const int c0 = 16 * 84;
        const int c1 = c0 + 6 * 12;
        const int c2 = c1 + 4 * 8;
        const int c3 = c2 + 4 * 8;
        const int c4 = c3 + 8 * 16;
        const int c5 = c4 + 8 * 16;
        const int c6 = c5 + 16 * 16;
        const int c7 = c6 + 4 * 8;
        const int c8 = c7 + 4 * 8;
        for (int j = bid; j < c8; j += nb) {
            const float* src; int sld, nval, ntn, loc; bf16_t* dst; int dld; const float* ksc = nullptr;
            if (j < c0)      { loc = j;      src = p.w_in; sld = IN_COLS; nval = IN_COLS; ntn = 84; dst = p.WIN_T; dld = 1024; }
            else if (j < c1) { loc = j - c0; src = p.w_uq; sld = 768;  nval = 768;  ntn = 12; dst = p.WUQ_T; dld = 384; ksc = p.g_cq; }
            else if (j < c2) { loc = j - c1; src = p.w_uk; sld = 512;  nval = 512;  ntn = 8;  dst = p.WUKV_T; dld = 256; }
            else if (j < c3) { loc = j - c2; src = p.w_uv; sld = 512;  nval = 512;  ntn = 8;  dst = p.WUKV_T + (size_t)512 * 256; dld = 256; }
            else if (j < c4) { loc = j - c3; src = p.w_oa; sld = 1024; nval = 1024; ntn = 16; dst = p.WOA_T; dld = 512; }
            else if (j < c5) { loc = j - c4; src = p.w_ob; sld = 1024; nval = 1024; ntn = 16; dst = p.WOB_T; dld = 512; }
            else if (j < c6) { loc = j - c5; src = p.w_o;  sld = 1024; nval = 1024; ntn = 16; dst = p.WO_T; dld = 1024; }
            else if (j < c7) { loc = j - c6; src = p.w_uk; sld = 512;  nval = 512;  ntn = 8;  dst = p.WUKVG_T; dld = 256; ksc = p.g_ckv; }
            else             { loc = j - c7; src = p.w_uv; sld = 512;  nval = 512;  ntn = 8;  dst = p.WUKVG_T + (size_t)512 * 256; dld = 256; ksc = p.g_ckv; }
            const int kt = loc / ntn, nt = loc % ntn;
            transpose_tile(src, sld, nval, kt * 64, nt * 64, dst, dld, tile, ksc);
        }
    }
    for (int i = bid * NTHREADS + tid; i < 64 * 64 * 48; i += nb * NTHREADS) {
        const int row = i / 48, c = i - row * 48;
        p.VTG[(size_t)row * 2112 + LTOT + c] = 0;
    }
    for (int r = bid * 8 + wid; r < R_PAD; r += nb * 8) {
        bf16_t* dst = p.XN + (size_t)r * 1024;
        if (r >= R_ALL) {
#pragma unroll
            for (int i = 0; i < 4; ++i) *(u32x2*)(dst + lane * 4 + 256 * i) = (u32x2){0u, 0u};
            continue;
        }
        const float* src;
        if (r < R_PROMPT) { const int b = r / LTOT, t = r - b * LTOT; src = (t < NMETA) ? p.meta + (size_t)t * 1024 : p.x_prompt + ((size_t)b * SEQ + (t - NMETA)) * 1024; }
        else src = p.x_sample + (size_t)(r - R_PROMPT) * 1024;
        f32x4 v[4]; float ss = 0.f;
#pragma unroll
        for (int i = 0; i < 4; ++i) { v[i] = *(const f32x4*)(src + lane * 4 + 256 * i); ss += v[i][0] * v[i][0] + v[i][1] * v[i][1] + v[i][2] * v[i][2] + v[i][3] * v[i][3]; }
        ss = wave_sum(ss);
        const float rs = 1.0f / sqrtf(ss * (1.0f / 1024.0f) + EPSF);
#pragma unroll
        for (int i = 0; i < 4; ++i) {
            const f32x4 g = *(const f32x4*)(p.norm_g + lane * 4 + 256 * i);
            u32x2 w; w[0] = cvtpk(v[i][0] * rs * g[0], v[i][1] * rs * g[1]); w[1] = cvtpk(v[i][2] * rs * g[2], v[i][3] * rs * g[3]);
            *(u32x2*)(dst + lane * 4 + 256 * i) = w;
        }
    }
    for (int i = bid * NTHREADS + tid; i < 2065 * 16; i += nb * NTHREADS) {
        const int pi = i >> 4, k = i & 15;
        const float pos = (pi < LTOT) ? (float)pi : (float)PAST_LEN;
        const float inv = (float)exp(-(double)k / 16.0 * log(10000.0));
        const float ang = pos * inv;
        p.ROPE[pi * 32 + k] = cosf(ang); p.ROPE[pi * 32 + 16 + k] = sinf(ang);
    }
    if (bid == 0) {
        if (tid < 512) { const float l0 = p.lb_logits[tid], l1 = p.lb_logits[512 + tid]; p.LB[tid] = 1.0f / (1.0f + expf(l1 - l0)); }
        if (tid < 16) p.INV[tid] = (float)exp(-(double)tid / 16.0 * log(10000.0));
        if (wid == 0) {
            float gq = 0.f, gk = 0.f;
            for (int i = lane; i < A_QK; i += 64) { gq = fmaxf(gq, fabsf(p.g_qn[i])); gk = fmaxf(gk, fabsf(p.g_kn[i])); }
#pragma unroll
            for (int o = 32; o >= 1; o >>= 1) { gq = fmaxf(gq, __shfl_xor(gq, o)); gk = fmaxf(gk, __shfl_xor(gk, o)); }
            if (lane == 0) p.SCAL[0] = sqrtf((float)A_QK) * gq * gk;
        }
    }
}

__device__ __forceinline__ void phase1(const Params& p, char* lds) {
    pg8::Gemm g{p.XN, p.WIN_T, R_PAD, IN_COLS_PAD, 1024, p.XN, p.WIN_T};
    pg8::StaticOrder S; S.init(R_PAD, IN_COLS_PAD, (int)gridDim.x, (int)blockIdx.x);
    EpiInProj E{p.F32B, p.GLOG, p.PBUF, p.LB, p.CQN, p.CKVN};
    pg8::gemm_phase<EpiInProj, pg8::StaticOrder, true, true>((PG8_LAS unsigned char*)lds, g, S, E);
}

#define LOG2E 1.4426950408889634f
__device__ __forceinline__ void fin1_chunk(const Params& p, const int c) {
    int tid_ = threadIdx.x; asm volatile("" : "+v"(tid_));
    const int tid = tid_, lane = tid & 63, wid = tid >> 6;
#pragma unroll 1
    for (int i = 0; i < 8; ++i) {
        const int r = c * 64 + wid * 8 + i;
        if (r >= R_ALL) break;
        const float* src = p.F32B + (size_t)r * 288;
        int pidx; float* o_lat; float* o_kr;
        if (r < R_PROMPT) { pidx = r % LTOT; o_lat = p.out + OFF_LAT_P + (size_t)r * 256; o_kr = p.out + OFF_KR_P + (size_t)r * 32; }
        else { const int j = r - R_PROMPT; pidx = LTOT; o_lat = p.out + OFF_LAT_S + (size_t)j * 256; o_kr = p.out + OFF_KR_S + (size_t)j * 32; }
        const f32x4 v = *(const f32x4*)(src + lane * 4);
        float ss = v[0] * v[0] + v[1] * v[1] + v[2] * v[2] + v[3] * v[3];
        ss = wave_sum(ss);
        const float rs = 1.0f / sqrtf(ss * (1.0f / 256.0f) + EPSF);
        const f32x4 g = *(const f32x4*)(p.g_ckv + lane * 4);
        f32x4 o; o[0] = v[0] * rs * g[0]; o[1] = v[1] * rs * g[1]; o[2] = v[2] * rs * g[2]; o[3] = v[3] * rs * g[3];
        *(f32x4*)(o_lat + lane * 4) = o;
        if (lane < 16) {
            const float x1 = src[256 + lane], x2 = src[256 + 16 + lane];
            const float cs = p.ROPE[pidx * 32 + lane], sn = p.ROPE[pidx * 32 + 16 + lane];
            o_kr[lane] = x1 * cs - x2 * sn; o_kr[16 + lane] = x1 * sn + x2 * cs;
        }
    }
}

#define UF_XQ_LD 784
#define UF_XK_LD 528
__device__ __forceinline__ float diag_pick(const f32x4 a, int lr, int lg) {
    const int j = lr & 3;
    float v = (j == 0) ? a[0] : (j == 1) ? a[1] : (j == 2) ? a[2] : a[3];
    v = (lg == (lr >> 2)) ? v : 0.f;
    v += __shfl_xor(v, 16); v += __shfl_xor(v, 32);
    return v;
}
__device__ __forceinline__ void upfused_item(const Params& p, char* lds, const int item) {
    int tid_ = threadIdx.x; asm volatile("" : "+v"(tid_));
    const int tid = tid_, lane = tid & 63, h = tid >> 6, lr = lane & 15, lg = lane >> 4;
    const int rt = item / 3, part = item - rt * 3, row0 = rt * 64;
    const float qk_scale = 0.10206207261596577f;
    if (part == 0) {
        char* X = lds;
#pragma unroll
        for (int i = 0; i < 6; ++i) {
            const int id = tid + 512 * i, row = id / 48, ch = id - row * 48;
            *(u32x4*)(X + row * UF_XQ_LD + ch * 16) = *(const u32x4*)(p.CQN + (size_t)(row0 + row) * 384 + ch * 8);
        }
        __syncthreads();
        f32x4 acc[4][6], accs[4];
#pragma unroll
        for (int mt = 0; mt < 4; ++mt) { accs[mt] = (f32x4){0.f, 0.f, 0.f, 0.f};
#pragma unroll
            for (int nt = 0; nt < 6; ++nt) acc[mt][nt] = (f32x4){0.f, 0.f, 0.f, 0.f}; }
        const bf16_t* wb = p.WUQ_T + (size_t)(h * 96 + lr) * 384 + 8 * lg;
#pragma unroll 1
        for (int ks = 0; ks < 12; ++ks) {
            bf16x8 xf[4], wf[6];
#pragma unroll
            for (int nt = 0; nt < 6; ++nt) wf[nt] = *(const bf16x8*)(wb + (size_t)nt * 16 * 384 + ks * 32);
#pragma unroll
            for (int mt = 0; mt < 4; ++mt) xf[mt] = *(const bf16x8*)(X + (16 * mt + lr) * UF_XQ_LD + ks * 64 + lg * 16);
#pragma unroll
            for (int mt = 0; mt < 4; ++mt) {
                accs[mt] = mfma16(xf[mt], xf[mt], accs[mt]);
#pragma unroll
                for (int nt = 0; nt < 6; ++nt) acc[mt][nt] = mfma16(wf[nt], xf[mt], acc[mt][nt]);
            }
        }
#pragma unroll
        for (int mt = 0; mt < 4; ++mt) {
            const int r = row0 + 16 * mt + lr;
            const float rs_cq = 1.0f / sqrtf(diag_pick(accs[mt], lr, lg) * (1.0f / 384.0f) + EPSF);
            const bool is_s = r >= R_PROMPT;
            const int b = r / LTOT, t = r - b * LTOT;
            const int pidx = is_s ? LTOT : t;
            f32x4 q[6];
#pragma unroll
            for (int nt = 0; nt < 6; ++nt) q[nt] = acc[mt][nt] * rs_cq;
            {
                const f32x4 c4 = *(const f32x4*)(p.ROPE + pidx * 32 + 4 * lg), s4 = *(const f32x4*)(p.ROPE + pidx * 32 + 16 + 4 * lg);
#pragma unroll
                for (int j = 0; j < 4; ++j) { const float x1 = q[4][j], x2 = q[5][j]; q[4][j] = x1 * c4[j] - x2 * s4[j]; q[5][j] = x1 * s4[j] + x2 * c4[j]; }
            }
            float ss = 0.f;
#pragma unroll
            for (int nt = 0; nt < 6; ++nt)
#pragma unroll
                for (int j = 0; j < 4; ++j) ss += q[nt][j] * q[nt][j];
            ss += __shfl_xor(ss, 16); ss += __shfl_xor(ss, 32);
            const float rs = 1.0f / sqrtf(ss * (1.0f / 96.0f) + EPSF);
            if (!is_s) {
                if (t >= NMETA && r < R_PROMPT) {
                    bf16_t* dst = p.QA + ((size_t)(b * 8 + h) * 2048 + (t - NMETA)) * 96 + 4 * lg;
                    const float sc = rs * qk_scale * LOG2E;
#pragma unroll
                    for (int nt = 0; nt < 6; ++nt) {
                        const f32x4 g = *(const f32x4*)(p.g_qn + 16 * nt + 4 * lg);
                        u32x2 w; w[0] = cvtpk(q[nt][0] * sc * g[0], q[nt][1] * sc * g[1]); w[1] = cvtpk(q[nt][2] * sc * g[2], q[nt][3] * sc * g[3]);
                        *(u32x2*)(dst + 16 * nt) = w;
                    }
                }
            } else if (r < R_ALL) {
                float* dst = p.QS + ((size_t)(r - R_PROMPT) * 8 + h) * 96 + 4 * lg;
                const float sc = rs * qk_scale;
#pragma unroll
                for (int nt = 0; nt < 6; ++nt) {
                    const f32x4 g = *(const f32x4*)(p.g_qn + 16 * nt + 4 * lg), gk = *(const f32x4*)(p.g_kn + 16 * nt + 4 * lg);
                    f32x4 o; o[0] = q[nt][0] * sc * g[0] * gk[0]; o[1] = q[nt][1] * sc * g[1] * gk[1]; o[2] = q[nt][2] * sc * g[2] * gk[2]; o[3] = q[nt][3] * sc * g[3] * gk[3];
                    *(f32x4*)(dst + 16 * nt) = o;
                }
            }
        }
    } else {
        char* X = lds;
        float* KR = (float*)(lds + 64 * UF_XK_LD);
#pragma unroll
        for (int i = 0; i < 4; ++i) {
            const int id = tid + 512 * i, row = id >> 5, ch = id & 31;
            *(u32x4*)(X + row * UF_XK_LD + ch * 16) = *(const u32x4*)(p.CKVN + (size_t)(row0 + row) * 256 + ch * 8);
        }
        if (part == 1) { const int row = tid >> 3, c4 = tid & 7; *(f32x4*)(KR + row * 36 + c4 * 4) = *(const f32x4*)(p.F32B + (size_t)(row0 + row) * 288 + 256 + c4 * 4); }
        __syncthreads();
        f32x4 ak[4][4], accs[4];
#pragma unroll
        for (int mt = 0; mt < 4; ++mt) { accs[mt] = (f32x4){0.f, 0.f, 0.f, 0.f};
#pragma unroll
            for (int nt = 0; nt < 4; ++nt) ak[mt][nt] = (f32x4){0.f, 0.f, 0.f, 0.f}; }
        const bf16_t* wk = p.WUKVG_T + (size_t)((part == 1 ? 0 : 512) + h * 64 + lr) * 256 + 8 * lg;
#pragma unroll 1
        for (int ks = 0; ks < 8; ++ks) {
            bf16x8 xf[4], wfk[4];
#pragma unroll
            for (int nt = 0; nt < 4; ++nt) wfk[nt] = *(const bf16x8*)(wk + (size_t)nt * 16 * 256 + ks * 32);
#pragma unroll
            for (int mt = 0; mt < 4; ++mt) xf[mt] = *(const bf16x8*)(X + (16 * mt + lr) * UF_XK_LD + ks * 64 + lg * 16);
#pragma unroll
            for (int mt = 0; mt < 4; ++mt) {
                accs[mt] = mfma16(xf[mt], xf[mt], accs[mt]);
#pragma unroll
                for (int nt = 0; nt < 4; ++nt) ak[mt][nt] = mfma16(wfk[nt], xf[mt], ak[mt][nt]);
            }
        }
#pragma unroll
        for (int mt = 0; mt < 4; ++mt) {
            const int r = row0 + 16 * mt + lr;
            const float rs_ckv = 1.0f / sqrtf(diag_pick(accs[mt], lr, lg) * (1.0f / 256.0f) + EPSF);
            const bool is_s = r >= R_PROMPT;
            const int b = r / LTOT, t = r - b * LTOT;
            if (part == 2) {
                if (!is_s) {
                    const int x = t & 15, slot = (t & ~15) | (x & 3) | ((x & 4) << 1) | ((x & 8) >> 1);
                    bf16_t* vd = p.VTG + (size_t)(b * 8 + h) * 64 * 2112 + slot;
#pragma unroll
                    for (int nt = 0; nt < 4; ++nt)
#pragma unroll
                        for (int j = 0; j < 4; ++j) vd[(size_t)(16 * nt + 4 * lg + j) * 2112] = f2bf(ak[mt][nt][j] * rs_ckv);
                }
                continue;
            }
            const int pidx = is_s ? LTOT : t;
            const f32x4 x1 = *(const f32x4*)(KR + (16 * mt + lr) * 36 + 4 * lg), x2 = *(const f32x4*)(KR + (16 * mt + lr) * 36 + 16 + 4 * lg);
            float ss = 0.f;
#pragma unroll
            for (int j = 0; j < 4; ++j) ss += x1[j] * x1[j] + x2[j] * x2[j];
            f32x4 kn[4];
#pragma unroll
            for (int nt = 0; nt < 4; ++nt) { kn[nt] = ak[mt][nt] * rs_ckv;
#pragma unroll
                for (int j = 0; j < 4; ++j) ss += kn[nt][j] * kn[nt][j]; }
            ss += __shfl_xor(ss, 16); ss += __shfl_xor(ss, 32);
            const float rs = 1.0f / sqrtf(ss * (1.0f / 96.0f) + EPSF);
            const f32x4 c4 = *(const f32x4*)(p.ROPE + pidx * 32 + 4 * lg), s4 = *(const f32x4*)(p.ROPE + pidx * 32 + 16 + 4 * lg);
            f32x4 y1, y2;
#pragma unroll
            for (int j = 0; j < 4; ++j) { y1[j] = x1[j] * c4[j] - x2[j] * s4[j]; y2[j] = x1[j] * s4[j] + x2[j] * c4[j]; }
            if (!is_s) {
                bf16_t* dst = p.KA + ((size_t)(b * 8 + h) * LTOT + t) * 96 + 4 * lg;
#pragma unroll
                for (int nt = 0; nt < 4; ++nt) {
                    const f32x4 g = *(const f32x4*)(p.g_kn + 16 * nt + 4 * lg);
                    u32x2 w; w[0] = cvtpk(kn[nt][0] * rs * g[0], kn[nt][1] * rs * g[1]); w[1] = cvtpk(kn[nt][2] * rs * g[2], kn[nt][3] * rs * g[3]);
                    *(u32x2*)(dst + 16 * nt) = w;
                }
                {
                    const f32x4 g1 = *(const f32x4*)(p.g_kn + 64 + 4 * lg), g2 = *(const f32x4*)(p.g_kn + 80 + 4 * lg);
                    u32x2 w1, w2;
                    w1[0] = cvtpk(y1[0] * rs * g1[0], y1[1] * rs * g1[1]); w1[1] = cvtpk(y1[2] * rs * g1[2], y1[3] * rs * g1[3]);
                    w2[0] = cvtpk(y2[0] * rs * g2[0], y2[1] * rs * g2[1]); w2[1] = cvtpk(y2[2] * rs * g2[2], y2[3] * rs * g2[3]);
                    *(u32x2*)(dst + 64) = w1; *(u32x2*)(dst + 80) = w2;
                }
            } else if (r < R_ALL) {
                float* dst = p.KSRAW + ((size_t)(r - R_PROMPT) * 8 + h) * 96 + 4 * lg;
#pragma unroll
                for (int nt = 0; nt < 4; ++nt) *(f32x4*)(dst + 16 * nt) = kn[nt];
                *(f32x4*)(dst + 64) = y1; *(f32x4*)(dst + 80) = y2;
            }
        }
    }
    __syncthreads();
}

#define HA_LD 144
#define HC_LD 272
__device__ __forceinline__ void hgrn_passA_unit(const Params& p, char* lds, const int u) {
    int tid_ = threadIdx.x; asm volatile("" : "+v"(tid_));
    const int tid = tid_, lane = tid & 63, wid = tid >> 6, lr = lane & 15, lg = lane >> 4;
    float* cumL = (float*)lds;
    float* tot = (float*)(lds + 32768);
    char* KT = lds + 32768 + 2048;
    char* VT = KT + 128 * HA_LD;
    {
        const int c = u % NCHUNK, bh = u / NCHUNK, h = bh % B_HEADS, b = bh / B_HEADS;
        const int nvalid = (c == 0) ? NMETA : 64;
        const int t0 = (c == 0) ? 0 : NMETA + 64 * (c - 1);
        const size_t rowbase = (size_t)b * LTOT + t0;
        const int d = tid & 127, part = tid >> 7;
        char* KR = VT + 128 * HA_LD;
#pragma unroll
        for (int i = 0; i < 4; ++i) {
            const int id = tid + 512 * i, row = id >> 5, c4 = id & 31;
            f32x4 g = {0.f, 0.f, 0.f, 0.f};
            if (row < nvalid) g = *(const f32x4*)(p.GLOG + (rowbase + row) * 512 + h * 128 + c4 * 4);
            *(f32x4*)(cumL + row * 128 + c4 * 4) = g;
        }
#pragma unroll
        for (int i = 0; i < 2; ++i) {
            const int id = tid + 512 * i, row = id >> 4, ch = id & 15;
            u32x4 kw = {0u, 0u, 0u, 0u}, w = {0u, 0u, 0u, 0u};
            if (row < nvalid) {
                kw = *(const u32x4*)(p.PBUF + (rowbase + row) * IN_COLS_PAD + C_BF + h * 128 + ch * 8);
                w = *(const u32x4*)(p.PBUF + (rowbase + row) * IN_COLS_PAD + C_BI + h * 128 + ch * 8);
            }
            *(u32x4*)(KR + row * HC_LD + ch * 16) = kw;
#pragma unroll
            for (int e = 0; e < 4; ++e) {
                *(bf16_t*)(VT + (ch * 8 + 2 * e) * HA_LD + row * 2) = (bf16_t)(w[e] & 0xffffu);
                *(bf16_t*)(VT + (ch * 8 + 2 * e + 1) * HA_LD + row * 2) = (bf16_t)(w[e] >> 16);
            }
        }
        __syncthreads();
        {
            float run = 0.f;
#pragma unroll
            for (int i = 0; i < 16; ++i) { const int s = part * 16 + i; run += cumL[s * 128 + d]; cumL[s * 128 + d] = run; }
            tot[part * 128 + d] = run;
        }
        __syncthreads();
        {
            float off = 0.f, last = 0.f;
#pragma unroll
            for (int q = 0; q < 4; ++q) { const float tq = tot[q * 128 + d]; last += tq; if (q < part) off += tq; }
            if (part == 0) p.DEC[(size_t)u * 128 + d] = expf(last);
#pragma unroll
            for (int i = 0; i < 16; ++i) {
                const int s = part * 16 + i;
                const float cum = cumL[s * 128 + d] + off;
                const float kv = bf2f(*(const bf16_t*)(KR + s * HC_LD + d * 2));
                *(bf16_t*)(KT + d * HA_LD + s * 2) = f2bf(kv * __expf(last - cum));
            }
        }
        __syncthreads();
        {
            const char* xs = VT + (wid * 16 + lr) * HA_LD + lg * 16;
            bf16x8 xf0 = *(const bf16x8*)(xs), xf1 = *(const bf16x8*)(xs + 64);
            bf16_t* dst = p.UT + (size_t)u * 16384 + (size_t)(wid * 16 + lr) * 128;
#pragma unroll
            for (int nt = 0; nt < 8; ++nt) {
                const char* ws = KT + (nt * 16 + lr) * HA_LD + lg * 16;
                f32x4 acc = {0.f, 0.f, 0.f, 0.f};
                acc = mfma16(*(const bf16x8*)(ws), xf0, acc);
                acc = mfma16(*(const bf16x8*)(ws + 64), xf1, acc);
                { u32x2 w; w[0] = cvtpk(acc[0], acc[1]); w[1] = cvtpk(acc[2], acc[3]); *(u32x2*)(dst + nt * 16 + 4 * lg) = w; }
            }
        }
        __syncthreads();
    }
}

__device__ __forceinline__ void hgrn_sample_step_unit(const Params& p, char* lds, const int u) {
    int tid_ = threadIdx.x; asm volatile("" : "+v"(tid_));
    const int tid = tid_;
    float* part = (float*)lds;
    float* red = (float*)(lds + 8192);
    {
        const int i = u / B_HEADS, h = u % B_HEADS;
        const size_t r = R_PROMPT + i;
        const int v4 = (tid & 31) * 4, dp = tid >> 5;
        const float* S0 = p.state_hgrn + (size_t)u * 16384;
        float* S1 = p.out + OFF_HG_S + (size_t)u * 16384;
        const u32x2 vw = *(const u32x2*)(p.PBUF + r * IN_COLS_PAD + C_BI + h * 128 + v4);
        const float vv[4] = {bflo(vw[0]), bfhi(vw[0]), bflo(vw[1]), bfhi(vw[1])};
        float o[4] = {0.f, 0.f, 0.f, 0.f};
#pragma unroll
        for (int e = 0; e < 8; ++e) {
            const int d = dp * 8 + e;
            const float q = bf2f(p.PBUF[r * IN_COLS_PAD + C_BQ + h * 128 + d]);
            const float k = bf2f(p.PBUF[r * IN_COLS_PAD + C_BF + h * 128 + d]);
            const float f = expf(p.GLOG[r * 512 + h * 128 + d]);
            const f32x4 s0 = *(const f32x4*)(S0 + d * 128 + v4);
            f32x4 s1;
#pragma unroll
            for (int j = 0; j < 4; ++j) { s1[j] = f * s0[j] + k * vv[j]; o[j] += q * s1[j]; }
            *(f32x4*)(S1 + d * 128 + v4) = s1;
        }
#pragma unroll
        for (int j = 0; j < 4; ++j) part[dp * 128 + v4 + j] = o[j];
        __syncthreads();
        float osum = 0.f;
        if (tid < 128) {
#pragma unroll
            for (int q = 0; q < 16; ++q) osum += part[q * 128 + tid];
            float ss = wave_sum(osum * osum);
            if ((tid & 63) == 0) red[tid >> 6] = ss;
        }
        __syncthreads();
        if (tid < 128) {
            const float ss = red[0] + red[1];
            const float rs = 1.0f / sqrtf(ss * (1.0f / 128.0f) + EPSF);
            const float gb = bf2f(p.PBUF[r * IN_COLS_PAD + C_GB + h * 128 + tid]);
            p.AMB[(size_t)(NQ + i) * 512 + h * 128 + tid] = f2bf(osum * rs * p.g_bn[tid] * gb);
        }
        __syncthreads();
    }
}

#define Q_UF_ITEMS (3 * (R_PAD / 64))
#define Q_HA_ITEMS (BATCH * B_HEADS * NCHUNK)
#define Q_SS_ITEMS (DEC_BATCH * B_HEADS)
#define Q_F1_ITEMS ((R_ALL + 63) / 64)
#define QCTR_WORD 3584
__device__ __forceinline__ void phase2(const Params& p, char* lds) {
    volatile int* slot = (volatile int*)(lds + LDS_ITEM_OFF);
    const int total = Q_UF_ITEMS + Q_HA_ITEMS + Q_SS_ITEMS + Q_F1_ITEMS;
    for (;;) {
        if (threadIdx.x == 0) *slot = (int)atomicAdd(p.bar + QCTR_WORD, 1u);
        __syncthreads();
        const int it = __builtin_amdgcn_readfirstlane(*slot);
        __syncthreads();
        if (it >= total) break;
        if (it < Q_UF_ITEMS) upfused_item(p, lds, it);
        else if (it < Q_UF_ITEMS + Q_HA_ITEMS) hgrn_passA_unit(p, lds, it - Q_UF_ITEMS);
        else if (it < Q_UF_ITEMS + Q_HA_ITEMS + Q_SS_ITEMS) hgrn_sample_step_unit(p, lds, it - Q_UF_ITEMS - Q_HA_ITEMS);
        else fin1_chunk(p, it - Q_UF_ITEMS - Q_HA_ITEMS - Q_SS_ITEMS);
    }
}

__device__ __forceinline__ void hgrn_passB(const Params& p) {
    for (int g = blockIdx.x * NTHREADS + threadIdx.x; g < 32 * 128 * 32; g += gridDim.x * NTHREADS) {
        const int d4 = (g & 31) * 4, v = (g >> 5) & 127, bh = g >> 12;
        f32x4 S = {0.f, 0.f, 0.f, 0.f};
        for (int c = 0; c < NCHUNK; ++c) {
            const size_t u = (size_t)bh * NCHUNK + c;
            u32x2 w; w[0] = cvtpk(S[0], S[1]); w[1] = cvtpk(S[2], S[3]);
            *(u32x2*)(p.ST + u * 16384 + v * 128 + d4) = w;
            const f32x4 dec = *(const f32x4*)(p.DEC + u * 128 + d4);
            const u32x2 uw = *(const u32x2*)(p.UT + u * 16384 + v * 128 + d4);
            const f32x4 ut = {bflo(uw[0]), bfhi(uw[0]), bflo(uw[1]), bfhi(uw[1])};
#pragma unroll
            for (int j = 0; j < 4; ++j) S[j] = dec[j] * S[j] + ut[j];
        }
        float* o = p.out + OFF_HG_P + (size_t)bh * 16384;
#pragma unroll
        for (int j = 0; j < 4; ++j) o[(d4 + j) * 128 + v] = S[j];
    }
}

#define AK_LD 208
#define AV_LD 144
#define AP_LD 144
#define AK_BUF (64 * AK_LD)
#define AV_BUF (64 * AV_LD)
__device__ __forceinline__ void attn_unit(const Params& p, char* lds, int b, int h, int qb) {
    const int tid = threadIdx.x, lane = tid & 63, wid = tid >> 6, lr = lane & 15, lg = lane >> 4;
    char* Ks = lds;
    char* VTs = lds + 2 * AK_BUF;
    char* Ps = VTs + 2 * AV_BUF + wid * 16 * AP_LD;
    const int tq0 = qb * 128;
    const int ntile = 2 * qb + 3;
    const float Mb = p.SCAL[0] * LOG2E;
    const bf16_t* qsrc = p.QA + ((size_t)(b * 8 + h) * 2048 + tq0 + 16 * wid + lr) * 96 + lg * 8;
    bf16x8 qf[3];
#pragma unroll
    for (int ks = 0; ks < 3; ++ks) qf[ks] = *(const bf16x8*)(qsrc + ks * 32);
    const int qpos = NMETA + tq0 + 16 * wid + lr;
    const int wq_max = NMETA + tq0 + 16 * wid + 15;
    const bf16_t* kbase = p.KA + (size_t)(b * 8 + h) * LTOT * 96;
    const bf16_t* vbase = p.KVRAW + (size_t)b * LTOT * 1024 + 512 + h * 64;
    const int kkey0 = tid / 12, kpart0 = tid % 12;
    const int kkey1 = (512 + tid) / 12, kpart1 = (512 + tid) % 12;
    const int vkey = tid >> 3, vdc = tid & 7;
    u32x4 kr0, kr1 = {0u, 0u, 0u, 0u}, vr;
    auto load_tile = [&](int ti) {
        const int key0 = ti * 64;
        int ka = key0 + kkey0; ka = ka < LTOT ? ka : LTOT - 1;
        kr0 = *(const u32x4*)(kbase + (size_t)ka * 96 + kpart0 * 8);
        if (tid < 256) { int kb = key0 + kkey1; kb = kb < LTOT ? kb : LTOT - 1; kr1 = *(const u32x4*)(kbase + (size_t)kb * 96 + kpart1 * 8); }
        int kv = key0 + vkey; kv = kv < LTOT ? kv : LTOT - 1;
        vr = *(const u32x4*)(vbase + (size_t)kv * 1024 + vdc * 8);
    };
    auto store_tile = [&](int buf) {
        *(u32x4*)(Ks + buf * AK_BUF + kkey0 * AK_LD + kpart0 * 16) = kr0;
        if (tid < 256) *(u32x4*)(Ks + buf * AK_BUF + kkey1 * AK_LD + kpart1 * 16) = kr1;
        char* vt = VTs + buf * AV_BUF + vkey * 2;
#pragma unroll
        for (int e = 0; e < 4; ++e) {
            *(bf16_t*)(vt + (vdc * 8 + 2 * e) * AV_LD) = (bf16_t)(vr[e] & 0xffffu);
            *(bf16_t*)(vt + (vdc * 8 + 2 * e + 1) * AV_LD) = (bf16_t)(vr[e] >> 16);
        }
    };
    f32x4 o[4];
#pragma unroll
    for (int i = 0; i < 4; ++i) o[i] = (f32x4){0.f, 0.f, 0.f, 0.f};
    float lsum = 0.f;
    load_tile(0); store_tile(0);
    __syncthreads();
    for (int ti = 0; ti < ntile; ++ti) {
        const int cur = ti & 1;
        if (ti + 1 < ntile) load_tile(ti + 1);
        if (ti * 64 <= wq_max) {
            const char* kb_ = Ks + cur * AK_BUF + lr * AK_LD + lg * 16;
#pragma unroll
            for (int nt = 0; nt < 4; ++nt) {
                f32x4 s = {0.f, 0.f, 0.f, 0.f};
#pragma unroll
                for (int ks = 0; ks < 3; ++ks) s = mfma16(*(const bf16x8*)(kb_ + nt * 16 * AK_LD + ks * 64), qf[ks], s);
                const int key = ti * 64 + nt * 16 + 4 * lg;
                float pe[4];
#pragma unroll
                for (int j = 0; j < 4; ++j) { pe[j] = (key + j <= qpos) ? exp2f(s[j] - Mb) : 0.f; lsum += pe[j]; }
                u32x2 w; w[0] = cvtpk(pe[0], pe[1]); w[1] = cvtpk(pe[2], pe[3]);
                *(u32x2*)(Ps + lr * AP_LD + (nt * 16 + 4 * lg) * 2) = w;
            }
            asm volatile("s_waitcnt lgkmcnt(0)" ::: "memory");
            __builtin_amdgcn_wave_barrier();
            const bf16x8 pf0 = *(const bf16x8*)(Ps + lr * AP_LD + lg * 16);
            const bf16x8 pf1 = *(const bf16x8*)(Ps + lr * AP_LD + 64 + lg * 16);
            const char* vb_ = VTs + cur * AV_BUF + lr * AV_LD + lg * 16;
#pragma unroll
            for (int nt = 0; nt < 4; ++nt) {
                o[nt] = mfma16(*(const bf16x8*)(vb_ + nt * 16 * AV_LD), pf0, o[nt]);
                o[nt] = mfma16(*(const bf16x8*)(vb_ + nt * 16 * AV_LD + 64), pf1, o[nt]);
            }
            asm volatile("s_waitcnt lgkmcnt(0)" ::: "memory");
            __builtin_amdgcn_wave_barrier();
        }
        if (ti + 1 < ntile) store_tile(cur ^ 1);
        __syncthreads();
    }
    lsum += __shfl_xor(lsum, 16); lsum += __shfl_xor(lsum, 32);
    const float inv = 1.0f / lsum;
    const int tq = tq0 + 16 * wid + lr;
    const size_t r = (size_t)b * LTOT + NMETA + tq;
    const size_t mrow = (size_t)b * 2048 + tq;
#pragma unroll
    for (int nt = 0; nt < 4; ++nt) {
        const int dv = nt * 16 + 4 * lg;
        const u32x2 gw = *(const u32x2*)(p.PBUF + r * IN_COLS_PAD + C_GA + h * 64 + dv);
        u32x2 w; w[0] = cvtpk(o[nt][0] * inv * bflo(gw[0]), o[nt][1] * inv * bfhi(gw[0])); w[1] = cvtpk(o[nt][2] * inv * bflo(gw[1]), o[nt][3] * inv * bfhi(gw[1]));
        *(u32x2*)(p.AMA + mrow * 512 + h * 64 + dv) = w;
    }
}

typedef float f32x16 __attribute__((ext_vector_type(16)));
#define A2K_LD 208
#define A2V_LD 144
#define A2K_BUF (64 * A2K_LD)
#define A2V_BUF (64 * A2V_LD)
__device__ __forceinline__ f32x16 mfma32(bf16x8 a, bf16x8 b, f32x16 c) { return __builtin_amdgcn_mfma_f32_32x32x16_bf16(a, b, c, 0, 0, 0); }
__device__ __forceinline__ void attn_unit2(const Params& p, char* lds, int b, int h, int qb) {
    const int tid = threadIdx.x, lane = tid & 63, wid = tid >> 6, r32 = lane & 31, hi = lane >> 5;
    char* Ks = lds;
    char* Vs = lds + 2 * A2K_BUF;
    const int tq0 = qb * 256;
    const int ntile = 4 * qb + 5;
    const float negMb = -p.SCAL[0] * LOG2E;
    const bf16_t* qsrc = p.QA + ((size_t)(b * 8 + h) * 2048 + tq0 + 32 * wid + r32) * 96 + hi * 8;
    bf16x8 qf[6];
#pragma unroll
    for (int s = 0; s < 6; ++s) qf[s] = *(const bf16x8*)(qsrc + 16 * s);
    const int wq_min = NMETA + tq0 + 32 * wid, wq_max = wq_min + 31, qpos = wq_min + r32;
    const bf16_t* kbase = p.KA + (size_t)(b * 8 + h) * LTOT * 96;
    const bf16_t* vbase = p.VTG + (size_t)(b * 8 + h) * 64 * 2112;
    const int kkey0 = tid / 12, kpart0 = tid % 12;
    const int kkey1 = (512 + tid) / 12, kpart1 = (512 + tid) % 12;
    const int vdv = tid >> 3, vpart = tid & 7;
    u32x4 kr0, kr1 = {0u, 0u, 0u, 0u}, vr;
    auto load_tile = [&](int ti) {
        const int key0 = ti * 64;
        int ka = key0 + kkey0; ka = ka < LTOT ? ka : LTOT - 1;
        kr0 = *(const u32x4*)(kbase + (size_t)ka * 96 + kpart0 * 8);
        if (tid < 256) { int kb = key0 + kkey1; kb = kb < LTOT ? kb : LTOT - 1; kr1 = *(const u32x4*)(kbase + (size_t)kb * 96 + kpart1 * 8); }
        vr = *(const u32x4*)(vbase + (size_t)vdv * 2112 + key0 + vpart * 8);
    };
    auto store_tile = [&](int buf) {
        *(u32x4*)(Ks + buf * A2K_BUF + kkey0 * A2K_LD + kpart0 * 16) = kr0;
        if (tid < 256) *(u32x4*)(Ks + buf * A2K_BUF + kkey1 * A2K_LD + kpart1 * 16) = kr1;
        *(u32x4*)(Vs + buf * A2V_BUF + vdv * A2V_LD + vpart * 16) = vr;
    };
    f32x16 o0, o1;
#pragma unroll
    for (int i = 0; i < 16; ++i) { o0[i] = 0.f; o1[i] = 0.f; }
    float lsum = 0.f;
    load_tile(0); store_tile(0);
    __syncthreads();
    for (int ti = 0; ti < ntile; ++ti) {
        const int cur = ti & 1;
        if (ti + 1 < ntile) load_tile(ti + 1);
        if (ti * 64 <= wq_max) {
            f32x16 s0, s1;
#pragma unroll
            for (int i = 0; i < 16; ++i) { s0[i] = negMb; s1[i] = negMb; }
            const char* ka = Ks + cur * A2K_BUF + r32 * A2K_LD + hi * 16;
#pragma unroll
            for (int s = 0; s < 6; ++s) {
                s0 = mfma32(*(const bf16x8*)(ka + s * 32), qf[s], s0);
                s1 = mfma32(*(const bf16x8*)(ka + 32 * A2K_LD + s * 32), qf[s], s1);
            }
            const bool diag = (ti * 64 + 63 > wq_min);
#pragma unroll
            for (int i = 0; i < 16; ++i) { s0[i] = __builtin_amdgcn_exp2f(s0[i]); s1[i] = __builtin_amdgcn_exp2f(s1[i]); }
            if (diag) {
                const int kb0 = ti * 64 + 4 * hi;
#pragma unroll
                for (int i = 0; i < 16; ++i) {
                    const int key = kb0 + (i & 3) + 8 * (i >> 2);
                    if (key > qpos) s0[i] = 0.f;
                    if (key + 32 > qpos) s1[i] = 0.f;
                }
            }
            float la = 0.f, lb = 0.f;
#pragma unroll
            for (int i = 0; i < 16; ++i) { la += s0[i]; lb += s1[i]; }
            lsum += la + lb;
            bf16x8 pb[2][2];
#pragma unroll
            for (int s = 0; s < 2; ++s) {
                u32x4 w0, w1;
#pragma unroll
                for (int e = 0; e < 4; ++e) { w0[e] = cvtpk(s0[8 * s + 2 * e], s0[8 * s + 2 * e + 1]); w1[e] = cvtpk(s1[8 * s + 2 * e], s1[8 * s + 2 * e + 1]); }
                pb[0][s] = __builtin_bit_cast(bf16x8, w0); pb[1][s] = __builtin_bit_cast(bf16x8, w1);
            }
            const char* va = Vs + cur * A2V_BUF + r32 * A2V_LD + hi * 16;
#pragma unroll
            for (int kt = 0; kt < 2; ++kt)
#pragma unroll
                for (int s = 0; s < 2; ++s) {
                    o0 = mfma32(*(const bf16x8*)(va + kt * 64 + s * 32), pb[kt][s], o0);
                    o1 = mfma32(*(const bf16x8*)(va + 32 * A2V_LD + kt * 64 + s * 32), pb[kt][s], o1);
                }
        }
        if (ti + 1 < ntile) store_tile(cur ^ 1);
        __syncthreads();
    }
    lsum += __shfl_xor(lsum, 32);
    const float inv = 1.0f / lsum;
    const int tq = tq0 + 32 * wid + r32;
    const size_t r = (size_t)b * LTOT + NMETA + tq;
    const size_t mrow = (size_t)b * 2048 + tq;
#pragma unroll
    for (int vt = 0; vt < 2; ++vt)
#pragma unroll
        for (int g = 0; g < 4; ++g) {
            const int dv = 32 * vt + 8 * g + 4 * hi;
            const u32x2 gw = *(const u32x2*)(p.PBUF + r * IN_COLS_PAD + C_GA + h * 64 + dv);
            const float v0 = (vt ? o1[4 * g] : o0[4 * g]) * inv, v1 = (vt ? o1[4 * g + 1] : o0[4 * g + 1]) * inv;
            const float v2 = (vt ? o1[4 * g + 2] : o0[4 * g + 2]) * inv, v3 = (vt ? o1[4 * g + 3] : o0[4 * g + 3]) * inv;
            u32x2 w; w[0] = cvtpk(v0 * bflo(gw[0]), v1 * bfhi(gw[0])); w[1] = cvtpk(v2 * bflo(gw[1]), v3 * bfhi(gw[1]));
            *(u32x2*)(p.AMA + mrow * 512 + h * 64 + dv) = w;
        }
}

__device__ __forceinline__ void attn_phase(const Params& p, char* lds) {
    const int i = blockIdx.x;
    if (i < 256) {
        const int bh = i >> 2, pair = i & 3;
        attn_unit2(p, lds, bh >> 3, bh & 7, 7 - pair);
        attn_unit2(p, lds, bh >> 3, bh & 7, pair);
    }
}

__device__ __forceinline__ void hgrn_passC(const Params& p, char* lds) {
    const int tid = threadIdx.x, lane = tid & 63, wid = tid >> 6, lr = lane & 15, lg = lane >> 4;
    float* cumL = (float*)lds;
    float* tot = (float*)(lds + 32768);
    char* QT = lds + 34816;
    char* KN = QT + 64 * HC_LD;
    char* QH = KN + 64 * HC_LD;
    char* VT = QH + 64 * HC_LD;
    char* AT = VT + 128 * HA_LD;
    char* STl = AT + 64 * HA_LD;
    for (int uu = blockIdx.x; uu < 32 * 32; uu += gridDim.x) {
        const int c = 1 + (uu & 31), bh = uu >> 5, h = bh & 3, b = bh >> 2;
        const size_t u = (size_t)bh * NCHUNK + c;
        const int t0 = NMETA + 64 * (c - 1);
        const size_t rowbase = (size_t)b * LTOT + t0;
        const int d = tid & 127, part = tid >> 7;
#pragma unroll
        for (int i = 0; i < 4; ++i) {
            const int id = tid + 512 * i, row = id >> 5, c4 = id & 31;
            *(f32x4*)(cumL + row * 128 + c4 * 4) = *(const f32x4*)(p.GLOG + (rowbase + row) * 512 + h * 128 + c4 * 4);
        }
#pragma unroll
        for (int i = 0; i < 2; ++i) {
            const int id = tid + 512 * i, row = id >> 4, ch = id & 15;
            const bf16_t* src = p.PBUF + (rowbase + row) * IN_COLS_PAD + h * 128 + ch * 8;
            const u32x4 qw = *(const u32x4*)(src + C_BQ), kw = *(const u32x4*)(src + C_BF), w = *(const u32x4*)(src + C_BI);
            *(u32x4*)(QH + row * HC_LD + ch * 16) = qw;
            *(u32x4*)(KN + row * HC_LD + ch * 16) = kw;
#pragma unroll
            for (int e = 0; e < 4; ++e) {
                *(bf16_t*)(VT + (ch * 8 + 2 * e) * HA_LD + row * 2) = (bf16_t)(w[e] & 0xffffu);
                *(bf16_t*)(VT + (ch * 8 + 2 * e + 1) * HA_LD + row * 2) = (bf16_t)(w[e] >> 16);
            }
        }
#pragma unroll
        for (int i = 0; i < 4; ++i) {
            const int id = tid + 512 * i, v = id >> 4, dc = id & 15;
            *(u32x4*)(STl + v * HC_LD + dc * 16) = *(const u32x4*)(p.ST + u * 16384 + v * 128 + dc * 8);
        }
        __syncthreads();
        {
            float run = 0.f;
#pragma unroll
            for (int i = 0; i < 16; ++i) { const int s = part * 16 + i; run += cumL[s * 128 + d]; cumL[s * 128 + d] = run; }
            tot[part * 128 + d] = run;
        }
        __syncthreads();
        {
            float off = 0.f;
#pragma unroll
            for (int q = 0; q < 4; ++q) { const float tq = tot[q * 128 + d]; if (q < part) off += tq; }
            const float ref = tot[d] + tot[128 + d];
#pragma unroll
            for (int i = 0; i < 16; ++i) {
                const int s = part * 16 + i;
                const float cum = cumL[s * 128 + d] + off;
                const float qv = bf2f(*(const bf16_t*)(QH + s * HC_LD + d * 2));
                const float kv = bf2f(*(const bf16_t*)(KN + s * HC_LD + d * 2));
                *(bf16_t*)(QT + s * HC_LD + d * 2) = f2bf(qv * __expf(cum - ref));
                *(bf16_t*)(KN + s * HC_LD + d * 2) = f2bf(kv * __expf(ref - cum));
                *(bf16_t*)(QH + s * HC_LD + d * 2) = f2bf(qv * __expf(cum));
            }
        }
        __syncthreads();
        {
            const int mt = wid >> 1;
            const char* xs = QT + (mt * 16 + lr) * HC_LD + lg * 16;
            bf16x8 xf[4];
#pragma unroll
            for (int ks = 0; ks < 4; ++ks) xf[ks] = *(const bf16x8*)(xs + ks * 64);
#pragma unroll
            for (int q = 0; q < 2; ++q) {
                const int nt = 2 * (wid & 1) + q;
                const char* ws = KN + (nt * 16 + lr) * HC_LD + lg * 16;
                f32x4 a = {0.f, 0.f, 0.f, 0.f};
#pragma unroll
                for (int ks = 0; ks < 4; ++ks) a = mfma16(*(const bf16x8*)(ws + ks * 64), xf[ks], a);
                const int t = mt * 16 + lr, s0 = nt * 16 + 4 * lg;
                float m[4];
#pragma unroll
                for (int j = 0; j < 4; ++j) m[j] = (s0 + j <= t) ? a[j] : 0.f;
                u32x2 w; w[0] = cvtpk(m[0], m[1]); w[1] = cvtpk(m[2], m[3]);
                *(u32x2*)(AT + t * HA_LD + s0 * 2) = w;
            }
        }
        __syncthreads();
        {
            const int mt = wid >> 1;
            const char* xa = AT + (mt * 16 + lr) * HA_LD + lg * 16;
            const char* xq = QH + (mt * 16 + lr) * HC_LD + lg * 16;
            bf16x8 af[2], qf[4];
#pragma unroll
            for (int ks = 0; ks < 2; ++ks) af[ks] = *(const bf16x8*)(xa + ks * 64);
#pragma unroll
            for (int ks = 0; ks < 4; ++ks) qf[ks] = *(const bf16x8*)(xq + ks * 64);
#pragma unroll
            for (int q = 0; q < 4; ++q) {
                const int nt = 4 * (wid & 1) + q;
                const char* wv = VT + (nt * 16 + lr) * HA_LD + lg * 16;
                const char* wsx = STl + (nt * 16 + lr) * HC_LD + lg * 16;
                f32x4 a = {0.f, 0.f, 0.f, 0.f};
#pragma unroll
                for (int ks = 0; ks < 2; ++ks) a = mfma16(*(const bf16x8*)(wv + ks * 64), af[ks], a);
#pragma unroll
                for (int ks = 0; ks < 4; ++ks) a = mfma16(*(const bf16x8*)(wsx + ks * 64), qf[ks], a);
                *(f32x4*)(cumL + (mt * 16 + lr) * 128 + nt * 16 + 4 * lg) = a;
            }
        }
        __syncthreads();
        {
#pragma unroll
            for (int i = 0; i < 8; ++i) {
                const int t = wid * 8 + i;
                const f32x2 ov = *(const f32x2*)(cumL + t * 128 + 2 * lane);
                const float ss = wave_sum(ov[0] * ov[0] + ov[1] * ov[1]);
                const float rs = 1.0f / sqrtf(ss * (1.0f / 128.0f) + EPSF);
                const unsigned gw = *(const unsigned*)(p.PBUF + (rowbase + t) * IN_COLS_PAD + C_GB + h * 128 + 2 * lane);
                const f32x2 gbn = *(const f32x2*)(p.g_bn + 2 * lane);
                const size_t mrow = (size_t)b * 2048 + 64 * (c - 1) + t;
                *(unsigned*)(p.AMB + mrow * 512 + h * 128 + 2 * lane) = cvtpk(ov[0] * rs * gbn[0] * bflo(gw), ov[1] * rs * gbn[1] * bfhi(gw));
            }
        }
        __syncthreads();
    }
}

#define SC_LD 528
#define SP_LD 272
#define SC_BUF (128 * SC_LD)
__device__ __forceinline__ void sample_attn(const Params& p, char* lds) {
    const int tid = threadIdx.x, lane = tid & 63, wid = tid >> 6, lr = lane & 15, lg = lane >> 4;
    char* Cs = lds;
    float* RS = (float*)(lds + 2 * SC_BUF);
    char* Pl = lds + 2 * SC_BUF + 2 * 9 * 128 * 4;
    float* Qsl = (float*)(Pl + 16 * SP_LD);
    for (int blk = blockIdx.x; blk < DEC_BATCH * 8; blk += gridDim.x) {
        const int b = blk >> 3, split = blk & 7, h = wid;
        for (int i = tid; i < 16 * SP_LD / 4; i += NTHREADS) ((unsigned*)Pl)[i] = 0u;
        for (int i = tid; i < 8 * 96; i += NTHREADS) Qsl[i] = p.QS[(size_t)b * 768 + i];
        bf16x8 wf[4][8];
        {
            const bf16_t* wb = p.WUKV_T + (size_t)(64 * h + lr) * 256 + 8 * lg;
#pragma unroll
            for (int nt = 0; nt < 4; ++nt) {
                asm volatile("" : "+v"(wb));
#pragma unroll
                for (int ks = 0; ks < 8; ++ks) wf[nt][ks] = *(const bf16x8*)(wb + 32 * ks);
                wb += 16 * 256;
            }
        }
        const float* qsl = Qsl + h * 96;
        const float M = p.SCAL[0];
        f32x4 accl[2] = {{0.f, 0.f, 0.f, 0.f}, {0.f, 0.f, 0.f, 0.f}};
        float lacc = 0.f;
        __syncthreads();
        f32x4 pre[4], rpre[2];
        const int crow = tid >> 6, cc4 = (tid & 63) * 4;
        const int rrow = tid >> 2, rq = tid & 3;
        const int* ptab = p.page_table + b * NPAGES + split * 16;
        auto issue_c = [&](const float* csrc, int qt) {
#pragma unroll
            for (int it = 0; it < 4; ++it) pre[it] = *(const f32x4*)(csrc + (qt * 32 + crow + 8 * it) * 256 + cc4);
        };
        auto write_c = [&](int buf, int qt) {
#pragma unroll
            for (int it = 0; it < 4; ++it) {
                u32x2 w; w[0] = cvtpk(pre[it][0], pre[it][1]); w[1] = cvtpk(pre[it][2], pre[it][3]);
                *(u32x2*)(Cs + buf * SC_BUF + (qt * 32 + crow + 8 * it) * SC_LD + cc4 * 2) = w;
            }
        };
        auto issue_r = [&](const float* rsrc) {
            rpre[0] = *(const f32x4*)(rsrc + rrow * 32 + rq * 8); rpre[1] = *(const f32x4*)(rsrc + rrow * 32 + rq * 8 + 4);
        };
        auto write_r = [&](int buf) {
            float v[9];
            v[0] = rpre[0][0] * rpre[0][0] + rpre[0][1] * rpre[0][1] + rpre[0][2] * rpre[0][2] + rpre[0][3] * rpre[0][3]
                 + rpre[1][0] * rpre[1][0] + rpre[1][1] * rpre[1][1] + rpre[1][2] * rpre[1][2] + rpre[1][3] * rpre[1][3];
#pragma unroll
            for (int hh = 0; hh < 8; ++hh) {
                const f32x4 q0 = *(const f32x4*)(Qsl + hh * 96 + 64 + rq * 8), q1 = *(const f32x4*)(Qsl + hh * 96 + 64 + rq * 8 + 4);
                v[1 + hh] = rpre[0][0] * q0[0] + rpre[0][1] * q0[1] + rpre[0][2] * q0[2] + rpre[0][3] * q0[3]
                          + rpre[1][0] * q1[0] + rpre[1][1] * q1[1] + rpre[1][2] * q1[2] + rpre[1][3] * q1[3];
            }
#pragma unroll
            for (int k = 0; k < 9; ++k) { v[k] += __shfl_xor(v[k], 1); v[k] += __shfl_xor(v[k], 2); }
            if (rq == 0) {
#pragma unroll
                for (int k = 0; k < 9; ++k) RS[(buf * 9 + k) * 128 + rrow] = v[k];
            }
        };
        auto compute_mt = [&](int cur, int mt) {
            f32x4 a[4];
#pragma unroll
            for (int nt = 0; nt < 4; ++nt) a[nt] = (f32x4){0.f, 0.f, 0.f, 0.f};
            const char* xs = Cs + cur * SC_BUF + (16 * mt + lr) * SC_LD + lg * 16;
#pragma unroll
            for (int ks = 0; ks < 8; ++ks) {
                const bf16x8 xf = *(const bf16x8*)(xs + ks * 64);
#pragma unroll
                for (int nt = 0; nt < 4; ++nt) a[nt] = mfma16(wf[nt][ks], xf, a[nt]);
            }
            float ss = 0.f, sq = 0.f;
#pragma unroll
            for (int nt = 0; nt < 4; ++nt) {
                const f32x4 qg = *(const f32x4*)(qsl + 16 * nt + 4 * lg);
#pragma unroll
                for (int j = 0; j < 4; ++j) { ss += a[nt][j] * a[nt][j]; sq += a[nt][j] * qg[j]; }
            }
            ss += __shfl_xor(ss, 16); ss += __shfl_xor(ss, 32);
            sq += __shfl_xor(sq, 16); sq += __shfl_xor(sq, 32);
            ss += RS[(cur * 9) * 128 + 16 * mt + lr];
            sq += RS[(cur * 9 + 1 + h) * 128 + 16 * mt + lr];
            const float sc = sq / sqrtf(ss * (1.0f / 96.0f) + EPSF);
            const float pe = __expf(sc - M);
            lacc += pe;
            if (lg == 0) *(bf16_t*)(Pl + h * SP_LD + (16 * mt + lr) * 2) = f2bf(pe);
        };
        {
            const int pg = ptab[0];
            const float* csrc = p.cache_latent + (size_t)pg * PAGE * KV_LORA;
            issue_r(p.cache_krope + (size_t)pg * PAGE * A_ROPE);
            issue_c(csrc, 0); write_c(0, 0); write_r(0);
            issue_c(csrc, 1); write_c(0, 1);
            issue_c(csrc, 2); write_c(0, 2);
            issue_c(csrc, 3); write_c(0, 3);
        }
        __syncthreads();
#pragma unroll 1
        for (int pi = 0; pi < 16; ++pi) {
            const int cur = pi & 1;
            const bool has_next = pi + 1 < 16;
            const int pgn = has_next ? ptab[pi + 1] : ptab[pi];
            const float* csrc = p.cache_latent + (size_t)pgn * PAGE * KV_LORA;
            if (has_next) { issue_r(p.cache_krope + (size_t)pgn * PAGE * A_ROPE); issue_c(csrc, 0); }
#pragma unroll 1
            for (int qt = 0; qt < 4; ++qt) {
                compute_mt(cur, 2 * qt); compute_mt(cur, 2 * qt + 1);
                if (has_next) { write_c(cur ^ 1, qt); if (qt == 0) write_r(cur ^ 1); if (qt < 3) issue_c(csrc, qt + 1); }
            }
            __syncthreads();
            {
                const char* xp = Pl + lr * SP_LD + lg * 16;
#pragma unroll
                for (int q = 0; q < 2; ++q) {
                    const int n0 = 32 * wid + 16 * q;
#pragma unroll 1
                    for (int ks = 0; ks < 4; ++ks) {
                        const bf16x8 xf = *(const bf16x8*)(xp + ks * 64);
                        const char* cc = Cs + cur * SC_BUF + (32 * ks + 8 * lg) * SC_LD + (n0 + lr) * 2;
                        bf16x8 wfr;
#pragma unroll
                        for (int e = 0; e < 8; ++e) wfr[e] = (short)*(const bf16_t*)(cc + e * SC_LD);
                        accl[q] = mfma16(wfr, xf, accl[q]);
                    }
                }
            }
            __syncthreads();
        }
        if (lr < 8) {
#pragma unroll
            for (int q = 0; q < 2; ++q) *(f32x4*)(p.PART + ((size_t)(b * 8 + split) * 8 + lr) * 256 + 32 * wid + 16 * q + 4 * lg) = accl[q];
        }
        lacc += __shfl_xor(lacc, 8); lacc += __shfl_xor(lacc, 4); lacc += __shfl_xor(lacc, 2); lacc += __shfl_xor(lacc, 1);
        if (lane == 0) p.PL[(b * 8 + split) * 8 + h] = lacc;
        __syncthreads();
    }
}

#define SA_D 6
#define SA_STG (SA_D * 16384)
#define SA_RSTG (SA_D * 2048)
#define SA_CB_SLOT (16 * SC_LD)
#define SA_NG 128
typedef __attribute__((address_space(3))) unsigned las_u32;
__device__ __forceinline__ void sample_attn2(const Params& p, char* lds) {
    const int tid = threadIdx.x, lane = tid & 63, lr = lane & 15, lg = lane >> 4;
    const int wid = __builtin_amdgcn_readfirstlane(tid >> 6);
    char* stg = lds;
    char* rstg = lds + SA_STG;
    char* cb = rstg + SA_RSTG;
    char* pl = cb + 3 * SA_CB_SLOT;
    float* rs = (float*)(pl + 1024);
    float* Qsl = (float*)((char*)rs + 1152);
    for (int blk = blockIdx.x; blk < DEC_BATCH * 8; blk += gridDim.x) {
        const int b = blk >> 3, split = blk & 7, h = wid;
        if (tid < 256) ((unsigned*)pl)[tid] = 0u;
        for (int i = tid; i < 8 * 96; i += NTHREADS) Qsl[i] = p.QS[(size_t)b * 768 + i];
        bf16x8 wf[4][8];
        {
            const bf16_t* wb = p.WUKV_T + (size_t)(64 * h + lr) * 256 + 8 * lg;
#pragma unroll
            for (int nt = 0; nt < 4; ++nt) {
                asm volatile("" : "+v"(wb));
#pragma unroll
                for (int ks = 0; ks < 8; ++ks) wf[nt][ks] = *(const bf16x8*)(wb + 32 * ks);
                wb += 16 * 256;
            }
        }
        const int pgid = p.page_table[b * NPAGES + split * 16 + (lane & 15)];
        const float* qsl = Qsl + h * 96;
        const float M = p.SCAL[0];
        f32x4 accl[2] = {{0.f, 0.f, 0.f, 0.f}, {0.f, 0.f, 0.f, 0.f}};
        float lacc = 0.f;
        asm volatile("s_waitcnt vmcnt(0) lgkmcnt(0)" ::: "memory");
        __syncthreads();
        auto issue = [&](int gi, int slot) {
            const int pg = __builtin_amdgcn_readlane(pgid, gi >> 3);
            const size_t row0 = (size_t)pg * PAGE + 16 * (gi & 7) + 2 * wid;
            const float* src = p.cache_latent + row0 * KV_LORA + lane * 4;
            las_u32* d0 = (las_u32*)(stg + slot * 16384 + (2 * wid) * 1024);
            __builtin_amdgcn_global_load_lds((const unsigned*)src, d0, 16, 0, 0);
            __builtin_amdgcn_global_load_lds((const unsigned*)(src + KV_LORA), (las_u32*)((char __attribute__((address_space(3)))*)d0 + 1024), 16, 0, 0);
            const float* rsrc = p.cache_krope + row0 * A_ROPE + lane;
            __builtin_amdgcn_global_load_lds((const unsigned*)rsrc, (las_u32*)(rstg + slot * 2048 + wid * 256), 4, 0, 0);
        };
#pragma unroll 1
        for (int gi = 0; gi < SA_D; ++gi) issue(gi, gi);
        int c3_g = 2, d_g1 = 0;
#pragma unroll 1
        for (int g = -1; g <= SA_NG; ++g) {
            const int c3_g1 = (c3_g == 2) ? 0 : c3_g + 1;
            const int c3_gm1 = (c3_g == 0) ? 2 : c3_g - 1;
            if (g + 1 < SA_NG) {
                if (g + SA_D <= SA_NG - 1) asm volatile("s_waitcnt vmcnt(%0)" :: "n"(3 * (SA_D - 1)) : "memory");
                else asm volatile("s_waitcnt vmcnt(0)" ::: "memory");
            }
            asm volatile("s_waitcnt lgkmcnt(0)" ::: "memory");
            __builtin_amdgcn_s_barrier();
            asm volatile("" ::: "memory");
            if (g + 1 < SA_NG) {
                const int gc = g + 1;
#pragma unroll
                for (int i = 0; i < 2; ++i) {
                    const f32x4 v = *(const f32x4*)(stg + d_g1 * 16384 + (2 * wid + i) * 1024 + lane * 16);
                    u32x2 w; w[0] = cvtpk(v[0], v[1]); w[1] = cvtpk(v[2], v[3]);
                    *(u32x2*)(cb + c3_g1 * SA_CB_SLOT + (2 * wid + i) * SC_LD + lane * 8) = w;
                }
                {
                    const int rrow = 2 * wid + (lane >> 5), hh = (lane >> 2) & 7, part = lane & 3;
                    const f32x4 r0 = *(const f32x4*)(rstg + d_g1 * 2048 + rrow * 128 + part * 32);
                    const f32x4 r1 = *(const f32x4*)(rstg + d_g1 * 2048 + rrow * 128 + part * 32 + 16);
                    const f32x4 q0 = *(const f32x4*)(Qsl + hh * 96 + 64 + part * 8), q1 = *(const f32x4*)(Qsl + hh * 96 + 64 + part * 8 + 4);
                    float dot = r0[0] * q0[0] + r0[1] * q0[1] + r0[2] * q0[2] + r0[3] * q0[3] + r1[0] * q1[0] + r1[1] * q1[1] + r1[2] * q1[2] + r1[3] * q1[3];
                    float rr = r0[0] * r0[0] + r0[1] * r0[1] + r0[2] * r0[2] + r0[3] * r0[3] + r1[0] * r1[0] + r1[1] * r1[1] + r1[2] * r1[2] + r1[3] * r1[3];
                    dot += __shfl_xor(dot, 1); dot += __shfl_xor(dot, 2);
                    rr += __shfl_xor(rr, 1); rr += __shfl_xor(rr, 2);
                    if (part == 0) {
                        rs[((gc & 1) * 9 + 1 + hh) * 16 + rrow] = dot;
                        if (hh == 0) rs[((gc & 1) * 9) * 16 + rrow] = rr;
                    }
                }
                asm volatile("s_waitcnt lgkmcnt(0)" ::: "memory");
                if (gc + SA_D < SA_NG) issue(gc + SA_D, d_g1);
            }
            if (g >= 0 && g < SA_NG) {
                f32x4 a[4];
#pragma unroll
                for (int nt = 0; nt < 4; ++nt) a[nt] = (f32x4){0.f, 0.f, 0.f, 0.f};
                const char* xs = cb + c3_g * SA_CB_SLOT + lr * SC_LD + lg * 16;
#pragma unroll
                for (int ks = 0; ks < 8; ++ks) {
                    const bf16x8 xf = *(const bf16x8*)(xs + ks * 64);
#pragma unroll
                    for (int nt = 0; nt < 4; ++nt) a[nt] = mfma16(wf[nt][ks], xf, a[nt]);
                }
                float ss = 0.f, sq = 0.f;
#pragma unroll
                for (int nt = 0; nt < 4; ++nt) {
                    const f32x4 qg = *(const f32x4*)(qsl + 16 * nt + 4 * lg);
#pragma unroll
                    for (int j = 0; j < 4; ++j) { ss += a[nt][j] * a[nt][j]; sq += a[nt][j] * qg[j]; }
                }
                ss += __shfl_xor(ss, 16); ss += __shfl_xor(ss, 32);
                sq += __shfl_xor(sq, 16); sq += __shfl_xor(sq, 32);
                ss += rs[((g & 1) * 9) * 16 + lr];
                sq += rs[((g & 1) * 9 + 1 + h) * 16 + lr];
                const float sc = sq / sqrtf(ss * (1.0f / 96.0f) + EPSF);
                const float pe = __expf(sc - M);
                lacc += pe;
                if (lg == 0) *(bf16_t*)(pl + (g & 1) * 512 + h * 32 + lr * 2) = f2bf(pe);
            }
            if (g >= 1) {
                bf16x8 xf = {0, 0, 0, 0, 0, 0, 0, 0};
                if (lg < 2) xf = *(const bf16x8*)(pl + ((g - 1) & 1) * 512 + lr * 32 + lg * 16);
#pragma unroll
                for (int q = 0; q < 2; ++q) {
                    const char* cc = cb + c3_gm1 * SA_CB_SLOT + ((8 * lg) & 15) * SC_LD + (32 * wid + 16 * q + lr) * 2;
                    bf16x8 wfr;
#pragma unroll
                    for (int e = 0; e < 8; ++e) wfr[e] = (short)*(const bf16_t*)(cc + e * SC_LD);
                    accl[q] = mfma16(wfr, xf, accl[q]);
                }
            }
            c3_g = c3_g1;
            d_g1 = (d_g1 + 1 == SA_D) ? 0 : d_g1 + 1;
        }
        if (lr < 8) {
#pragma unroll
            for (int q = 0; q < 2; ++q) *(f32x4*)(p.PART + ((size_t)(b * 8 + split) * 8 + lr) * 256 + 32 * wid + 16 * q + 4 * lg) = accl[q];
        }
        lacc += __shfl_xor(lacc, 8); lacc += __shfl_xor(lacc, 4); lacc += __shfl_xor(lacc, 2); lacc += __shfl_xor(lacc, 1);
        if (lane == 0) p.PL[(b * 8 + split) * 8 + h] = lacc;
        __syncthreads();
    }
}

#define SB_D 2
#define SB_STG (SB_D * 32768)
#define SB_RSTG (SB_D * 4096)
#define SB_CB_SLOT (32 * SC_LD)
#define SB_NG 64
__device__ __forceinline__ void sample_attn3(const Params& p, char* lds) {
    const int tid = threadIdx.x, lane = tid & 63, lr = lane & 15, lg = lane >> 4;
    const int wid = __builtin_amdgcn_readfirstlane(tid >> 6);
    char* stg = lds;
    char* rstg = lds + SB_STG;
    char* cb = rstg + SB_RSTG;
    char* pl = cb + 3 * SB_CB_SLOT;
    float* rs = (float*)(pl + 2048);
    float* Qsl = (float*)((char*)rs + 2304);
    for (int blk = blockIdx.x; blk < DEC_BATCH * 8; blk += gridDim.x) {
        const int b = blk >> 3, split = blk & 7, h = wid;
        ((unsigned*)pl)[tid] = 0u;
        for (int i = tid; i < 8 * 96; i += NTHREADS) Qsl[i] = p.QS[(size_t)b * 768 + i];
        bf16x8 wf[4][8];
        {
            const bf16_t* wb = p.WUKV_T + (size_t)(64 * h + lr) * 256 + 8 * lg;
#pragma unroll
            for (int nt = 0; nt < 4; ++nt) {
                asm volatile("" : "+v"(wb));
#pragma unroll
                for (int ks = 0; ks < 8; ++ks) wf[nt][ks] = *(const bf16x8*)(wb + 32 * ks);
                wb += 16 * 256;
            }
        }
        const int pgid = p.page_table[b * NPAGES + split * 16 + (lane & 15)];
        const float* qsl = Qsl + h * 96;
        const float M = p.SCAL[0];
        f32x4 accl[2] = {{0.f, 0.f, 0.f, 0.f}, {0.f, 0.f, 0.f, 0.f}};
        float lacc = 0.f;
        asm volatile("s_waitcnt vmcnt(0) lgkmcnt(0)" ::: "memory");
        __syncthreads();
        auto issue = [&](int gi, int slot) {
            const int pg = __builtin_amdgcn_readlane(pgid, gi >> 2);
            const size_t row0 = (size_t)pg * PAGE + 32 * (gi & 3) + 4 * wid;
            const float* src = p.cache_latent + row0 * KV_LORA + lane * 4;
            char __attribute__((address_space(3)))* d0 = (char __attribute__((address_space(3)))*)(stg + slot * 32768 + (4 * wid) * 1024);
            __builtin_amdgcn_global_load_lds((const unsigned*)src, (las_u32*)d0, 16, 0, 0);
            __builtin_amdgcn_global_load_lds((const unsigned*)(src + KV_LORA), (las_u32*)(d0 + 1024), 16, 0, 0);
            __builtin_amdgcn_global_load_lds((const unsigned*)(src + 2 * KV_LORA), (las_u32*)(d0 + 2048), 16, 0, 0);
            __builtin_amdgcn_global_load_lds((const unsigned*)(src + 3 * KV_LORA), (las_u32*)(d0 + 3072), 16, 0, 0);
            const float* rsrc = p.cache_krope + row0 * A_ROPE + lane;
            char __attribute__((address_space(3)))* r0 = (char __attribute__((address_space(3)))*)(rstg + slot * 4096 + wid * 512);
            __builtin_amdgcn_global_load_lds((const unsigned*)rsrc, (las_u32*)r0, 4, 0, 0);
            __builtin_amdgcn_global_load_lds((const unsigned*)(rsrc + 64), (las_u32*)(r0 + 256), 4, 0, 0);
        };
#pragma unroll 1
        for (int gi = 0; gi < SB_D; ++gi) issue(gi, gi);
        int c3_g = 2, d_g1 = 0;
#pragma unroll 1
        for (int g = -1; g <= SB_NG; ++g) {
            const int c3_g1 = (c3_g == 2) ? 0 : c3_g + 1;
            const int c3_gm1 = (c3_g == 0) ? 2 : c3_g - 1;
            if (g + 1 < SB_NG) {
                if (g + SB_D <= SB_NG - 1) asm volatile("s_waitcnt vmcnt(%0)" :: "n"(6 * (SB_D - 1)) : "memory");
                else asm volatile("s_waitcnt vmcnt(0)" ::: "memory");
            }
            asm volatile("s_waitcnt lgkmcnt(0)" ::: "memory");
            __builtin_amdgcn_s_barrier();
            asm volatile("" ::: "memory");
            if (g + 1 < SB_NG) {
                const int gc = g + 1;
#pragma unroll
                for (int i = 0; i < 4; ++i) {
                    const f32x4 v = *(const f32x4*)(stg + d_g1 * 32768 + (4 * wid + i) * 1024 + lane * 16);
                    u32x2 w; w[0] = cvtpk(v[0], v[1]); w[1] = cvtpk(v[2], v[3]);
                    *(u32x2*)(cb + c3_g1 * SB_CB_SLOT + (4 * wid + i) * SC_LD + lane * 8) = w;
                }
                {
                    const int hh = (lane >> 2) & 7, part = lane & 3;
                    const f32x4 q0 = *(const f32x4*)(Qsl + hh * 96 + 64 + part * 8), q1 = *(const f32x4*)(Qsl + hh * 96 + 64 + part * 8 + 4);
#pragma unroll
                    for (int i = 0; i < 2; ++i) {
                        const int rrow = 4 * wid + 2 * i + (lane >> 5);
                        const f32x4 r0 = *(const f32x4*)(rstg + d_g1 * 4096 + rrow * 128 + part * 32);
                        const f32x4 r1 = *(const f32x4*)(rstg + d_g1 * 4096 + rrow * 128 + part * 32 + 16);
                        float dot = r0[0] * q0[0] + r0[1] * q0[1] + r0[2] * q0[2] + r0[3] * q0[3] + r1[0] * q1[0] + r1[1] * q1[1] + r1[2] * q1[2] + r1[3] * q1[3];
                        float rr = r0[0] * r0[0] + r0[1] * r0[1] + r0[2] * r0[2] + r0[3] * r0[3] + r1[0] * r1[0] + r1[1] * r1[1] + r1[2] * r1[2] + r1[3] * r1[3];
                        dot += __shfl_xor(dot, 1); dot += __shfl_xor(dot, 2);
                        rr += __shfl_xor(rr, 1); rr += __shfl_xor(rr, 2);
                        if (part == 0) {
                            rs[((gc & 1) * 9 + 1 + hh) * 32 + rrow] = dot;
                            if (hh == 0) rs[((gc & 1) * 9) * 32 + rrow] = rr;
                        }
                    }
                }
                asm volatile("s_waitcnt lgkmcnt(0)" ::: "memory");
                if (gc + SB_D < SB_NG) issue(gc + SB_D, d_g1);
            }
            if (g >= 0 && g < SB_NG) {
#pragma unroll
                for (int mt2 = 0; mt2 < 2; ++mt2) {
                    f32x4 a[4];
#pragma unroll
                    for (int nt = 0; nt < 4; ++nt) a[nt] = (f32x4){0.f, 0.f, 0.f, 0.f};
                    const char* xs = cb + c3_g * SB_CB_SLOT + (16 * mt2 + lr) * SC_LD + lg * 16;
#pragma unroll
                    for (int ks = 0; ks < 8; ++ks) {
                        const bf16x8 xf = *(const bf16x8*)(xs + ks * 64);
#pragma unroll
                        for (int nt = 0; nt < 4; ++nt) a[nt] = mfma16(wf[nt][ks], xf, a[nt]);
                    }
                    float ss = 0.f, sq = 0.f;
#pragma unroll
                    for (int nt = 0; nt < 4; ++nt) {
                        const f32x4 qg = *(const f32x4*)(qsl + 16 * nt + 4 * lg);
#pragma unroll
                        for (int j = 0; j < 4; ++j) { ss += a[nt][j] * a[nt][j]; sq += a[nt][j] * qg[j]; }
                    }
                    ss += __shfl_xor(ss, 16); ss += __shfl_xor(ss, 32);
                    sq += __shfl_xor(sq, 16); sq += __shfl_xor(sq, 32);
                    ss += rs[((g & 1) * 9) * 32 + 16 * mt2 + lr];
                    sq += rs[((g & 1) * 9 + 1 + h) * 32 + 16 * mt2 + lr];
                    const float sc = sq * __builtin_amdgcn_rsqf(ss * (1.0f / 96.0f) + EPSF);
                    const float pe = __expf(sc - M);
                    lacc += pe;
                    if (lg == 0) *(bf16_t*)(pl + (g & 1) * 1024 + h * 64 + (16 * mt2 + lr) * 2) = f2bf(pe);
                }
            }
            if (g >= 1) {
                const bf16x8 xf = *(const bf16x8*)(pl + ((g - 1) & 1) * 1024 + lr * 64 + lg * 16);
#pragma unroll
                for (int q = 0; q < 2; ++q) {
                    const char* cc = cb + c3_gm1 * SB_CB_SLOT + (8 * lg) * SC_LD + (32 * wid + 16 * q + lr) * 2;
                    bf16x8 wfr;
#pragma unroll
                    for (int e = 0; e < 8; ++e) wfr[e] = (short)*(const bf16_t*)(cc + e * SC_LD);
                    accl[q] = mfma16(wfr, xf, accl[q]);
                }
            }
            c3_g = c3_g1;
            d_g1 = (d_g1 + 1 == SB_D) ? 0 : d_g1 + 1;
        }
        if (lr < 8) {
#pragma unroll
            for (int q = 0; q < 2; ++q) *(f32x4*)(p.PART + ((size_t)(b * 8 + split) * 8 + lr) * 256 + 32 * wid + 16 * q + 4 * lg) = accl[q];
        }
        lacc += __shfl_xor(lacc, 8); lacc += __shfl_xor(lacc, 4); lacc += __shfl_xor(lacc, 2); lacc += __shfl_xor(lacc, 1);
        if (lane == 0) p.PL[(b * 8 + split) * 8 + h] = lacc;
        __syncthreads();
    }
}

__device__ __forceinline__ void phase3(const Params& p, char* lds) {
    hgrn_passB(p);
    sample_attn3(p, lds);
}
__device__ __forceinline__ void phase4(const Params& p, char* lds) {
    attn_phase(p, lds);
    hgrn_passC(p, lds);
}

__device__ __forceinline__ void sample_combine(const Params& p, char* lds) {
    const int tid = threadIdx.x;
    float* ol = (float*)lds;
    float* sc = (float*)(lds + 8192);
    for (int b = blockIdx.x; b < DEC_BATCH; b += gridDim.x) {
        if (tid < 8) {
            const int h = tid;
            const float* kraw = p.KSRAW + (size_t)(b * 8 + h) * 96;
            const float* qs = p.QS + (size_t)(b * 8 + h) * 96;
            float ss = 0.f, sq = 0.f;
            for (int d = 0; d < 96; ++d) { ss += kraw[d] * kraw[d]; sq += kraw[d] * qs[d]; }
            const float s = sq / sqrtf(ss * (1.0f / 96.0f) + EPSF);
            const float pn = __expf(s - p.SCAL[0]);
            float l = pn;
            for (int sp = 0; sp < 8; ++sp) l += p.PL[(b * 8 + sp) * 8 + h];
            sc[h] = pn; sc[8 + h] = 1.0f / l;
        }
        __syncthreads();
#pragma unroll
        for (int i = 0; i < 4; ++i) {
            const int id = tid + 512 * i, h = id >> 8, c = id & 255;
            float a = sc[h] * p.out[OFF_LAT_S + b * 256 + c];
            for (int sp = 0; sp < 8; ++sp) a += p.PART[((size_t)(b * 8 + sp) * 8 + h) * 256 + c];
            ol[h * 256 + c] = a * sc[8 + h];
        }
        __syncthreads();
        {
            const int h = tid >> 6, d = tid & 63;
            float a = 0.f;
            const bf16_t* wrow = p.WUKV_T + (size_t)(512 + h * 64 + d) * 256;
#pragma unroll 8
            for (int c = 0; c < 256; c += 8) {
                const u32x4 w = *(const u32x4*)(wrow + c);
                const f32x4 o0 = *(const f32x4*)(ol + h * 256 + c), o1 = *(const f32x4*)(ol + h * 256 + c + 4);
                a += o0[0] * bflo(w[0]) + o0[1] * bfhi(w[0]) + o0[2] * bflo(w[1]) + o0[3] * bfhi(w[1]) + o1[0] * bflo(w[2]) + o1[1] * bfhi(w[2]) + o1[2] * bflo(w[3]) + o1[3] * bfhi(w[3]);
            }
            const float ga = bf2f(p.PBUF[(size_t)(R_PROMPT + b) * IN_COLS_PAD + C_GA + h * 64 + d]);
            p.AMA[(size_t)(NQ + b) * 512 + h * 64 + d] = f2bf(a * ga);
        }
        __syncthreads();
    }
}

__device__ __forceinline__ void merge_m_gemm(const Params& p, char* lds) {
    const int bx = blockIdx.x, vcu = (bx & 7) * 32 + (bx >> 3);
    OneTileOrder S{vcu, 1};
    {
        pg8::Gemm g{p.AMA, p.WOA_T, NQ, 1024, 512, p.AMA, p.WOA_T};
        EpiMerge<0> E{p.PBUF, p.TMP, p.MM};
        pg8::gemm_phase<EpiMerge<0>, OneTileOrder, false, true>((PG8_LAS unsigned char*)lds, g, S, E);
    }
    {
        pg8::Gemm g{p.AMB, p.WOB_T, NQ, 1024, 512, p.AMB, p.WOB_T};
        EpiMerge<1> E{p.PBUF, p.TMP, p.MM};
        pg8::gemm_phase<EpiMerge<1>, OneTileOrder, false, true>((PG8_LAS unsigned char*)lds, g, S, E);
    }
}

__device__ __forceinline__ void phase5(const Params& p, char* lds) {
    sample_combine(p, lds);
    merge_m_gemm(p, lds);
}

__device__ __forceinline__ float dot_bf16_row(const bf16_t* a, const bf16_t* w, int K) {
    float s = 0.f;
    for (int k = 0; k < K; k += 8) {
        const u32x4 x = *(const u32x4*)(a + k), y = *(const u32x4*)(w + k);
#pragma unroll
        for (int e = 0; e < 4; ++e) s += bflo(x[e]) * bflo(y[e]) + bfhi(x[e]) * bfhi(y[e]);
    }
    return s;
}
__device__ __forceinline__ void rows32_tile(f32x4 (&acc)[2], const bf16_t* __restrict__ X, int ldx, const bf16_t* __restrict__ W, int K, int nt) {
    const int lane = threadIdx.x & 63, lr = lane & 15, lg = lane >> 4;
    const bf16_t* x0 = X + (size_t)lr * ldx + lg * 8;
    const bf16_t* x1 = X + (size_t)(16 + lr) * ldx + lg * 8;
    const bf16_t* w = W + (size_t)(nt * 16 + lr) * K + lg * 8;
#pragma unroll 8
    for (int ks = 0; ks < (K >> 5); ++ks) {
        const bf16x8 wf = *(const bf16x8*)(w + ks * 32);
        acc[0] = mfma16(wf, *(const bf16x8*)(x0 + ks * 32), acc[0]);
        acc[1] = mfma16(wf, *(const bf16x8*)(x1 + ks * 32), acc[1]);
    }
}
__device__ __forceinline__ void sample_m(const Params& p) {
    const int lane = threadIdx.x & 63, lr = lane & 15, lg = lane >> 4;
    for (int nt = blockIdx.x * 8 + (threadIdx.x >> 6); nt < 64; nt += gridDim.x * 8) {
        f32x4 ya[2] = {{0.f, 0.f, 0.f, 0.f}, {0.f, 0.f, 0.f, 0.f}}, yb[2] = {{0.f, 0.f, 0.f, 0.f}, {0.f, 0.f, 0.f, 0.f}};
        rows32_tile(ya, p.AMA + (size_t)NQ * 512, 512, p.WOA_T, 512, nt);
        rows32_tile(yb, p.AMB + (size_t)NQ * 512, 512, p.WOB_T, 512, nt);
#pragma unroll
        for (int mt = 0; mt < 2; ++mt) {
            const int i = 16 * mt + lr, n = 16 * nt + 4 * lg;
            const size_t r = R_PROMPT + i;
            const u32x2 ga = *(const u32x2*)(p.PBUF + r * IN_COLS_PAD + C_MA + n);
            const u32x2 gb = *(const u32x2*)(p.PBUF + r * IN_COLS_PAD + C_MB + n);
            u32x2 w;
            w[0] = cvtpk(bflo(ga[0]) * ya[mt][0] + bflo(gb[0]) * yb[mt][0], bfhi(ga[0]) * ya[mt][1] + bfhi(gb[0]) * yb[mt][1]);
            w[1] = cvtpk(bflo(ga[1]) * ya[mt][2] + bflo(gb[1]) * yb[mt][2], bfhi(ga[1]) * ya[mt][3] + bfhi(gb[1]) * yb[mt][3]);
            *(u32x2*)(p.MM + (size_t)(NQ + i) * 1024 + n) = w;
        }
    }
}
__device__ __forceinline__ void final_gemm(const Params& p, char* lds) {
    const int bx = blockIdx.x, vcu = (bx & 7) * 32 + (bx >> 3);
    pg8::Gemm g{p.MM, p.WO_T, NQ, 1024, 1024, p.MM, p.WO_T};
    OneTileOrder S{vcu, 1};
    EpiFinal E{p.x_prompt, p.out + OFF_Y_P};
    pg8::gemm_phase<EpiFinal, OneTileOrder, false, true>((PG8_LAS unsigned char*)lds, g, S, E);
}

__device__ __forceinline__ void phase6(const Params& p, char* lds) {
    sample_m(p);
    final_gemm(p, lds);
}
__device__ __forceinline__ void phase7(const Params& p, char* lds) {
    const int lane = threadIdx.x & 63, lr = lane & 15, lg = lane >> 4;
    for (int nt = blockIdx.x * 8 + (threadIdx.x >> 6); nt < 64; nt += gridDim.x * 8) {
        f32x4 y[2] = {{0.f, 0.f, 0.f, 0.f}, {0.f, 0.f, 0.f, 0.f}};
        rows32_tile(y, p.MM + (size_t)NQ * 1024, 1024, p.WO_T, 1024, nt);
#pragma unroll
        for (int mt = 0; mt < 2; ++mt) {
            const int i = 16 * mt + lr, n = 16 * nt + 4 * lg;
            const f32x4 x = *(const f32x4*)(p.x_sample + (size_t)i * 1024 + n);
            *(f32x4*)(p.out + OFF_Y_S + (size_t)i * 1024 + n) = x + y[mt];
        }
    }
}

#define XB_TMO      128
#define XB_XCNT(j)  (256  + 64 * (j))
#define XB_XSUB(j)  (1280 + 64 * (j))
#define XB_XGEN(j)  (2304 + 64 * (j))
#define XB_TOP      3328
#define XB_TOPGEN   3392
#define XCD_BAR_WORDS 3456
#define XB_SPIN_CAP (1u << 22)
#define LAS __attribute__((address_space(3)))
__device__ __forceinline__ unsigned xb_ld(unsigned* p)              { return __hip_atomic_load(p, __ATOMIC_RELAXED, __HIP_MEMORY_SCOPE_AGENT); }
__device__ __forceinline__ unsigned xb_add(unsigned* p, unsigned v) { return __hip_atomic_fetch_add(p, v, __ATOMIC_RELAXED, __HIP_MEMORY_SCOPE_AGENT); }
__device__ __forceinline__ unsigned xb_xcc_id() { return (unsigned)__builtin_amdgcn_s_getreg((3 << 11) | 20) & 0xFu; }
#define XB_SPIN(cond, bar) do { unsigned _sp = 0; while (cond) { __builtin_amdgcn_s_sleep(1); \
    if ((++_sp & 255u) == 0u) { if (xb_ld(&(bar)[XB_TMO])) break; if (_sp > XB_SPIN_CAP) { atomicAdd(&(bar)[XB_TMO], 1u); break; } } } } while (0)
struct XcdBarrier { unsigned* bar; unsigned x; volatile LAS unsigned* st; };
__device__ __forceinline__ XcdBarrier xcd_barrier_post(unsigned* bar, volatile LAS unsigned* st) {
    XcdBarrier b; b.bar = bar; b.x = xb_xcc_id(); b.st = st;
    if (threadIdx.x == 0) (void)xb_add(&bar[XB_XCNT(b.x)], 1u);
    return b;
}
__device__ __forceinline__ void xcd_barrier_complete(unsigned* bar, unsigned x, unsigned& nloc, unsigned& nx) {
    const unsigned G = gridDim.x * gridDim.y * gridDim.z;
    unsigned sum, cnt, mine, sp = 0u;
    for (;;) {
        sum = 0u; cnt = 0u; mine = 0u;
#pragma unroll
        for (unsigned j = 0; j < 16; ++j) { const unsigned c = xb_ld(&bar[XB_XCNT(j)]); sum += c; cnt += (c > 0u) ? 1u : 0u; mine = (j == x) ? c : mine; }
        if (sum == G) break;
        __builtin_amdgcn_s_sleep(1);
        if ((++sp & 255u) == 0u) { if (xb_ld(&bar[XB_TMO])) break; if (sp > XB_SPIN_CAP) { atomicAdd(&bar[XB_TMO], 1u); break; } }
    }
    nloc = mine > 0u ? mine : 1u; nx = cnt > 0u ? cnt : 1u;
}
__device__ __forceinline__ void xcd_barrier(const XcdBarrier& b) {
    asm volatile("s_waitcnt vmcnt(0)" ::: "memory");
    __syncthreads();
    if (threadIdx.x == 0) {
        unsigned* bar = b.bar;
        __builtin_amdgcn_s_waitcnt(0);
        unsigned nloc = b.st[0], nx = b.st[1];
        if (nloc == 0u) { xcd_barrier_complete(bar, b.x, nloc, nx); b.st[0] = nloc; b.st[1] = nx; }
        const unsigned old = xb_add(&bar[XB_XSUB(b.x)], 1u);
        const unsigned gen = old / nloc;
        if (old + 1u == (gen + 1u) * nloc) {
            __builtin_amdgcn_fence(__ATOMIC_RELEASE, "agent");
            asm volatile("s_waitcnt vmcnt(0)" ::: "memory");
            const unsigned og = xb_add(&bar[XB_TOP], 1u);
            const unsigned tg = og / nx;
            if (og + 1u == (tg + 1u) * nx) xb_add(&bar[XB_TOPGEN], 1u);
            else XB_SPIN(xb_ld(&bar[XB_TOPGEN]) == tg, bar);
            __builtin_amdgcn_fence(__ATOMIC_ACQUIRE, "agent");
            xb_add(&bar[XB_XGEN(b.x)], 1u);
            asm volatile("s_waitcnt vmcnt(0)" ::: "memory");
        } else {
            XB_SPIN(xb_ld(&bar[XB_XGEN(b.x)]) == gen, bar);
            __builtin_amdgcn_fence(__ATOMIC_ACQUIRE, "agent");
            asm volatile("s_waitcnt vmcnt(0)" ::: "memory");
        }
    }
    __syncthreads();
}

extern __shared__ __attribute__((aligned(16))) char smem[];
#define NPHASES 8

#define XB_LDS_OFF (LDS_BYTES - 16)
__global__ void __launch_bounds__(NTHREADS) mega(Params p, int ph0, int ph1) {
    XcdBarrier xb;
    const bool multi = (ph1 - ph0) > 1;
    if (multi) {
        if (threadIdx.x == 0) *(u32x4*)(smem + XB_LDS_OFF) = (u32x4){0u, 0u, 0u, 0u};
        __syncthreads();
        xb = xcd_barrier_post(p.bar, (volatile LAS unsigned*)(smem + XB_LDS_OFF));
    }
#define RUN_PHASE(k) if (ph0 <= k && k < ph1) { phase##k(p, smem); if (k + 1 < ph1) xcd_barrier(xb); }
    RUN_PHASE(0)
    RUN_PHASE(1)
    RUN_PHASE(2)
    RUN_PHASE(3)
    RUN_PHASE(4)
    RUN_PHASE(5)
    RUN_PHASE(6)
    RUN_PHASE(7)
}

static inline size_t align_up(size_t x, size_t a) { return (x + a - 1) / a * a; }

extern "C" void kernel_launch(void* const* d_in, const int* in_sizes, int n_in,
                              void* d_out, int out_size, void* d_ws, size_t ws_size,
                              hipStream_t stream) {
    Params p{};
    p.x_prompt = (const float*)d_in[0]; p.x_sample = (const float*)d_in[1]; p.cache_latent = (const float*)d_in[2]; p.cache_krope = (const float*)d_in[3];
    p.state_hgrn = (const float*)d_in[4]; p.page_table = (const int*)d_in[5]; p.meta = (const float*)d_in[6]; p.norm_g = (const float*)d_in[7];
    p.w_in = (const float*)d_in[8]; p.g_cq = (const float*)d_in[9]; p.w_uq = (const float*)d_in[10]; p.g_ckv = (const float*)d_in[11];
    p.w_uk = (const float*)d_in[12]; p.w_uv = (const float*)d_in[13]; p.g_qn = (const float*)d_in[14]; p.g_kn = (const float*)d_in[15];
    p.lb_logits = (const float*)d_in[16]; p.g_bn = (const float*)d_in[17]; p.w_oa = (const float*)d_in[18]; p.w_ob = (const float*)d_in[19]; p.w_o = (const float*)d_in[20];
    p.out = (float*)d_out;
    char* w = (char*)d_ws; size_t off = 0;
    auto take = [&](size_t bytes) { char* r = w + off; off = align_up(off + bytes, 256); return r; };
    p.bar    = (unsigned*)take(16384);
    p.XN     = (bf16_t*)take((size_t)R_PAD * 1024 * 2);
    p.WIN_T  = (bf16_t*)take((size_t)IN_COLS_PAD * 1024 * 2);
    p.PBUF   = (bf16_t*)take((size_t)R_PAD * IN_COLS_PAD * 2);
    p.F32A   = (float*)take((size_t)R_PAD * 672 * 4);
    p.GLOG   = (float*)take((size_t)R_PAD * 512 * 4);
    p.CQN    = (bf16_t*)take((size_t)R_PAD * 384 * 2);
    p.CKVN   = (bf16_t*)take((size_t)R_PAD * 256 * 2);
    p.KRR    = (float*)take((size_t)R_PAD * 32 * 4);
    p.WUQ_T  = (bf16_t*)take((size_t)768 * 384 * 2);
    p.WUKV_T = (bf16_t*)take((size_t)1024 * 256 * 2);
    p.WUKVG_T = (bf16_t*)take((size_t)1024 * 256 * 2);
    p.F32B   = (float*)take((size_t)R_PAD * 288 * 4);
    p.WOA_T  = (bf16_t*)take((size_t)1024 * 512 * 2);
    p.WOB_T  = (bf16_t*)take((size_t)1024 * 512 * 2);
    p.WO_T   = (bf16_t*)take((size_t)1024 * 1024 * 2);
    p.QRAW   = (bf16_t*)take((size_t)R_PAD * 768 * 2);
    p.KVRAW  = (bf16_t*)take((size_t)R_PAD * 1024 * 2);
    p.QA     = (bf16_t*)take((size_t)8 * 8 * 2048 * 96 * 2);
    p.KA     = (bf16_t*)take((size_t)8 * 8 * 2064 * 96 * 2 + 65536);
    p.VTG    = (bf16_t*)take((size_t)64 * 64 * 2112 * 2);
    p.QS     = (float*)take((size_t)32 * 8 * 96 * 4);
    p.KSRAW  = (float*)take((size_t)32 * 8 * 96 * 4);
    p.AMA    = (bf16_t*)take((size_t)MROWS_PAD * 512 * 2);
    p.AMB    = (bf16_t*)take((size_t)MROWS_PAD * 512 * 2);
    p.MM     = (bf16_t*)take((size_t)MROWS_PAD * 1024 * 2);
    p.TMP    = (float*)take((size_t)NQ * 1024 * 4);
    p.UT     = (bf16_t*)take((size_t)32 * NCHUNK * 16384 * 2);
    p.ST     = (bf16_t*)take((size_t)32 * NCHUNK * 16384 * 2);
    p.DEC    = (float*)take((size_t)32 * NCHUNK * 128 * 4);
    p.LB     = (float*)take(512 * 4);
    p.INV    = (float*)take(64);
    p.ROPE   = (float*)take((size_t)2065 * 32 * 4);
    p.SCAL   = (float*)take(64);
    p.PART   = (float*)take((size_t)32 * 8 * 8 * 256 * 4);
    p.PL     = (float*)take((size_t)32 * 8 * 8 * 4);
    p.OLAT   = (float*)take((size_t)32 * 8 * 256 * 4);
    (void)ws_size; (void)in_sizes; (void)n_in; (void)out_size;
    static int mode = -1;
    if (mode < 0) {
        (void)hipFuncSetAttribute((const void*)mega, hipFuncAttributeMaxDynamicSharedMemorySize, LDS_BYTES);
        int dev = 0, cus = 0, per_cu = 0;
        (void)hipGetDevice(&dev);
        (void)hipDeviceGetAttribute(&cus, hipDeviceAttributeMultiprocessorCount, dev);
        (void)hipOccupancyMaxActiveBlocksPerMultiprocessor(&per_cu, (const void*)mega, NTHREADS, LDS_BYTES);
        mode = (cus * per_cu >= 256) ? 1 : 0;
    }
    (void)hipMemsetAsync(p.bar, 0, 16384, stream);
    if (mode == 1) {
        mega<<<dim3(256), dim3(NTHREADS), LDS_BYTES, stream>>>(p, 0, NPHASES);
    } else {
        for (int ph = 0; ph < NPHASES; ++ph) mega<<<dim3(256), dim3(NTHREADS), LDS_BYTES, stream>>>(p, ph, ph + 1);
    }
}
```

```cpp
#include <hip/hip_runtime.h>
#include <stdint.h>

#define D_MODEL 1024
#define BATCH 8
#define SEQ 2048
#define NMETA 16
#define LTOT 2064
#define DEC_BATCH 32
#define PAST_LEN 16384
#define PAGE 128
#define NPAGES 128
#define A_HEADS 8
#define A_NOPE 64
#define A_ROPE 32
#define A_QK 96
#define A_V 64
#define Q_LORA 384
#define KV_LORA 256
#define B_HEADS 4
#define B_DK 128
#define B_DV 128
#define IN_COLS 5280
#define IN_COLS_PAD 5376
#define EPSF 1e-6f

#define C_CQ 0
#define C_CKV 384
#define C_KR 640
#define C_BQ 672
#define C_BF 1184
#define C_BI 1696
#define C_GA 2208
#define C_GB 2720
#define C_MA 3232
#define C_MB 4256
#define C_END 5280

#define R_PROMPT 16512
#define R_ALL 16544
#define R_PAD 16640
#define NQ 16384
#define MROWS 16416
#define MROWS_PAD 16512

#define OFF_Y_P 0
#define OFF_Y_S 16777216
#define OFF_LAT_P 16809984
#define OFF_KR_P 21037056
#define OFF_HG_P 21565440
#define OFF_LAT_S 22089728
#define OFF_KR_S 22097920
#define OFF_HG_S 22098944
#define OUT_TOTAL 24196096

#define NTHREADS 512
#define LDS_BYTES 155648
#define LDS_ITEM_OFF (LDS_BYTES - 32)
#define NCHUNK 33

typedef unsigned short bf16_t;
typedef short bf16x8 __attribute__((ext_vector_type(8)));
typedef float f32x4 __attribute__((ext_vector_type(4)));
typedef float f32x2 __attribute__((ext_vector_type(2)));
typedef unsigned u32x4 __attribute__((ext_vector_type(4)));
typedef unsigned u32x2 __attribute__((ext_vector_type(2)));
typedef __bf16 bf16x2_t __attribute__((ext_vector_type(2)));

__device__ __forceinline__ unsigned cvtpk(float lo, float hi) {
    f32x2 v = {lo, hi};
    bf16x2_t b = __builtin_convertvector(v, bf16x2_t);
    return __builtin_bit_cast(unsigned, b);
}
__device__ __forceinline__ bf16_t f2bf(float x) { return (bf16_t)(cvtpk(x, 0.f) & 0xffffu); }
__device__ __forceinline__ float bf2f(bf16_t u) { return __uint_as_float(((unsigned)u) << 16); }
__device__ __forceinline__ float bflo(unsigned w) { return __uint_as_float(w << 16); }
__device__ __forceinline__ float bfhi(unsigned w) { return __uint_as_float(w & 0xffff0000u); }
__device__ __forceinline__ float sigmoidf_(float x) { return 1.0f / (1.0f + __expf(-x)); }
__device__ __forceinline__ float siluf_(float x) { return x / (1.0f + __expf(-x)); }
__device__ __forceinline__ float wave_sum(float v) {
    v += __shfl_xor(v, 32); v += __shfl_xor(v, 16); v += __shfl_xor(v, 8);
    v += __shfl_xor(v, 4);  v += __shfl_xor(v, 2);  v += __shfl_xor(v, 1);
    return v;
}

struct Params {
    const float* x_prompt; const float* x_sample; const float* cache_latent; const float* cache_krope;
    const float* state_hgrn; const int* page_table; const float* meta; const float* norm_g;
    const float* w_in; const float* g_cq; const float* w_uq; const float* g_ckv; const float* w_uk; const float* w_uv;
    const float* g_qn; const float* g_kn; const float* lb_logits; const float* g_bn;
    const float* w_oa; const float* w_ob; const float* w_o;
    float* out;
    bf16_t* XN;
    bf16_t* WIN_T;
    bf16_t* PBUF;
    float*  F32A;
    float*  GLOG;
    bf16_t* CQN;
    bf16_t* CKVN;
    float*  KRR;
    bf16_t* WUQ_T;
    bf16_t* WUKV_T;
    bf16_t* WUKVG_T;
    float*  F32B;
    bf16_t* WOA_T;
    bf16_t* WOB_T;
    bf16_t* WO_T;
    bf16_t* QRAW;
    bf16_t* KVRAW;
    bf16_t* QA;
    bf16_t* KA;
    bf16_t* VTG;
    float*  QS;
    float*  KSRAW;
    bf16_t* AMA;
    bf16_t* AMB;
    bf16_t* MM;
    float*  TMP;
    bf16_t* UT;
    bf16_t* ST;
    float*  DEC;
    float*  LB;
    float*  INV;
    float*  ROPE;
    float*  SCAL;
    float*  PART;
    float*  PL;
    float*  OLAT;
    unsigned* bar;
};

__device__ __forceinline__ f32x4 mfma16(bf16x8 w, bf16x8 x, f32x4 acc) {
    return __builtin_amdgcn_mfma_f32_16x16x32_bf16(w, x, acc, 0, 0, 0);
}

#define GT_LD 144
#define GT_BUF (128 * GT_LD)
#define GT_LDS_BYTES (4 * GT_BUF)

__device__ __forceinline__ void gemm_tile_accum(f32x4 (&acc)[4][2], const bf16_t* __restrict__ X, int ldx, const bf16_t* __restrict__ W, int ldw,
                                                int K, char* lds) {
    const int tid = threadIdx.x, lane = tid & 63, wid = tid >> 6, wm = wid >> 2, wn = wid & 3;
    const int lr = lane & 15, lg = lane >> 4;
    const int r0 = tid >> 3, kc = tid & 7;
    const bf16_t* xp0 = X + (size_t)r0 * ldx + kc * 8;
    const bf16_t* xp1 = X + (size_t)(r0 + 64) * ldx + kc * 8;
    const bf16_t* wp0 = W + (size_t)r0 * ldw + kc * 8;
    const bf16_t* wp1 = W + (size_t)(r0 + 64) * ldw + kc * 8;
    const int so0 = r0 * GT_LD + kc * 16, so1 = (r0 + 64) * GT_LD + kc * 16;
    char* Xs = lds; char* Ws = lds + 2 * GT_BUF;
    const int nk = K >> 6;
    u32x4 a0 = *(const u32x4*)xp0, a1 = *(const u32x4*)xp1, b0 = *(const u32x4*)wp0, b1 = *(const u32x4*)wp1;
    *(u32x4*)(Xs + so0) = a0; *(u32x4*)(Xs + so1) = a1; *(u32x4*)(Ws + so0) = b0; *(u32x4*)(Ws + so1) = b1;
    __syncthreads();
    const int xoff = (wm * 64 + lr) * GT_LD + lg * 16;
    const int woff = (wn * 32 + lr) * GT_LD + lg * 16;
    for (int kt = 0; kt < nk; ++kt) {
        const int cur = kt & 1;
        if (kt + 1 < nk) {
            const int ko = (kt + 1) * 64;
            a0 = *(const u32x4*)(xp0 + ko); a1 = *(const u32x4*)(xp1 + ko); b0 = *(const u32x4*)(wp0 + ko); b1 = *(const u32x4*)(wp1 + ko);
        }
        const char* xs = Xs + cur * GT_BUF + xoff;
        const char* ws = Ws + cur * GT_BUF + woff;
#pragma unroll
        for (int ks = 0; ks < 2; ++ks) {
            bf16x8 xf[4], wf[2];
#pragma unroll
            for (int mt = 0; mt < 4; ++mt) xf[mt] = *(const bf16x8*)(xs + mt * 16 * GT_LD + ks * 64);
#pragma unroll
            for (int nt = 0; nt < 2; ++nt) wf[nt] = *(const bf16x8*)(ws + nt * 16 * GT_LD + ks * 64);
#pragma unroll
            for (int mt = 0; mt < 4; ++mt)
#pragma unroll
                for (int nt = 0; nt < 2; ++nt) acc[mt][nt] = mfma16(wf[nt], xf[mt], acc[mt][nt]);
        }
        if (kt + 1 < nk) {
            char* xd = Xs + (cur ^ 1) * GT_BUF; char* wd = Ws + (cur ^ 1) * GT_BUF;
            *(u32x4*)(xd + so0) = a0; *(u32x4*)(xd + so1) = a1; *(u32x4*)(wd + so0) = b0; *(u32x4*)(wd + so1) = b1;
        }
        __syncthreads();
    }
}

namespace pg8 {
#define PG8_LAS __attribute__((address_space(3)))
constexpr int BM = 256, BK = 64, HALF = 128, HTB = HALF * BK * 2  , STAGE_BYTES = 8 * HTB, NXCD = 8, WGM = 8;

__host__ __device__ __forceinline__ int lds_byte(int r, int c) { const int st = (r >> 4) * 2 + (c >> 5), rr = r & 15, cc = c & 31, ob = rr * 64 + cc * 2; return st * 1024 + (ob ^ (((ob >> 9) & 1) << 5)); }
__host__ __device__ __forceinline__ void stage_rc(int b, int& R, int& C) { const int st = b / 1024, sb = b % 1024, swz = sb ^ (((sb >> 9) & 1) << 5); R = (st >> 1) * 16 + swz / 64; C = (st & 1) * 32 + (swz % 64) / 2; }
__host__ __device__ __forceinline__ int perm32(int rho) { const int n = rho >> 4, i = rho & 15; return 8 * (i >> 2) + 4 * n + (i & 3); }

struct Unit { int pm, pn, sel; };
struct Gemm { const bf16_t* A; const bf16_t* Bt; int M, N, K; const bf16_t* A1; const bf16_t* Bt1; };

struct StaticOrder {
    int nM, nN, nwg, G, c;
    __host__ __device__ void init(int M, int N, int G_, int c_) { nM = M / BM; nN = N / BM; nwg = nM * nN; G = G_; c = c_; }
    __host__ __device__ bool next(int i, Unit& u) const {
        const long L = (long)i * G + c; if (L >= nwg) return false;
        int wgid = (int)L; { const int q = nwg / NXCD, r = nwg % NXCD, xcd = wgid % NXCD, off = wgid / NXCD; wgid = (xcd < r ? xcd * (q + 1) : r * (q + 1) + (xcd - r) * q) + off; }
        const int nig = WGM * nN, gid = wgid / nig, fm = gid * WGM, gsz = (nM - fm) < WGM ? (nM - fm) : WGM;
        u.pm = fm + ((wgid % nig) % gsz); u.pn = (wgid % nig) / gsz; u.sel = 0; return true;
    }
    __device__ __forceinline__ void a_ready(const Unit&) const {}
    __device__ __forceinline__ void done(const Unit&) const {}
};


template <class Epi, class Sched, bool ALIGN_EPI = false, bool SP2 = false>
__device__ __forceinline__ void gemm_phase(PG8_LAS unsigned char* lds, const Gemm g, const Sched& S, const Epi& E) {
    const int tid = threadIdx.x, wid = __builtin_amdgcn_readfirstlane(tid >> 6), lane = tid & 63, wr = wid >> 2, wc = wid & 3, fr = lane & 15, fq = lane >> 4;
    const int K = g.K, nt = K / BK;
    unsigned voffA[2], voffB[2];
#pragma unroll
    for (int i = 0; i < 2; ++i) { int R, C; stage_rc(tid * 16 + i * 8192, R, C); const int Rb = Epi::PERM ? ((R & ~31) + perm32(R & 31)) : R;
        voffA[i] = (unsigned)(R * K + C) * 2u; voffB[i] = (unsigned)(Rb * K + C) * 2u; }
    const size_t kstep = (size_t)(BK * 2);
    const size_t hstep = (size_t)HALF * K * 2;
    const size_t tstep = 2 * hstep;
    const unsigned ldsw = (unsigned)wid * 1024u;
    const int aoff = lds_byte(wr * 64 + fr, fq * 8), boff = lds_byte(wc * 32 + fr, fq * 8);
#define PG8_SA(b, h) (((b) * 2 + (h)) * HTB)
#define PG8_SB(b, h) ((4 + (b) * 2 + (h)) * HTB)
#define PG8_STAGE(bufoff, gbase, voff) do { _Pragma("unroll") for (int _i = 0; _i < 2; ++_i) \
        __builtin_amdgcn_global_load_lds((const unsigned*)((const char*)(gbase) + (voff)[_i]), (PG8_LAS unsigned*)(lds + (bufoff) + ldsw + _i * 8192), 16, 0, 0); } while (0)
#define PG8_LDA(dst, b, h) do { _Pragma("unroll") for (int m = 0; m < 4; ++m) _Pragma("unroll") for (int k = 0; k < 2; ++k) dst[m][k] = *(const PG8_LAS bf16x8*)(lds + PG8_SA(b, h) + aoff + m * 2048 + k * 1024); } while (0)
#define PG8_LDB(dst, b, h) do { _Pragma("unroll") for (int n = 0; n < 2; ++n) _Pragma("unroll") for (int k = 0; k < 2; ++k) dst[n][k] = *(const PG8_LAS bf16x8*)(lds + PG8_SB(b, h) + boff + n * 2048 + k * 1024); } while (0)
#define PG8_MMA(ai, bj, At, Bt) do { __builtin_amdgcn_s_setprio(1); _Pragma("unroll") for (int m = 0; m < 4; ++m) _Pragma("unroll") for (int n = 0; n < 2; ++n) _Pragma("unroll") for (int k = 0; k < 2; ++k) \
        acc[ai][bj][m][n] = __builtin_amdgcn_mfma_f32_16x16x32_bf16(Bt[n][k], At[m][k], acc[ai][bj][m][n], 0, 0, 0); __builtin_amdgcn_s_setprio(0); } while (0)
#define PG8_WAIT_V(n) asm volatile("s_waitcnt vmcnt(" #n ")" ::: "memory")
#define PG8_WAIT_L(n) asm volatile("s_waitcnt lgkmcnt(" #n ")" ::: "memory")
#define PG8_BAR __builtin_amdgcn_s_barrier()
#define PG8_SCHED __builtin_amdgcn_sched_barrier(0)
    Unit cur, nxt; int ui = 0;
    if (!S.next(0, cur)) return;
    f32x4 acc[2][2][4][2];
#pragma unroll
    for (int a = 0; a < 2; ++a)
#pragma unroll
        for (int b = 0; b < 2; ++b)
#pragma unroll
            for (int m = 0; m < 4; ++m)
#pragma unroll
                for (int n = 0; n < 2; ++n) acc[a][b][m][n] = (f32x4){0.f, 0.f, 0.f, 0.f};
    bf16x8 At[4][2], B0[2][2], B1[2][2];
    const char* cA = (const char*)(cur.sel ? g.A1 : g.A) + (size_t)cur.pm * tstep; const char* cB = (const char*)(cur.sel ? g.Bt1 : g.Bt) + (size_t)cur.pn * tstep;
    S.a_ready(cur);
    if constexpr (SP2) {
        PG8_STAGE(PG8_SB(0, 0), cB, voffB); PG8_STAGE(PG8_SB(0, 1), cB + hstep, voffB); PG8_STAGE(PG8_SA(0, 0), cA, voffA); PG8_STAGE(PG8_SA(0, 1), cA + hstep, voffA);
        if (wr == 1) PG8_BAR;
        PG8_WAIT_V(2); PG8_BAR;
        PG8_STAGE(PG8_SB(1, 0), cB + kstep, voffB); PG8_STAGE(PG8_SA(1, 0), cA + kstep, voffA); PG8_STAGE(PG8_SB(1, 1), cB + hstep + kstep, voffB);
        PG8_WAIT_V(6); PG8_BAR;
    } else {
        PG8_STAGE(PG8_SB(0, 0), cB, voffB); PG8_STAGE(PG8_SA(0, 0), cA, voffA); PG8_STAGE(PG8_SB(0, 1), cB + hstep, voffB); PG8_STAGE(PG8_SA(0, 1), cA + hstep, voffA);
        if (wr == 1) PG8_BAR;
        PG8_WAIT_V(4); PG8_BAR;
        PG8_STAGE(PG8_SB(1, 0), cB + kstep, voffB); PG8_STAGE(PG8_SA(1, 0), cA + kstep, voffA); PG8_STAGE(PG8_SB(1, 1), cB + hstep + kstep, voffB);
        PG8_WAIT_V(6); PG8_BAR;
    }
    for (;;) {
        const bool has_next = S.next(ui + 1, nxt);
        const char* nA = has_next ? (const char*)(nxt.sel ? g.A1 : g.A) + (size_t)nxt.pm * tstep : cA; const char* nB = has_next ? (const char*)(nxt.sel ? g.Bt1 : g.Bt) + (size_t)nxt.pn * tstep : cB;
        for (int t = 0; t < nt; t += 2) {
            const bool last = (t == nt - 2);
            const char* a1 = cA + (size_t)(t + 1) * kstep;
            const char* a2 = last ? nA : cA + (size_t)(t + 2) * kstep; const char* b2 = last ? nB : cB + (size_t)(t + 2) * kstep;
            const char* a3 = a2 + kstep; const char* b3 = b2 + kstep;
            if (last && has_next) S.a_ready(nxt);
            if constexpr (SP2) {
            PG8_LDB(B0, 0, 0); PG8_LDB(B1, 0, 1); PG8_SCHED; PG8_LDA(At, 0, 0); PG8_STAGE(PG8_SA(1, 1), a1 + hstep, voffA);
            PG8_WAIT_V(8); PG8_WAIT_L(0); PG8_BAR; PG8_MMA(0, 0, At, B0); PG8_MMA(0, 1, At, B1); PG8_BAR; PG8_SCHED;
            PG8_LDA(At, 0, 1); PG8_STAGE(PG8_SB(0, 0), b2, voffB); PG8_STAGE(PG8_SB(0, 1), b2 + hstep, voffB); PG8_STAGE(PG8_SA(0, 0), a2, voffA);
            PG8_WAIT_V(8); PG8_WAIT_L(0); PG8_BAR; PG8_MMA(1, 0, At, B0); PG8_MMA(1, 1, At, B1); PG8_BAR; PG8_SCHED;
            PG8_LDB(B0, 1, 0); PG8_LDB(B1, 1, 1); PG8_SCHED; PG8_LDA(At, 1, 0); PG8_STAGE(PG8_SA(0, 1), a2 + hstep, voffA);
            PG8_WAIT_V(8); PG8_WAIT_L(0); PG8_BAR; PG8_MMA(0, 0, At, B0); PG8_MMA(0, 1, At, B1); PG8_BAR; PG8_SCHED;
            PG8_LDA(At, 1, 1); PG8_STAGE(PG8_SB(1, 0), b3, voffB); PG8_STAGE(PG8_SB(1, 1), b3 + hstep, voffB); PG8_STAGE(PG8_SA(1, 0), a3, voffA);
            PG8_WAIT_V(8); PG8_WAIT_L(0); PG8_BAR; PG8_MMA(1, 0, At, B0); PG8_MMA(1, 1, At, B1); PG8_BAR; PG8_SCHED;
            } else {
            PG8_LDB(B0, 0, 0); PG8_SCHED; PG8_LDA(At, 0, 0); PG8_STAGE(PG8_SA(1, 1), a1 + hstep, voffA);
            PG8_WAIT_L(8); PG8_BAR; PG8_WAIT_L(0); PG8_MMA(0, 0, At, B0); PG8_BAR; PG8_SCHED;
            PG8_LDB(B1, 0, 1); PG8_STAGE(PG8_SB(0, 0), b2, voffB);
            PG8_BAR; PG8_WAIT_L(0); PG8_MMA(0, 1, At, B1); PG8_BAR;
            PG8_LDA(At, 0, 1); PG8_STAGE(PG8_SA(0, 0), a2, voffA);
            PG8_BAR; PG8_WAIT_L(0); PG8_MMA(1, 0, At, B0); PG8_BAR; PG8_SCHED;
            PG8_STAGE(PG8_SB(0, 1), b2 + hstep, voffB);
            PG8_WAIT_V(6); PG8_BAR; PG8_MMA(1, 1, At, B1); PG8_BAR;
            PG8_LDB(B0, 1, 0); PG8_SCHED; PG8_LDA(At, 1, 0); PG8_STAGE(PG8_SA(0, 1), a2 + hstep, voffA);
            PG8_WAIT_L(8); PG8_BAR; PG8_WAIT_L(0); PG8_MMA(0, 0, At, B0); PG8_BAR; PG8_SCHED;
            PG8_LDB(B1, 1, 1); PG8_STAGE(PG8_SB(1, 0), b3, voffB);
            PG8_BAR; PG8_WAIT_L(0); PG8_MMA(0, 1, At, B1); PG8_BAR;
            PG8_LDA(At, 1, 1); PG8_STAGE(PG8_SA(1, 0), a3, voffA);
            PG8_BAR; PG8_WAIT_L(0); PG8_MMA(1, 0, At, B0); PG8_BAR; PG8_SCHED;
            PG8_STAGE(PG8_SB(1, 1), b3 + hstep, voffB);
            PG8_WAIT_V(6); PG8_BAR; PG8_MMA(1, 1, At, B1); PG8_BAR;
            }
        }
        if constexpr (ALIGN_EPI) { if (wr == 0) PG8_BAR; }
        if constexpr (!Epi::AFTER_DRAIN) { E(acc, cur, wr, wc, fr, fq); S.done(cur); }
        if (!has_next) break;
        if (!Epi::keep(cur)) {
#pragma unroll
        for (int a = 0; a < 2; ++a)
#pragma unroll
            for (int b = 0; b < 2; ++b)
#pragma unroll
                for (int m = 0; m < 4; ++m)
#pragma unroll
                    for (int n = 0; n < 2; ++n) acc[a][b][m][n] = (f32x4){0.f, 0.f, 0.f, 0.f};
        }
        cur = nxt; cA = nA; cB = nB; ++ui;
        if constexpr (ALIGN_EPI) { if (wr == 1) PG8_BAR; }
    }
    PG8_WAIT_V(0);
    if constexpr (!ALIGN_EPI) { if (wr == 0) PG8_BAR; }
    PG8_BAR;
    if constexpr (Epi::AFTER_DRAIN) { E.fused(acc, cur, wr, wc, fr, fq, lds, wid, lane); S.done(cur); }
#undef PG8_SA
#undef PG8_SB
#undef PG8_STAGE
#undef PG8_LDA
#undef PG8_LDB
#undef PG8_MMA
#undef PG8_WAIT_V
#undef PG8_WAIT_L
#undef PG8_BAR
#undef PG8_SCHED
}
}

struct EpiInProj {
    static constexpr bool PERM = true, AFTER_DRAIN = false;
    static __device__ __forceinline__ bool keep(const pg8::Unit&) { return false; }
    float* F32B; float* GLOG; bf16_t* PBUF; const float* LB; bf16_t* CQN; bf16_t* CKVN;
    __device__ __forceinline__ void operator()(f32x4 (&acc)[2][2][4][2], const pg8::Unit& u, int wr, int wc, int fr, int fq) const {
#pragma unroll
        for (int bj = 0; bj < 2; ++bj) {
            const int nseg = u.pn * 256 + bj * 128 + wc * 32;
            if (nseg >= C_END) continue;
            const int c = nseg + 8 * fq;
#pragma unroll
            for (int ai = 0; ai < 2; ++ai)
#pragma unroll
                for (int m = 0; m < 4; ++m) {
                    const size_t r = (size_t)u.pm * 256 + ai * 128 + wr * 64 + m * 16 + fr;
                    const f32x4 v0 = acc[ai][bj][m][0], v1 = acc[ai][bj][m][1];
                    if (nseg < C_BQ) {
                        if (nseg >= C_CKV) { *(f32x4*)(F32B + r * 288 + (c - C_CKV)) = v0; *(f32x4*)(F32B + r * 288 + (c - C_CKV) + 4) = v1; }
                        if (nseg < C_KR) {
                            u32x4 w; w[0] = cvtpk(v0[0], v0[1]); w[1] = cvtpk(v0[2], v0[3]); w[2] = cvtpk(v1[0], v1[1]); w[3] = cvtpk(v1[2], v1[3]);
                            if (nseg < C_CKV) *(u32x4*)(CQN + r * 384 + c) = w; else *(u32x4*)(CKVN + r * 256 + (c - C_CKV)) = w;
                        }
                        continue;
                    }
                    f32x4 o0, o1;
                    if (nseg < C_BF) {
#pragma unroll
                        for (int e = 0; e < 4; ++e) { o0[e] = siluf_(v0[e]); o1[e] = siluf_(v1[e]); }
                    } else if (nseg < C_BI) {
                        const f32x4 lb0 = *(const f32x4*)(LB + (c - C_BF)), lb1 = *(const f32x4*)(LB + (c - C_BF) + 4);
                        f32x4 l0, l1;
#pragma unroll
                        for (int e = 0; e < 4; ++e) {
                            const float sg0 = 1.0f / (1.0f + expf(-v0[e])), sg1 = 1.0f / (1.0f + expf(-v1[e]));
                            l0[e] = logf(lb0[e] + (1.0f - lb0[e]) * sg0); l1[e] = logf(lb1[e] + (1.0f - lb1[e]) * sg1);
                            o0[e] = (1.0f - lb0[e]) * (1.0f - sg0); o1[e] = (1.0f - lb1[e]) * (1.0f - sg1);
                        }
                        *(f32x4*)(GLOG + r * 512 + (c - C_BF)) = l0; *(f32x4*)(GLOG + r * 512 + (c - C_BF) + 4) = l1;
                    } else if (nseg < C_GA) {
                        o0 = v0; o1 = v1;
                    } else if (nseg < C_MA) {
#pragma unroll
                        for (int e = 0; e < 4; ++e) { o0[e] = siluf_(v0[e]); o1[e] = siluf_(v1[e]); }
                    } else {
#pragma unroll
                        for (int e = 0; e < 4; ++e) { o0[e] = sigmoidf_(v0[e]); o1[e] = sigmoidf_(v1[e]); }
                    }
                    u32x4 w; w[0] = cvtpk(o0[0], o0[1]); w[1] = cvtpk(o0[2], o0[3]); w[2] = cvtpk(o1[0], o1[1]); w[3] = cvtpk(o1[2], o1[3]);
                    *(u32x4*)(PBUF + r * IN_COLS_PAD + c) = w;
                    asm volatile("" ::: "memory");
                }
        }
    }
};
template <int STAGE> struct EpiMerge {
    static constexpr bool PERM = true, AFTER_DRAIN = false;
    static __device__ __forceinline__ bool keep(const pg8::Unit&) { return false; }
    const bf16_t* PBUF; float* TMP; bf16_t* MM;
    __device__ __forceinline__ void operator()(f32x4 (&acc)[2][2][4][2], const pg8::Unit& u, int wr, int wc, int fr, int fq) const {
#pragma unroll
        for (int ai = 0; ai < 2; ++ai)
#pragma unroll
            for (int m = 0; m < 4; ++m) {
                const int mq = u.pm * 256 + ai * 128 + wr * 64 + m * 16 + fr;
                const size_t r = (size_t)(mq >> 11) * LTOT + NMETA + (mq & 2047);
#pragma unroll
                for (int bj = 0; bj < 2; ++bj) {
                    const int c = u.pn * 256 + bj * 128 + wc * 32 + 8 * fq;
                    const u32x4 g = *(const u32x4*)(PBUF + r * IN_COLS_PAD + (STAGE == 0 ? C_MA : C_MB) + c);
                    const f32x4 v0 = acc[ai][bj][m][0], v1 = acc[ai][bj][m][1];
                    f32x4 o0, o1;
                    o0[0] = v0[0] * bflo(g[0]); o0[1] = v0[1] * bfhi(g[0]); o0[2] = v0[2] * bflo(g[1]); o0[3] = v0[3] * bfhi(g[1]);
                    o1[0] = v1[0] * bflo(g[2]); o1[1] = v1[1] * bfhi(g[2]); o1[2] = v1[2] * bflo(g[3]); o1[3] = v1[3] * bfhi(g[3]);
                    if (STAGE == 0) {
                        u32x4 w; w[0] = cvtpk(o0[0], o0[1]); w[1] = cvtpk(o0[2], o0[3]); w[2] = cvtpk(o1[0], o1[1]); w[3] = cvtpk(o1[2], o1[3]);
                        *(u32x4*)(MM + (size_t)mq * 1024 + c) = w;
                    }
                    else {
                        const u32x4 tw = *(const u32x4*)(MM + (size_t)mq * 1024 + c);
                        f32x4 t0, t1;
                        t0[0] = bflo(tw[0]); t0[1] = bfhi(tw[0]); t0[2] = bflo(tw[1]); t0[3] = bfhi(tw[1]);
                        t1[0] = bflo(tw[2]); t1[1] = bfhi(tw[2]); t1[2] = bflo(tw[3]); t1[3] = bfhi(tw[3]);
                        u32x4 w; w[0] = cvtpk(o0[0] + t0[0], o0[1] + t0[1]); w[1] = cvtpk(o0[2] + t0[2], o0[3] + t0[3]);
                        w[2] = cvtpk(o1[0] + t1[0], o1[1] + t1[1]); w[3] = cvtpk(o1[2] + t1[2], o1[3] + t1[3]);
                        *(u32x4*)(MM + (size_t)mq * 1024 + c) = w;
                    }
                }
                asm volatile("" ::: "memory");
            }
    }
};
struct EpiFinal {
    static constexpr bool PERM = true, AFTER_DRAIN = false;
    static __device__ __forceinline__ bool keep(const pg8::Unit&) { return false; }
    const float* X; float* Y;
    __device__ __forceinline__ void operator()(f32x4 (&acc)[2][2][4][2], const pg8::Unit& u, int wr, int wc, int fr, int fq) const {
#pragma unroll
        for (int ai = 0; ai < 2; ++ai)
#pragma unroll
            for (int m = 0; m < 4; ++m) {
                const size_t mq = (size_t)u.pm * 256 + ai * 128 + wr * 64 + m * 16 + fr;
#pragma unroll
                for (int bj = 0; bj < 2; ++bj) {
                    const int c = u.pn * 256 + bj * 128 + wc * 32 + 8 * fq;
                    const f32x4 x0 = *(const f32x4*)(X + mq * 1024 + c), x1 = *(const f32x4*)(X + mq * 1024 + c + 4);
                    *(f32x4*)(Y + mq * 1024 + c) = x0 + acc[ai][bj][m][0];
                    *(f32x4*)(Y + mq * 1024 + c + 4) = x1 + acc[ai][bj][m][1];
                }
            }
    }
};
struct OneTileOrder {
    int tile, nsel;
    __device__ __forceinline__ bool next(int i, pg8::Unit& u) const { if (i >= nsel) return false; u.pm = tile >> 2; u.pn = tile & 3; u.sel = i; return true; }
    __device__ __forceinline__ void a_ready(const pg8::Unit&) const {}
    __device__ __forceinline__ void done(const pg8::Unit&) const {}
};

__device__ __forceinline__ void transpose_tile(const float* __restrict__ src, int src_ld, int nvalid, int k0, int n0,
                                               bf16_t* __restrict__ dst, int dst_ld, float* tile  , const float* __restrict__ kscale) {
    const int tid = threadIdx.x;
#pragma unroll
    for (int i = 0; i < 2; ++i) {
        const int kk = (tid >> 4) + 32 * i, nn = (tid & 15) * 4;
        f32x4 v = {0.f, 0.f, 0.f, 0.f};
        if (n0 + nn < nvalid) v = *(const f32x4*)(src + (size_t)(k0 + kk) * src_ld + n0 + nn);
        if (kscale) v = v * kscale[k0 + kk];
        tile[kk * 65 + nn + 0] = v[0]; tile[kk * 65 + nn + 1] = v[1]; tile[kk * 65 + nn + 2] = v[2]; tile[kk * 65 + nn + 3] = v[3];
    }
    __syncthreads();
    {
        const int n = tid >> 3, kq = (tid & 7) * 8;
        u32x4 w;
        w[0] = cvtpk(tile[(kq + 0) * 65 + n], tile[(kq + 1) * 65 + n]);
        w[1] = cvtpk(tile[(kq + 2) * 65 + n], tile[(kq + 3) * 65 + n]);
        w[2] = cvtpk(tile[(kq + 4) * 65 + n], tile[(kq + 5) * 65 + n]);
        w[3] = cvtpk(tile[(kq + 6) * 65 + n], tile[(kq + 7) * 65 + n]);
        *(u32x4*)(dst + (size_t)(n0 + n) * dst_ld + k0 + kq) = w;
    }
    __syncthreads();
}

__device__ __forceinline__ void phase0(const Params& p, char* lds) {
    const int tid = threadIdx.x, lane = tid & 63, wid = tid >> 6;
    const int nb = gridDim.x, bid = blockIdx.x;
    {
        float* tile = (float*)lds;
        const int c0 = 16 * 84;
        const int c1 = c0 + 6 * 12;
        const int c2 = c1 + 4 * 8;
        const int c3 = c2 + 4 * 8;
        const int c4 = c3 + 8 * 16;
        const int c5 = c4 + 8 * 16;
        const int c6 = c5 + 16 * 16;
        const int c7 = c6 + 4 * 8;
        const int c8 = c7 + 4 * 8;
        for (int j = bid; j < c8; j += nb) {
            const float* src; int sld, nval, ntn, loc; bf16_t* dst; int dld; const float* ksc = nullptr;
            if (j < c0)      { loc = j;      src = p.w_in; sld = IN_COLS; nval = IN_COLS; ntn = 84; dst = p.WIN_T; dld = 1024; }
            else if (j < c1) { loc = j - c0; src = p.w_uq; sld = 768;  nval = 768;  ntn = 12; dst = p.WUQ_T; dld = 384; ksc = p.g_cq; }
            else if (j < c2) { loc = j - c1; src = p.w_uk; sld = 512;  nval = 512;  ntn = 8;  dst = p.WUKV_T; dld = 256; }
            else if (j < c3) { loc = j - c2; src = p.w_uv; sld = 512;  nval = 512;  ntn = 8;  dst = p.WUKV_T + (size_t)512 * 256; dld = 256; }
            else if (j < c4) { loc = j - c3; src = p.w_oa; sld = 1024; nval = 1024; ntn = 16; dst = p.WOA_T; dld = 512; }
            else if (j < c5) { loc = j - c4; src = p.w_ob; sld = 1024; nval = 1024; ntn = 16; dst = p.WOB_T; dld = 512; }
            else if (j < c6) { loc = j - c5; src = p.w_o;  sld = 1024; nval = 1024; ntn = 16; dst = p.WO_T; dld = 1024; }
            else if (j < c7) { loc = j - c6; src = p.w_uk; sld = 512;  nval = 512;  ntn = 8;  dst = p.WUKVG_T; dld = 256; ksc = p.g_ckv; }
            else             { loc = j - c7; src = p.w_uv; sld = 512;  nval = 512;  ntn = 8;  dst = p.WUKVG_T + (size_t)512 * 256; dld = 256; ksc = p.g_ckv; }
            const int kt = loc / ntn, nt = loc % ntn;
            transpose_tile(src, sld, nval, kt * 64, nt * 64, dst, dld, tile, ksc);
        }
    }
    for (int i = bid * NTHREADS + tid; i < 64 * 64 * 48; i += nb * NTHREADS) {
        const int row = i / 48, c = i - row * 48;
        p.VTG[(size_t)row * 2112 + LTOT + c] = 0;
    }
    for (int r = bid * 8 + wid; r < R_PAD; r += nb * 8) {
        bf16_t* dst = p.XN + (size_t)r * 1024;
        if (r >= R_ALL) {
#pragma unroll
            for (int i = 0; i < 4; ++i) *(u32x2*)(dst + lane * 4 + 256 * i) = (u32x2){0u, 0u};
            continue;
        }
        const float* src;
        if (r < R_PROMPT) { const int b = r / LTOT, t = r - b * LTOT; src = (t < NMETA) ? p.meta + (size_t)t * 1024 : p.x_prompt + ((size_t)b * SEQ + (t - NMETA)) * 1024; }
        else src = p.x_sample + (size_t)(r - R_PROMPT) * 1024;
        f32x4 v[4]; float ss = 0.f;
#pragma unroll
        for (int i = 0; i < 4; ++i) { v[i] = *(const f32x4*)(src + lane * 4 + 256 * i); ss += v[i][0] * v[i][0] + v[i][1] * v[i][1] + v[i][2] * v[i][2] + v[i][3] * v[i][3]; }
        ss = wave_sum(ss);
        const float rs = 1.0f / sqrtf(ss * (1.0f / 1024.0f) + EPSF);
#pragma unroll
        for (int i = 0; i < 4; ++i) {
            const f32x4 g = *(const f32x4*)(p.norm_g + lane * 4 + 256 * i);
            u32x2 w; w[0] = cvtpk(v[i][0] * rs * g[0], v[i][1] * rs * g[1]); w[1] = cvtpk(v[i][2] * rs * g[2], v[i][3] * rs * g[3]);
            *(u32x2*)(dst + lane * 4 + 256 * i) = w;
        }
    }
    for (int i = bid * NTHREADS + tid; i < 2065 * 16; i += nb * NTHREADS) {
        const int pi = i >> 4, k = i & 15;
        const float pos = (pi < LTOT) ? (float)pi : (float)PAST_LEN;
        const float inv = (float)exp(-(double)k / 16.0 * log(10000.0));
        const float ang = pos * inv;
        p.ROPE[pi * 32 + k] = cosf(ang); p.ROPE[pi * 32 + 16 + k] = sinf(ang);
    }
    if (bid == 0) {
        if (tid < 512) { const float l0 = p.lb_logits[tid], l1 = p.lb_logits[512 + tid]; p.LB[tid] = 1.0f / (1.0f + expf(l1 - l0)); }
        if (tid < 16) p.INV[tid] = (float)exp(-(double)tid / 16.0 * log(10000.0));
        if (wid == 0) {
            float gq = 0.f, gk = 0.f;
            for (int i = lane; i < A_QK; i += 64) { gq = fmaxf(gq, fabsf(p.g_qn[i])); gk = fmaxf(gk, fabsf(p.g_kn[i])); }
#pragma unroll
            for (int o = 32; o >= 1; o >>= 1) { gq = fmaxf(gq, __shfl_xor(gq, o)); gk = fmaxf(gk, __shfl_xor(gk, o)); }
            if (lane == 0) p.SCAL[0] = sqrtf((float)A_QK) * gq * gk;
        }
    }
}

__device__ __forceinline__ void phase1(const Params& p, char* lds) {
    pg8::Gemm g{p.XN, p.WIN_T, R_PAD, IN_COLS_PAD, 1024, p.XN, p.WIN_T};
    pg8::StaticOrder S; S.init(R_PAD, IN_COLS_PAD, (int)gridDim.x, (int)blockIdx.x);
    EpiInProj E{p.F32B, p.GLOG, p.PBUF, p.LB, p.CQN, p.CKVN};
    pg8::gemm_phase<EpiInProj, pg8::StaticOrder, true, true>((PG8_LAS unsigned char*)lds, g, S, E);
}

#define LOG2E 1.4426950408889634f
__device__ __forceinline__ void fin1_chunk(const Params& p, const int c) {
    int tid_ = threadIdx.x; asm volatile("" : "+v"(tid_));
    const int tid = tid_, lane = tid & 63, wid = tid >> 6;
#pragma unroll 1
    for (int i = 0; i < 8; ++i) {
        const int r = c * 64 + wid * 8 + i;
        if (r >= R_ALL) break;
        const float* src = p.F32B + (size_t)r * 288;
        int pidx; float* o_lat; float* o_kr;
        if (r < R_PROMPT) { pidx = r % LTOT; o_lat = p.out + OFF_LAT_P + (size_t)r * 256; o_kr = p.out + OFF_KR_P + (size_t)r * 32; }
        else { const int j = r - R_PROMPT; pidx = LTOT; o_lat = p.out + OFF_LAT_S + (size_t)j * 256; o_kr = p.out + OFF_KR_S + (size_t)j * 32; }
        const f32x4 v = *(const f32x4*)(src + lane * 4);
        float ss = v[0] * v[0] + v[1] * v[1] + v[2] * v[2] + v[3] * v[3];
        ss = wave_sum(ss);
        const float rs = 1.0f / sqrtf(ss * (1.0f / 256.0f) + EPSF);
        const f32x4 g = *(const f32x4*)(p.g_ckv + lane * 4);
        f32x4 o; o[0] = v[0] * rs * g[0]; o[1] = v[1] * rs * g[1]; o[2] = v[2] * rs * g[2]; o[3] = v[3] * rs * g[3];
        *(f32x4*)(o_lat + lane * 4) = o;
        if (lane < 16) {
            const float x1 = src[256 + lane], x2 = src[256 + 16 + lane];
            const float cs = p.ROPE[pidx * 32 + lane], sn = p.ROPE[pidx * 32 + 16 + lane];
            o_kr[lane] = x1 * cs - x2 * sn; o_kr[16 + lane] = x1 * sn + x2 * cs;
        }
    }
}

#define UF_XQ_LD 784
#define UF_XK_LD 528
__device__ __forceinline__ float diag_pick(const f32x4 a, int lr, int lg) {
    const int j = lr & 3;
    float v = (j == 0) ? a[0] : (j == 1) ? a[1] : (j == 2) ? a[2] : a[3];
    v = (lg == (lr >> 2)) ? v : 0.f;
    v += __shfl_xor(v, 16); v += __shfl_xor(v, 32);
    return v;
}
__device__ __forceinline__ void upfused_item(const Params& p, char* lds, const int item) {
    int tid_ = threadIdx.x; asm volatile("" : "+v"(tid_));
    const int tid = tid_, lane = tid & 63, h = tid >> 6, lr = lane & 15, lg = lane >> 4;
    const int rt = item / 3, part = item - rt * 3, row0 = rt * 64;
    const float qk_scale = 0.10206207261596577f;
    if (part == 0) {
        char* X = lds;
#pragma unroll
        for (int i = 0; i < 6; ++i) {
            const int id = tid + 512 * i, row = id / 48, ch = id - row * 48;
            *(u32x4*)(X + row * UF_XQ_LD + ch * 16) = *(const u32x4*)(p.CQN + (size_t)(row0 + row) * 384 + ch * 8);
        }
        __syncthreads();
        f32x4 acc[4][6], accs[4];
#pragma unroll
        for (int mt = 0; mt < 4; ++mt) { accs[mt] = (f32x4){0.f, 0.f, 0.f, 0.f};
#pragma unroll
            for (int nt = 0; nt < 6; ++nt) acc[mt][nt] = (f32x4){0.f, 0.f, 0.f, 0.f}; }
        const bf16_t* wb = p.WUQ_T + (size_t)(h * 96 + lr) * 384 + 8 * lg;
#pragma unroll 1
        for (int ks = 0; ks < 12; ++ks) {
            bf16x8 xf[4], wf[6];
#pragma unroll
            for (int nt = 0; nt < 6; ++nt) wf[nt] = *(const bf16x8*)(wb + (size_t)nt * 16 * 384 + ks * 32);
#pragma unroll
            for (int mt = 0; mt < 4; ++mt) xf[mt] = *(const bf16x8*)(X + (16 * mt + lr) * UF_XQ_LD + ks * 64 + lg * 16);
#pragma unroll
            for (int mt = 0; mt < 4; ++mt) {
                accs[mt] = mfma16(xf[mt], xf[mt], accs[mt]);
#pragma unroll
                for (int nt = 0; nt < 6; ++nt) acc[mt][nt] = mfma16(wf[nt], xf[mt], acc[mt][nt]);
            }
        }
#pragma unroll
        for (int mt = 0; mt < 4; ++mt) {
            const int r = row0 + 16 * mt + lr;
            const float rs_cq = 1.0f / sqrtf(diag_pick(accs[mt], lr, lg) * (1.0f / 384.0f) + EPSF);
            const bool is_s = r >= R_PROMPT;
            const int b = r / LTOT, t = r - b * LTOT;
            const int pidx = is_s ? LTOT : t;
            f32x4 q[6];
#pragma unroll
            for (int nt = 0; nt < 6; ++nt) q[nt] = acc[mt][nt] * rs_cq;
            {
                const f32x4 c4 = *(const f32x4*)(p.ROPE + pidx * 32 + 4 * lg), s4 = *(const f32x4*)(p.ROPE + pidx * 32 + 16 + 4 * lg);
#pragma unroll
                for (int j = 0; j < 4; ++j) { const float x1 = q[4][j], x2 = q[5][j]; q[4][j] = x1 * c4[j] - x2 * s4[j]; q[5][j] = x1 * s4[j] + x2 * c4[j]; }
            }
            float ss = 0.f;
#pragma unroll
            for (int nt = 0; nt < 6; ++nt)
#pragma unroll
                for (int j = 0; j < 4; ++j) ss += q[nt][j] * q[nt][j];
            ss += __shfl_xor(ss, 16); ss += __shfl_xor(ss, 32);
            const float rs = 1.0f / sqrtf(ss * (1.0f / 96.0f) + EPSF);
            if (!is_s) {
                if (t >= NMETA && r < R_PROMPT) {
                    bf16_t* dst = p.QA + ((size_t)(b * 8 + h) * 2048 + (t - NMETA)) * 96 + 4 * lg;
                    const float sc = rs * qk_scale * LOG2E;
#pragma unroll
                    for (int nt = 0; nt < 6; ++nt) {
                        const f32x4 g = *(const f32x4*)(p.g_qn + 16 * nt + 4 * lg);
                        u32x2 w; w[0] = cvtpk(q[nt][0] * sc * g[0], q[nt][1] * sc * g[1]); w[1] = cvtpk(q[nt][2] * sc * g[2], q[nt][3] * sc * g[3]);
                        *(u32x2*)(dst + 16 * nt) = w;
                    }
                }
            } else if (r < R_ALL) {
                float* dst = p.QS + ((size_t)(r - R_PROMPT) * 8 + h) * 96 + 4 * lg;
                const float sc = rs * qk_scale;
#pragma unroll
                for (int nt = 0; nt < 6; ++nt) {
                    const f32x4 g = *(const f32x4*)(p.g_qn + 16 * nt + 4 * lg), gk = *(const f32x4*)(p.g_kn + 16 * nt + 4 * lg);
                    f32x4 o; o[0] = q[nt][0] * sc * g[0] * gk[0]; o[1] = q[nt][1] * sc * g[1] * gk[1]; o[2] = q[nt][2] * sc * g[2] * gk[2]; o[3] = q[nt][3] * sc * g[3] * gk[3];
                    *(f32x4*)(dst + 16 * nt) = o;
                }
            }
        }
    } else {
        char* X = lds;
        float* KR = (float*)(lds + 64 * UF_XK_LD);
#pragma unroll
        for (int i = 0; i < 4; ++i) {
            const int id = tid + 512 * i, row = id >> 5, ch = id & 31;
            *(u32x4*)(X + row * UF_XK_LD + ch * 16) = *(const u32x4*)(p.CKVN + (size_t)(row0 + row) * 256 + ch * 8);
        }
        if (part == 1) { const int row = tid >> 3, c4 = tid & 7; *(f32x4*)(KR + row * 36 + c4 * 4) = *(const f32x4*)(p.F32B + (size_t)(row0 + row) * 288 + 256 + c4 * 4); }
        __syncthreads();
        f32x4 ak[4][4], accs[4];
#pragma unroll
        for (int mt = 0; mt < 4; ++mt) { accs[mt] = (f32x4){0.f, 0.f, 0.f, 0.f};
#pragma unroll
            for (int nt = 0; nt < 4; ++nt) ak[mt][nt] = (f32x4){0.f, 0.f, 0.f, 0.f}; }
        const bf16_t* wk = p.WUKVG_T + (size_t)((part == 1 ? 0 : 512) + h * 64 + lr) * 256 + 8 * lg;
#pragma unroll 1
        for (int ks = 0; ks < 8; ++ks) {
            bf16x8 xf[4], wfk[4];
#pragma unroll
            for (int nt = 0; nt < 4; ++nt) wfk[nt] = *(const bf16x8*)(wk + (size_t)nt * 16 * 256 + ks * 32);
#pragma unroll
            for (int mt = 0; mt < 4; ++mt) xf[mt] = *(const bf16x8*)(X + (16 * mt + lr) * UF_XK_LD + ks * 64 + lg * 16);
#pragma unroll
            for (int mt = 0; mt < 4; ++mt) {
                accs[mt] = mfma16(xf[mt], xf[mt], accs[mt]);
#pragma unroll
                for (int nt = 0; nt < 4; ++nt) ak[mt][nt] = mfma16(wfk[nt], xf[mt], ak[mt][nt]);
            }
        }
#pragma unroll
        for (int mt = 0; mt < 4; ++mt) {
            const int r = row0 + 16 * mt + lr;
            const float rs_ckv = 1.0f / sqrtf(diag_pick(accs[mt], lr, lg) * (1.0f / 256.0f) + EPSF);
            const bool is_s = r >= R_PROMPT;
            const int b = r / LTOT, t = r - b * LTOT;
            if (part == 2) {
                if (!is_s) {
                    const int x = t & 15, slot = (t & ~15) | (x & 3) | ((x & 4) << 1) | ((x & 8) >> 1);
                    bf16_t* vd = p.VTG + (size_t)(b * 8 + h) * 64 * 2112 + slot;
#pragma unroll
                    for (int nt = 0; nt < 4; ++nt)
#pragma unroll
                        for (int j = 0; j < 4; ++j) vd[(size_t)(16 * nt + 4 * lg + j) * 2112] = f2bf(ak[mt][nt][j] * rs_ckv);
                }
                continue;
            }
            const int pidx = is_s ? LTOT : t;
            const f32x4 x1 = *(const f32x4*)(KR + (16 * mt + lr) * 36 + 4 * lg), x2 = *(const f32x4*)(KR + (16 * mt + lr) * 36 + 16 + 4 * lg);
            float ss = 0.f;
#pragma unroll
            for (int j = 0; j < 4; ++j) ss += x1[j] * x1[j] + x2[j] * x2[j];
            f32x4 kn[4];
#pragma unroll
            for (int nt = 0; nt < 4; ++nt) { kn[nt] = ak[mt][nt] * rs_ckv;
#pragma unroll
                for (int j = 0; j < 4; ++j) ss += kn[nt][j] * kn[nt][j]; }
            ss += __shfl_xor(ss, 16); ss += __shfl_xor(ss, 32);
            const float rs = 1.0f / sqrtf(ss * (1.0f / 96.0f) + EPSF);
            const f32x4 c4 = *(const f32x4*)(p.ROPE + pidx * 32 + 4 * lg), s4 = *(const f32x4*)(p.ROPE + pidx * 32 + 16 + 4 * lg);
            f32x4 y1, y2;
#pragma unroll
            for (int j = 0; j < 4; ++j) { y1[j] = x1[j] * c4[j] - x2[j] * s4[j]; y2[j] = x1[j] * s4[j] + x2[j] * c4[j]; }
            if (!is_s) {
                bf16_t* dst = p.KA + ((size_t)(b * 8 + h) * LTOT + t) * 96 + 4 * lg;
#pragma unroll
                for (int nt = 0; nt < 4; ++nt) {
                    const f32x4 g = *(const f32x4*)(p.g_kn + 16 * nt + 4 * lg);
                    u32x2 w; w[0] = cvtpk(kn[nt][0] * rs * g[0], kn[nt][1] * rs * g[1]); w[1] = cvtpk(kn[nt][2] * rs * g[2], kn[nt][3] * rs * g[3]);
                    *(u32x2*)(dst + 16 * nt) = w;
                }
                {
                    const f32x4 g1 = *(const f32x4*)(p.g_kn + 64 + 4 * lg), g2 = *(const f32x4*)(p.g_kn + 80 + 4 * lg);
                    u32x2 w1, w2;
                    w1[0] = cvtpk(y1[0] * rs * g1[0], y1[1] * rs * g1[1]); w1[1] = cvtpk(y1[2] * rs * g1[2], y1[3] * rs * g1[3]);
                    w2[0] = cvtpk(y2[0] * rs * g2[0], y2[1] * rs * g2[1]); w2[1] = cvtpk(y2[2] * rs * g2[2], y2[3] * rs * g2[3]);
                    *(u32x2*)(dst + 64) = w1; *(u32x2*)(dst + 80) = w2;
                }
            } else if (r < R_ALL) {
                float* dst = p.KSRAW + ((size_t)(r - R_PROMPT) * 8 + h) * 96 + 4 * lg;
#pragma unroll
                for (int nt = 0; nt < 4; ++nt) *(f32x4*)(dst + 16 * nt) = kn[nt];
                *(f32x4*)(dst + 64) = y1; *(f32x4*)(dst + 80) = y2;
            }
        }
    }
    __syncthreads();
}

#define HA_LD 144
#define HC_LD 272
__device__ __forceinline__ void hgrn_passA_unit(const Params& p, char* lds, const int u) {
    int tid_ = threadIdx.x; asm volatile("" : "+v"(tid_));
    const int tid = tid_, lane = tid & 63, wid = tid >> 6, lr = lane & 15, lg = lane >> 4;
    float* cumL = (float*)lds;
    float* tot = (float*)(lds + 32768);
    char* KT = lds + 32768 + 2048;
    char* VT = KT + 128 * HA_LD;
    {
        const int c = u % NCHUNK, bh = u / NCHUNK, h = bh % B_HEADS, b = bh / B_HEADS;
        const int nvalid = (c == 0) ? NMETA : 64;
        const int t0 = (c == 0) ? 0 : NMETA + 64 * (c - 1);
        const size_t rowbase = (size_t)b * LTOT + t0;
        const int d = tid & 127, part = tid >> 7;
        char* KR = VT + 128 * HA_LD;
#pragma unroll
        for (int i = 0; i < 4; ++i) {
            const int id = tid + 512 * i, row = id >> 5, c4 = id & 31;
            f32x4 g = {0.f, 0.f, 0.f, 0.f};
            if (row < nvalid) g = *(const f32x4*)(p.GLOG + (rowbase + row) * 512 + h * 128 + c4 * 4);
            *(f32x4*)(cumL + row * 128 + c4 * 4) = g;
        }
#pragma unroll
        for (int i = 0; i < 2; ++i) {
            const int id = tid + 512 * i, row = id >> 4, ch = id & 15;
            u32x4 kw = {0u, 0u, 0u, 0u}, w = {0u, 0u, 0u, 0u};
            if (row < nvalid) {
                kw = *(const u32x4*)(p.PBUF + (rowbase + row) * IN_COLS_PAD + C_BF + h * 128 + ch * 8);
                w = *(const u32x4*)(p.PBUF + (rowbase + row) * IN_COLS_PAD + C_BI + h * 128 + ch * 8);
            }
            *(u32x4*)(KR + row * HC_LD + ch * 16) = kw;
#pragma unroll
            for (int e = 0; e < 4; ++e) {
                *(bf16_t*)(VT + (ch * 8 + 2 * e) * HA_LD + row * 2) = (bf16_t)(w[e] & 0xffffu);
                *(bf16_t*)(VT + (ch * 8 + 2 * e + 1) * HA_LD + row * 2) = (bf16_t)(w[e] >> 16);
            }
        }
        __syncthreads();
        {
            float run = 0.f;
#pragma unroll
            for (int i = 0; i < 16; ++i) { const int s = part * 16 + i; run += cumL[s * 128 + d]; cumL[s * 128 + d] = run; }
            tot[part * 128 + d] = run;
        }
        __syncthreads();
        {
            float off = 0.f, last = 0.f;
#pragma unroll
            for (int q = 0; q < 4; ++q) { const float tq = tot[q * 128 + d]; last += tq; if (q < part) off += tq; }
            if (part == 0) p.DEC[(size_t)u * 128 + d] = expf(last);
#pragma unroll
            for (int i = 0; i < 16; ++i) {
                const int s = part * 16 + i;
                const float cum = cumL[s * 128 + d] + off;
                const float kv = bf2f(*(const bf16_t*)(KR + s * HC_LD + d * 2));
                *(bf16_t*)(KT + d * HA_LD + s * 2) = f2bf(kv * __expf(last - cum));
            }
        }
        __syncthreads();
        {
            const char* xs = VT + (wid * 16 + lr) * HA_LD + lg * 16;
            bf16x8 xf0 = *(const bf16x8*)(xs), xf1 = *(const bf16x8*)(xs + 64);
            bf16_t* dst = p.UT + (size_t)u * 16384 + (size_t)(wid * 16 + lr) * 128;
#pragma unroll
            for (int nt = 0; nt < 8; ++nt) {
                const char* ws = KT + (nt * 16 + lr) * HA_LD + lg * 16;
                f32x4 acc = {0.f, 0.f, 0.f, 0.f};
                acc = mfma16(*(const bf16x8*)(ws), xf0, acc);
                acc = mfma16(*(const bf16x8*)(ws + 64), xf1, acc);
                { u32x2 w; w[0] = cvtpk(acc[0], acc[1]); w[1] = cvtpk(acc[2], acc[3]); *(u32x2*)(dst + nt * 16 + 4 * lg) = w; }
            }
        }
        __syncthreads();
    }
}

__device__ __forceinline__ void hgrn_sample_step_unit(const Params& p, char* lds, const int u) {
    int tid_ = threadIdx.x; asm volatile("" : "+v"(tid_));
    const int tid = tid_;
    float* part = (float*)lds;
    float* red = (float*)(lds + 8192);
    {
        const int i = u / B_HEADS, h = u % B_HEADS;
        const size_t r = R_PROMPT + i;
        const int v4 = (tid & 31) * 4, dp = tid >> 5;
        const float* S0 = p.state_hgrn + (size_t)u * 16384;
        float* S1 = p.out + OFF_HG_S + (size_t)u * 16384;
        const u32x2 vw = *(const u32x2*)(p.PBUF + r * IN_COLS_PAD + C_BI + h * 128 + v4);
        const float vv[4] = {bflo(vw[0]), bfhi(vw[0]), bflo(vw[1]), bfhi(vw[1])};
        float o[4] = {0.f, 0.f, 0.f, 0.f};
#pragma unroll
        for (int e = 0; e < 8; ++e) {
            const int d = dp * 8 + e;
            const float q = bf2f(p.PBUF[r * IN_COLS_PAD + C_BQ + h * 128 + d]);
            const float k = bf2f(p.PBUF[r * IN_COLS_PAD + C_BF + h * 128 + d]);
            const float f = expf(p.GLOG[r * 512 + h * 128 + d]);
            const f32x4 s0 = *(const f32x4*)(S0 + d * 128 + v4);
            f32x4 s1;
#pragma unroll
            for (int j = 0; j < 4; ++j) { s1[j] = f * s0[j] + k * vv[j]; o[j] += q * s1[j]; }
            *(f32x4*)(S1 + d * 128 + v4) = s1;
        }
#pragma unroll
        for (int j = 0; j < 4; ++j) part[dp * 128 + v4 + j] = o[j];
        __syncthreads();
        float osum = 0.f;
        if (tid < 128) {
#pragma unroll
            for (int q = 0; q < 16; ++q) osum += part[q * 128 + tid];
            float ss = wave_sum(osum * osum);
            if ((tid & 63) == 0) red[tid >> 6] = ss;
        }
        __syncthreads();
        if (tid < 128) {
            const float ss = red[0] + red[1];
            const float rs = 1.0f / sqrtf(ss * (1.0f / 128.0f) + EPSF);
            const float gb = bf2f(p.PBUF[r * IN_COLS_PAD + C_GB + h * 128 + tid]);
            p.AMB[(size_t)(NQ + i) * 512 + h * 128 + tid] = f2bf(osum * rs * p.g_bn[tid] * gb);
        }
        __syncthreads();
    }
}

#define Q_UF_ITEMS (3 * (R_PAD / 64))
#define Q_HA_ITEMS (BATCH * B_HEADS * NCHUNK)
#define Q_SS_ITEMS (DEC_BATCH * B_HEADS)
#define Q_F1_ITEMS ((R_ALL + 63) / 64)
#define QCTR_WORD 3584
__device__ __forceinline__ void phase2(const Params& p, char* lds) {
    volatile int* slot = (volatile int*)(lds + LDS_ITEM_OFF);
    const int total = Q_UF_ITEMS + Q_HA_ITEMS + Q_SS_ITEMS + Q_F1_ITEMS;
    int nxt = 0;
    if (threadIdx.x == 0) nxt = (int)atomicAdd(p.bar + QCTR_WORD, 1u);
    for (;;) {
        if (threadIdx.x == 0) *slot = nxt;
        __syncthreads();
        const int it = __builtin_amdgcn_readfirstlane(*slot);
        __syncthreads();
        if (it >= total) break;
        if (threadIdx.x == 0) nxt = (int)atomicAdd(p.bar + QCTR_WORD, 1u);
        if (it < Q_UF_ITEMS) upfused_item(p, lds, it);
        else if (it < Q_UF_ITEMS + Q_HA_ITEMS) hgrn_passA_unit(p, lds, it - Q_UF_ITEMS);
        else if (it < Q_UF_ITEMS + Q_HA_ITEMS + Q_SS_ITEMS) hgrn_sample_step_unit(p, lds, it - Q_UF_ITEMS - Q_HA_ITEMS);
        else fin1_chunk(p, it - Q_UF_ITEMS - Q_HA_ITEMS - Q_SS_ITEMS);
    }
}

__device__ __forceinline__ void hgrn_passB(const Params& p) {
    for (int g = blockIdx.x * NTHREADS + threadIdx.x; g < 32 * 128 * 32; g += gridDim.x * NTHREADS) {
        const int d4 = (g & 31) * 4, v = (g >> 5) & 127, bh = g >> 12;
        f32x4 S = {0.f, 0.f, 0.f, 0.f};
        for (int c = 0; c < NCHUNK; ++c) {
            const size_t u = (size_t)bh * NCHUNK + c;
            u32x2 w; w[0] = cvtpk(S[0], S[1]); w[1] = cvtpk(S[2], S[3]);
            *(u32x2*)(p.ST + u * 16384 + v * 128 + d4) = w;
            const f32x4 dec = *(const f32x4*)(p.DEC + u * 128 + d4);
            const u32x2 uw = *(const u32x2*)(p.UT + u * 16384 + v * 128 + d4);
            const f32x4 ut = {bflo(uw[0]), bfhi(uw[0]), bflo(uw[1]), bfhi(uw[1])};
#pragma unroll
            for (int j = 0; j < 4; ++j) S[j] = dec[j] * S[j] + ut[j];
        }
        float* o = p.out + OFF_HG_P + (size_t)bh * 16384;
#pragma unroll
        for (int j = 0; j < 4; ++j) o[(d4 + j) * 128 + v] = S[j];
    }
}

#define AK_LD 208
#define AV_LD 144
#define AP_LD 144
#define AK_BUF (64 * AK_LD)
#define AV_BUF (64 * AV_LD)
__device__ __forceinline__ void attn_unit(const Params& p, char* lds, int b, int h, int qb) {
    const int tid = threadIdx.x, lane = tid & 63, wid = tid >> 6, lr = lane & 15, lg = lane >> 4;
    char* Ks = lds;
    char* VTs = lds + 2 * AK_BUF;
    char* Ps = VTs + 2 * AV_BUF + wid * 16 * AP_LD;
    const int tq0 = qb * 128;
    const int ntile = 2 * qb + 3;
    const float Mb = p.SCAL[0] * LOG2E;
    const bf16_t* qsrc = p.QA + ((size_t)(b * 8 + h) * 2048 + tq0 + 16 * wid + lr) * 96 + lg * 8;
    bf16x8 qf[3];
#pragma unroll
    for (int ks = 0; ks < 3; ++ks) qf[ks] = *(const bf16x8*)(qsrc + ks * 32);
    const int qpos = NMETA + tq0 + 16 * wid + lr;
    const int wq_max = NMETA + tq0 + 16 * wid + 15;
    const bf16_t* kbase = p.KA + (size_t)(b * 8 + h) * LTOT * 96;
    const bf16_t* vbase = p.KVRAW + (size_t)b * LTOT * 1024 + 512 + h * 64;
    const int kkey0 = tid / 12, kpart0 = tid % 12;
    const int kkey1 = (512 + tid) / 12, kpart1 = (512 + tid) % 12;
    const int vkey = tid >> 3, vdc = tid & 7;
    u32x4 kr0, kr1 = {0u, 0u, 0u, 0u}, vr;
    auto load_tile = [&](int ti) {
        const int key0 = ti * 64;
        int ka = key0 + kkey0; ka = ka < LTOT ? ka : LTOT - 1;
        kr0 = *(const u32x4*)(kbase + (size_t)ka * 96 + kpart0 * 8);
        if (tid < 256) { int kb = key0 + kkey1; kb = kb < LTOT ? kb : LTOT - 1; kr1 = *(const u32x4*)(kbase + (size_t)kb * 96 + kpart1 * 8); }
        int kv = key0 + vkey; kv = kv < LTOT ? kv : LTOT - 1;
        vr = *(const u32x4*)(vbase + (size_t)kv * 1024 + vdc * 8);
    };
    auto store_tile = [&](int buf) {
        *(u32x4*)(Ks + buf * AK_BUF + kkey0 * AK_LD + kpart0 * 16) = kr0;
        if (tid < 256) *(u32x4*)(Ks + buf * AK_BUF + kkey1 * AK_LD + kpart1 * 16) = kr1;
        char* vt = VTs + buf * AV_BUF + vkey * 2;
#pragma unroll
        for (int e = 0; e < 4; ++e) {
            *(bf16_t*)(vt + (vdc * 8 + 2 * e) * AV_LD) = (bf16_t)(vr[e] & 0xffffu);
            *(bf16_t*)(vt + (vdc * 8 + 2 * e + 1) * AV_LD) = (bf16_t)(vr[e] >> 16);
        }
    };
    f32x4 o[4];
#pragma unroll
    for (int i = 0; i < 4; ++i) o[i] = (f32x4){0.f, 0.f, 0.f, 0.f};
    float lsum = 0.f;
    load_tile(0); store_tile(0);
    __syncthreads();
    for (int ti = 0; ti < ntile; ++ti) {
        const int cur = ti & 1;
        if (ti + 1 < ntile) load_tile(ti + 1);
        if (ti * 64 <= wq_max) {
            const char* kb_ = Ks + cur * AK_BUF + lr * AK_LD + lg * 16;
#pragma unroll
            for (int nt = 0; nt < 4; ++nt) {
                f32x4 s = {0.f, 0.f, 0.f, 0.f};
#pragma unroll
                for (int ks = 0; ks < 3; ++ks) s = mfma16(*(const bf16x8*)(kb_ + nt * 16 * AK_LD + ks * 64), qf[ks], s);
                const int key = ti * 64 + nt * 16 + 4 * lg;
                float pe[4];
#pragma unroll
                for (int j = 0; j < 4; ++j) { pe[j] = (key + j <= qpos) ? exp2f(s[j] - Mb) : 0.f; lsum += pe[j]; }
                u32x2 w; w[0] = cvtpk(pe[0], pe[1]); w[1] = cvtpk(pe[2], pe[3]);
                *(u32x2*)(Ps + lr * AP_LD + (nt * 16 + 4 * lg) * 2) = w;
            }
            asm volatile("s_waitcnt lgkmcnt(0)" ::: "memory");
            __builtin_amdgcn_wave_barrier();
            const bf16x8 pf0 = *(const bf16x8*)(Ps + lr * AP_LD + lg * 16);
            const bf16x8 pf1 = *(const bf16x8*)(Ps + lr * AP_LD + 64 + lg * 16);
            const char* vb_ = VTs + cur * AV_BUF + lr * AV_LD + lg * 16;
#pragma unroll
            for (int nt = 0; nt < 4; ++nt) {
                o[nt] = mfma16(*(const bf16x8*)(vb_ + nt * 16 * AV_LD), pf0, o[nt]);
                o[nt] = mfma16(*(const bf16x8*)(vb_ + nt * 16 * AV_LD + 64), pf1, o[nt]);
            }
            asm volatile("s_waitcnt lgkmcnt(0)" ::: "memory");
            __builtin_amdgcn_wave_barrier();
        }
        if (ti + 1 < ntile) store_tile(cur ^ 1);
        __syncthreads();
    }
    lsum += __shfl_xor(lsum, 16); lsum += __shfl_xor(lsum, 32);
    const float inv = 1.0f / lsum;
    const int tq = tq0 + 16 * wid + lr;
    const size_t r = (size_t)b * LTOT + NMETA + tq;
    const size_t mrow = (size_t)b * 2048 + tq;
#pragma unroll
    for (int nt = 0; nt < 4; ++nt) {
        const int dv = nt * 16 + 4 * lg;
        const u32x2 gw = *(const u32x2*)(p.PBUF + r * IN_COLS_PAD + C_GA + h * 64 + dv);
        u32x2 w; w[0] = cvtpk(o[nt][0] * inv * bflo(gw[0]), o[nt][1] * inv * bfhi(gw[0])); w[1] = cvtpk(o[nt][2] * inv * bflo(gw[1]), o[nt][3] * inv * bfhi(gw[1]));
        *(u32x2*)(p.AMA + mrow * 512 + h * 64 + dv) = w;
    }
}

typedef float f32x16 __attribute__((ext_vector_type(16)));
#define A2K_LD 208
#define A2V_LD 144
#define A2K_BUF (64 * A2K_LD)
#define A2V_BUF (64 * A2V_LD)
__device__ __forceinline__ f32x16 mfma32(bf16x8 a, bf16x8 b, f32x16 c) { return __builtin_amdgcn_mfma_f32_32x32x16_bf16(a, b, c, 0, 0, 0); }
__device__ __forceinline__ void attn_unit2(const Params& p, char* lds, int b, int h, int qb) {
    const int tid = threadIdx.x, lane = tid & 63, wid = tid >> 6, r32 = lane & 31, hi = lane >> 5;
    char* Ks = lds;
    char* Vs = lds + 2 * A2K_BUF;
    const int tq0 = qb * 256;
    const int ntile = 4 * qb + 5;
    const float negMb = -p.SCAL[0] * LOG2E;
    const bf16_t* qsrc = p.QA + ((size_t)(b * 8 + h) * 2048 + tq0 + 32 * wid + r32) * 96 + hi * 8;
    bf16x8 qf[6];
#pragma unroll
    for (int s = 0; s < 6; ++s) qf[s] = *(const bf16x8*)(qsrc + 16 * s);
    const int wq_min = NMETA + tq0 + 32 * wid, wq_max = wq_min + 31, qpos = wq_min + r32;
    const bf16_t* kbase = p.KA + (size_t)(b * 8 + h) * LTOT * 96;
    const bf16_t* vbase = p.VTG + (size_t)(b * 8 + h) * 64 * 2112;
    const int kkey0 = tid / 12, kpart0 = tid % 12;
    const int kkey1 = (512 + tid) / 12, kpart1 = (512 + tid) % 12;
    const int vdv = tid >> 3, vpart = tid & 7;
    u32x4 kr0, kr1 = {0u, 0u, 0u, 0u}, vr;
    auto load_tile = [&](int ti) {
        const int key0 = ti * 64;
        int ka = key0 + kkey0; ka = ka < LTOT ? ka : LTOT - 1;
        kr0 = *(const u32x4*)(kbase + (size_t)ka * 96 + kpart0 * 8);
        if (tid < 256) { int kb = key0 + kkey1; kb = kb < LTOT ? kb : LTOT - 1; kr1 = *(const u32x4*)(kbase + (size_t)kb * 96 + kpart1 * 8); }
        vr = *(const u32x4*)(vbase + (size_t)vdv * 2112 + key0 + vpart * 8);
    };
    auto store_tile = [&](int buf) {
        *(u32x4*)(Ks + buf * A2K_BUF + kkey0 * A2K_LD + kpart0 * 16) = kr0;
        if (tid < 256) *(u32x4*)(Ks + buf * A2K_BUF + kkey1 * A2K_LD + kpart1 * 16) = kr1;
        *(u32x4*)(Vs + buf * A2V_BUF + vdv * A2V_LD + vpart * 16) = vr;
    };
    f32x16 o0, o1;
#pragma unroll
    for (int i = 0; i < 16; ++i) { o0[i] = 0.f; o1[i] = 0.f; }
    float lsum = 0.f;
    load_tile(0); store_tile(0);
    __syncthreads();
    for (int ti = 0; ti < ntile; ++ti) {
        const int cur = ti & 1;
        if (ti + 1 < ntile) load_tile(ti + 1);
        if (ti * 64 <= wq_max) {
            f32x16 s0, s1;
#pragma unroll
            for (int i = 0; i < 16; ++i) { s0[i] = negMb; s1[i] = negMb; }
            const char* ka = Ks + cur * A2K_BUF + r32 * A2K_LD + hi * 16;
#pragma unroll
            for (int s = 0; s < 6; ++s) {
                s0 = mfma32(*(const bf16x8*)(ka + s * 32), qf[s], s0);
                s1 = mfma32(*(const bf16x8*)(ka + 32 * A2K_LD + s * 32), qf[s], s1);
            }
            const bool diag = (ti * 64 + 63 > wq_min);
#pragma unroll
            for (int i = 0; i < 16; ++i) { s0[i] = __builtin_amdgcn_exp2f(s0[i]); s1[i] = __builtin_amdgcn_exp2f(s1[i]); }
            if (diag) {
                const int kb0 = ti * 64 + 4 * hi;
#pragma unroll
                for (int i = 0; i < 16; ++i) {
                    const int key = kb0 + (i & 3) + 8 * (i >> 2);
                    if (key > qpos) s0[i] = 0.f;
                    if (key + 32 > qpos) s1[i] = 0.f;
                }
            }
            float la = 0.f, lb = 0.f;
#pragma unroll
            for (int i = 0; i < 16; ++i) { la += s0[i]; lb += s1[i]; }
            lsum += la + lb;
            bf16x8 pb[2][2];
#pragma unroll
            for (int s = 0; s < 2; ++s) {
                u32x4 w0, w1;
#pragma unroll
                for (int e = 0; e < 4; ++e) { w0[e] = cvtpk(s0[8 * s + 2 * e], s0[8 * s + 2 * e + 1]); w1[e] = cvtpk(s1[8 * s + 2 * e], s1[8 * s + 2 * e + 1]); }
                pb[0][s] = __builtin_bit_cast(bf16x8, w0); pb[1][s] = __builtin_bit_cast(bf16x8, w1);
            }
            const char* va = Vs + cur * A2V_BUF + r32 * A2V_LD + hi * 16;
#pragma unroll
            for (int kt = 0; kt < 2; ++kt)
#pragma unroll
                for (int s = 0; s < 2; ++s) {
                    o0 = mfma32(*(const bf16x8*)(va + kt * 64 + s * 32), pb[kt][s], o0);
                    o1 = mfma32(*(const bf16x8*)(va + 32 * A2V_LD + kt * 64 + s * 32), pb[kt][s], o1);
                }
        }
        if (ti + 1 < ntile) store_tile(cur ^ 1);
        __syncthreads();
    }
    lsum += __shfl_xor(lsum, 32);
    const float inv = 1.0f / lsum;
    const int tq = tq0 + 32 * wid + r32;
    const size_t r = (size_t)b * LTOT + NMETA + tq;
    const size_t mrow = (size_t)b * 2048 + tq;
#pragma unroll
    for (int vt = 0; vt < 2; ++vt)
#pragma unroll
        for (int g = 0; g < 4; ++g) {
            const int dv = 32 * vt + 8 * g + 4 * hi;
            const u32x2 gw = *(const u32x2*)(p.PBUF + r * IN_COLS_PAD + C_GA + h * 64 + dv);
            const float v0 = (vt ? o1[4 * g] : o0[4 * g]) * inv, v1 = (vt ? o1[4 * g + 1] : o0[4 * g + 1]) * inv;
            const float v2 = (vt ? o1[4 * g + 2] : o0[4 * g + 2]) * inv, v3 = (vt ? o1[4 * g + 3] : o0[4 * g + 3]) * inv;
            u32x2 w; w[0] = cvtpk(v0 * bflo(gw[0]), v1 * bfhi(gw[0])); w[1] = cvtpk(v2 * bflo(gw[1]), v3 * bfhi(gw[1]));
            *(u32x2*)(p.AMA + mrow * 512 + h * 64 + dv) = w;
        }
}

__device__ __forceinline__ void attn_phase(const Params& p, char* lds) {
    const int i = blockIdx.x;
    if (i < 256) {
        const int bh = i >> 2, pair = i & 3;
        attn_unit2(p, lds, bh >> 3, bh & 7, 7 - pair);
        attn_unit2(p, lds, bh >> 3, bh & 7, pair);
    }
}

__device__ __forceinline__ void hgrn_passC(const Params& p, char* lds) {
    const int tid = threadIdx.x, lane = tid & 63, wid = tid >> 6, lr = lane & 15, lg = lane >> 4;
    float* cumL = (float*)lds;
    float* tot = (float*)(lds + 32768);
    char* QT = lds + 34816;
    char* KN = QT + 64 * HC_LD;
    char* QH = KN + 64 * HC_LD;
    char* VT = QH + 64 * HC_LD;
    char* AT = VT + 128 * HA_LD;
    char* STl = AT + 64 * HA_LD;
    for (int uu = blockIdx.x; uu < 32 * 32; uu += gridDim.x) {
        const int c = 1 + (uu & 31), bh = uu >> 5, h = bh & 3, b = bh >> 2;
        const size_t u = (size_t)bh * NCHUNK + c;
        const int t0 = NMETA + 64 * (c - 1);
        const size_t rowbase = (size_t)b * LTOT + t0;
        const int d = tid & 127, part = tid >> 7;
#pragma unroll
        for (int i = 0; i < 4; ++i) {
            const int id = tid + 512 * i, row = id >> 5, c4 = id & 31;
            *(f32x4*)(cumL + row * 128 + c4 * 4) = *(const f32x4*)(p.GLOG + (rowbase + row) * 512 + h * 128 + c4 * 4);
        }
#pragma unroll
        for (int i = 0; i < 2; ++i) {
            const int id = tid + 512 * i, row = id >> 4, ch = id & 15;
            const bf16_t* src = p.PBUF + (rowbase + row) * IN_COLS_PAD + h * 128 + ch * 8;
            const u32x4 qw = *(const u32x4*)(src + C_BQ), kw = *(const u32x4*)(src + C_BF), w = *(const u32x4*)(src + C_BI);
            *(u32x4*)(QH + row * HC_LD + ch * 16) = qw;
            *(u32x4*)(KN + row * HC_LD + ch * 16) = kw;
#pragma unroll
            for (int e = 0; e < 4; ++e) {
                *(bf16_t*)(VT + (ch * 8 + 2 * e) * HA_LD + row * 2) = (bf16_t)(w[e] & 0xffffu);
                *(bf16_t*)(VT + (ch * 8 + 2 * e + 1) * HA_LD + row * 2) = (bf16_t)(w[e] >> 16);
            }
        }
#pragma unroll
        for (int i = 0; i < 4; ++i) {
            const int id = tid + 512 * i, v = id >> 4, dc = id & 15;
            *(u32x4*)(STl + v * HC_LD + dc * 16) = *(const u32x4*)(p.ST + u * 16384 + v * 128 + dc * 8);
        }
        __syncthreads();
        {
            float run = 0.f;
#pragma unroll
            for (int i = 0; i < 16; ++i) { const int s = part * 16 + i; run += cumL[s * 128 + d]; cumL[s * 128 + d] = run; }
            tot[part * 128 + d] = run;
        }
        __syncthreads();
        {
            float off = 0.f;
#pragma unroll
            for (int q = 0; q < 4; ++q) { const float tq = tot[q * 128 + d]; if (q < part) off += tq; }
            const float ref = tot[d] + tot[128 + d];
#pragma unroll
            for (int i = 0; i < 16; ++i) {
                const int s = part * 16 + i;
                const float cum = cumL[s * 128 + d] + off;
                const float qv = bf2f(*(const bf16_t*)(QH + s * HC_LD + d * 2));
                const float kv = bf2f(*(const bf16_t*)(KN + s * HC_LD + d * 2));
                *(bf16_t*)(QT + s * HC_LD + d * 2) = f2bf(qv * __expf(cum - ref));
                *(bf16_t*)(KN + s * HC_LD + d * 2) = f2bf(kv * __expf(ref - cum));
                *(bf16_t*)(QH + s * HC_LD + d * 2) = f2bf(qv * __expf(cum));
            }
        }
        __syncthreads();
        {
            const int mt = wid >> 1;
            const char* xs = QT + (mt * 16 + lr) * HC_LD + lg * 16;
            bf16x8 xf[4];
#pragma unroll
            for (int ks = 0; ks < 4; ++ks) xf[ks] = *(const bf16x8*)(xs + ks * 64);
#pragma unroll
            for (int q = 0; q < 2; ++q) {
                const int nt = 2 * (wid & 1) + q;
                const char* ws = KN + (nt * 16 + lr) * HC_LD + lg * 16;
                f32x4 a = {0.f, 0.f, 0.f, 0.f};
#pragma unroll
                for (int ks = 0; ks < 4; ++ks) a = mfma16(*(const bf16x8*)(ws + ks * 64), xf[ks], a);
                const int t = mt * 16 + lr, s0 = nt * 16 + 4 * lg;
                float m[4];
#pragma unroll
                for (int j = 0; j < 4; ++j) m[j] = (s0 + j <= t) ? a[j] : 0.f;
                u32x2 w; w[0] = cvtpk(m[0], m[1]); w[1] = cvtpk(m[2], m[3]);
                *(u32x2*)(AT + t * HA_LD + s0 * 2) = w;
            }
        }
        __syncthreads();
        {
            const int mt = wid >> 1;
            const char* xa = AT + (mt * 16 + lr) * HA_LD + lg * 16;
            const char* xq = QH + (mt * 16 + lr) * HC_LD + lg * 16;
            bf16x8 af[2], qf[4];
#pragma unroll
            for (int ks = 0; ks < 2; ++ks) af[ks] = *(const bf16x8*)(xa + ks * 64);
#pragma unroll
            for (int ks = 0; ks < 4; ++ks) qf[ks] = *(const bf16x8*)(xq + ks * 64);
#pragma unroll
            for (int q = 0; q < 4; ++q) {
                const int nt = 4 * (wid & 1) + q;
                const char* wv = VT + (nt * 16 + lr) * HA_LD + lg * 16;
                const char* wsx = STl + (nt * 16 + lr) * HC_LD + lg * 16;
                f32x4 a = {0.f, 0.f, 0.f, 0.f};
#pragma unroll
                for (int ks = 0; ks < 2; ++ks) a = mfma16(*(const bf16x8*)(wv + ks * 64), af[ks], a);
#pragma unroll
                for (int ks = 0; ks < 4; ++ks) a = mfma16(*(const bf16x8*)(wsx + ks * 64), qf[ks], a);
                *(f32x4*)(cumL + (mt * 16 + lr) * 128 + nt * 16 + 4 * lg) = a;
            }
        }
        __syncthreads();
        {
#pragma unroll
            for (int i = 0; i < 8; ++i) {
                const int t = wid * 8 + i;
                const f32x2 ov = *(const f32x2*)(cumL + t * 128 + 2 * lane);
                const float ss = wave_sum(ov[0] * ov[0] + ov[1] * ov[1]);
                const float rs = 1.0f / sqrtf(ss * (1.0f / 128.0f) + EPSF);
                const unsigned gw = *(const unsigned*)(p.PBUF + (rowbase + t) * IN_COLS_PAD + C_GB + h * 128 + 2 * lane);
                const f32x2 gbn = *(const f32x2*)(p.g_bn + 2 * lane);
                const size_t mrow = (size_t)b * 2048 + 64 * (c - 1) + t;
                *(unsigned*)(p.AMB + mrow * 512 + h * 128 + 2 * lane) = cvtpk(ov[0] * rs * gbn[0] * bflo(gw), ov[1] * rs * gbn[1] * bfhi(gw));
            }
        }
        __syncthreads();
    }
}

#define SC_LD 528
#define SP_LD 272
#define SC_BUF (128 * SC_LD)
__device__ __forceinline__ void sample_attn(const Params& p, char* lds) {
    const int tid = threadIdx.x, lane = tid & 63, wid = tid >> 6, lr = lane & 15, lg = lane >> 4;
    char* Cs = lds;
    float* RS = (float*)(lds + 2 * SC_BUF);
    char* Pl = lds + 2 * SC_BUF + 2 * 9 * 128 * 4;
    float* Qsl = (float*)(Pl + 16 * SP_LD);
    for (int blk = blockIdx.x; blk < DEC_BATCH * 8; blk += gridDim.x) {
        const int b = blk >> 3, split = blk & 7, h = wid;
        for (int i = tid; i < 16 * SP_LD / 4; i += NTHREADS) ((unsigned*)Pl)[i] = 0u;
        for (int i = tid; i < 8 * 96; i += NTHREADS) Qsl[i] = p.QS[(size_t)b * 768 + i];
        bf16x8 wf[4][8];
        {
            const bf16_t* wb = p.WUKV_T + (size_t)(64 * h + lr) * 256 + 8 * lg;
#pragma unroll
            for (int nt = 0; nt < 4; ++nt) {
                asm volatile("" : "+v"(wb));
#pragma unroll
                for (int ks = 0; ks < 8; ++ks) wf[nt][ks] = *(const bf16x8*)(wb + 32 * ks);
                wb += 16 * 256;
            }
        }
        const float* qsl = Qsl + h * 96;
        const float M = p.SCAL[0];
        f32x4 accl[2] = {{0.f, 0.f, 0.f, 0.f}, {0.f, 0.f, 0.f, 0.f}};
        float lacc = 0.f;
        __syncthreads();
        f32x4 pre[4], rpre[2];
        const int crow = tid >> 6, cc4 = (tid & 63) * 4;
        const int rrow = tid >> 2, rq = tid & 3;
        const int* ptab = p.page_table + b * NPAGES + split * 16;
        auto issue_c = [&](const float* csrc, int qt) {
#pragma unroll
            for (int it = 0; it < 4; ++it) pre[it] = *(const f32x4*)(csrc + (qt * 32 + crow + 8 * it) * 256 + cc4);
        };
        auto write_c = [&](int buf, int qt) {
#pragma unroll
            for (int it = 0; it < 4; ++it) {
                u32x2 w; w[0] = cvtpk(pre[it][0], pre[it][1]); w[1] = cvtpk(pre[it][2], pre[it][3]);
                *(u32x2*)(Cs + buf * SC_BUF + (qt * 32 + crow + 8 * it) * SC_LD + cc4 * 2) = w;
            }
        };
        auto issue_r = [&](const float* rsrc) {
            rpre[0] = *(const f32x4*)(rsrc + rrow * 32 + rq * 8); rpre[1] = *(const f32x4*)(rsrc + rrow * 32 + rq * 8 + 4);
        };
        auto write_r = [&](int buf) {
            float v[9];
            v[0] = rpre[0][0] * rpre[0][0] + rpre[0][1] * rpre[0][1] + rpre[0][2] * rpre[0][2] + rpre[0][3] * rpre[0][3]
                 + rpre[1][0] * rpre[1][0] + rpre[1][1] * rpre[1][1] + rpre[1][2] * rpre[1][2] + rpre[1][3] * rpre[1][3];
#pragma unroll
            for (int hh = 0; hh < 8; ++hh) {
                const f32x4 q0 = *(const f32x4*)(Qsl + hh * 96 + 64 + rq * 8), q1 = *(const f32x4*)(Qsl + hh * 96 + 64 + rq * 8 + 4);
                v[1 + hh] = rpre[0][0] * q0[0] + rpre[0][1] * q0[1] + rpre[0][2] * q0[2] + rpre[0][3] * q0[3]
                          + rpre[1][0] * q1[0] + rpre[1][1] * q1[1] + rpre[1][2] * q1[2] + rpre[1][3] * q1[3];
            }
#pragma unroll
            for (int k = 0; k < 9; ++k) { v[k] += __shfl_xor(v[k], 1); v[k] += __shfl_xor(v[k], 2); }
            if (rq == 0) {
#pragma unroll
                for (int k = 0; k < 9; ++k) RS[(buf * 9 + k) * 128 + rrow] = v[k];
            }
        };
        auto compute_mt = [&](int cur, int mt) {
            f32x4 a[4];
#pragma unroll
            for (int nt = 0; nt < 4; ++nt) a[nt] = (f32x4){0.f, 0.f, 0.f, 0.f};
            const char* xs = Cs + cur * SC_BUF + (16 * mt + lr) * SC_LD + lg * 16;
#pragma unroll
            for (int ks = 0; ks < 8; ++ks) {
                const bf16x8 xf = *(const bf16x8*)(xs + ks * 64);
#pragma unroll
                for (int nt = 0; nt < 4; ++nt) a[nt] = mfma16(wf[nt][ks], xf, a[nt]);
            }
            float ss = 0.f, sq = 0.f;
#pragma unroll
            for (int nt = 0; nt < 4; ++nt) {
                const f32x4 qg = *(const f32x4*)(qsl + 16 * nt + 4 * lg);
#pragma unroll
                for (int j = 0; j < 4; ++j) { ss += a[nt][j] * a[nt][j]; sq += a[nt][j] * qg[j]; }
            }
            ss += __shfl_xor(ss, 16); ss += __shfl_xor(ss, 32);
            sq += __shfl_xor(sq, 16); sq += __shfl_xor(sq, 32);
            ss += RS[(cur * 9) * 128 + 16 * mt + lr];
            sq += RS[(cur * 9 + 1 + h) * 128 + 16 * mt + lr];
            const float sc = sq / sqrtf(ss * (1.0f / 96.0f) + EPSF);
            const float pe = __expf(sc - M);
            lacc += pe;
            if (lg == 0) *(bf16_t*)(Pl + h * SP_LD + (16 * mt + lr) * 2) = f2bf(pe);
        };
        {
            const int pg = ptab[0];
            const float* csrc = p.cache_latent + (size_t)pg * PAGE * KV_LORA;
            issue_r(p.cache_krope + (size_t)pg * PAGE * A_ROPE);
            issue_c(csrc, 0); write_c(0, 0); write_r(0);
            issue_c(csrc, 1); write_c(0, 1);
            issue_c(csrc, 2); write_c(0, 2);
            issue_c(csrc, 3); write_c(0, 3);
        }
        __syncthreads();
#pragma unroll 1
        for (int pi = 0; pi < 16; ++pi) {
            const int cur = pi & 1;
            const bool has_next = pi + 1 < 16;
            const int pgn = has_next ? ptab[pi + 1] : ptab[pi];
            const float* csrc = p.cache_latent + (size_t)pgn * PAGE * KV_LORA;
            if (has_next) { issue_r(p.cache_krope + (size_t)pgn * PAGE * A_ROPE); issue_c(csrc, 0); }
#pragma unroll 1
            for (int qt = 0; qt < 4; ++qt) {
                compute_mt(cur, 2 * qt); compute_mt(cur, 2 * qt + 1);
                if (has_next) { write_c(cur ^ 1, qt); if (qt == 0) write_r(cur ^ 1); if (qt < 3) issue_c(csrc, qt + 1); }
            }
            __syncthreads();
            {
                const char* xp = Pl + lr * SP_LD + lg * 16;
#pragma unroll
                for (int q = 0; q < 2; ++q) {
                    const int n0 = 32 * wid + 16 * q;
#pragma unroll 1
                    for (int ks = 0; ks < 4; ++ks) {
                        const bf16x8 xf = *(const bf16x8*)(xp + ks * 64);
                        const char* cc = Cs + cur * SC_BUF + (32 * ks + 8 * lg) * SC_LD + (n0 + lr) * 2;
                        bf16x8 wfr;
#pragma unroll
                        for (int e = 0; e < 8; ++e) wfr[e] = (short)*(const bf16_t*)(cc + e * SC_LD);
                        accl[q] = mfma16(wfr, xf, accl[q]);
                    }
                }
            }
            __syncthreads();
        }
        if (lr < 8) {
#pragma unroll
            for (int q = 0; q < 2; ++q) *(f32x4*)(p.PART + ((size_t)(b * 8 + split) * 8 + lr) * 256 + 32 * wid + 16 * q + 4 * lg) = accl[q];
        }
        lacc += __shfl_xor(lacc, 8); lacc += __shfl_xor(lacc, 4); lacc += __shfl_xor(lacc, 2); lacc += __shfl_xor(lacc, 1);
        if (lane == 0) p.PL[(b * 8 + split) * 8 + h] = lacc;
        __syncthreads();
    }
}

#define SA_D 6
#define SA_STG (SA_D * 16384)
#define SA_RSTG (SA_D * 2048)
#define SA_CB_SLOT (16 * SC_LD)
#define SA_NG 128
typedef __attribute__((address_space(3))) unsigned las_u32;
__device__ __forceinline__ void sample_attn2(const Params& p, char* lds) {
    const int tid = threadIdx.x, lane = tid & 63, lr = lane & 15, lg = lane >> 4;
    const int wid = __builtin_amdgcn_readfirstlane(tid >> 6);
    char* stg = lds;
    char* rstg = lds + SA_STG;
    char* cb = rstg + SA_RSTG;
    char* pl = cb + 3 * SA_CB_SLOT;
    float* rs = (float*)(pl + 1024);
    float* Qsl = (float*)((char*)rs + 1152);
    for (int blk = blockIdx.x; blk < DEC_BATCH * 8; blk += gridDim.x) {
        const int b = blk >> 3, split = blk & 7, h = wid;
        if (tid < 256) ((unsigned*)pl)[tid] = 0u;
        for (int i = tid; i < 8 * 96; i += NTHREADS) Qsl[i] = p.QS[(size_t)b * 768 + i];
        bf16x8 wf[4][8];
        {
            const bf16_t* wb = p.WUKV_T + (size_t)(64 * h + lr) * 256 + 8 * lg;
#pragma unroll
            for (int nt = 0; nt < 4; ++nt) {
                asm volatile("" : "+v"(wb));
#pragma unroll
                for (int ks = 0; ks < 8; ++ks) wf[nt][ks] = *(const bf16x8*)(wb + 32 * ks);
                wb += 16 * 256;
            }
        }
        const int pgid = p.page_table[b * NPAGES + split * 16 + (lane & 15)];
        const float* qsl = Qsl + h * 96;
        const float M = p.SCAL[0];
        f32x4 accl[2] = {{0.f, 0.f, 0.f, 0.f}, {0.f, 0.f, 0.f, 0.f}};
        float lacc = 0.f;
        asm volatile("s_waitcnt vmcnt(0) lgkmcnt(0)" ::: "memory");
        __syncthreads();
        auto issue = [&](int gi, int slot) {
            const int pg = __builtin_amdgcn_readlane(pgid, gi >> 3);
            const size_t row0 = (size_t)pg * PAGE + 16 * (gi & 7) + 2 * wid;
            const float* src = p.cache_latent + row0 * KV_LORA + lane * 4;
            las_u32* d0 = (las_u32*)(stg + slot * 16384 + (2 * wid) * 1024);
            __builtin_amdgcn_global_load_lds((const unsigned*)src, d0, 16, 0, 0);
            __builtin_amdgcn_global_load_lds((const unsigned*)(src + KV_LORA), (las_u32*)((char __attribute__((address_space(3)))*)d0 + 1024), 16, 0, 0);
            const float* rsrc = p.cache_krope + row0 * A_ROPE + lane;
            __builtin_amdgcn_global_load_lds((const unsigned*)rsrc, (las_u32*)(rstg + slot * 2048 + wid * 256), 4, 0, 0);
        };
#pragma unroll 1
        for (int gi = 0; gi < SA_D; ++gi) issue(gi, gi);
        int c3_g = 2, d_g1 = 0;
#pragma unroll 1
        for (int g = -1; g <= SA_NG; ++g) {
            const int c3_g1 = (c3_g == 2) ? 0 : c3_g + 1;
            const int c3_gm1 = (c3_g == 0) ? 2 : c3_g - 1;
            if (g + 1 < SA_NG) {
                if (g + SA_D <= SA_NG - 1) asm volatile("s_waitcnt vmcnt(%0)" :: "n"(3 * (SA_D - 1)) : "memory");
                else asm volatile("s_waitcnt vmcnt(0)" ::: "memory");
            }
            asm volatile("s_waitcnt lgkmcnt(0)" ::: "memory");
            __builtin_amdgcn_s_barrier();
            asm volatile("" ::: "memory");
            if (g + 1 < SA_NG) {
                const int gc = g + 1;
#pragma unroll
                for (int i = 0; i < 2; ++i) {
                    const f32x4 v = *(const f32x4*)(stg + d_g1 * 16384 + (2 * wid + i) * 1024 + lane * 16);
                    u32x2 w; w[0] = cvtpk(v[0], v[1]); w[1] = cvtpk(v[2], v[3]);
                    *(u32x2*)(cb + c3_g1 * SA_CB_SLOT + (2 * wid + i) * SC_LD + lane * 8) = w;
                }
                {
                    const int rrow = 2 * wid + (lane >> 5), hh = (lane >> 2) & 7, part = lane & 3;
                    const f32x4 r0 = *(const f32x4*)(rstg + d_g1 * 2048 + rrow * 128 + part * 32);
                    const f32x4 r1 = *(const f32x4*)(rstg + d_g1 * 2048 + rrow * 128 + part * 32 + 16);
                    const f32x4 q0 = *(const f32x4*)(Qsl + hh * 96 + 64 + part * 8), q1 = *(const f32x4*)(Qsl + hh * 96 + 64 + part * 8 + 4);
                    float dot = r0[0] * q0[0] + r0[1] * q0[1] + r0[2] * q0[2] + r0[3] * q0[3] + r1[0] * q1[0] + r1[1] * q1[1] + r1[2] * q1[2] + r1[3] * q1[3];
                    float rr = r0[0] * r0[0] + r0[1] * r0[1] + r0[2] * r0[2] + r0[3] * r0[3] + r1[0] * r1[0] + r1[1] * r1[1] + r1[2] * r1[2] + r1[3] * r1[3];
                    dot += __shfl_xor(dot, 1); dot += __shfl_xor(dot, 2);
                    rr += __shfl_xor(rr, 1); rr += __shfl_xor(rr, 2);
                    if (part == 0) {
                        rs[((gc & 1) * 9 + 1 + hh) * 16 + rrow] = dot;
                        if (hh == 0) rs[((gc & 1) * 9) * 16 + rrow] = rr;
                    }
                }
                asm volatile("s_waitcnt lgkmcnt(0)" ::: "memory");
                if (gc + SA_D < SA_NG) issue(gc + SA_D, d_g1);
            }
            if (g >= 0 && g < SA_NG) {
                f32x4 a[4];
#pragma unroll
                for (int nt = 0; nt < 4; ++nt) a[nt] = (f32x4){0.f, 0.f, 0.f, 0.f};
                const char* xs = cb + c3_g * SA_CB_SLOT + lr * SC_LD + lg * 16;
#pragma unroll
                for (int ks = 0; ks < 8; ++ks) {
                    const bf16x8 xf = *(const bf16x8*)(xs + ks * 64);
#pragma unroll
                    for (int nt = 0; nt < 4; ++nt) a[nt] = mfma16(wf[nt][ks], xf, a[nt]);
                }
                float ss = 0.f, sq = 0.f;
#pragma unroll
                for (int nt = 0; nt < 4; ++nt) {
                    const f32x4 qg = *(const f32x4*)(qsl + 16 * nt + 4 * lg);
#pragma unroll
                    for (int j = 0; j < 4; ++j) { ss += a[nt][j] * a[nt][j]; sq += a[nt][j] * qg[j]; }
                }
                ss += __shfl_xor(ss, 16); ss += __shfl_xor(ss, 32);
                sq += __shfl_xor(sq, 16); sq += __shfl_xor(sq, 32);
                ss += rs[((g & 1) * 9) * 16 + lr];
                sq += rs[((g & 1) * 9 + 1 + h) * 16 + lr];
                const float sc = sq / sqrtf(ss * (1.0f / 96.0f) + EPSF);
                const float pe = __expf(sc - M);
                lacc += pe;
                if (lg == 0) *(bf16_t*)(pl + (g & 1) * 512 + h * 32 + lr * 2) = f2bf(pe);
            }
            if (g >= 1) {
                bf16x8 xf = {0, 0, 0, 0, 0, 0, 0, 0};
                if (lg < 2) xf = *(const bf16x8*)(pl + ((g - 1) & 1) * 512 + lr * 32 + lg * 16);
#pragma unroll
                for (int q = 0; q < 2; ++q) {
                    const char* cc = cb + c3_gm1 * SA_CB_SLOT + ((8 * lg) & 15) * SC_LD + (32 * wid + 16 * q + lr) * 2;
                    bf16x8 wfr;
#pragma unroll
                    for (int e = 0; e < 8; ++e) wfr[e] = (short)*(const bf16_t*)(cc + e * SC_LD);
                    accl[q] = mfma16(wfr, xf, accl[q]);
                }
            }
            c3_g = c3_g1;
            d_g1 = (d_g1 + 1 == SA_D) ? 0 : d_g1 + 1;
        }
        if (lr < 8) {
#pragma unroll
            for (int q = 0; q < 2; ++q) *(f32x4*)(p.PART + ((size_t)(b * 8 + split) * 8 + lr) * 256 + 32 * wid + 16 * q + 4 * lg) = accl[q];
        }
        lacc += __shfl_xor(lacc, 8); lacc += __shfl_xor(lacc, 4); lacc += __shfl_xor(lacc, 2); lacc += __shfl_xor(lacc, 1);
        if (lane == 0) p.PL[(b * 8 + split) * 8 + h] = lacc;
        __syncthreads();
    }
}

#define SB_D 2
#define SB_STG (SB_D * 32768)
#define SB_RSTG (SB_D * 4096)
#define SB_CB_SLOT (32 * SC_LD)
#define SB_NG 64
__device__ __forceinline__ void sample_attn3(const Params& p, char* lds) {
    const int tid = threadIdx.x, lane = tid & 63, lr = lane & 15, lg = lane >> 4;
    const int wid = __builtin_amdgcn_readfirstlane(tid >> 6);
    char* stg = lds;
    char* rstg = lds + SB_STG;
    char* cb = rstg + SB_RSTG;
    char* pl = cb + 3 * SB_CB_SLOT;
    float* rs = (float*)(pl + 2048);
    float* Qsl = (float*)((char*)rs + 2304);
    for (int blk = blockIdx.x; blk < DEC_BATCH * 8; blk += gridDim.x) {
        const int b = blk >> 3, split = blk & 7, h = wid;
        ((unsigned*)pl)[tid] = 0u;
        for (int i = tid; i < 8 * 96; i += NTHREADS) Qsl[i] = p.QS[(size_t)b * 768 + i];
        bf16x8 wf[4][8];
        {
            const bf16_t* wb = p.WUKV_T + (size_t)(64 * h + lr) * 256 + 8 * lg;
#pragma unroll
            for (int nt = 0; nt < 4; ++nt) {
                asm volatile("" : "+v"(wb));
#pragma unroll
                for (int ks = 0; ks < 8; ++ks) wf[nt][ks] = *(const bf16x8*)(wb + 32 * ks);
                wb += 16 * 256;
            }
        }
        const int pgid = p.page_table[b * NPAGES + split * 16 + (lane & 15)];
        const float* qsl = Qsl + h * 96;
        const float M = p.SCAL[0];
        f32x4 accl[2] = {{0.f, 0.f, 0.f, 0.f}, {0.f, 0.f, 0.f, 0.f}};
        float lacc = 0.f;
        asm volatile("s_waitcnt vmcnt(0) lgkmcnt(0)" ::: "memory");
        __syncthreads();
        auto issue = [&](int gi, int slot) {
            const int pg = __builtin_amdgcn_readlane(pgid, gi >> 2);
            const size_t row0 = (size_t)pg * PAGE + 32 * (gi & 3) + 4 * wid;
            const float* src = p.cache_latent + row0 * KV_LORA + lane * 4;
            char __attribute__((address_space(3)))* d0 = (char __attribute__((address_space(3)))*)(stg + slot * 32768 + (4 * wid) * 1024);
            __builtin_amdgcn_global_load_lds((const unsigned*)src, (las_u32*)d0, 16, 0, 0);
            __builtin_amdgcn_global_load_lds((const unsigned*)(src + KV_LORA), (las_u32*)(d0 + 1024), 16, 0, 0);
            __builtin_amdgcn_global_load_lds((const unsigned*)(src + 2 * KV_LORA), (las_u32*)(d0 + 2048), 16, 0, 0);
            __builtin_amdgcn_global_load_lds((const unsigned*)(src + 3 * KV_LORA), (las_u32*)(d0 + 3072), 16, 0, 0);
            const float* rsrc = p.cache_krope + row0 * A_ROPE + lane;
            char __attribute__((address_space(3)))* r0 = (char __attribute__((address_space(3)))*)(rstg + slot * 4096 + wid * 512);
            __builtin_amdgcn_global_load_lds((const unsigned*)rsrc, (las_u32*)r0, 4, 0, 0);
            __builtin_amdgcn_global_load_lds((const unsigned*)(rsrc + 64), (las_u32*)(r0 + 256), 4, 0, 0);
        };
#pragma unroll 1
        for (int gi = 0; gi < SB_D; ++gi) issue(gi, gi);
        int c3_g = 2, d_g1 = 0;
#pragma unroll 1
        for (int g = -1; g <= SB_NG; ++g) {
            const int c3_g1 = (c3_g == 2) ? 0 : c3_g + 1;
            const int c3_gm1 = (c3_g == 0) ? 2 : c3_g - 1;
            if (g + 1 < SB_NG) {
                if (g + SB_D <= SB_NG - 1) asm volatile("s_waitcnt vmcnt(%0)" :: "n"(6 * (SB_D - 1)) : "memory");
                else asm volatile("s_waitcnt vmcnt(0)" ::: "memory");
            }
            asm volatile("s_waitcnt lgkmcnt(0)" ::: "memory");
            __builtin_amdgcn_s_barrier();
            asm volatile("" ::: "memory");
            if (g + 1 < SB_NG) {
                const int gc = g + 1;
#pragma unroll
                for (int i = 0; i < 4; ++i) {
                    const f32x4 v = *(const f32x4*)(stg + d_g1 * 32768 + (4 * wid + i) * 1024 + lane * 16);
                    u32x2 w; w[0] = cvtpk(v[0], v[1]); w[1] = cvtpk(v[2], v[3]);
                    *(u32x2*)(cb + c3_g1 * SB_CB_SLOT + (4 * wid + i) * SC_LD + lane * 8) = w;
                }
                {
                    const int hh = (lane >> 2) & 7, part = lane & 3;
                    const f32x4 q0 = *(const f32x4*)(Qsl + hh * 96 + 64 + part * 8), q1 = *(const f32x4*)(Qsl + hh * 96 + 64 + part * 8 + 4);
#pragma unroll
                    for (int i = 0; i < 2; ++i) {
                        const int rrow = 4 * wid + 2 * i + (lane >> 5);
                        const f32x4 r0 = *(const f32x4*)(rstg + d_g1 * 4096 + rrow * 128 + part * 32);
                        const f32x4 r1 = *(const f32x4*)(rstg + d_g1 * 4096 + rrow * 128 + part * 32 + 16);
                        float dot = r0[0] * q0[0] + r0[1] * q0[1] + r0[2] * q0[2] + r0[3] * q0[3] + r1[0] * q1[0] + r1[1] * q1[1] + r1[2] * q1[2] + r1[3] * q1[3];
                        float rr = r0[0] * r0[0] + r0[1] * r0[1] + r0[2] * r0[2] + r0[3] * r0[3] + r1[0] * r1[0] + r1[1] * r1[1] + r1[2] * r1[2] + r1[3] * r1[3];
                        dot += __shfl_xor(dot, 1); dot += __shfl_xor(dot, 2);
                        rr += __shfl_xor(rr, 1); rr += __shfl_xor(rr, 2);
                        if (part == 0) {
                            rs[((gc & 1) * 9 + 1 + hh) * 32 + rrow] = dot;
                            if (hh == 0) rs[((gc & 1) * 9) * 32 + rrow] = rr;
                        }
                    }
                }
                asm volatile("s_waitcnt lgkmcnt(0)" ::: "memory");
                if (gc + SB_D < SB_NG) issue(gc + SB_D, d_g1);
            }
            if (g >= 0 && g < SB_NG) {
#pragma unroll
                for (int mt2 = 0; mt2 < 2; ++mt2) {
                    f32x4 a[4];
#pragma unroll
                    for (int nt = 0; nt < 4; ++nt) a[nt] = (f32x4){0.f, 0.f, 0.f, 0.f};
                    const char* xs = cb + c3_g * SB_CB_SLOT + (16 * mt2 + lr) * SC_LD + lg * 16;
#pragma unroll
                    for (int ks = 0; ks < 8; ++ks) {
                        const bf16x8 xf = *(const bf16x8*)(xs + ks * 64);
#pragma unroll
                        for (int nt = 0; nt < 4; ++nt) a[nt] = mfma16(wf[nt][ks], xf, a[nt]);
                    }
                    float ss = 0.f, sq = 0.f;
#pragma unroll
                    for (int nt = 0; nt < 4; ++nt) {
                        const f32x4 qg = *(const f32x4*)(qsl + 16 * nt + 4 * lg);
#pragma unroll
                        for (int j = 0; j < 4; ++j) { ss += a[nt][j] * a[nt][j]; sq += a[nt][j] * qg[j]; }
                    }
                    ss += __shfl_xor(ss, 16); ss += __shfl_xor(ss, 32);
                    sq += __shfl_xor(sq, 16); sq += __shfl_xor(sq, 32);
                    ss += rs[((g & 1) * 9) * 32 + 16 * mt2 + lr];
                    sq += rs[((g & 1) * 9 + 1 + h) * 32 + 16 * mt2 + lr];
                    const float sc = sq * __builtin_amdgcn_rsqf(ss * (1.0f / 96.0f) + EPSF);
                    const float pe = __expf(sc - M);
                    lacc += pe;
                    if (lg == 0) *(bf16_t*)(pl + (g & 1) * 1024 + h * 64 + (16 * mt2 + lr) * 2) = f2bf(pe);
                }
            }
            if (g >= 1) {
                const bf16x8 xf = *(const bf16x8*)(pl + ((g - 1) & 1) * 1024 + lr * 64 + lg * 16);
#pragma unroll
                for (int q = 0; q < 2; ++q) {
                    const char* cc = cb + c3_gm1 * SB_CB_SLOT + (8 * lg) * SC_LD + (32 * wid + 16 * q + lr) * 2;
                    bf16x8 wfr;
#pragma unroll
                    for (int e = 0; e < 8; ++e) wfr[e] = (short)*(const bf16_t*)(cc + e * SC_LD);
                    accl[q] = mfma16(wfr, xf, accl[q]);
                }
            }
            c3_g = c3_g1;
            d_g1 = (d_g1 + 1 == SB_D) ? 0 : d_g1 + 1;
        }
        if (lr < 8) {
#pragma unroll
            for (int q = 0; q < 2; ++q) *(f32x4*)(p.PART + ((size_t)(b * 8 + split) * 8 + lr) * 256 + 32 * wid + 16 * q + 4 * lg) = accl[q];
        }
        lacc += __shfl_xor(lacc, 8); lacc += __shfl_xor(lacc, 4); lacc += __shfl_xor(lacc, 2); lacc += __shfl_xor(lacc, 1);
        if (lane == 0) p.PL[(b * 8 + split) * 8 + h] = lacc;
        __syncthreads();
    }
}

#define SR_LD 80
typedef short v4i16_t __attribute__((ext_vector_type(4)));
__device__ __forceinline__ float xsum16_32(float v) {
    auto r = __builtin_amdgcn_permlane16_swap(__float_as_uint(v), __float_as_uint(v), false, false);
    v = __uint_as_float(r[0]) + __uint_as_float(r[1]);
    auto q = __builtin_amdgcn_permlane32_swap(__float_as_uint(v), __float_as_uint(v), false, false);
    return __uint_as_float(q[0]) + __uint_as_float(q[1]);
}
__device__ __forceinline__ void sample_attn4(const Params& p, char* lds) {
    const int tid = threadIdx.x, lane = tid & 63, lr = lane & 15, lg = lane >> 4;
    const int wid = __builtin_amdgcn_readfirstlane(tid >> 6);
    char* stg = lds;
    char* rstg = lds + SB_STG;
    char* cb = rstg + SB_RSTG;
    char* rb = cb + 3 * SB_CB_SLOT;
    char* pl = rb + 3 * 32 * SR_LD;
    for (int blk = blockIdx.x; blk < DEC_BATCH * 8; blk += gridDim.x) {
        const int b = blk >> 3, split = blk & 7, h = wid;
        ((unsigned*)pl)[tid] = 0u;
        bf16x8 wf[4][8];
        {
            const bf16_t* wb = p.WUKV_T + (size_t)(64 * h + lr) * 256 + 8 * lg;
#pragma unroll
            for (int nt = 0; nt < 4; ++nt) {
                asm volatile("" : "+v"(wb));
#pragma unroll
                for (int ks = 0; ks < 8; ++ks) wf[nt][ks] = *(const bf16x8*)(wb + 32 * ks);
                wb += 16 * 256;
            }
        }
        const float* qs = p.QS + (size_t)(b * 8 + h) * 96;
        f32x4 qg[4];
#pragma unroll
        for (int nt = 0; nt < 4; ++nt) qg[nt] = *(const f32x4*)(qs + 16 * nt + 4 * lg) * LOG2E;
        bf16x8 qrf;
        {
            u32x4 w = {0u, 0u, 0u, 0u};
            if (lr < 8) {
                const float* q = p.QS + (size_t)(b * 8 + lr) * 96 + 64 + 8 * lg;
                const f32x4 a0 = *(const f32x4*)q * LOG2E, a1 = *(const f32x4*)(q + 4) * LOG2E;
                w[0] = cvtpk(a0[0], a0[1]); w[1] = cvtpk(a0[2], a0[3]); w[2] = cvtpk(a1[0], a1[1]); w[3] = cvtpk(a1[2], a1[3]);
            }
            qrf = __builtin_bit_cast(bf16x8, w);
        }
        const int pgid = p.page_table[b * NPAGES + split * 16 + (lane & 15)];
        const float Mb = p.SCAL[0] * LOG2E;
        f32x4 accl[2] = {{0.f, 0.f, 0.f, 0.f}, {0.f, 0.f, 0.f, 0.f}};
        float lacc = 0.f;
        asm volatile("s_waitcnt vmcnt(0) lgkmcnt(0)" ::: "memory");
        __syncthreads();
        auto issue = [&](int gi, int slot) {
            const int pg = __builtin_amdgcn_readlane(pgid, gi >> 2);
            const size_t row0 = (size_t)pg * PAGE + 32 * (gi & 3) + 4 * wid;
            const float* src = p.cache_latent + row0 * KV_LORA + lane * 4;
            char __attribute__((address_space(3)))* d0 = (char __attribute__((address_space(3)))*)(stg + slot * 32768 + (4 * wid) * 1024);
            __builtin_amdgcn_global_load_lds((const unsigned*)src, (las_u32*)d0, 16, 0, 0);
            __builtin_amdgcn_global_load_lds((const unsigned*)(src + KV_LORA), (las_u32*)(d0 + 1024), 16, 0, 0);
            __builtin_amdgcn_global_load_lds((const unsigned*)(src + 2 * KV_LORA), (las_u32*)(d0 + 2048), 16, 0, 0);
            __builtin_amdgcn_global_load_lds((const unsigned*)(src + 3 * KV_LORA), (las_u32*)(d0 + 3072), 16, 0, 0);
            const float* rsrc = p.cache_krope + row0 * A_ROPE + lane;
            char __attribute__((address_space(3)))* r0 = (char __attribute__((address_space(3)))*)(rstg + slot * 4096 + wid * 512);
            __builtin_amdgcn_global_load_lds((const unsigned*)rsrc, (las_u32*)r0, 4, 0, 0);
            __builtin_amdgcn_global_load_lds((const unsigned*)(rsrc + 64), (las_u32*)(r0 + 256), 4, 0, 0);
        };
#pragma unroll 1
        for (int gi = 0; gi < SB_D; ++gi) issue(gi, gi);
        int c3_g = 2, d_g1 = 0;
        const int hsel = h & 3;
        const float fhg = (lg == (h >> 2)) ? 1.f : 0.f, fdg = (lg == (lr >> 2)) ? 1.f : 0.f;
#pragma unroll 1
        for (int g = -1; g <= SB_NG; ++g) {
            const int c3_g1 = (c3_g == 2) ? 0 : c3_g + 1;
            const int c3_gm1 = (c3_g == 0) ? 2 : c3_g - 1;
            if (g + 1 < SB_NG) {
                if (g + SB_D <= SB_NG - 1) asm volatile("s_waitcnt vmcnt(%0)" :: "n"(6 * (SB_D - 1)) : "memory");
                else asm volatile("s_waitcnt vmcnt(0)" ::: "memory");
            }
            asm volatile("s_waitcnt lgkmcnt(0)" ::: "memory");
            __builtin_amdgcn_s_barrier();
            asm volatile("" ::: "memory");
            if (g + 1 < SB_NG) {
#pragma unroll
                for (int i = 0; i < 4; ++i) {
                    const f32x4 v = *(const f32x4*)(stg + d_g1 * 32768 + (4 * wid + i) * 1024 + lane * 16);
                    u32x2 w; w[0] = cvtpk(v[0], v[1]); w[1] = cvtpk(v[2], v[3]);
                    *(u32x2*)(cb + c3_g1 * SB_CB_SLOT + (4 * wid + i) * SC_LD + lane * 8) = w;
                }
                {
                    const int rrow = 4 * wid + (lane >> 4), c2 = (lane & 15) * 2;
                    const f32x2 v = *(const f32x2*)(rstg + d_g1 * 4096 + rrow * 128 + c2 * 4);
                    *(unsigned*)(rb + c3_g1 * 32 * SR_LD + rrow * SR_LD + c2 * 2) = cvtpk(v[0], v[1]);
                }
                asm volatile("" ::: "memory");
                if (g + 1 + SB_D < SB_NG) issue(g + 1 + SB_D, d_g1);
            }
            if (g >= 0 && g < SB_NG) {
#pragma unroll
                for (int mt2 = 0; mt2 < 2; ++mt2) {
                    f32x4 a[4];
#pragma unroll
                    for (int nt = 0; nt < 4; ++nt) a[nt] = (f32x4){0.f, 0.f, 0.f, 0.f};
                    const char* xs = cb + c3_g * SB_CB_SLOT + (16 * mt2 + lr) * SC_LD + lg * 16;
                    const bf16x8 rf = *(const bf16x8*)(rb + c3_g * 32 * SR_LD + (16 * mt2 + lr) * SR_LD + lg * 16);
#pragma unroll
                    for (int ks = 0; ks < 8; ++ks) {
                        const bf16x8 xf = *(const bf16x8*)(xs + ks * 64);
#pragma unroll
                        for (int nt = 0; nt < 4; ++nt) a[nt] = mfma16(wf[nt][ks], xf, a[nt]);
                    }
                    const f32x4 z4 = {0.f, 0.f, 0.f, 0.f};
                    const f32x4 asr = mfma16(qrf, rf, z4);
                    const f32x4 arr = mfma16(rf, rf, z4);
                    const float srv = (hsel == 0) ? asr[0] : (hsel == 1) ? asr[1] : (hsel == 2) ? asr[2] : asr[3];
                    const int dj = lr & 3;
                    const float rrv = (dj == 0) ? arr[0] : (dj == 1) ? arr[1] : (dj == 2) ? arr[2] : arr[3];
                    float ss = rrv * fdg, sq = srv * fhg;
#pragma unroll
                    for (int nt = 0; nt < 4; ++nt)
#pragma unroll
                        for (int j = 0; j < 4; ++j) { ss += a[nt][j] * a[nt][j]; sq += a[nt][j] * qg[nt][j]; }
                    ss = xsum16_32(ss); sq = xsum16_32(sq);
                    const float sc = sq * __builtin_amdgcn_rsqf(ss * (1.0f / 96.0f) + EPSF);
                    const float pe = __builtin_amdgcn_exp2f(sc - Mb);
                    lacc += pe;
                    if (lg == 0) *(bf16_t*)(pl + (g & 1) * 1024 + h * 64 + (16 * mt2 + lr) * 2) = f2bf(pe);
                }
            }
            if (g >= 1) {
                const bf16x8 xf = *(const bf16x8*)(pl + ((g - 1) & 1) * 1024 + lr * 64 + lg * 16);
#pragma unroll
                for (int q = 0; q < 2; ++q) {
                    const char* cc = cb + c3_gm1 * SB_CB_SLOT + (8 * lg + (lr >> 2)) * SC_LD + (32 * wid + 16 * q + 4 * (lr & 3)) * 2;
                    const v4i16_t t0 = __builtin_amdgcn_ds_read_tr16_b64_v4i16((__attribute__((address_space(3))) v4i16_t*)(cc));
                    const v4i16_t t1 = __builtin_amdgcn_ds_read_tr16_b64_v4i16((__attribute__((address_space(3))) v4i16_t*)(cc + 4 * SC_LD));
                    const bf16x8 wfr = {t0[0], t0[1], t0[2], t0[3], t1[0], t1[1], t1[2], t1[3]};
                    accl[q] = mfma16(wfr, xf, accl[q]);
                }
            }
            c3_g = c3_g1;
            d_g1 = (d_g1 + 1 == SB_D) ? 0 : d_g1 + 1;
        }
        if (lr < 8) {
#pragma unroll
            for (int q = 0; q < 2; ++q) *(f32x4*)(p.PART + ((size_t)(b * 8 + split) * 8 + lr) * 256 + 32 * wid + 16 * q + 4 * lg) = accl[q];
        }
        lacc += __shfl_xor(lacc, 8); lacc += __shfl_xor(lacc, 4); lacc += __shfl_xor(lacc, 2); lacc += __shfl_xor(lacc, 1);
        if (lane == 0) p.PL[(b * 8 + split) * 8 + h] = lacc;
        __syncthreads();
    }
}

__device__ __forceinline__ void phase3(const Params& p, char* lds) {
    hgrn_passB(p);
    sample_attn4(p, lds);
}

__device__ __forceinline__ void sample_combine(const Params& p, char* lds) {
    const int tid = threadIdx.x;
    float* ol = (float*)lds;
    float* red = ol + 256;
    float* sc = red + 512;
    for (int u = blockIdx.x; u < DEC_BATCH * 8; u += gridDim.x) {
        const int b = u >> 3, h = u & 7;
        if (tid < 64) {
            const float* kraw = p.KSRAW + (size_t)(b * 8 + h) * 96;
            const float* qs = p.QS + (size_t)(b * 8 + h) * 96;
            float ss = 0.f, sq = 0.f;
            for (int d = tid; d < 96; d += 64) { const float k = kraw[d]; ss += k * k; sq += k * qs[d]; }
            ss = wave_sum(ss); sq = wave_sum(sq);
            if (tid == 0) {
                const float s = sq / sqrtf(ss * (1.0f / 96.0f) + EPSF);
                const float pn = __expf(s - p.SCAL[0]);
                float l = pn;
                for (int sp = 0; sp < 8; ++sp) l += p.PL[(b * 8 + sp) * 8 + h];
                sc[0] = pn; sc[1] = 1.0f / l;
            }
        }
        __syncthreads();
        if (tid < 256) {
            const int c = tid;
            float a = sc[0] * p.out[OFF_LAT_S + b * 256 + c];
#pragma unroll
            for (int sp = 0; sp < 8; ++sp) a += p.PART[((size_t)(b * 8 + sp) * 8 + h) * 256 + c];
            ol[c] = a * sc[1];
        }
        __syncthreads();
        {
            const int d = tid & 63, part = tid >> 6;
            const bf16_t* wrow = p.WUKV_T + (size_t)(512 + h * 64 + d) * 256 + part * 32;
            float a = 0.f;
#pragma unroll
            for (int c = 0; c < 32; c += 8) {
                const u32x4 w = *(const u32x4*)(wrow + c);
                const f32x4 o0 = *(const f32x4*)(ol + part * 32 + c), o1 = *(const f32x4*)(ol + part * 32 + c + 4);
                a += o0[0] * bflo(w[0]) + o0[1] * bfhi(w[0]) + o0[2] * bflo(w[1]) + o0[3] * bfhi(w[1]) + o1[0] * bflo(w[2]) + o1[1] * bfhi(w[2]) + o1[2] * bflo(w[3]) + o1[3] * bfhi(w[3]);
            }
            red[part * 64 + d] = a;
        }
        __syncthreads();
        if (tid < 64) {
            float a = 0.f;
#pragma unroll
            for (int q = 0; q < 8; ++q) a += red[q * 64 + tid];
            const float ga = bf2f(p.PBUF[(size_t)(R_PROMPT + b) * IN_COLS_PAD + C_GA + h * 64 + tid]);
            p.AMA[(size_t)(NQ + b) * 512 + h * 64 + tid] = f2bf(a * ga);
        }
        __syncthreads();
    }
}

__device__ __forceinline__ void merge_m_gemm(const Params& p, char* lds) {
    const int bx = blockIdx.x, vcu = (bx & 7) * 32 + (bx >> 3);
    OneTileOrder S{vcu, 1};
    {
        pg8::Gemm g{p.AMA, p.WOA_T, NQ, 1024, 512, p.AMA, p.WOA_T};
        EpiMerge<0> E{p.PBUF, p.TMP, p.MM};
        pg8::gemm_phase<EpiMerge<0>, OneTileOrder, false, true>((PG8_LAS unsigned char*)lds, g, S, E);
    }
    {
        pg8::Gemm g{p.AMB, p.WOB_T, NQ, 1024, 512, p.AMB, p.WOB_T};
        EpiMerge<1> E{p.PBUF, p.TMP, p.MM};
        pg8::gemm_phase<EpiMerge<1>, OneTileOrder, false, true>((PG8_LAS unsigned char*)lds, g, S, E);
    }
}


__device__ __forceinline__ float dot_bf16_row(const bf16_t* a, const bf16_t* w, int K) {
    float s = 0.f;
    for (int k = 0; k < K; k += 8) {
        const u32x4 x = *(const u32x4*)(a + k), y = *(const u32x4*)(w + k);
#pragma unroll
        for (int e = 0; e < 4; ++e) s += bflo(x[e]) * bflo(y[e]) + bfhi(x[e]) * bfhi(y[e]);
    }
    return s;
}
__device__ __forceinline__ void rows32_tile(f32x4 (&acc)[2], const bf16_t* __restrict__ X, int ldx, const bf16_t* __restrict__ W, int K, int nt) {
    const int lane = threadIdx.x & 63, lr = lane & 15, lg = lane >> 4;
    const bf16_t* x0 = X + (size_t)lr * ldx + lg * 8;
    const bf16_t* x1 = X + (size_t)(16 + lr) * ldx + lg * 8;
    const bf16_t* w = W + (size_t)(nt * 16 + lr) * K + lg * 8;
#pragma unroll 8
    for (int ks = 0; ks < (K >> 5); ++ks) {
        const bf16x8 wf = *(const bf16x8*)(w + ks * 32);
        acc[0] = mfma16(wf, *(const bf16x8*)(x0 + ks * 32), acc[0]);
        acc[1] = mfma16(wf, *(const bf16x8*)(x1 + ks * 32), acc[1]);
    }
}
__device__ __forceinline__ void sample_m(const Params& p) {
    const int lane = threadIdx.x & 63, lr = lane & 15, lg = lane >> 4;
    for (int nt = blockIdx.x * 8 + (threadIdx.x >> 6); nt < 64; nt += gridDim.x * 8) {
        f32x4 ya[2] = {{0.f, 0.f, 0.f, 0.f}, {0.f, 0.f, 0.f, 0.f}}, yb[2] = {{0.f, 0.f, 0.f, 0.f}, {0.f, 0.f, 0.f, 0.f}};
        rows32_tile(ya, p.AMA + (size_t)NQ * 512, 512, p.WOA_T, 512, nt);
        rows32_tile(yb, p.AMB + (size_t)NQ * 512, 512, p.WOB_T, 512, nt);
#pragma unroll
        for (int mt = 0; mt < 2; ++mt) {
            const int i = 16 * mt + lr, n = 16 * nt + 4 * lg;
            const size_t r = R_PROMPT + i;
            const u32x2 ga = *(const u32x2*)(p.PBUF + r * IN_COLS_PAD + C_MA + n);
            const u32x2 gb = *(const u32x2*)(p.PBUF + r * IN_COLS_PAD + C_MB + n);
            u32x2 w;
            w[0] = cvtpk(bflo(ga[0]) * ya[mt][0] + bflo(gb[0]) * yb[mt][0], bfhi(ga[0]) * ya[mt][1] + bfhi(gb[0]) * yb[mt][1]);
            w[1] = cvtpk(bflo(ga[1]) * ya[mt][2] + bflo(gb[1]) * yb[mt][2], bfhi(ga[1]) * ya[mt][3] + bfhi(gb[1]) * yb[mt][3]);
            *(u32x2*)(p.MM + (size_t)(NQ + i) * 1024 + n) = w;
        }
    }
}
__device__ __forceinline__ void final_gemm(const Params& p, char* lds) {
    const int bx = blockIdx.x, vcu = (bx & 7) * 32 + (bx >> 3);
    pg8::Gemm g{p.MM, p.WO_T, NQ, 1024, 1024, p.MM, p.WO_T};
    OneTileOrder S{vcu, 1};
    EpiFinal E{p.x_prompt, p.out + OFF_Y_P};
    pg8::gemm_phase<EpiFinal, OneTileOrder, false, true>((PG8_LAS unsigned char*)lds, g, S, E);
}


__device__ __forceinline__ void sample_y(const Params& p) {
    const int lane = threadIdx.x & 63, lr = lane & 15, lg = lane >> 4;
    for (int nt = blockIdx.x * 8 + (threadIdx.x >> 6); nt < 64; nt += gridDim.x * 8) {
        f32x4 y[2] = {{0.f, 0.f, 0.f, 0.f}, {0.f, 0.f, 0.f, 0.f}};
        rows32_tile(y, p.MM + (size_t)NQ * 1024, 1024, p.WO_T, 1024, nt);
#pragma unroll
        for (int mt = 0; mt < 2; ++mt) {
            const int i = 16 * mt + lr, n = 16 * nt + 4 * lg;
            const f32x4 x = *(const f32x4*)(p.x_sample + (size_t)i * 1024 + n);
            *(f32x4*)(p.out + OFF_Y_S + (size_t)i * 1024 + n) = x + y[mt];
        }
    }
}

__device__ __forceinline__ void phase4(const Params& p, char* lds) {
    sample_combine(p, lds);
    attn_phase(p, lds);
    hgrn_passC(p, lds);
}
__device__ __forceinline__ void phase5(const Params& p, char* lds) {
    sample_m(p);
    merge_m_gemm(p, lds);
}
__device__ __forceinline__ void phase6(const Params& p, char* lds) {
    sample_y(p);
    final_gemm(p, lds);
}

#define XB_TMO      128
#define XB_XCNT(j)  (256  + 64 * (j))
#define XB_XSUB(j)  (1280 + 64 * (j))
#define XB_XGEN(j)  (2304 + 64 * (j))
#define XB_TOP      3328
#define XB_TOPGEN   3392
#define XCD_BAR_WORDS 3456
#define XB_SPIN_CAP (1u << 22)
#define LAS __attribute__((address_space(3)))
__device__ __forceinline__ unsigned xb_ld(unsigned* p)              { return __hip_atomic_load(p, __ATOMIC_RELAXED, __HIP_MEMORY_SCOPE_AGENT); }
__device__ __forceinline__ unsigned xb_add(unsigned* p, unsigned v) { return __hip_atomic_fetch_add(p, v, __ATOMIC_RELAXED, __HIP_MEMORY_SCOPE_AGENT); }
__device__ __forceinline__ unsigned xb_xcc_id() { return (unsigned)__builtin_amdgcn_s_getreg((3 << 11) | 20) & 0xFu; }
#define XB_SPIN(cond, bar) do { unsigned _sp = 0; while (cond) { __builtin_amdgcn_s_sleep(1); \
    if ((++_sp & 255u) == 0u) { if (xb_ld(&(bar)[XB_TMO])) break; if (_sp > XB_SPIN_CAP) { atomicAdd(&(bar)[XB_TMO], 1u); break; } } } } while (0)
struct XcdBarrier { unsigned* bar; unsigned x; volatile LAS unsigned* st; };
__device__ __forceinline__ XcdBarrier xcd_barrier_post(unsigned* bar, volatile LAS unsigned* st) {
    XcdBarrier b; b.bar = bar; b.x = xb_xcc_id(); b.st = st;
    if (threadIdx.x == 0) (void)xb_add(&bar[XB_XCNT(b.x)], 1u);
    return b;
}
__device__ __forceinline__ void xcd_barrier_complete(unsigned* bar, unsigned x, unsigned& nloc, unsigned& nx) {
    const unsigned G = gridDim.x * gridDim.y * gridDim.z;
    unsigned sum, cnt, mine, sp = 0u;
    for (;;) {
        sum = 0u; cnt = 0u; mine = 0u;
#pragma unroll
        for (unsigned j = 0; j < 16; ++j) { const unsigned c = xb_ld(&bar[XB_XCNT(j)]); sum += c; cnt += (c > 0u) ? 1u : 0u; mine = (j == x) ? c : mine; }
        if (sum == G) break;
        __builtin_amdgcn_s_sleep(1);
        if ((++sp & 255u) == 0u) { if (xb_ld(&bar[XB_TMO])) break; if (sp > XB_SPIN_CAP) { atomicAdd(&bar[XB_TMO], 1u); break; } }
    }
    nloc = mine > 0u ? mine : 1u; nx = cnt > 0u ? cnt : 1u;
}
__device__ __forceinline__ void xcd_barrier(const XcdBarrier& b) {
    asm volatile("s_waitcnt vmcnt(0)" ::: "memory");
    __syncthreads();
    if (threadIdx.x == 0) {
        unsigned* bar = b.bar;
        __builtin_amdgcn_s_waitcnt(0);
        unsigned nloc = b.st[0], nx = b.st[1];
        if (nloc == 0u) { xcd_barrier_complete(bar, b.x, nloc, nx); b.st[0] = nloc; b.st[1] = nx; }
        const unsigned old = xb_add(&bar[XB_XSUB(b.x)], 1u);
        const unsigned gen = old / nloc;
        if (old + 1u == (gen + 1u) * nloc) {
            __builtin_amdgcn_fence(__ATOMIC_RELEASE, "agent");
            asm volatile("s_waitcnt vmcnt(0)" ::: "memory");
            const unsigned og = xb_add(&bar[XB_TOP], 1u);
            const unsigned tg = og / nx;
            if (og + 1u == (tg + 1u) * nx) xb_add(&bar[XB_TOPGEN], 1u);
            else XB_SPIN(xb_ld(&bar[XB_TOPGEN]) == tg, bar);
            __builtin_amdgcn_fence(__ATOMIC_ACQUIRE, "agent");
            xb_add(&bar[XB_XGEN(b.x)], 1u);
            asm volatile("s_waitcnt vmcnt(0)" ::: "memory");
        } else {
            XB_SPIN(xb_ld(&bar[XB_XGEN(b.x)]) == gen, bar);
            __builtin_amdgcn_fence(__ATOMIC_ACQUIRE, "agent");
            asm volatile("s_waitcnt vmcnt(0)" ::: "memory");
        }
    }
    __syncthreads();
}

extern __shared__ __attribute__((aligned(16))) char smem[];
#define NPHASES 7

#define XB_LDS_OFF (LDS_BYTES - 16)
__global__ void __launch_bounds__(NTHREADS) mega(Params p, int ph0, int ph1) {
    XcdBarrier xb;
    const bool multi = (ph1 - ph0) > 1;
    if (multi) {
        if (threadIdx.x == 0) *(u32x4*)(smem + XB_LDS_OFF) = (u32x4){0u, 0u, 0u, 0u};
        __syncthreads();
        xb = xcd_barrier_post(p.bar, (volatile LAS unsigned*)(smem + XB_LDS_OFF));
    }
#if defined(__HIP_DEVICE_COMPILE__)
    typedef const __attribute__((address_space(4))) Params* cparams_t;
    const cparams_t kp = (cparams_t)__builtin_amdgcn_kernarg_segment_ptr();
#define RUN_PHASE(k) if (ph0 <= k && k < ph1) { cparams_t q_ = kp; asm volatile("" : "+s"(q_)); const Params lp_ = *q_; phase##k(lp_, smem); if (k + 1 < ph1) xcd_barrier(xb); }
#else
#define RUN_PHASE(k) if (ph0 <= k && k < ph1) { phase##k(p, smem); if (k + 1 < ph1) xcd_barrier(xb); }
#endif
    RUN_PHASE(0)
    RUN_PHASE(1)
    RUN_PHASE(2)
    RUN_PHASE(3)
    RUN_PHASE(4)
    RUN_PHASE(5)
    RUN_PHASE(6)
}

static inline size_t align_up(size_t x, size_t a) { return (x + a - 1) / a * a; }

extern "C" void kernel_launch(void* const* d_in, const int* in_sizes, int n_in,
                              void* d_out, int out_size, void* d_ws, size_t ws_size,
                              hipStream_t stream) {
    Params p{};
    p.x_prompt = (const float*)d_in[0]; p.x_sample = (const float*)d_in[1]; p.cache_latent = (const float*)d_in[2]; p.cache_krope = (const float*)d_in[3];
    p.state_hgrn = (const float*)d_in[4]; p.page_table = (const int*)d_in[5]; p.meta = (const float*)d_in[6]; p.norm_g = (const float*)d_in[7];
    p.w_in = (const float*)d_in[8]; p.g_cq = (const float*)d_in[9]; p.w_uq = (const float*)d_in[10]; p.g_ckv = (const float*)d_in[11];
    p.w_uk = (const float*)d_in[12]; p.w_uv = (const float*)d_in[13]; p.g_qn = (const float*)d_in[14]; p.g_kn = (const float*)d_in[15];
    p.lb_logits = (const float*)d_in[16]; p.g_bn = (const float*)d_in[17]; p.w_oa = (const float*)d_in[18]; p.w_ob = (const float*)d_in[19]; p.w_o = (const float*)d_in[20];
    p.out = (float*)d_out;
    char* w = (char*)d_ws; size_t off = 0;
    auto take = [&](size_t bytes) { char* r = w + off; off = align_up(off + bytes, 256); return r; };
    p.bar    = (unsigned*)take(16384);
    p.XN     = (bf16_t*)take((size_t)R_PAD * 1024 * 2);
    p.WIN_T  = (bf16_t*)take((size_t)IN_COLS_PAD * 1024 * 2);
    p.PBUF   = (bf16_t*)take((size_t)R_PAD * IN_COLS_PAD * 2);
    p.F32A   = (float*)take((size_t)R_PAD * 672 * 4);
    p.GLOG   = (float*)take((size_t)R_PAD * 512 * 4);
    p.CQN    = (bf16_t*)take((size_t)R_PAD * 384 * 2);
    p.CKVN   = (bf16_t*)take((size_t)R_PAD * 256 * 2);
    p.KRR    = (float*)take((size_t)R_PAD * 32 * 4);
    p.WUQ_T  = (bf16_t*)take((size_t)768 * 384 * 2);
    p.WUKV_T = (bf16_t*)take((size_t)1024 * 256 * 2);
    p.WUKVG_T = (bf16_t*)take((size_t)1024 * 256 * 2);
    p.F32B   = (float*)take((size_t)R_PAD * 288 * 4);
    p.WOA_T  = (bf16_t*)take((size_t)1024 * 512 * 2);
    p.WOB_T  = (bf16_t*)take((size_t)1024 * 512 * 2);
    p.WO_T   = (bf16_t*)take((size_t)1024 * 1024 * 2);
    p.QRAW   = (bf16_t*)take((size_t)R_PAD * 768 * 2);
    p.KVRAW  = (bf16_t*)take((size_t)R_PAD * 1024 * 2);
    p.QA     = (bf16_t*)take((size_t)8 * 8 * 2048 * 96 * 2);
    p.KA     = (bf16_t*)take((size_t)8 * 8 * 2064 * 96 * 2 + 65536);
    p.VTG    = (bf16_t*)take((size_t)64 * 64 * 2112 * 2);
    p.QS     = (float*)take((size_t)32 * 8 * 96 * 4);
    p.KSRAW  = (float*)take((size_t)32 * 8 * 96 * 4);
    p.AMA    = (bf16_t*)take((size_t)MROWS_PAD * 512 * 2);
    p.AMB    = (bf16_t*)take((size_t)MROWS_PAD * 512 * 2);
    p.MM     = (bf16_t*)take((size_t)MROWS_PAD * 1024 * 2);
    p.TMP    = (float*)take((size_t)NQ * 1024 * 4);
    p.UT     = (bf16_t*)take((size_t)32 * NCHUNK * 16384 * 2);
    p.ST     = (bf16_t*)take((size_t)32 * NCHUNK * 16384 * 2);
    p.DEC    = (float*)take((size_t)32 * NCHUNK * 128 * 4);
    p.LB     = (float*)take(512 * 4);
    p.INV    = (float*)take(64);
    p.ROPE   = (float*)take((size_t)2065 * 32 * 4);
    p.SCAL   = (float*)take(64);
    p.PART   = (float*)take((size_t)32 * 8 * 8 * 256 * 4);
    p.PL     = (float*)take((size_t)32 * 8 * 8 * 4);
    p.OLAT   = (float*)take((size_t)32 * 8 * 256 * 4);
    (void)ws_size; (void)in_sizes; (void)n_in; (void)out_size;
    static int mode = -1;
    if (mode < 0) {
        (void)hipFuncSetAttribute((const void*)mega, hipFuncAttributeMaxDynamicSharedMemorySize, LDS_BYTES);
        int dev = 0, cus = 0, per_cu = 0;
        (void)hipGetDevice(&dev);
        (void)hipDeviceGetAttribute(&cus, hipDeviceAttributeMultiprocessorCount, dev);
        (void)hipOccupancyMaxActiveBlocksPerMultiprocessor(&per_cu, (const void*)mega, NTHREADS, LDS_BYTES);
        mode = (cus * per_cu >= 256) ? 1 : 0;
    }
    (void)hipMemsetAsync(p.bar, 0, 16384, stream);
    if (mode == 1) {
        mega<<<dim3(256), dim3(NTHREADS), LDS_BYTES, stream>>>(p, 0, NPHASES);
    } else {
        for (int ph = 0; ph < NPHASES; ++ph) mega<<<dim3(256), dim3(NTHREADS), LDS_BYTES, stream>>>(p, ph, ph + 1);
    }
}
```

```cpp
#include <hip/hip_runtime.h>
#include <stdint.h>

#define D_MODEL 1024
#define BATCH 8
#define SEQ 2048
#define NMETA 16
#define LTOT 2064
#define DEC_BATCH 32
#define PAST_LEN 16384
#define PAGE 128
#define NPAGES 128
#define A_HEADS 8
#define A_NOPE 64
#define A_ROPE 32
#define A_QK 96
#define A_V 64
#define Q_LORA 384
#define KV_LORA 256
#define B_HEADS 4
#define B_DK 128
#define B_DV 128
#define IN_COLS 5280
#define IN_COLS_PAD 5376
#define EPSF 1e-6f

#define C_CQ 0
#define C_CKV 384
#define C_KR 640
#define C_BQ 672
#define C_BF 1184
#define C_BI 1696
#define C_GA 2208
#define C_GB 2720
#define C_MA 3232
#define C_MB 4256
#define C_END 5280

#define R_PROMPT 16512
#define R_ALL 16544
#define R_PAD 16640
#define NQ 16384
#define MROWS 16416
#define MROWS_PAD 16512

#define OFF_Y_P 0
#define OFF_Y_S 16777216
#define OFF_LAT_P 16809984
#define OFF_KR_P 21037056
#define OFF_HG_P 21565440
#define OFF_LAT_S 22089728
#define OFF_KR_S 22097920
#define OFF_HG_S 22098944
#define OUT_TOTAL 24196096

#define NTHREADS 512
#define LDS_BYTES 155648
#define LDS_ITEM_OFF (LDS_BYTES - 32)
#define NCHUNK 33

typedef unsigned short bf16_t;
typedef short bf16x8 __attribute__((ext_vector_type(8)));
typedef float f32x4 __attribute__((ext_vector_type(4)));
typedef float f32x2 __attribute__((ext_vector_type(2)));
typedef unsigned u32x4 __attribute__((ext_vector_type(4)));
typedef unsigned u32x2 __attribute__((ext_vector_type(2)));
typedef __bf16 bf16x2_t __attribute__((ext_vector_type(2)));

__device__ __forceinline__ unsigned cvtpk(float lo, float hi) {
    f32x2 v = {lo, hi};
    bf16x2_t b = __builtin_convertvector(v, bf16x2_t);
    return __builtin_bit_cast(unsigned, b);
}
__device__ __forceinline__ bf16_t f2bf(float x) { return (bf16_t)(cvtpk(x, 0.f) & 0xffffu); }
__device__ __forceinline__ float bf2f(bf16_t u) { return __uint_as_float(((unsigned)u) << 16); }
__device__ __forceinline__ float bflo(unsigned w) { return __uint_as_float(w << 16); }
__device__ __forceinline__ float bfhi(unsigned w) { return __uint_as_float(w & 0xffff0000u); }
__device__ __forceinline__ float sigmoidf_(float x) { return 1.0f / (1.0f + __expf(-x)); }
__device__ __forceinline__ float siluf_(float x) { return x / (1.0f + __expf(-x)); }
__device__ __forceinline__ float wave_sum(float v) {
    v += __shfl_xor(v, 32); v += __shfl_xor(v, 16); v += __shfl_xor(v, 8);
    v += __shfl_xor(v, 4);  v += __shfl_xor(v, 2);  v += __shfl_xor(v, 1);
    return v;
}

struct Params {
    const float* x_prompt; const float* x_sample; const float* cache_latent; const float* cache_krope;
    const float* state_hgrn; const int* page_table; const float* meta; const float* norm_g;
    const float* w_in; const float* g_cq; const float* w_uq; const float* g_ckv; const float* w_uk; const float* w_uv;
    const float* g_qn; const float* g_kn; const float* lb_logits; const float* g_bn;
    const float* w_oa; const float* w_ob; const float* w_o;
    float* out;
    bf16_t* XN;
    bf16_t* WIN_T;
    bf16_t* PBUF;
    float*  F32A;
    float*  GLOG;
    bf16_t* CQN;
    bf16_t* CKVN;
    float*  KRR;
    bf16_t* WUQ_T;
    bf16_t* WUKV_T;
    bf16_t* WUKVG_T;
    float*  F32B;
    bf16_t* WOA_T;
    bf16_t* WOB_T;
    bf16_t* WO_T;
    bf16_t* QRAW;
    bf16_t* KVRAW;
    bf16_t* QA;
    bf16_t* KA;
    bf16_t* VTG;
    float*  QS;
    float*  KSRAW;
    bf16_t* AMA;
    bf16_t* AMB;
    bf16_t* MM;
    float*  TMP;
    bf16_t* UT;
    bf16_t* ST;
    float*  DEC;
    float*  LB;
    float*  INV;
    float*  ROPE;
    float*  SCAL;
    float*  PART;
    float*  PL;
    float*  OLAT;
    unsigned* bar;
};

__device__ __forceinline__ f32x4 mfma16(bf16x8 w, bf16x8 x, f32x4 acc) {
    return __builtin_amdgcn_mfma_f32_16x16x32_bf16(w, x, acc, 0, 0, 0);
}

#define GT_LD 144
#define GT_BUF (128 * GT_LD)
#define GT_LDS_BYTES (4 * GT_BUF)

__device__ __forceinline__ void gemm_tile_accum(f32x4 (&acc)[4][2], const bf16_t* __restrict__ X, int ldx, const bf16_t* __restrict__ W, int ldw,
                                                int K, char* lds) {
    const int tid = threadIdx.x, lane = tid & 63, wid = tid >> 6, wm = wid >> 2, wn = wid & 3;
    const int lr = lane & 15, lg = lane >> 4;
    const int r0 = tid >> 3, kc = tid & 7;
    const bf16_t* xp0 = X + (size_t)r0 * ldx + kc * 8;
    const bf16_t* xp1 = X + (size_t)(r0 + 64) * ldx + kc * 8;
    const bf16_t* wp0 = W + (size_t)r0 * ldw + kc * 8;
    const bf16_t* wp1 = W + (size_t)(r0 + 64) * ldw + kc * 8;
    const int so0 = r0 * GT_LD + kc * 16, so1 = (r0 + 64) * GT_LD + kc * 16;
    char* Xs = lds; char* Ws = lds + 2 * GT_BUF;
    const int nk = K >> 6;
    u32x4 a0 = *(const u32x4*)xp0, a1 = *(const u32x4*)xp1, b0 = *(const u32x4*)wp0, b1 = *(const u32x4*)wp1;
    *(u32x4*)(Xs + so0) = a0; *(u32x4*)(Xs + so1) = a1; *(u32x4*)(Ws + so0) = b0; *(u32x4*)(Ws + so1) = b1;
    __syncthreads();
    const int xoff = (wm * 64 + lr) * GT_LD + lg * 16;
    const int woff = (wn * 32 + lr) * GT_LD + lg * 16;
    for (int kt = 0; kt < nk; ++kt) {
        const int cur = kt & 1;
        if (kt + 1 < nk) {
            const int ko = (kt + 1) * 64;
            a0 = *(const u32x4*)(xp0 + ko); a1 = *(const u32x4*)(xp1 + ko); b0 = *(const u32x4*)(wp0 + ko); b1 = *(const u32x4*)(wp1 + ko);
        }
        const char* xs = Xs + cur * GT_BUF + xoff;
        const char* ws = Ws + cur * GT_BUF + woff;
#pragma unroll
        for (int ks = 0; ks < 2; ++ks) {
            bf16x8 xf[4], wf[2];
#pragma unroll
            for (int mt = 0; mt < 4; ++mt) xf[mt] = *(const bf16x8*)(xs + mt * 16 * GT_LD + ks * 64);
#pragma unroll
            for (int nt = 0; nt < 2; ++nt) wf[nt] = *(const bf16x8*)(ws + nt * 16 * GT_LD + ks * 64);
#pragma unroll
            for (int mt = 0; mt < 4; ++mt)
#pragma unroll
                for (int nt = 0; nt < 2; ++nt) acc[mt][nt] = mfma16(wf[nt], xf[mt], acc[mt][nt]);
        }
        if (kt + 1 < nk) {
            char* xd = Xs + (cur ^ 1) * GT_BUF; char* wd = Ws + (cur ^ 1) * GT_BUF;
            *(u32x4*)(xd + so0) = a0; *(u32x4*)(xd + so1) = a1; *(u32x4*)(wd + so0) = b0; *(u32x4*)(wd + so1) = b1;
        }
        __syncthreads();
    }
}

namespace pg8 {
#define PG8_LAS __attribute__((address_space(3)))
constexpr int BM = 256, BK = 64, HALF = 128, HTB = HALF * BK * 2  , STAGE_BYTES = 8 * HTB, NXCD = 8, WGM = 8;

__host__ __device__ __forceinline__ int lds_byte(int r, int c) { const int st = (r >> 4) * 2 + (c >> 5), rr = r & 15, cc = c & 31, ob = rr * 64 + cc * 2; return st * 1024 + (ob ^ (((ob >> 9) & 1) << 5)); }
__host__ __device__ __forceinline__ void stage_rc(int b, int& R, int& C) { const int st = b / 1024, sb = b % 1024, swz = sb ^ (((sb >> 9) & 1) << 5); R = (st >> 1) * 16 + swz / 64; C = (st & 1) * 32 + (swz % 64) / 2; }
__host__ __device__ __forceinline__ int perm32(int rho) { const int n = rho >> 4, i = rho & 15; return 8 * (i >> 2) + 4 * n + (i & 3); }

struct Unit { int pm, pn, sel; };
struct Gemm { const bf16_t* A; const bf16_t* Bt; int M, N, K; const bf16_t* A1; const bf16_t* Bt1; };

struct StaticOrder {
    int nM, nN, nwg, G, c;
    __host__ __device__ void init(int M, int N, int G_, int c_) { nM = M / BM; nN = N / BM; nwg = nM * nN; G = G_; c = c_; }
    __host__ __device__ bool next(int i, Unit& u) const {
        const long L = (long)i * G + c; if (L >= nwg) return false;
        int wgid = (int)L; { const int q = nwg / NXCD, r = nwg % NXCD, xcd = wgid % NXCD, off = wgid / NXCD; wgid = (xcd < r ? xcd * (q + 1) : r * (q + 1) + (xcd - r) * q) + off; }
        const int nig = WGM * nN, gid = wgid / nig, fm = gid * WGM, gsz = (nM - fm) < WGM ? (nM - fm) : WGM;
        u.pm = fm + ((wgid % nig) % gsz); u.pn = (wgid % nig) / gsz; u.sel = 0; return true;
    }
    __device__ __forceinline__ void a_ready(const Unit&) const {}
    __device__ __forceinline__ void done(const Unit&) const {}
};


template <class Epi, class Sched, bool ALIGN_EPI = false, bool SP2 = false>
__device__ __forceinline__ void gemm_phase(PG8_LAS unsigned char* lds, const Gemm g, const Sched& S, const Epi& E) {
    const int tid = threadIdx.x, wid = __builtin_amdgcn_readfirstlane(tid >> 6), lane = tid & 63, wr = wid >> 2, wc = wid & 3, fr = lane & 15, fq = lane >> 4;
    const int K = g.K, nt = K / BK;
    unsigned voffA[2], voffB[2];
#pragma unroll
    for (int i = 0; i < 2; ++i) { int R, C; stage_rc(tid * 16 + i * 8192, R, C); const int Rb = Epi::PERM ? ((R & ~31) + perm32(R & 31)) : R;
        voffA[i] = (unsigned)(R * K + C) * 2u; voffB[i] = (unsigned)(Rb * K + C) * 2u; }
    const size_t kstep = (size_t)(BK * 2);
    const size_t hstep = (size_t)HALF * K * 2;
    const size_t tstep = 2 * hstep;
    const unsigned ldsw = (unsigned)wid * 1024u;
    const int aoff = lds_byte(wr * 64 + fr, fq * 8), boff = lds_byte(wc * 32 + fr, fq * 8);
#define PG8_SA(b, h) (((b) * 2 + (h)) * HTB)
#define PG8_SB(b, h) ((4 + (b) * 2 + (h)) * HTB)
#define PG8_STAGE(bufoff, gbase, voff) do { _Pragma("unroll") for (int _i = 0; _i < 2; ++_i) \
        __builtin_amdgcn_global_load_lds((const unsigned*)((const char*)(gbase) + (voff)[_i]), (PG8_LAS unsigned*)(lds + (bufoff) + ldsw + _i * 8192), 16, 0, 0); } while (0)
#define PG8_LDA(dst, b, h) do { _Pragma("unroll") for (int m = 0; m < 4; ++m) _Pragma("unroll") for (int k = 0; k < 2; ++k) dst[m][k] = *(const PG8_LAS bf16x8*)(lds + PG8_SA(b, h) + aoff + m * 2048 + k * 1024); } while (0)
#define PG8_LDB(dst, b, h) do { _Pragma("unroll") for (int n = 0; n < 2; ++n) _Pragma("unroll") for (int k = 0; k < 2; ++k) dst[n][k] = *(const PG8_LAS bf16x8*)(lds + PG8_SB(b, h) + boff + n * 2048 + k * 1024); } while (0)
#define PG8_MMA(ai, bj, At, Bt) do { __builtin_amdgcn_s_setprio(1); _Pragma("unroll") for (int m = 0; m < 4; ++m) _Pragma("unroll") for (int n = 0; n < 2; ++n) _Pragma("unroll") for (int k = 0; k < 2; ++k) \
        acc[ai][bj][m][n] = __builtin_amdgcn_mfma_f32_16x16x32_bf16(Bt[n][k], At[m][k], acc[ai][bj][m][n], 0, 0, 0); __builtin_amdgcn_s_setprio(0); } while (0)
#define PG8_WAIT_V(n) asm volatile("s_waitcnt vmcnt(" #n ")" ::: "memory")
#define PG8_WAIT_L(n) asm volatile("s_waitcnt lgkmcnt(" #n ")" ::: "memory")
#define PG8_BAR __builtin_amdgcn_s_barrier()
#define PG8_SCHED __builtin_amdgcn_sched_barrier(0)
    Unit cur, nxt; int ui = 0;
    if (!S.next(0, cur)) return;
    f32x4 acc[2][2][4][2];
#pragma unroll
    for (int a = 0; a < 2; ++a)
#pragma unroll
        for (int b = 0; b < 2; ++b)
#pragma unroll
            for (int m = 0; m < 4; ++m)
#pragma unroll
                for (int n = 0; n < 2; ++n) acc[a][b][m][n] = (f32x4){0.f, 0.f, 0.f, 0.f};
    bf16x8 At[4][2], B0[2][2], B1[2][2];
    const char* cA = (const char*)(cur.sel ? g.A1 : g.A) + (size_t)cur.pm * tstep; const char* cB = (const char*)(cur.sel ? g.Bt1 : g.Bt) + (size_t)cur.pn * tstep;
    S.a_ready(cur);
    if constexpr (SP2) {
        PG8_STAGE(PG8_SB(0, 0), cB, voffB); PG8_STAGE(PG8_SB(0, 1), cB + hstep, voffB); PG8_STAGE(PG8_SA(0, 0), cA, voffA); PG8_STAGE(PG8_SA(0, 1), cA + hstep, voffA);
        if (wr == 1) PG8_BAR;
        PG8_WAIT_V(2); PG8_BAR;
        PG8_STAGE(PG8_SB(1, 0), cB + kstep, voffB); PG8_STAGE(PG8_SA(1, 0), cA + kstep, voffA); PG8_STAGE(PG8_SB(1, 1), cB + hstep + kstep, voffB);
        PG8_WAIT_V(6); PG8_BAR;
    } else {
        PG8_STAGE(PG8_SB(0, 0), cB, voffB); PG8_STAGE(PG8_SA(0, 0), cA, voffA); PG8_STAGE(PG8_SB(0, 1), cB + hstep, voffB); PG8_STAGE(PG8_SA(0, 1), cA + hstep, voffA);
        if (wr == 1) PG8_BAR;
        PG8_WAIT_V(4); PG8_BAR;
        PG8_STAGE(PG8_SB(1, 0), cB + kstep, voffB); PG8_STAGE(PG8_SA(1, 0), cA + kstep, voffA); PG8_STAGE(PG8_SB(1, 1), cB + hstep + kstep, voffB);
        PG8_WAIT_V(6); PG8_BAR;
    }
    for (;;) {
        const bool has_next = S.next(ui + 1, nxt);
        const char* nA = has_next ? (const char*)(nxt.sel ? g.A1 : g.A) + (size_t)nxt.pm * tstep : cA; const char* nB = has_next ? (const char*)(nxt.sel ? g.Bt1 : g.Bt) + (size_t)nxt.pn * tstep : cB;
        for (int t = 0; t < nt; t += 2) {
            const bool last = (t == nt - 2);
            const char* a1 = cA + (size_t)(t + 1) * kstep;
            const char* a2 = last ? nA : cA + (size_t)(t + 2) * kstep; const char* b2 = last ? nB : cB + (size_t)(t + 2) * kstep;
            const char* a3 = a2 + kstep; const char* b3 = b2 + kstep;
            if (last && has_next) S.a_ready(nxt);
            if constexpr (SP2) {
            PG8_LDB(B0, 0, 0); PG8_LDB(B1, 0, 1); PG8_SCHED; PG8_LDA(At, 0, 0); PG8_STAGE(PG8_SA(1, 1), a1 + hstep, voffA);
            PG8_WAIT_V(8); PG8_WAIT_L(0); PG8_BAR; PG8_MMA(0, 0, At, B0); PG8_MMA(0, 1, At, B1); PG8_BAR; PG8_SCHED;
            PG8_LDA(At, 0, 1); PG8_STAGE(PG8_SB(0, 0), b2, voffB); PG8_STAGE(PG8_SB(0, 1), b2 + hstep, voffB); PG8_STAGE(PG8_SA(0, 0), a2, voffA);
            PG8_WAIT_V(8); PG8_WAIT_L(0); PG8_BAR; PG8_MMA(1, 0, At, B0); PG8_MMA(1, 1, At, B1); PG8_BAR; PG8_SCHED;
            PG8_LDB(B0, 1, 0); PG8_LDB(B1, 1, 1); PG8_SCHED; PG8_LDA(At, 1, 0); PG8_STAGE(PG8_SA(0, 1), a2 + hstep, voffA);
            PG8_WAIT_V(8); PG8_WAIT_L(0); PG8_BAR; PG8_MMA(0, 0, At, B0); PG8_MMA(0, 1, At, B1); PG8_BAR; PG8_SCHED;
            PG8_LDA(At, 1, 1); PG8_STAGE(PG8_SB(1, 0), b3, voffB); PG8_STAGE(PG8_SB(1, 1), b3 + hstep, voffB); PG8_STAGE(PG8_SA(1, 0), a3, voffA);
            PG8_WAIT_V(8); PG8_WAIT_L(0); PG8_BAR; PG8_MMA(1, 0, At, B0); PG8_MMA(1, 1, At, B1); PG8_BAR; PG8_SCHED;
            } else {
            PG8_LDB(B0, 0, 0); PG8_SCHED; PG8_LDA(At, 0, 0); PG8_STAGE(PG8_SA(1, 1), a1 + hstep, voffA);
            PG8_WAIT_L(8); PG8_BAR; PG8_WAIT_L(0); PG8_MMA(0, 0, At, B0); PG8_BAR; PG8_SCHED;
            PG8_LDB(B1, 0, 1); PG8_STAGE(PG8_SB(0, 0), b2, voffB);
            PG8_BAR; PG8_WAIT_L(0); PG8_MMA(0, 1, At, B1); PG8_BAR;
            PG8_LDA(At, 0, 1); PG8_STAGE(PG8_SA(0, 0), a2, voffA);
            PG8_BAR; PG8_WAIT_L(0); PG8_MMA(1, 0, At, B0); PG8_BAR; PG8_SCHED;
            PG8_STAGE(PG8_SB(0, 1), b2 + hstep, voffB);
            PG8_WAIT_V(6); PG8_BAR; PG8_MMA(1, 1, At, B1); PG8_BAR;
            PG8_LDB(B0, 1, 0); PG8_SCHED; PG8_LDA(At, 1, 0); PG8_STAGE(PG8_SA(0, 1), a2 + hstep, voffA);
            PG8_WAIT_L(8); PG8_BAR; PG8_WAIT_L(0); PG8_MMA(0, 0, At, B0); PG8_BAR; PG8_SCHED;
            PG8_LDB(B1, 1, 1); PG8_STAGE(PG8_SB(1, 0), b3, voffB);
            PG8_BAR; PG8_WAIT_L(0); PG8_MMA(0, 1, At, B1); PG8_BAR;
            PG8_LDA(At, 1, 1); PG8_STAGE(PG8_SA(1, 0), a3, voffA);
            PG8_BAR; PG8_WAIT_L(0); PG8_MMA(1, 0, At, B0); PG8_BAR; PG8_SCHED;
            PG8_STAGE(PG8_SB(1, 1), b3 + hstep, voffB);
            PG8_WAIT_V(6); PG8_BAR; PG8_MMA(1, 1, At, B1); PG8_BAR;
            }
        }
        if constexpr (ALIGN_EPI) { if (wr == 0) PG8_BAR; }
        if constexpr (!Epi::AFTER_DRAIN) { E(acc, cur, wr, wc, fr, fq); S.done(cur); }
        if (!has_next) break;
        if (!Epi::keep(cur)) {
#pragma unroll
        for (int a = 0; a < 2; ++a)
#pragma unroll
            for (int b = 0; b < 2; ++b)
#pragma unroll
                for (int m = 0; m < 4; ++m)
#pragma unroll
                    for (int n = 0; n < 2; ++n) acc[a][b][m][n] = (f32x4){0.f, 0.f, 0.f, 0.f};
        }
        cur = nxt; cA = nA; cB = nB; ++ui;
        if constexpr (ALIGN_EPI) { if (wr == 1) PG8_BAR; }
    }
    PG8_WAIT_V(0);
    if constexpr (!ALIGN_EPI) { if (wr == 0) PG8_BAR; }
    PG8_BAR;
    if constexpr (Epi::AFTER_DRAIN) { E.fused(acc, cur, wr, wc, fr, fq, lds, wid, lane); S.done(cur); }
#undef PG8_SA
#undef PG8_SB
#undef PG8_STAGE
#undef PG8_LDA
#undef PG8_LDB
#undef PG8_MMA
#undef PG8_WAIT_V
#undef PG8_WAIT_L
#undef PG8_BAR
#undef PG8_SCHED
}
}

struct EpiInProj {
    static constexpr bool PERM = true, AFTER_DRAIN = false;
    static __device__ __forceinline__ bool keep(const pg8::Unit&) { return false; }
    float* F32B; float* GLOG; bf16_t* PBUF; const float* LB; bf16_t* CQN; bf16_t* CKVN;
    __device__ __forceinline__ void operator()(f32x4 (&acc)[2][2][4][2], const pg8::Unit& u, int wr, int wc, int fr, int fq) const {
#pragma unroll
        for (int bj = 0; bj < 2; ++bj) {
            const int nseg = u.pn * 256 + bj * 128 + wc * 32;
            if (nseg >= C_END) continue;
            const int c = nseg + 8 * fq;
#pragma unroll
            for (int ai = 0; ai < 2; ++ai)
#pragma unroll
                for (int m = 0; m < 4; ++m) {
                    const size_t r = (size_t)u.pm * 256 + ai * 128 + wr * 64 + m * 16 + fr;
                    const f32x4 v0 = acc[ai][bj][m][0], v1 = acc[ai][bj][m][1];
                    if (nseg < C_BQ) {
                        if (nseg >= C_CKV) { *(f32x4*)(F32B + r * 288 + (c - C_CKV)) = v0; *(f32x4*)(F32B + r * 288 + (c - C_CKV) + 4) = v1; }
                        if (nseg < C_KR) {
                            u32x4 w; w[0] = cvtpk(v0[0], v0[1]); w[1] = cvtpk(v0[2], v0[3]); w[2] = cvtpk(v1[0], v1[1]); w[3] = cvtpk(v1[2], v1[3]);
                            if (nseg < C_CKV) *(u32x4*)(CQN + r * 384 + c) = w; else *(u32x4*)(CKVN + r * 256 + (c - C_CKV)) = w;
                        }
                        continue;
                    }
                    f32x4 o0, o1;
                    if (nseg < C_BF) {
#pragma unroll
                        for (int e = 0; e < 4; ++e) { o0[e] = siluf_(v0[e]); o1[e] = siluf_(v1[e]); }
                    } else if (nseg < C_BI) {
                        const f32x4 lb0 = *(const f32x4*)(LB + (c - C_BF)), lb1 = *(const f32x4*)(LB + (c - C_BF) + 4);
                        f32x4 l0, l1;
#pragma unroll
                        for (int e = 0; e < 4; ++e) {
                            const float sg0 = 1.0f / (1.0f + expf(-v0[e])), sg1 = 1.0f / (1.0f + expf(-v1[e]));
                            l0[e] = logf(lb0[e] + (1.0f - lb0[e]) * sg0); l1[e] = logf(lb1[e] + (1.0f - lb1[e]) * sg1);
                            o0[e] = (1.0f - lb0[e]) * (1.0f - sg0); o1[e] = (1.0f - lb1[e]) * (1.0f - sg1);
                        }
                        *(f32x4*)(GLOG + r * 512 + (c - C_BF)) = l0; *(f32x4*)(GLOG + r * 512 + (c - C_BF) + 4) = l1;
                    } else if (nseg < C_GA) {
                        o0 = v0; o1 = v1;
                    } else if (nseg < C_MA) {
#pragma unroll
                        for (int e = 0; e < 4; ++e) { o0[e] = siluf_(v0[e]); o1[e] = siluf_(v1[e]); }
                    } else {
#pragma unroll
                        for (int e = 0; e < 4; ++e) { o0[e] = sigmoidf_(v0[e]); o1[e] = sigmoidf_(v1[e]); }
                    }
                    u32x4 w; w[0] = cvtpk(o0[0], o0[1]); w[1] = cvtpk(o0[2], o0[3]); w[2] = cvtpk(o1[0], o1[1]); w[3] = cvtpk(o1[2], o1[3]);
                    *(u32x4*)(PBUF + r * IN_COLS_PAD + c) = w;
                    asm volatile("" ::: "memory");
                }
        }
    }
};
template <int STAGE> struct EpiMerge {
    static constexpr bool PERM = true, AFTER_DRAIN = false;
    static __device__ __forceinline__ bool keep(const pg8::Unit&) { return false; }
    const bf16_t* PBUF; float* TMP; bf16_t* MM;
    __device__ __forceinline__ void operator()(f32x4 (&acc)[2][2][4][2], const pg8::Unit& u, int wr, int wc, int fr, int fq) const {
#pragma unroll
        for (int ai = 0; ai < 2; ++ai)
#pragma unroll
            for (int m = 0; m < 4; ++m) {
                const int mq = u.pm * 256 + ai * 128 + wr * 64 + m * 16 + fr;
                const size_t r = (size_t)(mq >> 11) * LTOT + NMETA + (mq & 2047);
#pragma unroll
                for (int bj = 0; bj < 2; ++bj) {
                    const int c = u.pn * 256 + bj * 128 + wc * 32 + 8 * fq;
                    const u32x4 g = *(const u32x4*)(PBUF + r * IN_COLS_PAD + (STAGE == 0 ? C_MA : C_MB) + c);
                    const f32x4 v0 = acc[ai][bj][m][0], v1 = acc[ai][bj][m][1];
                    f32x4 o0, o1;
                    o0[0] = v0[0] * bflo(g[0]); o0[1] = v0[1] * bfhi(g[0]); o0[2] = v0[2] * bflo(g[1]); o0[3] = v0[3] * bfhi(g[1]);
                    o1[0] = v1[0] * bflo(g[2]); o1[1] = v1[1] * bfhi(g[2]); o1[2] = v1[2] * bflo(g[3]); o1[3] = v1[3] * bfhi(g[3]);
                    if (STAGE == 0) {
                        u32x4 w; w[0] = cvtpk(o0[0], o0[1]); w[1] = cvtpk(o0[2], o0[3]); w[2] = cvtpk(o1[0], o1[1]); w[3] = cvtpk(o1[2], o1[3]);
                        *(u32x4*)(MM + (size_t)mq * 1024 + c) = w;
                    }
                    else {
                        const u32x4 tw = *(const u32x4*)(MM + (size_t)mq * 1024 + c);
                        f32x4 t0, t1;
                        t0[0] = bflo(tw[0]); t0[1] = bfhi(tw[0]); t0[2] = bflo(tw[1]); t0[3] = bfhi(tw[1]);
                        t1[0] = bflo(tw[2]); t1[1] = bfhi(tw[2]); t1[2] = bflo(tw[3]); t1[3] = bfhi(tw[3]);
                        u32x4 w; w[0] = cvtpk(o0[0] + t0[0], o0[1] + t0[1]); w[1] = cvtpk(o0[2] + t0[2], o0[3] + t0[3]);
                        w[2] = cvtpk(o1[0] + t1[0], o1[1] + t1[1]); w[3] = cvtpk(o1[2] + t1[2], o1[3] + t1[3]);
                        *(u32x4*)(MM + (size_t)mq * 1024 + c) = w;
                    }
                }
                asm volatile("" ::: "memory");
            }
    }
};
struct EpiFinal {
    static constexpr bool PERM = true, AFTER_DRAIN = false;
    static __device__ __forceinline__ bool keep(const pg8::Unit&) { return false; }
    const float* X; float* Y;
    __device__ __forceinline__ void operator()(f32x4 (&acc)[2][2][4][2], const pg8::Unit& u, int wr, int wc, int fr, int fq) const {
#pragma unroll
        for (int ai = 0; ai < 2; ++ai)
#pragma unroll
            for (int m = 0; m < 4; ++m) {
                const size_t mq = (size_t)u.pm * 256 + ai * 128 + wr * 64 + m * 16 + fr;
#pragma unroll
                for (int bj = 0; bj < 2; ++bj) {
                    const int c = u.pn * 256 + bj * 128 + wc * 32 + 8 * fq;
                    const f32x4 x0 = __builtin_nontemporal_load((const f32x4*)(X + mq * 1024 + c)), x1 = __builtin_nontemporal_load((const f32x4*)(X + mq * 1024 + c + 4));
                    __builtin_nontemporal_store(x0 + acc[ai][bj][m][0], (f32x4*)(Y + mq * 1024 + c));
                    __builtin_nontemporal_store(x1 + acc[ai][bj][m][1], (f32x4*)(Y + mq * 1024 + c + 4));
                }
            }
    }
};
struct OneTileOrder {
    int tile, nsel;
    __device__ __forceinline__ bool next(int i, pg8::Unit& u) const { if (i >= nsel) return false; u.pm = tile >> 2; u.pn = tile & 3; u.sel = i; return true; }
    __device__ __forceinline__ void a_ready(const pg8::Unit&) const {}
    __device__ __forceinline__ void done(const pg8::Unit&) const {}
};

__device__ __forceinline__ void transpose_tile(const float* __restrict__ src, int src_ld, int nvalid, int k0, int n0,
                                               bf16_t* __restrict__ dst, int dst_ld, float* tile  , const float* __restrict__ kscale, bool fragmajor = false) {
    const int tid = threadIdx.x;
#pragma unroll
    for (int i = 0; i < 2; ++i) {
        const int kk = (tid >> 4) + 32 * i, nn = (tid & 15) * 4;
        f32x4 v = {0.f, 0.f, 0.f, 0.f};
        if (n0 + nn < nvalid) v = *(const f32x4*)(src + (size_t)(k0 + kk) * src_ld + n0 + nn);
        if (kscale) v = v * kscale[k0 + kk];
        tile[kk * 65 + nn + 0] = v[0]; tile[kk * 65 + nn + 1] = v[1]; tile[kk * 65 + nn + 2] = v[2]; tile[kk * 65 + nn + 3] = v[3];
    }
    __syncthreads();
    {
        const int n = tid >> 3, kq = (tid & 7) * 8;
        u32x4 w;
        w[0] = cvtpk(tile[(kq + 0) * 65 + n], tile[(kq + 1) * 65 + n]);
        w[1] = cvtpk(tile[(kq + 2) * 65 + n], tile[(kq + 3) * 65 + n]);
        w[2] = cvtpk(tile[(kq + 4) * 65 + n], tile[(kq + 5) * 65 + n]);
        w[3] = cvtpk(tile[(kq + 6) * 65 + n], tile[(kq + 7) * 65 + n]);
        if (!fragmajor) *(u32x4*)(dst + (size_t)(n0 + n) * dst_ld + k0 + kq) = w;
        else {
            const int nn_ = n0 + n, kk_ = k0 + kq;
            const size_t f = (size_t)(nn_ >> 4) * (dst_ld >> 5) + (kk_ >> 5);
            *(u32x4*)(dst + f * 512 + ((((kk_ >> 3) & 3) << 4) + (nn_ & 15)) * 8) = w;
        }
    }
    __syncthreads();
}

#define TJ_C0 (16 * 84)
#define TJ_C8 (TJ_C0 + 6 * 12 + 4 * 8 + 4 * 8 + 8 * 16 + 8 * 16 + 16 * 16 + 4 * 8 + 4 * 8)
__device__ __forceinline__ void transpose_jobs(const Params& p, char* lds, int jbeg, int jend, int jstart, int jstride) {
    float* tile = (float*)lds;
    const int c0 = TJ_C0;
    const int c1 = c0 + 6 * 12;
    const int c2 = c1 + 4 * 8;
    const int c3 = c2 + 4 * 8;
    const int c4 = c3 + 8 * 16;
    const int c5 = c4 + 8 * 16;
    const int c6 = c5 + 16 * 16;
    const int c7 = c6 + 4 * 8;
    for (int j = jbeg + jstart; j < jend; j += jstride) {
        const float* src; int sld, nval, ntn, loc; bf16_t* dst; int dld; const float* ksc = nullptr; bool fm = false;
        if (j < c0)      { loc = j;      src = p.w_in; sld = IN_COLS; nval = IN_COLS; ntn = 84; dst = p.WIN_T; dld = 1024; }
        else if (j < c1) { loc = j - c0; src = p.w_uq; sld = 768;  nval = 768;  ntn = 12; dst = p.WUQ_T; dld = 384; ksc = p.g_cq; fm = true; }
        else if (j < c2) { loc = j - c1; src = p.w_uk; sld = 512;  nval = 512;  ntn = 8;  dst = p.WUKV_T; dld = 256; }
        else if (j < c3) { loc = j - c2; src = p.w_uv; sld = 512;  nval = 512;  ntn = 8;  dst = p.WUKV_T + (size_t)512 * 256; dld = 256; }
        else if (j < c4) { loc = j - c3; src = p.w_oa; sld = 1024; nval = 1024; ntn = 16; dst = p.WOA_T; dld = 512; }
        else if (j < c5) { loc = j - c4; src = p.w_ob; sld = 1024; nval = 1024; ntn = 16; dst = p.WOB_T; dld = 512; }
        else if (j < c6) { loc = j - c5; src = p.w_o;  sld = 1024; nval = 1024; ntn = 16; dst = p.WO_T; dld = 1024; }
        else if (j < c7) { loc = j - c6; src = p.w_uk; sld = 512;  nval = 512;  ntn = 8;  dst = p.WUKVG_T; dld = 256; ksc = p.g_ckv; fm = true; }
        else             { loc = j - c7; src = p.w_uv; sld = 512;  nval = 512;  ntn = 8;  dst = p.WUKVG_T + (size_t)512 * 256; dld = 256; ksc = p.g_ckv; fm = true; }
        const int kt = loc / ntn, nt = loc % ntn;
        transpose_tile(src, sld, nval, kt * 64, nt * 64, dst, dld, tile, ksc, fm);
    }
}

__device__ __forceinline__ void phase0(const Params& p, char* lds) {
    const int tid = threadIdx.x, lane = tid & 63, wid = tid >> 6;
    const int nb = gridDim.x, bid = blockIdx.x;
    transpose_jobs(p, lds, 0, TJ_C0, bid, nb);
    for (int i = bid * NTHREADS + tid; i < 64 * 64 * 48; i += nb * NTHREADS) {
        const int row = i / 48, c = i - row * 48;
        p.VTG[(size_t)row * 2112 + LTOT + c] = 0;
    }
    for (int r = bid * 8 + wid; r < R_PAD; r += nb * 8) {
        bf16_t* dst = p.XN + (size_t)r * 1024;
        if (r >= R_ALL) {
#pragma unroll
            for (int i = 0; i < 4; ++i) *(u32x2*)(dst + lane * 4 + 256 * i) = (u32x2){0u, 0u};
            continue;
        }
        const float* src;
        if (r < R_PROMPT) { const int b = r / LTOT, t = r - b * LTOT; src = (t < NMETA) ? p.meta + (size_t)t * 1024 : p.x_prompt + ((size_t)b * SEQ + (t - NMETA)) * 1024; }
        else src = p.x_sample + (size_t)(r - R_PROMPT) * 1024;
        f32x4 v[4]; float ss = 0.f;
#pragma unroll
        for (int i = 0; i < 4; ++i) { v[i] = *(const f32x4*)(src + lane * 4 + 256 * i); ss += v[i][0] * v[i][0] + v[i][1] * v[i][1] + v[i][2] * v[i][2] + v[i][3] * v[i][3]; }
        ss = wave_sum(ss);
        const float rs = 1.0f / sqrtf(ss * (1.0f / 1024.0f) + EPSF);
#pragma unroll
        for (int i = 0; i < 4; ++i) {
            const f32x4 g = *(const f32x4*)(p.norm_g + lane * 4 + 256 * i);
            u32x2 w; w[0] = cvtpk(v[i][0] * rs * g[0], v[i][1] * rs * g[1]); w[1] = cvtpk(v[i][2] * rs * g[2], v[i][3] * rs * g[3]);
            *(u32x2*)(dst + lane * 4 + 256 * i) = w;
        }
    }
    for (int i = bid * NTHREADS + tid; i < 2065 * 16; i += nb * NTHREADS) {
        const int pi = i >> 4, k = i & 15;
        const float pos = (pi < LTOT) ? (float)pi : (float)PAST_LEN;
        const float inv = (float)exp(-(double)k / 16.0 * log(10000.0));
        const float ang = pos * inv;
        p.ROPE[pi * 32 + k] = cosf(ang); p.ROPE[pi * 32 + 16 + k] = sinf(ang);
    }
    if (bid == 0) {
        if (tid < 512) { const float l0 = p.lb_logits[tid], l1 = p.lb_logits[512 + tid]; p.LB[tid] = 1.0f / (1.0f + expf(l1 - l0)); }
        if (tid < 16) p.INV[tid] = (float)exp(-(double)tid / 16.0 * log(10000.0));
        if (wid == 0) {
            float gq = 0.f, gk = 0.f;
            for (int i = lane; i < A_QK; i += 64) { gq = fmaxf(gq, fabsf(p.g_qn[i])); gk = fmaxf(gk, fabsf(p.g_kn[i])); }
#pragma unroll
            for (int o = 32; o >= 1; o >>= 1) { gq = fmaxf(gq, __shfl_xor(gq, o)); gk = fmaxf(gk, __shfl_xor(gk, o)); }
            if (lane == 0) p.SCAL[0] = sqrtf((float)A_QK) * gq * gk;
        }
    }
}

__device__ __forceinline__ void phase1(const Params& p, char* lds) {
    pg8::Gemm g{p.XN, p.WIN_T, R_PAD, IN_COLS_PAD, 1024, p.XN, p.WIN_T};
    pg8::StaticOrder S; S.init(R_PAD, IN_COLS_PAD, (int)gridDim.x, (int)blockIdx.x);
    EpiInProj E{p.F32B, p.GLOG, p.PBUF, p.LB, p.CQN, p.CKVN};
    pg8::gemm_phase<EpiInProj, pg8::StaticOrder, true, true>((PG8_LAS unsigned char*)lds, g, S, E);
    const int nidle = (int)gridDim.x - 85;
    if ((int)blockIdx.x >= 85 && nidle > 0) transpose_jobs(p, lds, TJ_C0, TJ_C8, (int)blockIdx.x - 85, nidle);
    else if (nidle <= 0) transpose_jobs(p, lds, TJ_C0, TJ_C8, (int)blockIdx.x, (int)gridDim.x);
}

#define LOG2E 1.4426950408889634f
__device__ __forceinline__ void fin1_chunk(const Params& p, const int c) {
    int tid_ = threadIdx.x; asm volatile("" : "+v"(tid_));
    const int tid = tid_, lane = tid & 63, wid = tid >> 6;
#pragma unroll 1
    for (int i = 0; i < 8; ++i) {
        const int r = c * 64 + wid * 8 + i;
        if (r >= R_ALL) break;
        const float* src = p.F32B + (size_t)r * 288;
        int pidx; float* o_lat; float* o_kr;
        if (r < R_PROMPT) { pidx = r % LTOT; o_lat = p.out + OFF_LAT_P + (size_t)r * 256; o_kr = p.out + OFF_KR_P + (size_t)r * 32; }
        else { const int j = r - R_PROMPT; pidx = LTOT; o_lat = p.out + OFF_LAT_S + (size_t)j * 256; o_kr = p.out + OFF_KR_S + (size_t)j * 32; }
        const f32x4 v = *(const f32x4*)(src + lane * 4);
        float ss = v[0] * v[0] + v[1] * v[1] + v[2] * v[2] + v[3] * v[3];
        ss = wave_sum(ss);
        const float rs = 1.0f / sqrtf(ss * (1.0f / 256.0f) + EPSF);
        const f32x4 g = *(const f32x4*)(p.g_ckv + lane * 4);
        f32x4 o; o[0] = v[0] * rs * g[0]; o[1] = v[1] * rs * g[1]; o[2] = v[2] * rs * g[2]; o[3] = v[3] * rs * g[3];
        *(f32x4*)(o_lat + lane * 4) = o;
        if (lane < 16) {
            const float x1 = src[256 + lane], x2 = src[256 + 16 + lane];
            const float cs = p.ROPE[pidx * 32 + lane], sn = p.ROPE[pidx * 32 + 16 + lane];
            o_kr[lane] = x1 * cs - x2 * sn; o_kr[16 + lane] = x1 * sn + x2 * cs;
        }
    }
}

#define UF_XQ_LD 784
#define UF_XK_LD 528
__device__ __forceinline__ float diag_pick(const f32x4 a, int lr, int lg) {
    const int j = lr & 3;
    float v = (j == 0) ? a[0] : (j == 1) ? a[1] : (j == 2) ? a[2] : a[3];
    v = (lg == (lr >> 2)) ? v : 0.f;
    v += __shfl_xor(v, 16); v += __shfl_xor(v, 32);
    return v;
}
__device__ __forceinline__ void upfused_item(const Params& p, char* lds, const int item) {
    int tid_ = threadIdx.x; asm volatile("" : "+v"(tid_));
    const int tid = tid_, lane = tid & 63, h = tid >> 6, lr = lane & 15, lg = lane >> 4;
    const int rt = item / 3, part = item - rt * 3, row0 = rt * 64;
    const float qk_scale = 0.10206207261596577f;
    if (part == 0) {
        char* X = lds;
#pragma unroll
        for (int i = 0; i < 6; ++i) {
            const int id = tid + 512 * i, row = id / 48, ch = id - row * 48;
            *(u32x4*)(X + row * UF_XQ_LD + ch * 16) = *(const u32x4*)(p.CQN + (size_t)(row0 + row) * 384 + ch * 8);
        }
        __syncthreads();
        f32x4 acc[4][6], accs[4];
#pragma unroll
        for (int mt = 0; mt < 4; ++mt) { accs[mt] = (f32x4){0.f, 0.f, 0.f, 0.f};
#pragma unroll
            for (int nt = 0; nt < 6; ++nt) acc[mt][nt] = (f32x4){0.f, 0.f, 0.f, 0.f}; }
        const bf16_t* wb = p.WUQ_T + (size_t)(h * 6) * 12 * 512 + lane * 8;
        f32x4 gq[6], rc[4], rsn[4];
#pragma unroll
        for (int nt = 0; nt < 6; ++nt) gq[nt] = *(const f32x4*)(p.g_qn + 16 * nt + 4 * lg);
#pragma unroll
        for (int mt = 0; mt < 4; ++mt) {
            const int r = row0 + 16 * mt + lr;
            const int pidx = (r >= R_PROMPT) ? LTOT : (r % LTOT);
            rc[mt] = *(const f32x4*)(p.ROPE + pidx * 32 + 4 * lg); rsn[mt] = *(const f32x4*)(p.ROPE + pidx * 32 + 16 + 4 * lg);
        }
#pragma unroll 1
        for (int ks = 0; ks < 12; ++ks) {
            bf16x8 xf[4], wf[6];
#pragma unroll
            for (int nt = 0; nt < 6; ++nt) wf[nt] = *(const bf16x8*)(wb + (size_t)(nt * 12 + ks) * 512);
#pragma unroll
            for (int mt = 0; mt < 4; ++mt) xf[mt] = *(const bf16x8*)(X + (16 * mt + lr) * UF_XQ_LD + ks * 64 + lg * 16);
#pragma unroll
            for (int mt = 0; mt < 4; ++mt) {
                accs[mt] = mfma16(xf[mt], xf[mt], accs[mt]);
#pragma unroll
                for (int nt = 0; nt < 6; ++nt) acc[mt][nt] = mfma16(wf[nt], xf[mt], acc[mt][nt]);
            }
        }
#pragma unroll
        for (int mt = 0; mt < 4; ++mt) {
            const int r = row0 + 16 * mt + lr;
            const float rs_cq = 1.0f / sqrtf(diag_pick(accs[mt], lr, lg) * (1.0f / 384.0f) + EPSF);
            const bool is_s = r >= R_PROMPT;
            const int b = r / LTOT, t = r - b * LTOT;
            const int pidx = is_s ? LTOT : t;
            f32x4 q[6];
#pragma unroll
            for (int nt = 0; nt < 6; ++nt) q[nt] = acc[mt][nt] * rs_cq;
            {
                const f32x4 c4 = rc[mt], s4 = rsn[mt];
#pragma unroll
                for (int j = 0; j < 4; ++j) { const float x1 = q[4][j], x2 = q[5][j]; q[4][j] = x1 * c4[j] - x2 * s4[j]; q[5][j] = x1 * s4[j] + x2 * c4[j]; }
            }
            float ss = 0.f;
#pragma unroll
            for (int nt = 0; nt < 6; ++nt)
#pragma unroll
                for (int j = 0; j < 4; ++j) ss += q[nt][j] * q[nt][j];
            ss += __shfl_xor(ss, 16); ss += __shfl_xor(ss, 32);
            const float rs = 1.0f / sqrtf(ss * (1.0f / 96.0f) + EPSF);
            if (!is_s) {
                if (t >= NMETA && r < R_PROMPT) {
                    bf16_t* dst = p.QA + ((size_t)(b * 8 + h) * 2048 + (t - NMETA)) * 96 + 4 * lg;
                    const float sc = rs * qk_scale * LOG2E;
#pragma unroll
                    for (int nt = 0; nt < 6; ++nt) {
                        const f32x4 g = gq[nt];
                        u32x2 w; w[0] = cvtpk(q[nt][0] * sc * g[0], q[nt][1] * sc * g[1]); w[1] = cvtpk(q[nt][2] * sc * g[2], q[nt][3] * sc * g[3]);
                        *(u32x2*)(dst + 16 * nt) = w;
                    }
                }
            } else if (r < R_ALL) {
                float* dst = p.QS + ((size_t)(r - R_PROMPT) * 8 + h) * 96 + 4 * lg;
                const float sc = rs * qk_scale;
#pragma unroll
                for (int nt = 0; nt < 6; ++nt) {
                    const f32x4 g = gq[nt], gk = *(const f32x4*)(p.g_kn + 16 * nt + 4 * lg);
                    f32x4 o; o[0] = q[nt][0] * sc * g[0] * gk[0]; o[1] = q[nt][1] * sc * g[1] * gk[1]; o[2] = q[nt][2] * sc * g[2] * gk[2]; o[3] = q[nt][3] * sc * g[3] * gk[3];
                    *(f32x4*)(dst + 16 * nt) = o;
                }
            }
        }
    } else {
        char* X = lds;
        float* KR = (float*)(lds + 64 * UF_XK_LD);
#pragma unroll
        for (int i = 0; i < 4; ++i) {
            const int id = tid + 512 * i, row = id >> 5, ch = id & 31;
            *(u32x4*)(X + row * UF_XK_LD + ch * 16) = *(const u32x4*)(p.CKVN + (size_t)(row0 + row) * 256 + ch * 8);
        }
        if (part == 1) { const int row = tid >> 3, c4 = tid & 7; *(f32x4*)(KR + row * 36 + c4 * 4) = *(const f32x4*)(p.F32B + (size_t)(row0 + row) * 288 + 256 + c4 * 4); }
        __syncthreads();
        f32x4 ak[4][4], accs[4];
#pragma unroll
        for (int mt = 0; mt < 4; ++mt) { accs[mt] = (f32x4){0.f, 0.f, 0.f, 0.f};
#pragma unroll
            for (int nt = 0; nt < 4; ++nt) ak[mt][nt] = (f32x4){0.f, 0.f, 0.f, 0.f}; }
        const bf16_t* wk = p.WUKVG_T + (size_t)((part == 1 ? 0 : 32) + h * 4) * 8 * 512 + lane * 8;
        f32x4 gk[6], rc[4], rsn[4];
        if (part == 1) {
#pragma unroll
            for (int nt = 0; nt < 6; ++nt) gk[nt] = *(const f32x4*)(p.g_kn + 16 * nt + 4 * lg);
#pragma unroll
            for (int mt = 0; mt < 4; ++mt) {
                const int r = row0 + 16 * mt + lr;
                const int pidx = (r >= R_PROMPT) ? LTOT : (r % LTOT);
                rc[mt] = *(const f32x4*)(p.ROPE + pidx * 32 + 4 * lg); rsn[mt] = *(const f32x4*)(p.ROPE + pidx * 32 + 16 + 4 * lg);
            }
        }
#pragma unroll 1
        for (int ks = 0; ks < 8; ++ks) {
            bf16x8 xf[4], wfk[4];
#pragma unroll
            for (int nt = 0; nt < 4; ++nt) wfk[nt] = *(const bf16x8*)(wk + (size_t)(nt * 8 + ks) * 512);
#pragma unroll
            for (int mt = 0; mt < 4; ++mt) xf[mt] = *(const bf16x8*)(X + (16 * mt + lr) * UF_XK_LD + ks * 64 + lg * 16);
#pragma unroll
            for (int mt = 0; mt < 4; ++mt) {
                accs[mt] = mfma16(xf[mt], xf[mt], accs[mt]);
#pragma unroll
                for (int nt = 0; nt < 4; ++nt) ak[mt][nt] = mfma16(wfk[nt], xf[mt], ak[mt][nt]);
            }
        }
#pragma unroll
        for (int mt = 0; mt < 4; ++mt) {
            const int r = row0 + 16 * mt + lr;
            const float rs_ckv = 1.0f / sqrtf(diag_pick(accs[mt], lr, lg) * (1.0f / 256.0f) + EPSF);
            const bool is_s = r >= R_PROMPT;
            const int b = r / LTOT, t = r - b * LTOT;
            if (part == 2) {
                if (!is_s) {
                    const int x = t & 15, slot = (t & ~15) | (x & 3) | ((x & 4) << 1) | ((x & 8) >> 1);
                    bf16_t* vd = p.VTG + (size_t)(b * 8 + h) * 64 * 2112 + slot;
#pragma unroll
                    for (int nt = 0; nt < 4; ++nt)
#pragma unroll
                        for (int j = 0; j < 4; ++j) vd[(size_t)(16 * nt + 4 * lg + j) * 2112] = f2bf(ak[mt][nt][j] * rs_ckv);
                }
                continue;
            }
            const int pidx = is_s ? LTOT : t;
            const f32x4 x1 = *(const f32x4*)(KR + (16 * mt + lr) * 36 + 4 * lg), x2 = *(const f32x4*)(KR + (16 * mt + lr) * 36 + 16 + 4 * lg);
            float ss = 0.f;
#pragma unroll
            for (int j = 0; j < 4; ++j) ss += x1[j] * x1[j] + x2[j] * x2[j];
            f32x4 kn[4];
#pragma unroll
            for (int nt = 0; nt < 4; ++nt) { kn[nt] = ak[mt][nt] * rs_ckv;
#pragma unroll
                for (int j = 0; j < 4; ++j) ss += kn[nt][j] * kn[nt][j]; }
            ss += __shfl_xor(ss, 16); ss += __shfl_xor(ss, 32);
            const float rs = 1.0f / sqrtf(ss * (1.0f / 96.0f) + EPSF);
            const f32x4 c4 = rc[mt], s4 = rsn[mt];
            f32x4 y1, y2;
#pragma unroll
            for (int j = 0; j < 4; ++j) { y1[j] = x1[j] * c4[j] - x2[j] * s4[j]; y2[j] = x1[j] * s4[j] + x2[j] * c4[j]; }
            if (!is_s) {
                bf16_t* dst = p.KA + ((size_t)(b * 8 + h) * LTOT + t) * 96 + 4 * lg;
#pragma unroll
                for (int nt = 0; nt < 4; ++nt) {
                    const f32x4 g = gk[nt];
                    u32x2 w; w[0] = cvtpk(kn[nt][0] * rs * g[0], kn[nt][1] * rs * g[1]); w[1] = cvtpk(kn[nt][2] * rs * g[2], kn[nt][3] * rs * g[3]);
                    *(u32x2*)(dst + 16 * nt) = w;
                }
                {
                    const f32x4 g1 = gk[4], g2 = gk[5];
                    u32x2 w1, w2;
                    w1[0] = cvtpk(y1[0] * rs * g1[0], y1[1] * rs * g1[1]); w1[1] = cvtpk(y1[2] * rs * g1[2], y1[3] * rs * g1[3]);
                    w2[0] = cvtpk(y2[0] * rs * g2[0], y2[1] * rs * g2[1]); w2[1] = cvtpk(y2[2] * rs * g2[2], y2[3] * rs * g2[3]);
                    *(u32x2*)(dst + 64) = w1; *(u32x2*)(dst + 80) = w2;
                }
            } else if (r < R_ALL) {
                float* dst = p.KSRAW + ((size_t)(r - R_PROMPT) * 8 + h) * 96 + 4 * lg;
#pragma unroll
                for (int nt = 0; nt < 4; ++nt) *(f32x4*)(dst + 16 * nt) = kn[nt];
                *(f32x4*)(dst + 64) = y1; *(f32x4*)(dst + 80) = y2;
            }
        }
    }
    __syncthreads();
}

#define HA_LD 144
#define HC_LD 272
__device__ __forceinline__ void hgrn_passA_unit(const Params& p, char* lds, const int u) {
    int tid_ = threadIdx.x; asm volatile("" : "+v"(tid_));
    const int tid = tid_, lane = tid & 63, wid = tid >> 6, lr = lane & 15, lg = lane >> 4;
    float* cumL = (float*)lds;
    float* tot = (float*)(lds + 32768);
    char* KT = lds + 32768 + 2048;
    char* VT = KT + 128 * HA_LD;
    {
        const int c = u % NCHUNK, bh = u / NCHUNK, h = bh % B_HEADS, b = bh / B_HEADS;
        const int nvalid = (c == 0) ? NMETA : 64;
        const int t0 = (c == 0) ? 0 : NMETA + 64 * (c - 1);
        const size_t rowbase = (size_t)b * LTOT + t0;
        const int d = tid & 127, part = tid >> 7;
        char* KR = VT + 128 * HA_LD;
#pragma unroll
        for (int i = 0; i < 4; ++i) {
            const int id = tid + 512 * i, row = id >> 5, c4 = id & 31;
            f32x4 g = {0.f, 0.f, 0.f, 0.f};
            if (row < nvalid) g = *(const f32x4*)(p.GLOG + (rowbase + row) * 512 + h * 128 + c4 * 4);
            *(f32x4*)(cumL + row * 128 + c4 * 4) = g;
        }
#pragma unroll
        for (int i = 0; i < 2; ++i) {
            const int id = tid + 512 * i, row = id >> 4, ch = id & 15;
            u32x4 kw = {0u, 0u, 0u, 0u}, w = {0u, 0u, 0u, 0u};
            if (row < nvalid) {
                kw = *(const u32x4*)(p.PBUF + (rowbase + row) * IN_COLS_PAD + C_BF + h * 128 + ch * 8);
                w = *(const u32x4*)(p.PBUF + (rowbase + row) * IN_COLS_PAD + C_BI + h * 128 + ch * 8);
            }
            *(u32x4*)(KR + row * HC_LD + ch * 16) = kw;
#pragma unroll
            for (int e = 0; e < 4; ++e) {
                *(bf16_t*)(VT + (ch * 8 + 2 * e) * HA_LD + row * 2) = (bf16_t)(w[e] & 0xffffu);
                *(bf16_t*)(VT + (ch * 8 + 2 * e + 1) * HA_LD + row * 2) = (bf16_t)(w[e] >> 16);
            }
        }
        __syncthreads();
        {
            float run = 0.f;
#pragma unroll
            for (int i = 0; i < 16; ++i) { const int s = part * 16 + i; run += cumL[s * 128 + d]; cumL[s * 128 + d] = run; }
            tot[part * 128 + d] = run;
        }
        __syncthreads();
        {
            float off = 0.f, last = 0.f;
#pragma unroll
            for (int q = 0; q < 4; ++q) { const float tq = tot[q * 128 + d]; last += tq; if (q < part) off += tq; }
            if (part == 0) p.DEC[(size_t)u * 128 + d] = expf(last);
#pragma unroll
            for (int i = 0; i < 16; ++i) {
                const int s = part * 16 + i;
                const float cum = cumL[s * 128 + d] + off;
                const float kv = bf2f(*(const bf16_t*)(KR + s * HC_LD + d * 2));
                *(bf16_t*)(KT + d * HA_LD + s * 2) = f2bf(kv * __expf(last - cum));
            }
        }
        __syncthreads();
        {
            const char* xs = VT + (wid * 16 + lr) * HA_LD + lg * 16;
            bf16x8 xf0 = *(const bf16x8*)(xs), xf1 = *(const bf16x8*)(xs + 64);
            bf16_t* dst = p.UT + (size_t)u * 16384 + (size_t)(wid * 16 + lr) * 128;
#pragma unroll
            for (int nt = 0; nt < 8; ++nt) {
                const char* ws = KT + (nt * 16 + lr) * HA_LD + lg * 16;
                f32x4 acc = {0.f, 0.f, 0.f, 0.f};
                acc = mfma16(*(const bf16x8*)(ws), xf0, acc);
                acc = mfma16(*(const bf16x8*)(ws + 64), xf1, acc);
                { u32x2 w; w[0] = cvtpk(acc[0], acc[1]); w[1] = cvtpk(acc[2], acc[3]); *(u32x2*)(dst + nt * 16 + 4 * lg) = w; }
            }
        }
        __syncthreads();
    }
}

__device__ __forceinline__ void hgrn_sample_step_unit(const Params& p, char* lds, const int u) {
    int tid_ = threadIdx.x; asm volatile("" : "+v"(tid_));
    const int tid = tid_;
    float* part = (float*)lds;
    float* red = (float*)(lds + 8192);
    {
        const int i = u / B_HEADS, h = u % B_HEADS;
        const size_t r = R_PROMPT + i;
        const int v4 = (tid & 31) * 4, dp = tid >> 5;
        const float* S0 = p.state_hgrn + (size_t)u * 16384;
        float* S1 = p.out + OFF_HG_S + (size_t)u * 16384;
        const u32x2 vw = *(const u32x2*)(p.PBUF + r * IN_COLS_PAD + C_BI + h * 128 + v4);
        const float vv[4] = {bflo(vw[0]), bfhi(vw[0]), bflo(vw[1]), bfhi(vw[1])};
        float o[4] = {0.f, 0.f, 0.f, 0.f};
#pragma unroll
        for (int e = 0; e < 8; ++e) {
            const int d = dp * 8 + e;
            const float q = bf2f(p.PBUF[r * IN_COLS_PAD + C_BQ + h * 128 + d]);
            const float k = bf2f(p.PBUF[r * IN_COLS_PAD + C_BF + h * 128 + d]);
            const float f = expf(p.GLOG[r * 512 + h * 128 + d]);
            const f32x4 s0 = *(const f32x4*)(S0 + d * 128 + v4);
            f32x4 s1;
#pragma unroll
            for (int j = 0; j < 4; ++j) { s1[j] = f * s0[j] + k * vv[j]; o[j] += q * s1[j]; }
            *(f32x4*)(S1 + d * 128 + v4) = s1;
        }
#pragma unroll
        for (int j = 0; j < 4; ++j) part[dp * 128 + v4 + j] = o[j];
        __syncthreads();
        float osum = 0.f;
        if (tid < 128) {
#pragma unroll
            for (int q = 0; q < 16; ++q) osum += part[q * 128 + tid];
            float ss = wave_sum(osum * osum);
            if ((tid & 63) == 0) red[tid >> 6] = ss;
        }
        __syncthreads();
        if (tid < 128) {
            const float ss = red[0] + red[1];
            const float rs = 1.0f / sqrtf(ss * (1.0f / 128.0f) + EPSF);
            const float gb = bf2f(p.PBUF[r * IN_COLS_PAD + C_GB + h * 128 + tid]);
            p.AMB[(size_t)(NQ + i) * 512 + h * 128 + tid] = f2bf(osum * rs * p.g_bn[tid] * gb);
        }
        __syncthreads();
    }
}

#define Q_UF_ITEMS (3 * (R_PAD / 64))
#define Q_HA_ITEMS (BATCH * B_HEADS * NCHUNK)
#define Q_SS_ITEMS (DEC_BATCH * B_HEADS)
#define Q_F1_ITEMS ((R_ALL + 63) / 64)
#define QCTR_WORD 3584
__device__ __forceinline__ void phase2(const Params& p, char* lds) {
    volatile int* slot = (volatile int*)(lds + LDS_ITEM_OFF);
    const int total = Q_UF_ITEMS + Q_HA_ITEMS + Q_SS_ITEMS + Q_F1_ITEMS;
    int nxt = 0;
    if (threadIdx.x == 0) nxt = (int)atomicAdd(p.bar + QCTR_WORD, 1u);
    for (;;) {
        if (threadIdx.x == 0) *slot = nxt;
        __syncthreads();
        const int it = __builtin_amdgcn_readfirstlane(*slot);
        __syncthreads();
        if (it >= total) break;
        if (threadIdx.x == 0) nxt = (int)atomicAdd(p.bar + QCTR_WORD, 1u);
        if (it < Q_UF_ITEMS) upfused_item(p, lds, it);
        else if (it < Q_UF_ITEMS + Q_HA_ITEMS) hgrn_passA_unit(p, lds, it - Q_UF_ITEMS);
        else if (it < Q_UF_ITEMS + Q_HA_ITEMS + Q_SS_ITEMS) hgrn_sample_step_unit(p, lds, it - Q_UF_ITEMS - Q_HA_ITEMS);
        else fin1_chunk(p, it - Q_UF_ITEMS - Q_HA_ITEMS - Q_SS_ITEMS);
    }
}

__device__ __forceinline__ void hgrn_passB(const Params& p) {
    for (int g = blockIdx.x * NTHREADS + threadIdx.x; g < 32 * 128 * 32; g += gridDim.x * NTHREADS) {
        const int d4 = (g & 31) * 4, v = (g >> 5) & 127, bh = g >> 12;
        f32x4 S = {0.f, 0.f, 0.f, 0.f};
        for (int c = 0; c < NCHUNK; ++c) {
            const size_t u = (size_t)bh * NCHUNK + c;
            u32x2 w; w[0] = cvtpk(S[0], S[1]); w[1] = cvtpk(S[2], S[3]);
            *(u32x2*)(p.ST + u * 16384 + v * 128 + d4) = w;
            const f32x4 dec = *(const f32x4*)(p.DEC + u * 128 + d4);
            const u32x2 uw = *(const u32x2*)(p.UT + u * 16384 + v * 128 + d4);
            const f32x4 ut = {bflo(uw[0]), bfhi(uw[0]), bflo(uw[1]), bfhi(uw[1])};
#pragma unroll
            for (int j = 0; j < 4; ++j) S[j] = dec[j] * S[j] + ut[j];
        }
        float* o = p.out + OFF_HG_P + (size_t)bh * 16384;
#pragma unroll
        for (int j = 0; j < 4; ++j) o[(d4 + j) * 128 + v] = S[j];
    }
}

#define AK_LD 208
#define AV_LD 144
#define AP_LD 144
#define AK_BUF (64 * AK_LD)
#define AV_BUF (64 * AV_LD)

typedef float f32x16 __attribute__((ext_vector_type(16)));
#define A2K_LD 208
#define A2V_LD 144
#define A2K_BUF (64 * A2K_LD)
#define A2V_BUF (64 * A2V_LD)
__device__ __forceinline__ f32x16 mfma32(bf16x8 a, bf16x8 b, f32x16 c) { return __builtin_amdgcn_mfma_f32_32x32x16_bf16(a, b, c, 0, 0, 0); }
__device__ __forceinline__ void attn_unit2(const Params& p, char* lds, int b, int h, int qb) {
    const int tid = threadIdx.x, lane = tid & 63, wid = tid >> 6, r32 = lane & 31, hi = lane >> 5;
    char* Ks = lds;
    char* Vs = lds + 2 * A2K_BUF;
    const int tq0 = qb * 256;
    const int ntile = 4 * qb + 5;
    const float negMb = -p.SCAL[0] * LOG2E;
    const bf16_t* qsrc = p.QA + ((size_t)(b * 8 + h) * 2048 + tq0 + 32 * wid + r32) * 96 + hi * 8;
    bf16x8 qf[6];
#pragma unroll
    for (int s = 0; s < 6; ++s) qf[s] = *(const bf16x8*)(qsrc + 16 * s);
    const int wq_min = NMETA + tq0 + 32 * wid, wq_max = wq_min + 31, qpos = wq_min + r32;
    const bf16_t* kbase = p.KA + (size_t)(b * 8 + h) * LTOT * 96;
    const bf16_t* vbase = p.VTG + (size_t)(b * 8 + h) * 64 * 2112;
    const int kkey0 = tid / 12, kpart0 = tid % 12;
    const int kkey1 = (512 + tid) / 12, kpart1 = (512 + tid) % 12;
    const int vdv = tid >> 3, vpart = tid & 7;
    u32x4 kA0, kA1 = {0u, 0u, 0u, 0u}, vA, kB0, kB1 = {0u, 0u, 0u, 0u}, vB;
#define A2_LOAD(K0, K1, V, ti_) { const int key0 = (ti_) * 64; \
        int ka = key0 + kkey0; ka = ka < LTOT ? ka : LTOT - 1; K0 = *(const u32x4*)(kbase + (size_t)ka * 96 + kpart0 * 8); \
        if (tid < 256) { int kb = key0 + kkey1; kb = kb < LTOT ? kb : LTOT - 1; K1 = *(const u32x4*)(kbase + (size_t)kb * 96 + kpart1 * 8); } \
        V = *(const u32x4*)(vbase + (size_t)vdv * 2112 + key0 + vpart * 8); }
#define A2_STORE(K0, K1, V, buf_) { *(u32x4*)(Ks + (buf_) * A2K_BUF + kkey0 * A2K_LD + kpart0 * 16) = K0; \
        if (tid < 256) *(u32x4*)(Ks + (buf_) * A2K_BUF + kkey1 * A2K_LD + kpart1 * 16) = K1; \
        *(u32x4*)(Vs + (buf_) * A2V_BUF + vdv * A2V_LD + vpart * 16) = V; }
    f32x16 o0, o1;
#pragma unroll
    for (int i = 0; i < 16; ++i) { o0[i] = 0.f; o1[i] = 0.f; }
    float lsum = 0.f;
    A2_LOAD(kA0, kA1, vA, 0); A2_STORE(kA0, kA1, vA, 0);
    A2_LOAD(kB0, kB1, vB, 1);
    __syncthreads();
#pragma unroll 2
    for (int ti = 0; ti < ntile; ++ti) {
        const int cur = ti & 1;
        if (ti + 2 < ntile) { if (cur == 0) { A2_LOAD(kA0, kA1, vA, ti + 2); } else { A2_LOAD(kB0, kB1, vB, ti + 2); } }
        if (ti * 64 <= wq_max) {
            f32x16 s0, s1;
#pragma unroll
            for (int i = 0; i < 16; ++i) { s0[i] = negMb; s1[i] = negMb; }
            const char* ka = Ks + cur * A2K_BUF + r32 * A2K_LD + hi * 16;
#pragma unroll
            for (int s = 0; s < 6; ++s) {
                s0 = mfma32(*(const bf16x8*)(ka + s * 32), qf[s], s0);
                s1 = mfma32(*(const bf16x8*)(ka + 32 * A2K_LD + s * 32), qf[s], s1);
            }
            const bool diag = (ti * 64 + 63 > wq_min);
#pragma unroll
            for (int i = 0; i < 16; ++i) { s0[i] = __builtin_amdgcn_exp2f(s0[i]); s1[i] = __builtin_amdgcn_exp2f(s1[i]); }
            if (diag) {
                const int kb0 = ti * 64 + 4 * hi;
#pragma unroll
                for (int i = 0; i < 16; ++i) {
                    const int key = kb0 + (i & 3) + 8 * (i >> 2);
                    if (key > qpos) s0[i] = 0.f;
                    if (key + 32 > qpos) s1[i] = 0.f;
                }
            }
            float la = 0.f, lb = 0.f;
#pragma unroll
            for (int i = 0; i < 16; ++i) { la += s0[i]; lb += s1[i]; }
            lsum += la + lb;
            bf16x8 pb[2][2];
#pragma unroll
            for (int s = 0; s < 2; ++s) {
                u32x4 w0, w1;
#pragma unroll
                for (int e = 0; e < 4; ++e) { w0[e] = cvtpk(s0[8 * s + 2 * e], s0[8 * s + 2 * e + 1]); w1[e] = cvtpk(s1[8 * s + 2 * e], s1[8 * s + 2 * e + 1]); }
                pb[0][s] = __builtin_bit_cast(bf16x8, w0); pb[1][s] = __builtin_bit_cast(bf16x8, w1);
            }
            const char* va = Vs + cur * A2V_BUF + r32 * A2V_LD + hi * 16;
#pragma unroll
            for (int kt = 0; kt < 2; ++kt)
#pragma unroll
                for (int s = 0; s < 2; ++s) {
                    o0 = mfma32(*(const bf16x8*)(va + kt * 64 + s * 32), pb[kt][s], o0);
                    o1 = mfma32(*(const bf16x8*)(va + 32 * A2V_LD + kt * 64 + s * 32), pb[kt][s], o1);
                }
        }
        if (ti + 1 < ntile) { if (cur == 0) { A2_STORE(kB0, kB1, vB, 1); } else { A2_STORE(kA0, kA1, vA, 0); } }
        __syncthreads();
    }
#undef A2_LOAD
#undef A2_STORE
    lsum += __shfl_xor(lsum, 32);
    const float inv = 1.0f / lsum;
    const int tq = tq0 + 32 * wid + r32;
    const size_t r = (size_t)b * LTOT + NMETA + tq;
    const size_t mrow = (size_t)b * 2048 + tq;
#pragma unroll
    for (int vt = 0; vt < 2; ++vt)
#pragma unroll
        for (int g = 0; g < 4; ++g) {
            const int dv = 32 * vt + 8 * g + 4 * hi;
            const u32x2 gw = *(const u32x2*)(p.PBUF + r * IN_COLS_PAD + C_GA + h * 64 + dv);
            const float v0 = (vt ? o1[4 * g] : o0[4 * g]) * inv, v1 = (vt ? o1[4 * g + 1] : o0[4 * g + 1]) * inv;
            const float v2 = (vt ? o1[4 * g + 2] : o0[4 * g + 2]) * inv, v3 = (vt ? o1[4 * g + 3] : o0[4 * g + 3]) * inv;
            u32x2 w; w[0] = cvtpk(v0 * bflo(gw[0]), v1 * bfhi(gw[0])); w[1] = cvtpk(v2 * bflo(gw[1]), v3 * bfhi(gw[1]));
            *(u32x2*)(p.AMA + mrow * 512 + h * 64 + dv) = w;
        }
}

__device__ __forceinline__ void attn_phase(const Params& p, char* lds) {
    const int i = blockIdx.x;
    if (i < 256) {
        const int bh = i >> 2, pair = i & 3;
        attn_unit2(p, lds, bh >> 3, bh & 7, 7 - pair);
        attn_unit2(p, lds, bh >> 3, bh & 7, pair);
    }
}

__device__ __forceinline__ void hgrn_passC(const Params& p, char* lds) {
    const int tid = threadIdx.x, lane = tid & 63, wid = tid >> 6, lr = lane & 15, lg = lane >> 4;
    float* cumL = (float*)lds;
    float* tot = (float*)(lds + 32768);
    char* QT = lds + 34816;
    char* KN = QT + 64 * HC_LD;
    char* QH = KN + 64 * HC_LD;
    char* VT = QH + 64 * HC_LD;
    char* AT = VT + 128 * HA_LD;
    char* STl = AT + 64 * HA_LD;
    for (int uu = blockIdx.x; uu < 32 * 32; uu += gridDim.x) {
        const int c = 1 + (uu & 31), bh = uu >> 5, h = bh & 3, b = bh >> 2;
        const size_t u = (size_t)bh * NCHUNK + c;
        const int t0 = NMETA + 64 * (c - 1);
        const size_t rowbase = (size_t)b * LTOT + t0;
        const int d = tid & 127, part = tid >> 7;
#pragma unroll
        for (int i = 0; i < 4; ++i) {
            const int id = tid + 512 * i, row = id >> 5, c4 = id & 31;
            *(f32x4*)(cumL + row * 128 + c4 * 4) = *(const f32x4*)(p.GLOG + (rowbase + row) * 512 + h * 128 + c4 * 4);
        }
#pragma unroll
        for (int i = 0; i < 2; ++i) {
            const int id = tid + 512 * i, row = id >> 4, ch = id & 15;
            const bf16_t* src = p.PBUF + (rowbase + row) * IN_COLS_PAD + h * 128 + ch * 8;
            const u32x4 qw = *(const u32x4*)(src + C_BQ), kw = *(const u32x4*)(src + C_BF), w = *(const u32x4*)(src + C_BI);
            *(u32x4*)(QH + row * HC_LD + ch * 16) = qw;
            *(u32x4*)(KN + row * HC_LD + ch * 16) = kw;
#pragma unroll
            for (int e = 0; e < 4; ++e) {
                *(bf16_t*)(VT + (ch * 8 + 2 * e) * HA_LD + row * 2) = (bf16_t)(w[e] & 0xffffu);
                *(bf16_t*)(VT + (ch * 8 + 2 * e + 1) * HA_LD + row * 2) = (bf16_t)(w[e] >> 16);
            }
        }
#pragma unroll
        for (int i = 0; i < 4; ++i) {
            const int id = tid + 512 * i, v = id >> 4, dc = id & 15;
            *(u32x4*)(STl + v * HC_LD + dc * 16) = *(const u32x4*)(p.ST + u * 16384 + v * 128 + dc * 8);
        }
        __syncthreads();
        {
            float run = 0.f;
#pragma unroll
            for (int i = 0; i < 16; ++i) { const int s = part * 16 + i; run += cumL[s * 128 + d]; cumL[s * 128 + d] = run; }
            tot[part * 128 + d] = run;
        }
        __syncthreads();
        {
            float off = 0.f;
#pragma unroll
            for (int q = 0; q < 4; ++q) { const float tq = tot[q * 128 + d]; if (q < part) off += tq; }
            const float ref = tot[d] + tot[128 + d];
#pragma unroll
            for (int i = 0; i < 16; ++i) {
                const int s = part * 16 + i;
                const float cum = cumL[s * 128 + d] + off;
                const float qv = bf2f(*(const bf16_t*)(QH + s * HC_LD + d * 2));
                const float kv = bf2f(*(const bf16_t*)(KN + s * HC_LD + d * 2));
                *(bf16_t*)(QT + s * HC_LD + d * 2) = f2bf(qv * __expf(cum - ref));
                *(bf16_t*)(KN + s * HC_LD + d * 2) = f2bf(kv * __expf(ref - cum));
                *(bf16_t*)(QH + s * HC_LD + d * 2) = f2bf(qv * __expf(cum));
            }
        }
        __syncthreads();
        {
            const int mt = wid >> 1;
            const char* xs = QT + (mt * 16 + lr) * HC_LD + lg * 16;
            bf16x8 xf[4];
#pragma unroll
            for (int ks = 0; ks < 4; ++ks) xf[ks] = *(const bf16x8*)(xs + ks * 64);
#pragma unroll
            for (int q = 0; q < 2; ++q) {
                const int nt = 2 * (wid & 1) + q;
                const char* ws = KN + (nt * 16 + lr) * HC_LD + lg * 16;
                f32x4 a = {0.f, 0.f, 0.f, 0.f};
#pragma unroll
                for (int ks = 0; ks < 4; ++ks) a = mfma16(*(const bf16x8*)(ws + ks * 64), xf[ks], a);
                const int t = mt * 16 + lr, s0 = nt * 16 + 4 * lg;
                float m[4];
#pragma unroll
                for (int j = 0; j < 4; ++j) m[j] = (s0 + j <= t) ? a[j] : 0.f;
                u32x2 w; w[0] = cvtpk(m[0], m[1]); w[1] = cvtpk(m[2], m[3]);
                *(u32x2*)(AT + t * HA_LD + s0 * 2) = w;
            }
        }
        __syncthreads();
        {
            const int mt = wid >> 1;
            const char* xa = AT + (mt * 16 + lr) * HA_LD + lg * 16;
            const char* xq = QH + (mt * 16 + lr) * HC_LD + lg * 16;
            bf16x8 af[2], qf[4];
#pragma unroll
            for (int ks = 0; ks < 2; ++ks) af[ks] = *(const bf16x8*)(xa + ks * 64);
#pragma unroll
            for (int ks = 0; ks < 4; ++ks) qf[ks] = *(const bf16x8*)(xq + ks * 64);
#pragma unroll
            for (int q = 0; q < 4; ++q) {
                const int nt = 4 * (wid & 1) + q;
                const char* wv = VT + (nt * 16 + lr) * HA_LD + lg * 16;
                const char* wsx = STl + (nt * 16 + lr) * HC_LD + lg * 16;
                f32x4 a = {0.f, 0.f, 0.f, 0.f};
#pragma unroll
                for (int ks = 0; ks < 2; ++ks) a = mfma16(*(const bf16x8*)(wv + ks * 64), af[ks], a);
#pragma unroll
                for (int ks = 0; ks < 4; ++ks) a = mfma16(*(const bf16x8*)(wsx + ks * 64), qf[ks], a);
                *(f32x4*)(cumL + (mt * 16 + lr) * 128 + nt * 16 + 4 * lg) = a;
            }
        }
        __syncthreads();
        {
#pragma unroll
            for (int i = 0; i < 8; ++i) {
                const int t = wid * 8 + i;
                const f32x2 ov = *(const f32x2*)(cumL + t * 128 + 2 * lane);
                const float ss = wave_sum(ov[0] * ov[0] + ov[1] * ov[1]);
                const float rs = 1.0f / sqrtf(ss * (1.0f / 128.0f) + EPSF);
                const unsigned gw = *(const unsigned*)(p.PBUF + (rowbase + t) * IN_COLS_PAD + C_GB + h * 128 + 2 * lane);
                const f32x2 gbn = *(const f32x2*)(p.g_bn + 2 * lane);
                const size_t mrow = (size_t)b * 2048 + 64 * (c - 1) + t;
                *(unsigned*)(p.AMB + mrow * 512 + h * 128 + 2 * lane) = cvtpk(ov[0] * rs * gbn[0] * bflo(gw), ov[1] * rs * gbn[1] * bfhi(gw));
            }
        }
        __syncthreads();
    }
}

#define SC_LD 528
#define SP_LD 272
#define SC_BUF (128 * SC_LD)

#define SA_D 6
#define SA_STG (SA_D * 16384)
#define SA_RSTG (SA_D * 2048)
#define SA_CB_SLOT (16 * SC_LD)
#define SA_NG 128
typedef __attribute__((address_space(3))) unsigned las_u32;

#define SB_D 2
#define SB_STG (SB_D * 32768)
#define SB_RSTG (SB_D * 4096)
#define SB_CB_SLOT (32 * SC_LD)
#define SB_NG 64

#define SR_LD 80
typedef short v4i16_t __attribute__((ext_vector_type(4)));
__device__ __forceinline__ float xsum16_32(float v) {
    auto r = __builtin_amdgcn_permlane16_swap(__float_as_uint(v), __float_as_uint(v), false, false);
    v = __uint_as_float(r[0]) + __uint_as_float(r[1]);
    auto q = __builtin_amdgcn_permlane32_swap(__float_as_uint(v), __float_as_uint(v), false, false);
    return __uint_as_float(q[0]) + __uint_as_float(q[1]);
}
__device__ __forceinline__ void sample_attn4(const Params& p, char* lds) {
    const int tid = threadIdx.x, lane = tid & 63, lr = lane & 15, lg = lane >> 4;
    const int wid = __builtin_amdgcn_readfirstlane(tid >> 6);
    char* stg = lds;
    char* rstg = lds + SB_STG;
    char* cb = rstg + SB_RSTG;
    char* rb = cb + 3 * SB_CB_SLOT;
    char* pl = rb + 3 * 32 * SR_LD;
    for (int blk = blockIdx.x; blk < DEC_BATCH * 8; blk += gridDim.x) {
        const int b = blk >> 3, split = blk & 7, h = wid;
        ((unsigned*)pl)[tid] = 0u;
        bf16x8 wf[4][8];
        {
            const bf16_t* wb = p.WUKV_T + (size_t)(64 * h + lr) * 256 + 8 * lg;
#pragma unroll
            for (int nt = 0; nt < 4; ++nt) {
                asm volatile("" : "+v"(wb));
#pragma unroll
                for (int ks = 0; ks < 8; ++ks) wf[nt][ks] = *(const bf16x8*)(wb + 32 * ks);
                wb += 16 * 256;
            }
        }
        const float* qs = p.QS + (size_t)(b * 8 + h) * 96;
        f32x4 qg[4];
#pragma unroll
        for (int nt = 0; nt < 4; ++nt) qg[nt] = *(const f32x4*)(qs + 16 * nt + 4 * lg) * LOG2E;
        bf16x8 qrf;
        {
            u32x4 w = {0u, 0u, 0u, 0u};
            if (lr < 8) {
                const float* q = p.QS + (size_t)(b * 8 + lr) * 96 + 64 + 8 * lg;
                const f32x4 a0 = *(const f32x4*)q * LOG2E, a1 = *(const f32x4*)(q + 4) * LOG2E;
                w[0] = cvtpk(a0[0], a0[1]); w[1] = cvtpk(a0[2], a0[3]); w[2] = cvtpk(a1[0], a1[1]); w[3] = cvtpk(a1[2], a1[3]);
            }
            qrf = __builtin_bit_cast(bf16x8, w);
        }
        const int pgid = p.page_table[b * NPAGES + split * 16 + (lane & 15)];
        const float Mb = p.SCAL[0] * LOG2E;
        f32x4 accl[2] = {{0.f, 0.f, 0.f, 0.f}, {0.f, 0.f, 0.f, 0.f}};
        float lacc = 0.f;
        asm volatile("s_waitcnt vmcnt(0) lgkmcnt(0)" ::: "memory");
        __syncthreads();
        auto issue = [&](int gi, int slot) {
            const int pg = __builtin_amdgcn_readlane(pgid, gi >> 2);
            const size_t row0 = (size_t)pg * PAGE + 32 * (gi & 3) + 4 * wid;
            const float* src = p.cache_latent + row0 * KV_LORA + lane * 4;
            char __attribute__((address_space(3)))* d0 = (char __attribute__((address_space(3)))*)(stg + slot * 32768 + (4 * wid) * 1024);
            __builtin_amdgcn_global_load_lds((const unsigned*)src, (las_u32*)d0, 16, 0, 0);
            __builtin_amdgcn_global_load_lds((const unsigned*)(src + KV_LORA), (las_u32*)(d0 + 1024), 16, 0, 0);
            __builtin_amdgcn_global_load_lds((const unsigned*)(src + 2 * KV_LORA), (las_u32*)(d0 + 2048), 16, 0, 0);
            __builtin_amdgcn_global_load_lds((const unsigned*)(src + 3 * KV_LORA), (las_u32*)(d0 + 3072), 16, 0, 0);
            const float* rsrc = p.cache_krope + row0 * A_ROPE + lane;
            char __attribute__((address_space(3)))* r0 = (char __attribute__((address_space(3)))*)(rstg + slot * 4096 + wid * 512);
            __builtin_amdgcn_global_load_lds((const unsigned*)rsrc, (las_u32*)r0, 4, 0, 0);
            __builtin_amdgcn_global_load_lds((const unsigned*)(rsrc + 64), (las_u32*)(r0 + 256), 4, 0, 0);
        };
#pragma unroll 1
        for (int gi = 0; gi < SB_D; ++gi) issue(gi, gi);
        int c3_g = 2, d_g1 = 0;
        const int hsel = h & 3;
        const float fhg = (lg == (h >> 2)) ? 1.f : 0.f, fdg = (lg == (lr >> 2)) ? 1.f : 0.f;
#pragma unroll 1
        for (int g = -1; g <= SB_NG; ++g) {
            const int c3_g1 = (c3_g == 2) ? 0 : c3_g + 1;
            const int c3_gm1 = (c3_g == 0) ? 2 : c3_g - 1;
            if (g + 1 < SB_NG) {
                if (g + SB_D <= SB_NG - 1) asm volatile("s_waitcnt vmcnt(%0)" :: "n"(6 * (SB_D - 1)) : "memory");
                else asm volatile("s_waitcnt vmcnt(0)" ::: "memory");
            }
            asm volatile("s_waitcnt lgkmcnt(0)" ::: "memory");
            __builtin_amdgcn_s_barrier();
            asm volatile("" ::: "memory");
            if (g + 1 < SB_NG) {
#pragma unroll
                for (int i = 0; i < 4; ++i) {
                    const f32x4 v = *(const f32x4*)(stg + d_g1 * 32768 + (4 * wid + i) * 1024 + lane * 16);
                    u32x2 w; w[0] = cvtpk(v[0], v[1]); w[1] = cvtpk(v[2], v[3]);
                    *(u32x2*)(cb + c3_g1 * SB_CB_SLOT + (4 * wid + i) * SC_LD + lane * 8) = w;
                }
                {
                    const int rrow = 4 * wid + (lane >> 4), c2 = (lane & 15) * 2;
                    const f32x2 v = *(const f32x2*)(rstg + d_g1 * 4096 + rrow * 128 + c2 * 4);
                    *(unsigned*)(rb + c3_g1 * 32 * SR_LD + rrow * SR_LD + c2 * 2) = cvtpk(v[0], v[1]);
                }
                asm volatile("" ::: "memory");
                if (g + 1 + SB_D < SB_NG) issue(g + 1 + SB_D, d_g1);
            }
            if (g >= 0 && g < SB_NG) {
#pragma unroll
                for (int mt2 = 0; mt2 < 2; ++mt2) {
                    f32x4 a[4];
#pragma unroll
                    for (int nt = 0; nt < 4; ++nt) a[nt] = (f32x4){0.f, 0.f, 0.f, 0.f};
                    const char* xs = cb + c3_g * SB_CB_SLOT + (16 * mt2 + lr) * SC_LD + lg * 16;
                    const bf16x8 rf = *(const bf16x8*)(rb + c3_g * 32 * SR_LD + (16 * mt2 + lr) * SR_LD + lg * 16);
#pragma unroll
                    for (int ks = 0; ks < 8; ++ks) {
                        const bf16x8 xf = *(const bf16x8*)(xs + ks * 64);
#pragma unroll
                        for (int nt = 0; nt < 4; ++nt) a[nt] = mfma16(wf[nt][ks], xf, a[nt]);
                    }
                    const f32x4 z4 = {0.f, 0.f, 0.f, 0.f};
                    const f32x4 asr = mfma16(qrf, rf, z4);
                    const f32x4 arr = mfma16(rf, rf, z4);
                    const float srv = (hsel == 0) ? asr[0] : (hsel == 1) ? asr[1] : (hsel == 2) ? asr[2] : asr[3];
                    const int dj = lr & 3;
                    const float rrv = (dj == 0) ? arr[0] : (dj == 1) ? arr[1] : (dj == 2) ? arr[2] : arr[3];
                    float ss = rrv * fdg, sq = srv * fhg;
#pragma unroll
                    for (int nt = 0; nt < 4; ++nt)
#pragma unroll
                        for (int j = 0; j < 4; ++j) { ss += a[nt][j] * a[nt][j]; sq += a[nt][j] * qg[nt][j]; }
                    ss = xsum16_32(ss); sq = xsum16_32(sq);
                    const float sc = sq * __builtin_amdgcn_rsqf(ss * (1.0f / 96.0f) + EPSF);
                    const float pe = __builtin_amdgcn_exp2f(sc - Mb);
                    lacc += pe;
                    if (lg == 0) *(bf16_t*)(pl + (g & 1) * 1024 + h * 64 + (16 * mt2 + lr) * 2) = f2bf(pe);
                }
            }
            if (g >= 1) {
                const bf16x8 xf = *(const bf16x8*)(pl + ((g - 1) & 1) * 1024 + lr * 64 + lg * 16);
#pragma unroll
                for (int q = 0; q < 2; ++q) {
                    const char* cc = cb + c3_gm1 * SB_CB_SLOT + (8 * lg + (lr >> 2)) * SC_LD + (32 * wid + 16 * q + 4 * (lr & 3)) * 2;
                    const v4i16_t t0 = __builtin_amdgcn_ds_read_tr16_b64_v4i16((__attribute__((address_space(3))) v4i16_t*)(cc));
                    const v4i16_t t1 = __builtin_amdgcn_ds_read_tr16_b64_v4i16((__attribute__((address_space(3))) v4i16_t*)(cc + 4 * SC_LD));
                    const bf16x8 wfr = {t0[0], t0[1], t0[2], t0[3], t1[0], t1[1], t1[2], t1[3]};
                    accl[q] = mfma16(wfr, xf, accl[q]);
                }
            }
            c3_g = c3_g1;
            d_g1 = (d_g1 + 1 == SB_D) ? 0 : d_g1 + 1;
        }
        if (lr < 8) {
#pragma unroll
            for (int q = 0; q < 2; ++q) *(f32x4*)(p.PART + ((size_t)(b * 8 + split) * 8 + lr) * 256 + 32 * wid + 16 * q + 4 * lg) = accl[q];
        }
        lacc += __shfl_xor(lacc, 8); lacc += __shfl_xor(lacc, 4); lacc += __shfl_xor(lacc, 2); lacc += __shfl_xor(lacc, 1);
        if (lane == 0) p.PL[(b * 8 + split) * 8 + h] = lacc;
        __syncthreads();
    }
}

__device__ __forceinline__ void phase3(const Params& p, char* lds) {
    hgrn_passB(p);
    sample_attn4(p, lds);
}

__device__ __forceinline__ void sample_combine(const Params& p, char* lds) {
    const int tid = threadIdx.x;
    float* ol = (float*)lds;
    float* red = ol + 256;
    float* sc = red + 512;
    for (int u = blockIdx.x; u < DEC_BATCH * 8; u += gridDim.x) {
        const int b = u >> 3, h = u & 7;
        if (tid < 64) {
            const float* kraw = p.KSRAW + (size_t)(b * 8 + h) * 96;
            const float* qs = p.QS + (size_t)(b * 8 + h) * 96;
            float ss = 0.f, sq = 0.f;
            for (int d = tid; d < 96; d += 64) { const float k = kraw[d]; ss += k * k; sq += k * qs[d]; }
            ss = wave_sum(ss); sq = wave_sum(sq);
            if (tid == 0) {
                const float s = sq / sqrtf(ss * (1.0f / 96.0f) + EPSF);
                const float pn = __expf(s - p.SCAL[0]);
                float l = pn;
                for (int sp = 0; sp < 8; ++sp) l += p.PL[(b * 8 + sp) * 8 + h];
                sc[0] = pn; sc[1] = 1.0f / l;
            }
        }
        __syncthreads();
        if (tid < 256) {
            const int c = tid;
            float a = sc[0] * p.out[OFF_LAT_S + b * 256 + c];
#pragma unroll
            for (int sp = 0; sp < 8; ++sp) a += p.PART[((size_t)(b * 8 + sp) * 8 + h) * 256 + c];
            ol[c] = a * sc[1];
        }
        __syncthreads();
        {
            const int d = tid & 63, part = tid >> 6;
            const bf16_t* wrow = p.WUKV_T + (size_t)(512 + h * 64 + d) * 256 + part * 32;
            float a = 0.f;
#pragma unroll
            for (int c = 0; c < 32; c += 8) {
                const u32x4 w = *(const u32x4*)(wrow + c);
                const f32x4 o0 = *(const f32x4*)(ol + part * 32 + c), o1 = *(const f32x4*)(ol + part * 32 + c + 4);
                a += o0[0] * bflo(w[0]) + o0[1] * bfhi(w[0]) + o0[2] * bflo(w[1]) + o0[3] * bfhi(w[1]) + o1[0] * bflo(w[2]) + o1[1] * bfhi(w[2]) + o1[2] * bflo(w[3]) + o1[3] * bfhi(w[3]);
            }
            red[part * 64 + d] = a;
        }
        __syncthreads();
        if (tid < 64) {
            float a = 0.f;
#pragma unroll
            for (int q = 0; q < 8; ++q) a += red[q * 64 + tid];
            const float ga = bf2f(p.PBUF[(size_t)(R_PROMPT + b) * IN_COLS_PAD + C_GA + h * 64 + tid]);
            p.AMA[(size_t)(NQ + b) * 512 + h * 64 + tid] = f2bf(a * ga);
        }
        __syncthreads();
    }
}

__device__ __forceinline__ void merge_m_gemm(const Params& p, char* lds) {
    const int bx = blockIdx.x, vcu = (bx & 7) * 32 + (bx >> 3);
    OneTileOrder S{vcu, 1};
    {
        pg8::Gemm g{p.AMA, p.WOA_T, NQ, 1024, 512, p.AMA, p.WOA_T};
        EpiMerge<0> E{p.PBUF, p.TMP, p.MM};
        pg8::gemm_phase<EpiMerge<0>, OneTileOrder, false, true>((PG8_LAS unsigned char*)lds, g, S, E);
    }
    {
        pg8::Gemm g{p.AMB, p.WOB_T, NQ, 1024, 512, p.AMB, p.WOB_T};
        EpiMerge<1> E{p.PBUF, p.TMP, p.MM};
        pg8::gemm_phase<EpiMerge<1>, OneTileOrder, false, true>((PG8_LAS unsigned char*)lds, g, S, E);
    }
}


__device__ __forceinline__ float dot_bf16_row(const bf16_t* a, const bf16_t* w, int K) {
    float s = 0.f;
    for (int k = 0; k < K; k += 8) {
        const u32x4 x = *(const u32x4*)(a + k), y = *(const u32x4*)(w + k);
#pragma unroll
        for (int e = 0; e < 4; ++e) s += bflo(x[e]) * bflo(y[e]) + bfhi(x[e]) * bfhi(y[e]);
    }
    return s;
}
__device__ __forceinline__ void rows32_tile(f32x4 (&acc)[2], const bf16_t* __restrict__ X, int ldx, const bf16_t* __restrict__ W, int K, int nt) {
    const int lane = threadIdx.x & 63, lr = lane & 15, lg = lane >> 4;
    const bf16_t* x0 = X + (size_t)lr * ldx + lg * 8;
    const bf16_t* x1 = X + (size_t)(16 + lr) * ldx + lg * 8;
    const bf16_t* w = W + (size_t)(nt * 16 + lr) * K + lg * 8;
#pragma unroll 8
    for (int ks = 0; ks < (K >> 5); ++ks) {
        const bf16x8 wf = *(const bf16x8*)(w + ks * 32);
        acc[0] = mfma16(wf, *(const bf16x8*)(x0 + ks * 32), acc[0]);
        acc[1] = mfma16(wf, *(const bf16x8*)(x1 + ks * 32), acc[1]);
    }
}
__device__ __forceinline__ void sample_m(const Params& p) {
    const int lane = threadIdx.x & 63, lr = lane & 15, lg = lane >> 4;
    for (int nt = blockIdx.x * 8 + (threadIdx.x >> 6); nt < 64; nt += gridDim.x * 8) {
        f32x4 ya[2] = {{0.f, 0.f, 0.f, 0.f}, {0.f, 0.f, 0.f, 0.f}}, yb[2] = {{0.f, 0.f, 0.f, 0.f}, {0.f, 0.f, 0.f, 0.f}};
        rows32_tile(ya, p.AMA + (size_t)NQ * 512, 512, p.WOA_T, 512, nt);
        rows32_tile(yb, p.AMB + (size_t)NQ * 512, 512, p.WOB_T, 512, nt);
#pragma unroll
        for (int mt = 0; mt < 2; ++mt) {
            const int i = 16 * mt + lr, n = 16 * nt + 4 * lg;
            const size_t r = R_PROMPT + i;
            const u32x2 ga = *(const u32x2*)(p.PBUF + r * IN_COLS_PAD + C_MA + n);
            const u32x2 gb = *(const u32x2*)(p.PBUF + r * IN_COLS_PAD + C_MB + n);
            u32x2 w;
            w[0] = cvtpk(bflo(ga[0]) * ya[mt][0] + bflo(gb[0]) * yb[mt][0], bfhi(ga[0]) * ya[mt][1] + bfhi(gb[0]) * yb[mt][1]);
            w[1] = cvtpk(bflo(ga[1]) * ya[mt][2] + bflo(gb[1]) * yb[mt][2], bfhi(ga[1]) * ya[mt][3] + bfhi(gb[1]) * yb[mt][3]);
            *(u32x2*)(p.MM + (size_t)(NQ + i) * 1024 + n) = w;
        }
    }
}
__device__ __forceinline__ void final_gemm(const Params& p, char* lds) {
    const int bx = blockIdx.x, vcu = (bx & 7) * 32 + (bx >> 3);
    pg8::Gemm g{p.MM, p.WO_T, NQ, 1024, 1024, p.MM, p.WO_T};
    OneTileOrder S{vcu, 1};
    EpiFinal E{p.x_prompt, p.out + OFF_Y_P};
    pg8::gemm_phase<EpiFinal, OneTileOrder, false, true>((PG8_LAS unsigned char*)lds, g, S, E);
}


__device__ __forceinline__ void sample_y(const Params& p) {
    const int lane = threadIdx.x & 63, lr = lane & 15, lg = lane >> 4;
    for (int nt = blockIdx.x * 8 + (threadIdx.x >> 6); nt < 64; nt += gridDim.x * 8) {
        f32x4 y[2] = {{0.f, 0.f, 0.f, 0.f}, {0.f, 0.f, 0.f, 0.f}};
        rows32_tile(y, p.MM + (size_t)NQ * 1024, 1024, p.WO_T, 1024, nt);
#pragma unroll
        for (int mt = 0; mt < 2; ++mt) {
            const int i = 16 * mt + lr, n = 16 * nt + 4 * lg;
            const f32x4 x = *(const f32x4*)(p.x_sample + (size_t)i * 1024 + n);
            *(f32x4*)(p.out + OFF_Y_S + (size_t)i * 1024 + n) = x + y[mt];
        }
    }
}

__device__ __forceinline__ void phase4(const Params& p, char* lds) {
    sample_combine(p, lds);
    attn_phase(p, lds);
    hgrn_passC(p, lds);
}
__device__ __forceinline__ void phase5(const Params& p, char* lds) {
    sample_m(p);
    merge_m_gemm(p, lds);
}
__device__ __forceinline__ void phase6(const Params& p, char* lds) {
    sample_y(p);
    final_gemm(p, lds);
}

#define XB_TMO      128
#define XB_XCNT(j)  (256  + 64 * (j))
#define XB_XSUB(j)  (1280 + 64 * (j))
#define XB_XGEN(j)  (2304 + 64 * (j))
#define XB_TOP      3328
#define XB_TOPGEN   3392
#define XCD_BAR_WORDS 3456
#define XB_SPIN_CAP (1u << 22)
#define LAS __attribute__((address_space(3)))
__device__ __forceinline__ unsigned xb_ld(unsigned* p)              { return __hip_atomic_load(p, __ATOMIC_RELAXED, __HIP_MEMORY_SCOPE_AGENT); }
__device__ __forceinline__ unsigned xb_add(unsigned* p, unsigned v) { return __hip_atomic_fetch_add(p, v, __ATOMIC_RELAXED, __HIP_MEMORY_SCOPE_AGENT); }
__device__ __forceinline__ unsigned xb_xcc_id() { return (unsigned)__builtin_amdgcn_s_getreg((3 << 11) | 20) & 0xFu; }
#define XB_SPIN(cond, bar) do { unsigned _sp = 0; while (cond) { __builtin_amdgcn_s_sleep(1); \
    if ((++_sp & 255u) == 0u) { if (xb_ld(&(bar)[XB_TMO])) break; if (_sp > XB_SPIN_CAP) { atomicAdd(&(bar)[XB_TMO], 1u); break; } } } } while (0)
struct XcdBarrier { unsigned* bar; unsigned x; volatile LAS unsigned* st; };
__device__ __forceinline__ XcdBarrier xcd_barrier_post(unsigned* bar, volatile LAS unsigned* st) {
    XcdBarrier b; b.bar = bar; b.x = xb_xcc_id(); b.st = st;
    if (threadIdx.x == 0) (void)xb_add(&bar[XB_XCNT(b.x)], 1u);
    return b;
}
__device__ __forceinline__ void xcd_barrier_complete(unsigned* bar, unsigned x, unsigned& nloc, unsigned& nx) {
    const unsigned G = gridDim.x * gridDim.y * gridDim.z;
    unsigned sum, cnt, mine, sp = 0u;
    for (;;) {
        sum = 0u; cnt = 0u; mine = 0u;
#pragma unroll
        for (unsigned j = 0; j < 16; ++j) { const unsigned c = xb_ld(&bar[XB_XCNT(j)]); sum += c; cnt += (c > 0u) ? 1u : 0u; mine = (j == x) ? c : mine; }
        if (sum == G) break;
        __builtin_amdgcn_s_sleep(1);
        if ((++sp & 255u) == 0u) { if (xb_ld(&bar[XB_TMO])) break; if (sp > XB_SPIN_CAP) { atomicAdd(&bar[XB_TMO], 1u); break; } }
    }
    nloc = mine > 0u ? mine : 1u; nx = cnt > 0u ? cnt : 1u;
}
__device__ __forceinline__ void xcd_barrier(const XcdBarrier& b) {
    asm volatile("s_waitcnt vmcnt(0)" ::: "memory");
    __syncthreads();
    if (threadIdx.x == 0) {
        unsigned* bar = b.bar;
        __builtin_amdgcn_s_waitcnt(0);
        unsigned nloc = b.st[0], nx = b.st[1];
        if (nloc == 0u) { xcd_barrier_complete(bar, b.x, nloc, nx); b.st[0] = nloc; b.st[1] = nx; }
        const unsigned old = xb_add(&bar[XB_XSUB(b.x)], 1u);
        const unsigned gen = old / nloc;
        if (old + 1u == (gen + 1u) * nloc) {
            __builtin_amdgcn_fence(__ATOMIC_RELEASE, "agent");
            asm volatile("s_waitcnt vmcnt(0)" ::: "memory");
            const unsigned og = xb_add(&bar[XB_TOP], 1u);
            const unsigned tg = og / nx;
            if (og + 1u == (tg + 1u) * nx) xb_add(&bar[XB_TOPGEN], 1u);
            else XB_SPIN(xb_ld(&bar[XB_TOPGEN]) == tg, bar);
            __builtin_amdgcn_fence(__ATOMIC_ACQUIRE, "agent");
            xb_add(&bar[XB_XGEN(b.x)], 1u);
            asm volatile("s_waitcnt vmcnt(0)" ::: "memory");
        } else {
            XB_SPIN(xb_ld(&bar[XB_XGEN(b.x)]) == gen, bar);
            __builtin_amdgcn_fence(__ATOMIC_ACQUIRE, "agent");
            asm volatile("s_waitcnt vmcnt(0)" ::: "memory");
        }
    }
    __syncthreads();
}

extern __shared__ __attribute__((aligned(16))) char smem[];
#define NPHASES 7

#define XB_LDS_OFF (LDS_BYTES - 16)
__global__ void __launch_bounds__(NTHREADS) mega(Params p, int ph0, int ph1) {
    XcdBarrier xb;
    const bool multi = (ph1 - ph0) > 1;
    if (multi) {
        if (threadIdx.x == 0) *(u32x4*)(smem + XB_LDS_OFF) = (u32x4){0u, 0u, 0u, 0u};
        __syncthreads();
        xb = xcd_barrier_post(p.bar, (volatile LAS unsigned*)(smem + XB_LDS_OFF));
    }
#if defined(__HIP_DEVICE_COMPILE__)
    typedef const __attribute__((address_space(4))) Params* cparams_t;
    const cparams_t kp = (cparams_t)__builtin_amdgcn_kernarg_segment_ptr();
#define RUN_PHASE(k) if (ph0 <= k && k < ph1) { cparams_t q_ = kp; asm volatile("" : "+s"(q_)); const Params lp_ = *q_; phase##k(lp_, smem); if (k + 1 < ph1) xcd_barrier(xb); }
#else
#define RUN_PHASE(k) if (ph0 <= k && k < ph1) { phase##k(p, smem); if (k + 1 < ph1) xcd_barrier(xb); }
#endif
    RUN_PHASE(0)
    RUN_PHASE(1)
    RUN_PHASE(2)
    RUN_PHASE(3)
    RUN_PHASE(4)
    RUN_PHASE(5)
    RUN_PHASE(6)
}

static inline size_t align_up(size_t x, size_t a) { return (x + a - 1) / a * a; }

extern "C" void kernel_launch(void* const* d_in, const int* in_sizes, int n_in,
                              void* d_out, int out_size, void* d_ws, size_t ws_size,
                              hipStream_t stream) {
    Params p{};
    p.x_prompt = (const float*)d_in[0]; p.x_sample = (const float*)d_in[1]; p.cache_latent = (const float*)d_in[2]; p.cache_krope = (const float*)d_in[3];
    p.state_hgrn = (const float*)d_in[4]; p.page_table = (const int*)d_in[5]; p.meta = (const float*)d_in[6]; p.norm_g = (const float*)d_in[7];
    p.w_in = (const float*)d_in[8]; p.g_cq = (const float*)d_in[9]; p.w_uq = (const float*)d_in[10]; p.g_ckv = (const float*)d_in[11];
    p.w_uk = (const float*)d_in[12]; p.w_uv = (const float*)d_in[13]; p.g_qn = (const float*)d_in[14]; p.g_kn = (const float*)d_in[15];
    p.lb_logits = (const float*)d_in[16]; p.g_bn = (const float*)d_in[17]; p.w_oa = (const float*)d_in[18]; p.w_ob = (const float*)d_in[19]; p.w_o = (const float*)d_in[20];
    p.out = (float*)d_out;
    char* w = (char*)d_ws; size_t off = 0;
    auto take = [&](size_t bytes) { char* r = w + off; off = align_up(off + bytes, 256); return r; };
    p.bar    = (unsigned*)take(16384);
    p.XN     = (bf16_t*)take((size_t)R_PAD * 1024 * 2);
    p.WIN_T  = (bf16_t*)take((size_t)IN_COLS_PAD * 1024 * 2);
    p.PBUF   = (bf16_t*)take((size_t)R_PAD * IN_COLS_PAD * 2);
    p.F32A   = (float*)take((size_t)R_PAD * 672 * 4);
    p.GLOG   = (float*)take((size_t)R_PAD * 512 * 4);
    p.CQN    = (bf16_t*)take((size_t)R_PAD * 384 * 2);
    p.CKVN   = (bf16_t*)take((size_t)R_PAD * 256 * 2);
    p.KRR    = (float*)take((size_t)R_PAD * 32 * 4);
    p.WUQ_T  = (bf16_t*)take((size_t)768 * 384 * 2);
    p.WUKV_T = (bf16_t*)take((size_t)1024 * 256 * 2);
    p.WUKVG_T = (bf16_t*)take((size_t)1024 * 256 * 2);
    p.F32B   = (float*)take((size_t)R_PAD * 288 * 4);
    p.WOA_T  = (bf16_t*)take((size_t)1024 * 512 * 2);
    p.WOB_T  = (bf16_t*)take((size_t)1024 * 512 * 2);
    p.WO_T   = (bf16_t*)take((size_t)1024 * 1024 * 2);
    p.QRAW   = (bf16_t*)take((size_t)R_PAD * 768 * 2);
    p.KVRAW  = (bf16_t*)take((size_t)R_PAD * 1024 * 2);
    p.QA     = (bf16_t*)take((size_t)8 * 8 * 2048 * 96 * 2);
    p.KA     = (bf16_t*)take((size_t)8 * 8 * 2064 * 96 * 2 + 65536);
    p.VTG    = (bf16_t*)take((size_t)64 * 64 * 2112 * 2);
    p.QS     = (float*)take((size_t)32 * 8 * 96 * 4);
    p.KSRAW  = (float*)take((size_t)32 * 8 * 96 * 4);
    p.AMA    = (bf16_t*)take((size_t)MROWS_PAD * 512 * 2);
    p.AMB    = (bf16_t*)take((size_t)MROWS_PAD * 512 * 2);
    p.MM     = (bf16_t*)take((size_t)MROWS_PAD * 1024 * 2);
    p.TMP    = (float*)take((size_t)NQ * 1024 * 4);
    p.UT     = (bf16_t*)take((size_t)32 * NCHUNK * 16384 * 2);
    p.ST     = (bf16_t*)take((size_t)32 * NCHUNK * 16384 * 2);
    p.DEC    = (float*)take((size_t)32 * NCHUNK * 128 * 4);
    p.LB     = (float*)take(512 * 4);
    p.INV    = (float*)take(64);
    p.ROPE   = (float*)take((size_t)2065 * 32 * 4);
    p.SCAL   = (float*)take(64);
    p.PART   = (float*)take((size_t)32 * 8 * 8 * 256 * 4);
    p.PL     = (float*)take((size_t)32 * 8 * 8 * 4);
    p.OLAT   = (float*)take((size_t)32 * 8 * 256 * 4);
    (void)ws_size; (void)in_sizes; (void)n_in; (void)out_size;
    static int mode = -1;
    if (mode < 0) {
        (void)hipFuncSetAttribute((const void*)mega, hipFuncAttributeMaxDynamicSharedMemorySize, LDS_BYTES);
        int dev = 0, cus = 0, per_cu = 0;
        (void)hipGetDevice(&dev);
        (void)hipDeviceGetAttribute(&cus, hipDeviceAttributeMultiprocessorCount, dev);
        (void)hipOccupancyMaxActiveBlocksPerMultiprocessor(&per_cu, (const void*)mega, NTHREADS, LDS_BYTES);
        mode = (cus * per_cu >= 256) ? 1 : 0;
    }
    (void)hipMemsetAsync(p.bar, 0, 16384, stream);
    if (mode == 1) {
        mega<<<dim3(256), dim3(NTHREADS), LDS_BYTES, stream>>>(p, 0, NPHASES);
    } else {
        for (int ph = 0; ph < NPHASES; ++ph) mega<<<dim3(256), dim3(NTHREADS), LDS_BYTES, stream>>>(p, ph, ph + 1);
    }
}
```

```cpp
#include <hip/hip_runtime.h>
#include <stdint.h>

#define D_MODEL 1024
#define BATCH 8
#define SEQ 2048
#define NMETA 16
#define LTOT 2064
#define DEC_BATCH 32
#define PAST_LEN 16384
#define PAGE 128
#define NPAGES 128
#define A_HEADS 8
#define A_NOPE 64
#define A_ROPE 32
#define A_QK 96
#define A_V 64
#define Q_LORA 384
#define KV_LORA 256
#define B_HEADS 4
#define B_DK 128
#define B_DV 128
#define IN_COLS 5280
#define IN_COLS_PAD 5376
#define EPSF 1e-6f

#define C_CQ 0
#define C_CKV 384
#define C_KR 640
#define C_BQ 672
#define C_BF 1184
#define C_BI 1696
#define C_GA 2208
#define C_GB 2720
#define C_MA 3232
#define C_MB 4256
#define C_END 5280

#define R_PROMPT 16512
#define R_ALL 16544
#define R_PAD 16640
#define NQ 16384
#define MROWS 16416
#define MROWS_PAD 16512

#define OFF_Y_P 0
#define OFF_Y_S 16777216
#define OFF_LAT_P 16809984
#define OFF_KR_P 21037056
#define OFF_HG_P 21565440
#define OFF_LAT_S 22089728
#define OFF_KR_S 22097920
#define OFF_HG_S 22098944
#define OUT_TOTAL 24196096

#define NTHREADS 512
#define LDS_BYTES 155648
#define LDS_ITEM_OFF (LDS_BYTES - 32)
#define NCHUNK 33

typedef unsigned short bf16_t;
typedef short bf16x8 __attribute__((ext_vector_type(8)));
typedef float f32x4 __attribute__((ext_vector_type(4)));
typedef float f32x2 __attribute__((ext_vector_type(2)));
typedef unsigned u32x4 __attribute__((ext_vector_type(4)));
typedef unsigned u32x2 __attribute__((ext_vector_type(2)));
typedef __bf16 bf16x2_t __attribute__((ext_vector_type(2)));

__device__ __forceinline__ unsigned cvtpk(float lo, float hi) {
    f32x2 v = {lo, hi};
    bf16x2_t b = __builtin_convertvector(v, bf16x2_t);
    return __builtin_bit_cast(unsigned, b);
}
__device__ __forceinline__ bf16_t f2bf(float x) { return (bf16_t)(cvtpk(x, 0.f) & 0xffffu); }
__device__ __forceinline__ float bf2f(bf16_t u) { return __uint_as_float(((unsigned)u) << 16); }
__device__ __forceinline__ float bflo(unsigned w) { return __uint_as_float(w << 16); }
__device__ __forceinline__ float bfhi(unsigned w) { return __uint_as_float(w & 0xffff0000u); }
__device__ __forceinline__ float sigmoidf_(float x) { return 1.0f / (1.0f + __expf(-x)); }
__device__ __forceinline__ float siluf_(float x) { return x / (1.0f + __expf(-x)); }
__device__ __forceinline__ float wave_sum(float v) {
    v += __shfl_xor(v, 32); v += __shfl_xor(v, 16); v += __shfl_xor(v, 8);
    v += __shfl_xor(v, 4);  v += __shfl_xor(v, 2);  v += __shfl_xor(v, 1);
    return v;
}

struct Params {
    const float* x_prompt; const float* x_sample; const float* cache_latent; const float* cache_krope;
    const float* state_hgrn; const int* page_table; const float* meta; const float* norm_g;
    const float* w_in; const float* g_cq; const float* w_uq; const float* g_ckv; const float* w_uk; const float* w_uv;
    const float* g_qn; const float* g_kn; const float* lb_logits; const float* g_bn;
    const float* w_oa; const float* w_ob; const float* w_o;
    float* out;
    bf16_t* XN;
    bf16_t* WIN_T;
    bf16_t* PBUF;
    float*  F32A;
    float*  GLOG;
    bf16_t* CQN;
    bf16_t* CKVN;
    float*  KRR;
    bf16_t* WUQ_T;
    bf16_t* WUKV_T;
    bf16_t* WUKVG_T;
    float*  F32B;
    bf16_t* WOA_T;
    bf16_t* WOB_T;
    bf16_t* WO_T;
    bf16_t* QRAW;
    bf16_t* KVRAW;
    bf16_t* QA;
    bf16_t* KA;
    bf16_t* VTG;
    float*  QS;
    float*  KSRAW;
    bf16_t* AMA;
    bf16_t* AMB;
    bf16_t* MM;
    float*  TMP;
    bf16_t* UT;
    bf16_t* ST;
    float*  DEC;
    float*  LB;
    float*  INV;
    float*  ROPE;
    float*  SCAL;
    float*  PART;
    float*  PL;
    float*  OLAT;
    unsigned* bar;
};

__device__ __forceinline__ f32x4 mfma16(bf16x8 w, bf16x8 x, f32x4 acc) {
    return __builtin_amdgcn_mfma_f32_16x16x32_bf16(w, x, acc, 0, 0, 0);
}

#define GT_LD 144
#define GT_BUF (128 * GT_LD)
#define GT_LDS_BYTES (4 * GT_BUF)

__device__ __forceinline__ void gemm_tile_accum(f32x4 (&acc)[4][2], const bf16_t* __restrict__ X, int ldx, const bf16_t* __restrict__ W, int ldw,
                                                int K, char* lds) {
    const int tid = threadIdx.x, lane = tid & 63, wid = tid >> 6, wm = wid >> 2, wn = wid & 3;
    const int lr = lane & 15, lg = lane >> 4;
    const int r0 = tid >> 3, kc = tid & 7;
    const bf16_t* xp0 = X + (size_t)r0 * ldx + kc * 8;
    const bf16_t* xp1 = X + (size_t)(r0 + 64) * ldx + kc * 8;
    const bf16_t* wp0 = W + (size_t)r0 * ldw + kc * 8;
    const bf16_t* wp1 = W + (size_t)(r0 + 64) * ldw + kc * 8;
    const int so0 = r0 * GT_LD + kc * 16, so1 = (r0 + 64) * GT_LD + kc * 16;
    char* Xs = lds; char* Ws = lds + 2 * GT_BUF;
    const int nk = K >> 6;
    u32x4 a0 = *(const u32x4*)xp0, a1 = *(const u32x4*)xp1, b0 = *(const u32x4*)wp0, b1 = *(const u32x4*)wp1;
    *(u32x4*)(Xs + so0) = a0; *(u32x4*)(Xs + so1) = a1; *(u32x4*)(Ws + so0) = b0; *(u32x4*)(Ws + so1) = b1;
    __syncthreads();
    const int xoff = (wm * 64 + lr) * GT_LD + lg * 16;
    const int woff = (wn * 32 + lr) * GT_LD + lg * 16;
    for (int kt = 0; kt < nk; ++kt) {
        const int cur = kt & 1;
        if (kt + 1 < nk) {
            const int ko = (kt + 1) * 64;
            a0 = *(const u32x4*)(xp0 + ko); a1 = *(const u32x4*)(xp1 + ko); b0 = *(const u32x4*)(wp0 + ko); b1 = *(const u32x4*)(wp1 + ko);
        }
        const char* xs = Xs + cur * GT_BUF + xoff;
        const char* ws = Ws + cur * GT_BUF + woff;
#pragma unroll
        for (int ks = 0; ks < 2; ++ks) {
            bf16x8 xf[4], wf[2];
#pragma unroll
            for (int mt = 0; mt < 4; ++mt) xf[mt] = *(const bf16x8*)(xs + mt * 16 * GT_LD + ks * 64);
#pragma unroll
            for (int nt = 0; nt < 2; ++nt) wf[nt] = *(const bf16x8*)(ws + nt * 16 * GT_LD + ks * 64);
#pragma unroll
            for (int mt = 0; mt < 4; ++mt)
#pragma unroll
                for (int nt = 0; nt < 2; ++nt) acc[mt][nt] = mfma16(wf[nt], xf[mt], acc[mt][nt]);
        }
        if (kt + 1 < nk) {
            char* xd = Xs + (cur ^ 1) * GT_BUF; char* wd = Ws + (cur ^ 1) * GT_BUF;
            *(u32x4*)(xd + so0) = a0; *(u32x4*)(xd + so1) = a1; *(u32x4*)(wd + so0) = b0; *(u32x4*)(wd + so1) = b1;
        }
        __syncthreads();
    }
}

namespace pg8 {
#define PG8_LAS __attribute__((address_space(3)))
constexpr int BM = 256, BK = 64, HALF = 128, HTB = HALF * BK * 2  , STAGE_BYTES = 8 * HTB, NXCD = 8, WGM = 8;

__host__ __device__ __forceinline__ int lds_byte(int r, int c) { const int st = (r >> 4) * 2 + (c >> 5), rr = r & 15, cc = c & 31, ob = rr * 64 + cc * 2; return st * 1024 + (ob ^ (((ob >> 9) & 1) << 5)); }
__host__ __device__ __forceinline__ void stage_rc(int b, int& R, int& C) { const int st = b / 1024, sb = b % 1024, swz = sb ^ (((sb >> 9) & 1) << 5); R = (st >> 1) * 16 + swz / 64; C = (st & 1) * 32 + (swz % 64) / 2; }
__host__ __device__ __forceinline__ int perm32(int rho) { const int n = rho >> 4, i = rho & 15; return 8 * (i >> 2) + 4 * n + (i & 3); }

struct Unit { int pm, pn, sel; };
struct Gemm { const bf16_t* A; const bf16_t* Bt; int M, N, K; const bf16_t* A1; const bf16_t* Bt1; };

struct StaticOrder {
    int nM, nN, nwg, G, c;
    __host__ __device__ void init(int M, int N, int G_, int c_) { nM = M / BM; nN = N / BM; nwg = nM * nN; G = G_; c = c_; }
    __host__ __device__ bool next(int i, Unit& u) const {
        const long L = (long)i * G + c; if (L >= nwg) return false;
        int wgid = (int)L; { const int q = nwg / NXCD, r = nwg % NXCD, xcd = wgid % NXCD, off = wgid / NXCD; wgid = (xcd < r ? xcd * (q + 1) : r * (q + 1) + (xcd - r) * q) + off; }
        const int nig = WGM * nN, gid = wgid / nig, fm = gid * WGM, gsz = (nM - fm) < WGM ? (nM - fm) : WGM;
        u.pm = fm + ((wgid % nig) % gsz); u.pn = (wgid % nig) / gsz; u.sel = 0; return true;
    }
    __device__ __forceinline__ void a_ready(const Unit&) const {}
    __device__ __forceinline__ void done(const Unit&) const {}
};


template <class Epi, class Sched, bool ALIGN_EPI = false, bool SP2 = false>
__device__ __forceinline__ void gemm_phase(PG8_LAS unsigned char* lds, const Gemm g, const Sched& S, const Epi& E) {
    const int tid = threadIdx.x, wid = __builtin_amdgcn_readfirstlane(tid >> 6), lane = tid & 63, wr = wid >> 2, wc = wid & 3, fr = lane & 15, fq = lane >> 4;
    const int K = g.K, nt = K / BK;
    unsigned voffA[2], voffB[2];
#pragma unroll
    for (int i = 0; i < 2; ++i) { int R, C; stage_rc(tid * 16 + i * 8192, R, C); const int Rb = Epi::PERM ? ((R & ~31) + perm32(R & 31)) : R;
        voffA[i] = (unsigned)(R * K + C) * 2u; voffB[i] = (unsigned)(Rb * K + C) * 2u; }
    const size_t kstep = (size_t)(BK * 2);
    const size_t hstep = (size_t)HALF * K * 2;
    const size_t tstep = 2 * hstep;
    const unsigned ldsw = (unsigned)wid * 1024u;
    const int aoff = lds_byte(wr * 64 + fr, fq * 8), boff = lds_byte(wc * 32 + fr, fq * 8);
#define PG8_SA(b, h) (((b) * 2 + (h)) * HTB)
#define PG8_SB(b, h) ((4 + (b) * 2 + (h)) * HTB)
#define PG8_STAGE(bufoff, gbase, voff) do { _Pragma("unroll") for (int _i = 0; _i < 2; ++_i) \
        __builtin_amdgcn_global_load_lds((const unsigned*)((const char*)(gbase) + (voff)[_i]), (PG8_LAS unsigned*)(lds + (bufoff) + ldsw + _i * 8192), 16, 0, 0); } while (0)
#define PG8_LDA(dst, b, h) do { _Pragma("unroll") for (int m = 0; m < 4; ++m) _Pragma("unroll") for (int k = 0; k < 2; ++k) dst[m][k] = *(const PG8_LAS bf16x8*)(lds + PG8_SA(b, h) + aoff + m * 2048 + k * 1024); } while (0)
#define PG8_LDB(dst, b, h) do { _Pragma("unroll") for (int n = 0; n < 2; ++n) _Pragma("unroll") for (int k = 0; k < 2; ++k) dst[n][k] = *(const PG8_LAS bf16x8*)(lds + PG8_SB(b, h) + boff + n * 2048 + k * 1024); } while (0)
#define PG8_MMA(ai, bj, At, Bt) do { __builtin_amdgcn_s_setprio(1); _Pragma("unroll") for (int m = 0; m < 4; ++m) _Pragma("unroll") for (int n = 0; n < 2; ++n) _Pragma("unroll") for (int k = 0; k < 2; ++k) \
        acc[ai][bj][m][n] = __builtin_amdgcn_mfma_f32_16x16x32_bf16(Bt[n][k], At[m][k], acc[ai][bj][m][n], 0, 0, 0); __builtin_amdgcn_s_setprio(0); } while (0)
#define PG8_WAIT_V(n) asm volatile("s_waitcnt vmcnt(" #n ")" ::: "memory")
#define PG8_WAIT_L(n) asm volatile("s_waitcnt lgkmcnt(" #n ")" ::: "memory")
#define PG8_BAR __builtin_amdgcn_s_barrier()
#define PG8_SCHED __builtin_amdgcn_sched_barrier(0)
    Unit cur, nxt; int ui = 0;
    if (!S.next(0, cur)) return;
    f32x4 acc[2][2][4][2];
#pragma unroll
    for (int a = 0; a < 2; ++a)
#pragma unroll
        for (int b = 0; b < 2; ++b)
#pragma unroll
            for (int m = 0; m < 4; ++m)
#pragma unroll
                for (int n = 0; n < 2; ++n) acc[a][b][m][n] = (f32x4){0.f, 0.f, 0.f, 0.f};
    bf16x8 At[4][2], B0[2][2], B1[2][2];
    const char* cA = (const char*)(cur.sel ? g.A1 : g.A) + (size_t)cur.pm * tstep; const char* cB = (const char*)(cur.sel ? g.Bt1 : g.Bt) + (size_t)cur.pn * tstep;
    S.a_ready(cur);
    if constexpr (SP2) {
        PG8_STAGE(PG8_SB(0, 0), cB, voffB); PG8_STAGE(PG8_SB(0, 1), cB + hstep, voffB); PG8_STAGE(PG8_SA(0, 0), cA, voffA); PG8_STAGE(PG8_SA(0, 1), cA + hstep, voffA);
        if (wr == 1) PG8_BAR;
        PG8_WAIT_V(2); PG8_BAR;
        PG8_STAGE(PG8_SB(1, 0), cB + kstep, voffB); PG8_STAGE(PG8_SA(1, 0), cA + kstep, voffA); PG8_STAGE(PG8_SB(1, 1), cB + hstep + kstep, voffB);
        PG8_WAIT_V(6); PG8_BAR;
    } else {
        PG8_STAGE(PG8_SB(0, 0), cB, voffB); PG8_STAGE(PG8_SA(0, 0), cA, voffA); PG8_STAGE(PG8_SB(0, 1), cB + hstep, voffB); PG8_STAGE(PG8_SA(0, 1), cA + hstep, voffA);
        if (wr == 1) PG8_BAR;
        PG8_WAIT_V(4); PG8_BAR;
        PG8_STAGE(PG8_SB(1, 0), cB + kstep, voffB); PG8_STAGE(PG8_SA(1, 0), cA + kstep, voffA); PG8_STAGE(PG8_SB(1, 1), cB + hstep + kstep, voffB);
        PG8_WAIT_V(6); PG8_BAR;
    }
    for (;;) {
        const bool has_next = S.next(ui + 1, nxt);
        const char* nA = has_next ? (const char*)(nxt.sel ? g.A1 : g.A) + (size_t)nxt.pm * tstep : cA; const char* nB = has_next ? (const char*)(nxt.sel ? g.Bt1 : g.Bt) + (size_t)nxt.pn * tstep : cB;
        for (int t = 0; t < nt; t += 2) {
            const bool last = (t == nt - 2);
            const char* a1 = cA + (size_t)(t + 1) * kstep;
            const char* a2 = last ? nA : cA + (size_t)(t + 2) * kstep; const char* b2 = last ? nB : cB + (size_t)(t + 2) * kstep;
            const char* a3 = a2 + kstep; const char* b3 = b2 + kstep;
            if (last && has_next) S.a_ready(nxt);
            if constexpr (SP2) {
            PG8_LDB(B0, 0, 0); PG8_LDB(B1, 0, 1); PG8_SCHED; PG8_LDA(At, 0, 0); PG8_STAGE(PG8_SA(1, 1), a1 + hstep, voffA);
            PG8_WAIT_V(8); PG8_WAIT_L(0); PG8_BAR; PG8_MMA(0, 0, At, B0); PG8_MMA(0, 1, At, B1); PG8_BAR; PG8_SCHED;
            PG8_LDA(At, 0, 1); PG8_STAGE(PG8_SB(0, 0), b2, voffB); PG8_STAGE(PG8_SB(0, 1), b2 + hstep, voffB); PG8_STAGE(PG8_SA(0, 0), a2, voffA);
            PG8_WAIT_V(8); PG8_WAIT_L(0); PG8_BAR; PG8_MMA(1, 0, At, B0); PG8_MMA(1, 1, At, B1); PG8_BAR; PG8_SCHED;
            PG8_LDB(B0, 1, 0); PG8_LDB(B1, 1, 1); PG8_SCHED; PG8_LDA(At, 1, 0); PG8_STAGE(PG8_SA(0, 1), a2 + hstep, voffA);
            PG8_WAIT_V(8); PG8_WAIT_L(0); PG8_BAR; PG8_MMA(0, 0, At, B0); PG8_MMA(0, 1, At, B1); PG8_BAR; PG8_SCHED;
            PG8_LDA(At, 1, 1); PG8_STAGE(PG8_SB(1, 0), b3, voffB); PG8_STAGE(PG8_SB(1, 1), b3 + hstep, voffB); PG8_STAGE(PG8_SA(1, 0), a3, voffA);
            PG8_WAIT_V(8); PG8_WAIT_L(0); PG8_BAR; PG8_MMA(1, 0, At, B0); PG8_MMA(1, 1, At, B1); PG8_BAR; PG8_SCHED;
            } else {
            PG8_LDB(B0, 0, 0); PG8_SCHED; PG8_LDA(At, 0, 0); PG8_STAGE(PG8_SA(1, 1), a1 + hstep, voffA);
            PG8_WAIT_L(8); PG8_BAR; PG8_WAIT_L(0); PG8_MMA(0, 0, At, B0); PG8_BAR; PG8_SCHED;
            PG8_LDB(B1, 0, 1); PG8_STAGE(PG8_SB(0, 0), b2, voffB);
            PG8_BAR; PG8_WAIT_L(0); PG8_MMA(0, 1, At, B1); PG8_BAR;
            PG8_LDA(At, 0, 1); PG8_STAGE(PG8_SA(0, 0), a2, voffA);
            PG8_BAR; PG8_WAIT_L(0); PG8_MMA(1, 0, At, B0); PG8_BAR; PG8_SCHED;
            PG8_STAGE(PG8_SB(0, 1), b2 + hstep, voffB);
            PG8_WAIT_V(6); PG8_BAR; PG8_MMA(1, 1, At, B1); PG8_BAR;
            PG8_LDB(B0, 1, 0); PG8_SCHED; PG8_LDA(At, 1, 0); PG8_STAGE(PG8_SA(0, 1), a2 + hstep, voffA);
            PG8_WAIT_L(8); PG8_BAR; PG8_WAIT_L(0); PG8_MMA(0, 0, At, B0); PG8_BAR; PG8_SCHED;
            PG8_LDB(B1, 1, 1); PG8_STAGE(PG8_SB(1, 0), b3, voffB);
            PG8_BAR; PG8_WAIT_L(0); PG8_MMA(0, 1, At, B1); PG8_BAR;
            PG8_LDA(At, 1, 1); PG8_STAGE(PG8_SA(1, 0), a3, voffA);
            PG8_BAR; PG8_WAIT_L(0); PG8_MMA(1, 0, At, B0); PG8_BAR; PG8_SCHED;
            PG8_STAGE(PG8_SB(1, 1), b3 + hstep, voffB);
            PG8_WAIT_V(6); PG8_BAR; PG8_MMA(1, 1, At, B1); PG8_BAR;
            }
        }
        if constexpr (ALIGN_EPI) { if (wr == 0) PG8_BAR; }
        if constexpr (!Epi::AFTER_DRAIN) { E(acc, cur, wr, wc, fr, fq); S.done(cur); }
        if (!has_next) break;
        if (!Epi::keep(cur)) {
#pragma unroll
        for (int a = 0; a < 2; ++a)
#pragma unroll
            for (int b = 0; b < 2; ++b)
#pragma unroll
                for (int m = 0; m < 4; ++m)
#pragma unroll
                    for (int n = 0; n < 2; ++n) acc[a][b][m][n] = (f32x4){0.f, 0.f, 0.f, 0.f};
        }
        cur = nxt; cA = nA; cB = nB; ++ui;
        if constexpr (ALIGN_EPI) { if (wr == 1) PG8_BAR; }
    }
    PG8_WAIT_V(0);
    if constexpr (!ALIGN_EPI) { if (wr == 0) PG8_BAR; }
    PG8_BAR;
    if constexpr (Epi::AFTER_DRAIN) { E.fused(acc, cur, wr, wc, fr, fq, lds, wid, lane); S.done(cur); }
#undef PG8_SA
#undef PG8_SB
#undef PG8_STAGE
#undef PG8_LDA
#undef PG8_LDB
#undef PG8_MMA
#undef PG8_WAIT_V
#undef PG8_WAIT_L
#undef PG8_BAR
#undef PG8_SCHED
}
}

struct EpiInProj {
    static constexpr bool PERM = true, AFTER_DRAIN = false;
    static __device__ __forceinline__ bool keep(const pg8::Unit&) { return false; }
    float* F32B; float* GLOG; bf16_t* PBUF; const float* LB; bf16_t* CQN; bf16_t* CKVN;
    __device__ __forceinline__ void operator()(f32x4 (&acc)[2][2][4][2], const pg8::Unit& u, int wr, int wc, int fr, int fq) const {
#pragma unroll
        for (int bj = 0; bj < 2; ++bj) {
            const int nseg = u.pn * 256 + bj * 128 + wc * 32;
            if (nseg >= C_END) continue;
            const int c = nseg + 8 * fq;
#pragma unroll
            for (int ai = 0; ai < 2; ++ai)
#pragma unroll
                for (int m = 0; m < 4; ++m) {
                    const size_t r = (size_t)u.pm * 256 + ai * 128 + wr * 64 + m * 16 + fr;
                    const f32x4 v0 = acc[ai][bj][m][0], v1 = acc[ai][bj][m][1];
                    if (nseg < C_BQ) {
                        if (nseg >= C_CKV) { *(f32x4*)(F32B + r * 288 + (c - C_CKV)) = v0; *(f32x4*)(F32B + r * 288 + (c - C_CKV) + 4) = v1; }
                        if (nseg < C_KR) {
                            u32x4 w; w[0] = cvtpk(v0[0], v0[1]); w[1] = cvtpk(v0[2], v0[3]); w[2] = cvtpk(v1[0], v1[1]); w[3] = cvtpk(v1[2], v1[3]);
                            if (nseg < C_CKV) *(u32x4*)(CQN + r * 384 + c) = w; else *(u32x4*)(CKVN + r * 256 + (c - C_CKV)) = w;
                        }
                        continue;
                    }
                    f32x4 o0, o1;
                    if (nseg < C_BF) {
#pragma unroll
                        for (int e = 0; e < 4; ++e) { o0[e] = siluf_(v0[e]); o1[e] = siluf_(v1[e]); }
                    } else if (nseg < C_BI) {
                        const f32x4 lb0 = *(const f32x4*)(LB + (c - C_BF)), lb1 = *(const f32x4*)(LB + (c - C_BF) + 4);
                        f32x4 l0, l1;
#pragma unroll
                        for (int e = 0; e < 4; ++e) {
                            const float sg0 = 1.0f / (1.0f + expf(-v0[e])), sg1 = 1.0f / (1.0f + expf(-v1[e]));
                            l0[e] = logf(lb0[e] + (1.0f - lb0[e]) * sg0); l1[e] = logf(lb1[e] + (1.0f - lb1[e]) * sg1);
                            o0[e] = (1.0f - lb0[e]) * (1.0f - sg0); o1[e] = (1.0f - lb1[e]) * (1.0f - sg1);
                        }
                        *(f32x4*)(GLOG + r * 512 + (c - C_BF)) = l0; *(f32x4*)(GLOG + r * 512 + (c - C_BF) + 4) = l1;
                    } else if (nseg < C_GA) {
                        o0 = v0; o1 = v1;
                    } else if (nseg < C_MA) {
#pragma unroll
                        for (int e = 0; e < 4; ++e) { o0[e] = siluf_(v0[e]); o1[e] = siluf_(v1[e]); }
                    } else {
#pragma unroll
                        for (int e = 0; e < 4; ++e) { o0[e] = sigmoidf_(v0[e]); o1[e] = sigmoidf_(v1[e]); }
                    }
                    u32x4 w; w[0] = cvtpk(o0[0], o0[1]); w[1] = cvtpk(o0[2], o0[3]); w[2] = cvtpk(o1[0], o1[1]); w[3] = cvtpk(o1[2], o1[3]);
                    *(u32x4*)(PBUF + r * IN_COLS_PAD + c) = w;
                    asm volatile("" ::: "memory");
                }
        }
    }
};
template <int STAGE> struct EpiMerge {
    static constexpr bool PERM = true, AFTER_DRAIN = false;
    static __device__ __forceinline__ bool keep(const pg8::Unit&) { return false; }
    const bf16_t* PBUF; float* TMP; bf16_t* MM;
    __device__ __forceinline__ void operator()(f32x4 (&acc)[2][2][4][2], const pg8::Unit& u, int wr, int wc, int fr, int fq) const {
#pragma unroll
        for (int ai = 0; ai < 2; ++ai)
#pragma unroll
            for (int m = 0; m < 4; ++m) {
                const int mq = u.pm * 256 + ai * 128 + wr * 64 + m * 16 + fr;
                const size_t r = (size_t)(mq >> 11) * LTOT + NMETA + (mq & 2047);
#pragma unroll
                for (int bj = 0; bj < 2; ++bj) {
                    const int c = u.pn * 256 + bj * 128 + wc * 32 + 8 * fq;
                    const u32x4 g = *(const u32x4*)(PBUF + r * IN_COLS_PAD + (STAGE == 0 ? C_MA : C_MB) + c);
                    const f32x4 v0 = acc[ai][bj][m][0], v1 = acc[ai][bj][m][1];
                    f32x4 o0, o1;
                    o0[0] = v0[0] * bflo(g[0]); o0[1] = v0[1] * bfhi(g[0]); o0[2] = v0[2] * bflo(g[1]); o0[3] = v0[3] * bfhi(g[1]);
                    o1[0] = v1[0] * bflo(g[2]); o1[1] = v1[1] * bfhi(g[2]); o1[2] = v1[2] * bflo(g[3]); o1[3] = v1[3] * bfhi(g[3]);
                    if (STAGE == 0) {
                        u32x4 w; w[0] = cvtpk(o0[0], o0[1]); w[1] = cvtpk(o0[2], o0[3]); w[2] = cvtpk(o1[0], o1[1]); w[3] = cvtpk(o1[2], o1[3]);
                        *(u32x4*)(MM + (size_t)mq * 1024 + c) = w;
                    }
                    else {
                        const u32x4 tw = *(const u32x4*)(MM + (size_t)mq * 1024 + c);
                        f32x4 t0, t1;
                        t0[0] = bflo(tw[0]); t0[1] = bfhi(tw[0]); t0[2] = bflo(tw[1]); t0[3] = bfhi(tw[1]);
                        t1[0] = bflo(tw[2]); t1[1] = bfhi(tw[2]); t1[2] = bflo(tw[3]); t1[3] = bfhi(tw[3]);
                        u32x4 w; w[0] = cvtpk(o0[0] + t0[0], o0[1] + t0[1]); w[1] = cvtpk(o0[2] + t0[2], o0[3] + t0[3]);
                        w[2] = cvtpk(o1[0] + t1[0], o1[1] + t1[1]); w[3] = cvtpk(o1[2] + t1[2], o1[3] + t1[3]);
                        *(u32x4*)(MM + (size_t)mq * 1024 + c) = w;
                    }
                }
                asm volatile("" ::: "memory");
            }
    }
};
struct EpiFinal {
    static constexpr bool PERM = true, AFTER_DRAIN = false;
    static __device__ __forceinline__ bool keep(const pg8::Unit&) { return false; }
    const float* X; float* Y;
    __device__ __forceinline__ void operator()(f32x4 (&acc)[2][2][4][2], const pg8::Unit& u, int wr, int wc, int fr, int fq) const {
#pragma unroll
        for (int ai = 0; ai < 2; ++ai)
#pragma unroll
            for (int m = 0; m < 4; ++m) {
                const size_t mq = (size_t)u.pm * 256 + ai * 128 + wr * 64 + m * 16 + fr;
#pragma unroll
                for (int bj = 0; bj < 2; ++bj) {
                    const int c = u.pn * 256 + bj * 128 + wc * 32 + 8 * fq;
                    const f32x4 x0 = __builtin_nontemporal_load((const f32x4*)(X + mq * 1024 + c)), x1 = __builtin_nontemporal_load((const f32x4*)(X + mq * 1024 + c + 4));
                    __builtin_nontemporal_store(x0 + acc[ai][bj][m][0], (f32x4*)(Y + mq * 1024 + c));
                    __builtin_nontemporal_store(x1 + acc[ai][bj][m][1], (f32x4*)(Y + mq * 1024 + c + 4));
                }
            }
    }
};
struct OneTileOrder {
    int tile, nsel;
    __device__ __forceinline__ bool next(int i, pg8::Unit& u) const { if (i >= nsel) return false; u.pm = tile >> 2; u.pn = tile & 3; u.sel = i; return true; }
    __device__ __forceinline__ void a_ready(const pg8::Unit&) const {}
    __device__ __forceinline__ void done(const pg8::Unit&) const {}
};

__device__ __forceinline__ void transpose_tile(const float* __restrict__ src, int src_ld, int nvalid, int k0, int n0,
                                               bf16_t* __restrict__ dst, int dst_ld, float* tile  , const float* __restrict__ kscale, bool fragmajor = false) {
    const int tid = threadIdx.x;
#pragma unroll
    for (int i = 0; i < 2; ++i) {
        const int kk = (tid >> 4) + 32 * i, nn = (tid & 15) * 4;
        f32x4 v = {0.f, 0.f, 0.f, 0.f};
        if (n0 + nn < nvalid) v = *(const f32x4*)(src + (size_t)(k0 + kk) * src_ld + n0 + nn);
        if (kscale) v = v * kscale[k0 + kk];
        tile[kk * 65 + nn + 0] = v[0]; tile[kk * 65 + nn + 1] = v[1]; tile[kk * 65 + nn + 2] = v[2]; tile[kk * 65 + nn + 3] = v[3];
    }
    __syncthreads();
    {
        const int n = tid >> 3, kq = (tid & 7) * 8;
        u32x4 w;
        w[0] = cvtpk(tile[(kq + 0) * 65 + n], tile[(kq + 1) * 65 + n]);
        w[1] = cvtpk(tile[(kq + 2) * 65 + n], tile[(kq + 3) * 65 + n]);
        w[2] = cvtpk(tile[(kq + 4) * 65 + n], tile[(kq + 5) * 65 + n]);
        w[3] = cvtpk(tile[(kq + 6) * 65 + n], tile[(kq + 7) * 65 + n]);
        if (!fragmajor) *(u32x4*)(dst + (size_t)(n0 + n) * dst_ld + k0 + kq) = w;
        else {
            const int nn_ = n0 + n, kk_ = k0 + kq;
            const size_t f = (size_t)(nn_ >> 4) * (dst_ld >> 5) + (kk_ >> 5);
            *(u32x4*)(dst + f * 512 + ((((kk_ >> 3) & 3) << 4) + (nn_ & 15)) * 8) = w;
        }
    }
    __syncthreads();
}

#define TJ_C0 (16 * 84)
#define TJ_C8 (TJ_C0 + 6 * 12 + 4 * 8 + 4 * 8 + 8 * 16 + 8 * 16 + 16 * 16 + 4 * 8 + 4 * 8)
__device__ __forceinline__ void transpose_jobs(const Params& p, char* lds, int jbeg, int jend, int jstart, int jstride) {
    float* tile = (float*)lds;
    const int c0 = TJ_C0;
    const int c1 = c0 + 6 * 12;
    const int c2 = c1 + 4 * 8;
    const int c3 = c2 + 4 * 8;
    const int c4 = c3 + 8 * 16;
    const int c5 = c4 + 8 * 16;
    const int c6 = c5 + 16 * 16;
    const int c7 = c6 + 4 * 8;
    for (int j = jbeg + jstart; j < jend; j += jstride) {
        const float* src; int sld, nval, ntn, loc; bf16_t* dst; int dld; const float* ksc = nullptr; bool fm = false;
        if (j < c0)      { loc = j;      src = p.w_in; sld = IN_COLS; nval = IN_COLS; ntn = 84; dst = p.WIN_T; dld = 1024; }
        else if (j < c1) { loc = j - c0; src = p.w_uq; sld = 768;  nval = 768;  ntn = 12; dst = p.WUQ_T; dld = 384; ksc = p.g_cq; fm = true; }
        else if (j < c2) { loc = j - c1; src = p.w_uk; sld = 512;  nval = 512;  ntn = 8;  dst = p.WUKV_T; dld = 256; }
        else if (j < c3) { loc = j - c2; src = p.w_uv; sld = 512;  nval = 512;  ntn = 8;  dst = p.WUKV_T + (size_t)512 * 256; dld = 256; }
        else if (j < c4) { loc = j - c3; src = p.w_oa; sld = 1024; nval = 1024; ntn = 16; dst = p.WOA_T; dld = 512; }
        else if (j < c5) { loc = j - c4; src = p.w_ob; sld = 1024; nval = 1024; ntn = 16; dst = p.WOB_T; dld = 512; }
        else if (j < c6) { loc = j - c5; src = p.w_o;  sld = 1024; nval = 1024; ntn = 16; dst = p.WO_T; dld = 1024; }
        else if (j < c7) { loc = j - c6; src = p.w_uk; sld = 512;  nval = 512;  ntn = 8;  dst = p.WUKVG_T; dld = 256; ksc = p.g_ckv; fm = true; }
        else             { loc = j - c7; src = p.w_uv; sld = 512;  nval = 512;  ntn = 8;  dst = p.WUKVG_T + (size_t)512 * 256; dld = 256; ksc = p.g_ckv; fm = true; }
        const int kt = loc / ntn, nt = loc % ntn;
        transpose_tile(src, sld, nval, kt * 64, nt * 64, dst, dld, tile, ksc, fm);
    }
}

__device__ __forceinline__ void phase0(const Params& p, char* lds) {
    const int tid = threadIdx.x, lane = tid & 63, wid = tid >> 6;
    const int nb = gridDim.x, bid = blockIdx.x;
    transpose_jobs(p, lds, 0, TJ_C0, bid, nb);
    for (int i = bid * NTHREADS + tid; i < 64 * 64 * 48; i += nb * NTHREADS) {
        const int row = i / 48, c = i - row * 48;
        p.VTG[(size_t)row * 2112 + LTOT + c] = 0;
    }
    for (int r = bid * 8 + wid; r < R_PAD; r += nb * 8) {
        bf16_t* dst = p.XN + (size_t)r * 1024;
        if (r >= R_ALL) {
#pragma unroll
            for (int i = 0; i < 4; ++i) *(u32x2*)(dst + lane * 4 + 256 * i) = (u32x2){0u, 0u};
            continue;
        }
        const float* src;
        if (r < R_PROMPT) { const int b = r / LTOT, t = r - b * LTOT; src = (t < NMETA) ? p.meta + (size_t)t * 1024 : p.x_prompt + ((size_t)b * SEQ + (t - NMETA)) * 1024; }
        else src = p.x_sample + (size_t)(r - R_PROMPT) * 1024;
        f32x4 v[4]; float ss = 0.f;
#pragma unroll
        for (int i = 0; i < 4; ++i) { v[i] = *(const f32x4*)(src + lane * 4 + 256 * i); ss += v[i][0] * v[i][0] + v[i][1] * v[i][1] + v[i][2] * v[i][2] + v[i][3] * v[i][3]; }
        ss = wave_sum(ss);
        const float rs = 1.0f / sqrtf(ss * (1.0f / 1024.0f) + EPSF);
#pragma unroll
        for (int i = 0; i < 4; ++i) {
            const f32x4 g = *(const f32x4*)(p.norm_g + lane * 4 + 256 * i);
            u32x2 w; w[0] = cvtpk(v[i][0] * rs * g[0], v[i][1] * rs * g[1]); w[1] = cvtpk(v[i][2] * rs * g[2], v[i][3] * rs * g[3]);
            *(u32x2*)(dst + lane * 4 + 256 * i) = w;
        }
    }
    for (int i = bid * NTHREADS + tid; i < 2065 * 16; i += nb * NTHREADS) {
        const int pi = i >> 4, k = i & 15;
        const float pos = (pi < LTOT) ? (float)pi : (float)PAST_LEN;
        const float inv = (float)exp(-(double)k / 16.0 * log(10000.0));
        const float ang = pos * inv;
        p.ROPE[pi * 32 + k] = cosf(ang); p.ROPE[pi * 32 + 16 + k] = sinf(ang);
    }
    if (bid == 0) {
        if (tid < 512) { const float l0 = p.lb_logits[tid], l1 = p.lb_logits[512 + tid]; p.LB[tid] = 1.0f / (1.0f + expf(l1 - l0)); }
        if (tid < 16) p.INV[tid] = (float)exp(-(double)tid / 16.0 * log(10000.0));
        if (wid == 0) {
            float gq = 0.f, gk = 0.f;
            for (int i = lane; i < A_QK; i += 64) { gq = fmaxf(gq, fabsf(p.g_qn[i])); gk = fmaxf(gk, fabsf(p.g_kn[i])); }
#pragma unroll
            for (int o = 32; o >= 1; o >>= 1) { gq = fmaxf(gq, __shfl_xor(gq, o)); gk = fmaxf(gk, __shfl_xor(gk, o)); }
            if (lane == 0) p.SCAL[0] = sqrtf((float)A_QK) * gq * gk;
        }
    }
}

__device__ __forceinline__ void phase1(const Params& p, char* lds) {
    pg8::Gemm g{p.XN, p.WIN_T, R_PAD, IN_COLS_PAD, 1024, p.XN, p.WIN_T};
    pg8::StaticOrder S; S.init(R_PAD, IN_COLS_PAD, (int)gridDim.x, (int)blockIdx.x);
    EpiInProj E{p.F32B, p.GLOG, p.PBUF, p.LB, p.CQN, p.CKVN};
    pg8::gemm_phase<EpiInProj, pg8::StaticOrder, true, true>((PG8_LAS unsigned char*)lds, g, S, E);
    const int nidle = (int)gridDim.x - 85;
    if ((int)blockIdx.x >= 85 && nidle > 0) transpose_jobs(p, lds, TJ_C0, TJ_C8, (int)blockIdx.x - 85, nidle);
    else if (nidle <= 0) transpose_jobs(p, lds, TJ_C0, TJ_C8, (int)blockIdx.x, (int)gridDim.x);
}

#define LOG2E 1.4426950408889634f
__device__ __forceinline__ void fin1_chunk(const Params& p, const int c) {
    int tid_ = threadIdx.x; asm volatile("" : "+v"(tid_));
    const int tid = tid_, lane = tid & 63, wid = tid >> 6;
#pragma unroll 1
    for (int i = 0; i < 8; ++i) {
        const int r = c * 64 + wid * 8 + i;
        if (r >= R_ALL) break;
        const float* src = p.F32B + (size_t)r * 288;
        int pidx; float* o_lat; float* o_kr;
        if (r < R_PROMPT) { pidx = r % LTOT; o_lat = p.out + OFF_LAT_P + (size_t)r * 256; o_kr = p.out + OFF_KR_P + (size_t)r * 32; }
        else { const int j = r - R_PROMPT; pidx = LTOT; o_lat = p.out + OFF_LAT_S + (size_t)j * 256; o_kr = p.out + OFF_KR_S + (size_t)j * 32; }
        const f32x4 v = *(const f32x4*)(src + lane * 4);
        float ss = v[0] * v[0] + v[1] * v[1] + v[2] * v[2] + v[3] * v[3];
        ss = wave_sum(ss);
        const float rs = 1.0f / sqrtf(ss * (1.0f / 256.0f) + EPSF);
        const f32x4 g = *(const f32x4*)(p.g_ckv + lane * 4);
        f32x4 o; o[0] = v[0] * rs * g[0]; o[1] = v[1] * rs * g[1]; o[2] = v[2] * rs * g[2]; o[3] = v[3] * rs * g[3];
        *(f32x4*)(o_lat + lane * 4) = o;
        if (lane < 16) {
            const float x1 = src[256 + lane], x2 = src[256 + 16 + lane];
            const float cs = p.ROPE[pidx * 32 + lane], sn = p.ROPE[pidx * 32 + 16 + lane];
            o_kr[lane] = x1 * cs - x2 * sn; o_kr[16 + lane] = x1 * sn + x2 * cs;
        }
    }
}

#define UF_XQ_LD 784
#define UF_XK_LD 528
__device__ __forceinline__ float diag_pick(const f32x4 a, int lr, int lg) {
    const int j = lr & 3;
    float v = (j == 0) ? a[0] : (j == 1) ? a[1] : (j == 2) ? a[2] : a[3];
    v = (lg == (lr >> 2)) ? v : 0.f;
    v += __shfl_xor(v, 16); v += __shfl_xor(v, 32);
    return v;
}
__device__ __forceinline__ void upfused_item(const Params& p, char* lds, const int item) {
    int tid_ = threadIdx.x; asm volatile("" : "+v"(tid_));
    const int tid = tid_, lane = tid & 63, h = tid >> 6, lr = lane & 15, lg = lane >> 4;
    const int rt = item / 3, part = item - rt * 3, row0 = rt * 64;
    const float qk_scale = 0.10206207261596577f;
    if (part == 0) {
        char* X = lds;
#pragma unroll
        for (int i = 0; i < 6; ++i) {
            const int id = tid + 512 * i, row = id / 48, ch = id - row * 48;
            *(u32x4*)(X + row * UF_XQ_LD + ch * 16) = *(const u32x4*)(p.CQN + (size_t)(row0 + row) * 384 + ch * 8);
        }
        __syncthreads();
        f32x4 acc[4][6], accs[4];
#pragma unroll
        for (int mt = 0; mt < 4; ++mt) { accs[mt] = (f32x4){0.f, 0.f, 0.f, 0.f};
#pragma unroll
            for (int nt = 0; nt < 6; ++nt) acc[mt][nt] = (f32x4){0.f, 0.f, 0.f, 0.f}; }
        const bf16_t* wb = p.WUQ_T + (size_t)(h * 6) * 12 * 512 + lane * 8;
        f32x4 gq[6], rc[4], rsn[4];
#pragma unroll
        for (int nt = 0; nt < 6; ++nt) gq[nt] = *(const f32x4*)(p.g_qn + 16 * nt + 4 * lg);
#pragma unroll
        for (int mt = 0; mt < 4; ++mt) {
            const int r = row0 + 16 * mt + lr;
            const int pidx = (r >= R_PROMPT) ? LTOT : (r % LTOT);
            rc[mt] = *(const f32x4*)(p.ROPE + pidx * 32 + 4 * lg); rsn[mt] = *(const f32x4*)(p.ROPE + pidx * 32 + 16 + 4 * lg);
        }
#pragma unroll 1
        for (int ks = 0; ks < 12; ++ks) {
            bf16x8 xf[4], wf[6];
#pragma unroll
            for (int nt = 0; nt < 6; ++nt) wf[nt] = *(const bf16x8*)(wb + (size_t)(nt * 12 + ks) * 512);
#pragma unroll
            for (int mt = 0; mt < 4; ++mt) xf[mt] = *(const bf16x8*)(X + (16 * mt + lr) * UF_XQ_LD + ks * 64 + lg * 16);
#pragma unroll
            for (int mt = 0; mt < 4; ++mt) {
                accs[mt] = mfma16(xf[mt], xf[mt], accs[mt]);
#pragma unroll
                for (int nt = 0; nt < 6; ++nt) acc[mt][nt] = mfma16(wf[nt], xf[mt], acc[mt][nt]);
            }
        }
#pragma unroll
        for (int mt = 0; mt < 4; ++mt) {
            const int r = row0 + 16 * mt + lr;
            const float rs_cq = 1.0f / sqrtf(diag_pick(accs[mt], lr, lg) * (1.0f / 384.0f) + EPSF);
            const bool is_s = r >= R_PROMPT;
            const int b = r / LTOT, t = r - b * LTOT;
            const int pidx = is_s ? LTOT : t;
            f32x4 q[6];
#pragma unroll
            for (int nt = 0; nt < 6; ++nt) q[nt] = acc[mt][nt] * rs_cq;
            {
                const f32x4 c4 = rc[mt], s4 = rsn[mt];
#pragma unroll
                for (int j = 0; j < 4; ++j) { const float x1 = q[4][j], x2 = q[5][j]; q[4][j] = x1 * c4[j] - x2 * s4[j]; q[5][j] = x1 * s4[j] + x2 * c4[j]; }
            }
            float ss = 0.f;
#pragma unroll
            for (int nt = 0; nt < 6; ++nt)
#pragma unroll
                for (int j = 0; j < 4; ++j) ss += q[nt][j] * q[nt][j];
            ss += __shfl_xor(ss, 16); ss += __shfl_xor(ss, 32);
            const float rs = 1.0f / sqrtf(ss * (1.0f / 96.0f) + EPSF);
            if (!is_s) {
                if (t >= NMETA && r < R_PROMPT) {
                    bf16_t* dst = p.QA + ((size_t)(b * 8 + h) * 2048 + (t - NMETA)) * 96 + 4 * lg;
                    const float sc = rs * qk_scale * LOG2E;
#pragma unroll
                    for (int nt = 0; nt < 6; ++nt) {
                        const f32x4 g = gq[nt];
                        u32x2 w; w[0] = cvtpk(q[nt][0] * sc * g[0], q[nt][1] * sc * g[1]); w[1] = cvtpk(q[nt][2] * sc * g[2], q[nt][3] * sc * g[3]);
                        *(u32x2*)(dst + 16 * nt) = w;
                    }
                }
            } else if (r < R_ALL) {
                float* dst = p.QS + ((size_t)(r - R_PROMPT) * 8 + h) * 96 + 4 * lg;
                const float sc = rs * qk_scale;
#pragma unroll
                for (int nt = 0; nt < 6; ++nt) {
                    const f32x4 g = gq[nt], gk = *(const f32x4*)(p.g_kn + 16 * nt + 4 * lg);
                    f32x4 o; o[0] = q[nt][0] * sc * g[0] * gk[0]; o[1] = q[nt][1] * sc * g[1] * gk[1]; o[2] = q[nt][2] * sc * g[2] * gk[2]; o[3] = q[nt][3] * sc * g[3] * gk[3];
                    *(f32x4*)(dst + 16 * nt) = o;
                }
            }
        }
    } else {
        char* X = lds;
        float* KR = (float*)(lds + 64 * UF_XK_LD);
#pragma unroll
        for (int i = 0; i < 4; ++i) {
            const int id = tid + 512 * i, row = id >> 5, ch = id & 31;
            *(u32x4*)(X + row * UF_XK_LD + ch * 16) = *(const u32x4*)(p.CKVN + (size_t)(row0 + row) * 256 + ch * 8);
        }
        if (part == 1) { const int row = tid >> 3, c4 = tid & 7; *(f32x4*)(KR + row * 36 + c4 * 4) = *(const f32x4*)(p.F32B + (size_t)(row0 + row) * 288 + 256 + c4 * 4); }
        __syncthreads();
        f32x4 ak[4][4], accs[4];
#pragma unroll
        for (int mt = 0; mt < 4; ++mt) { accs[mt] = (f32x4){0.f, 0.f, 0.f, 0.f};
#pragma unroll
            for (int nt = 0; nt < 4; ++nt) ak[mt][nt] = (f32x4){0.f, 0.f, 0.f, 0.f}; }
        const bf16_t* wk = p.WUKVG_T + (size_t)((part == 1 ? 0 : 32) + h * 4) * 8 * 512 + lane * 8;
        f32x4 gk[6], rc[4], rsn[4];
        if (part == 1) {
#pragma unroll
            for (int nt = 0; nt < 6; ++nt) gk[nt] = *(const f32x4*)(p.g_kn + 16 * nt + 4 * lg);
#pragma unroll
            for (int mt = 0; mt < 4; ++mt) {
                const int r = row0 + 16 * mt + lr;
                const int pidx = (r >= R_PROMPT) ? LTOT : (r % LTOT);
                rc[mt] = *(const f32x4*)(p.ROPE + pidx * 32 + 4 * lg); rsn[mt] = *(const f32x4*)(p.ROPE + pidx * 32 + 16 + 4 * lg);
            }
        }
#pragma unroll 1
        for (int ks = 0; ks < 8; ++ks) {
            bf16x8 xf[4], wfk[4];
#pragma unroll
            for (int nt = 0; nt < 4; ++nt) wfk[nt] = *(const bf16x8*)(wk + (size_t)(nt * 8 + ks) * 512);
#pragma unroll
            for (int mt = 0; mt < 4; ++mt) xf[mt] = *(const bf16x8*)(X + (16 * mt + lr) * UF_XK_LD + ks * 64 + lg * 16);
#pragma unroll
            for (int mt = 0; mt < 4; ++mt) {
                accs[mt] = mfma16(xf[mt], xf[mt], accs[mt]);
#pragma unroll
                for (int nt = 0; nt < 4; ++nt) ak[mt][nt] = mfma16(wfk[nt], xf[mt], ak[mt][nt]);
            }
        }
#pragma unroll
        for (int mt = 0; mt < 4; ++mt) {
            const int r = row0 + 16 * mt + lr;
            const float rs_ckv = 1.0f / sqrtf(diag_pick(accs[mt], lr, lg) * (1.0f / 256.0f) + EPSF);
            const bool is_s = r >= R_PROMPT;
            const int b = r / LTOT, t = r - b * LTOT;
            if (part == 2) {
                if (!is_s) {
                    const int x = t & 15, slot = (t & ~15) | (x & 3) | ((x & 4) << 1) | ((x & 8) >> 1);
                    bf16_t* vd = p.VTG + (size_t)(b * 8 + h) * 64 * 2112 + slot;
#pragma unroll
                    for (int nt = 0; nt < 4; ++nt)
#pragma unroll
                        for (int j = 0; j < 4; ++j) vd[(size_t)(16 * nt + 4 * lg + j) * 2112] = f2bf(ak[mt][nt][j] * rs_ckv);
                }
                continue;
            }
            const int pidx = is_s ? LTOT : t;
            const f32x4 x1 = *(const f32x4*)(KR + (16 * mt + lr) * 36 + 4 * lg), x2 = *(const f32x4*)(KR + (16 * mt + lr) * 36 + 16 + 4 * lg);
            float ss = 0.f;
#pragma unroll
            for (int j = 0; j < 4; ++j) ss += x1[j] * x1[j] + x2[j] * x2[j];
            f32x4 kn[4];
#pragma unroll
            for (int nt = 0; nt < 4; ++nt) { kn[nt] = ak[mt][nt] * rs_ckv;
#pragma unroll
                for (int j = 0; j < 4; ++j) ss += kn[nt][j] * kn[nt][j]; }
            ss += __shfl_xor(ss, 16); ss += __shfl_xor(ss, 32);
            const float rs = 1.0f / sqrtf(ss * (1.0f / 96.0f) + EPSF);
            const f32x4 c4 = rc[mt], s4 = rsn[mt];
            f32x4 y1, y2;
#pragma unroll
            for (int j = 0; j < 4; ++j) { y1[j] = x1[j] * c4[j] - x2[j] * s4[j]; y2[j] = x1[j] * s4[j] + x2[j] * c4[j]; }
            if (!is_s) {
                bf16_t* dst = p.KA + ((size_t)(b * 8 + h) * LTOT + t) * 96 + 4 * lg;
#pragma unroll
                for (int nt = 0; nt < 4; ++nt) {
                    const f32x4 g = gk[nt];
                    u32x2 w; w[0] = cvtpk(kn[nt][0] * rs * g[0], kn[nt][1] * rs * g[1]); w[1] = cvtpk(kn[nt][2] * rs * g[2], kn[nt][3] * rs * g[3]);
                    *(u32x2*)(dst + 16 * nt) = w;
                }
                {
                    const f32x4 g1 = gk[4], g2 = gk[5];
                    u32x2 w1, w2;
                    w1[0] = cvtpk(y1[0] * rs * g1[0], y1[1] * rs * g1[1]); w1[1] = cvtpk(y1[2] * rs * g1[2], y1[3] * rs * g1[3]);
                    w2[0] = cvtpk(y2[0] * rs * g2[0], y2[1] * rs * g2[1]); w2[1] = cvtpk(y2[2] * rs * g2[2], y2[3] * rs * g2[3]);
                    *(u32x2*)(dst + 64) = w1; *(u32x2*)(dst + 80) = w2;
                }
            } else if (r < R_ALL) {
                float* dst = p.KSRAW + ((size_t)(r - R_PROMPT) * 8 + h) * 96 + 4 * lg;
#pragma unroll
                for (int nt = 0; nt < 4; ++nt) *(f32x4*)(dst + 16 * nt) = kn[nt];
                *(f32x4*)(dst + 64) = y1; *(f32x4*)(dst + 80) = y2;
            }
        }
    }
    __syncthreads();
}

#define HA_LD 144
#define HC_LD 272
__device__ __forceinline__ void hgrn_passA_unit(const Params& p, char* lds, const int u) {
    int tid_ = threadIdx.x; asm volatile("" : "+v"(tid_));
    const int tid = tid_, lane = tid & 63, wid = tid >> 6, lr = lane & 15, lg = lane >> 4;
    float* cumL = (float*)lds;
    float* tot = (float*)(lds + 32768);
    char* KT = lds + 32768 + 2048;
    char* VT = KT + 128 * HA_LD;
    {
        const int c = u % NCHUNK, bh = u / NCHUNK, h = bh % B_HEADS, b = bh / B_HEADS;
        const int nvalid = (c == 0) ? NMETA : 64;
        const int t0 = (c == 0) ? 0 : NMETA + 64 * (c - 1);
        const size_t rowbase = (size_t)b * LTOT + t0;
        const int d = tid & 127, part = tid >> 7;
        char* KR = VT + 128 * HA_LD;
#pragma unroll
        for (int i = 0; i < 4; ++i) {
            const int id = tid + 512 * i, row = id >> 5, c4 = id & 31;
            f32x4 g = {0.f, 0.f, 0.f, 0.f};
            if (row < nvalid) g = *(const f32x4*)(p.GLOG + (rowbase + row) * 512 + h * 128 + c4 * 4);
            *(f32x4*)(cumL + row * 128 + c4 * 4) = g;
        }
#pragma unroll
        for (int i = 0; i < 2; ++i) {
            const int id = tid + 512 * i, row = id >> 4, ch = id & 15;
            u32x4 kw = {0u, 0u, 0u, 0u}, w = {0u, 0u, 0u, 0u};
            if (row < nvalid) {
                kw = *(const u32x4*)(p.PBUF + (rowbase + row) * IN_COLS_PAD + C_BF + h * 128 + ch * 8);
                w = *(const u32x4*)(p.PBUF + (rowbase + row) * IN_COLS_PAD + C_BI + h * 128 + ch * 8);
            }
            *(u32x4*)(KR + row * HC_LD + ch * 16) = kw;
#pragma unroll
            for (int e = 0; e < 4; ++e) {
                *(bf16_t*)(VT + (ch * 8 + 2 * e) * HA_LD + row * 2) = (bf16_t)(w[e] & 0xffffu);
                *(bf16_t*)(VT + (ch * 8 + 2 * e + 1) * HA_LD + row * 2) = (bf16_t)(w[e] >> 16);
            }
        }
        __syncthreads();
        {
            float run = 0.f;
#pragma unroll
            for (int i = 0; i < 16; ++i) { const int s = part * 16 + i; run += cumL[s * 128 + d]; cumL[s * 128 + d] = run; }
            tot[part * 128 + d] = run;
        }
        __syncthreads();
        {
            float off = 0.f, last = 0.f;
#pragma unroll
            for (int q = 0; q < 4; ++q) { const float tq = tot[q * 128 + d]; last += tq; if (q < part) off += tq; }
            if (part == 0) p.DEC[(size_t)u * 128 + d] = expf(last);
#pragma unroll
            for (int i = 0; i < 16; ++i) {
                const int s = part * 16 + i;
                const float cum = cumL[s * 128 + d] + off;
                const float kv = bf2f(*(const bf16_t*)(KR + s * HC_LD + d * 2));
                *(bf16_t*)(KT + d * HA_LD + s * 2) = f2bf(kv * __expf(last - cum));
            }
        }
        __syncthreads();
        {
            const char* xs = VT + (wid * 16 + lr) * HA_LD + lg * 16;
            bf16x8 xf0 = *(const bf16x8*)(xs), xf1 = *(const bf16x8*)(xs + 64);
            bf16_t* dst = p.UT + (size_t)u * 16384 + (size_t)(wid * 16 + lr) * 128;
#pragma unroll
            for (int nt = 0; nt < 8; ++nt) {
                const char* ws = KT + (nt * 16 + lr) * HA_LD + lg * 16;
                f32x4 acc = {0.f, 0.f, 0.f, 0.f};
                acc = mfma16(*(const bf16x8*)(ws), xf0, acc);
                acc = mfma16(*(const bf16x8*)(ws + 64), xf1, acc);
                { u32x2 w; w[0] = cvtpk(acc[0], acc[1]); w[1] = cvtpk(acc[2], acc[3]); *(u32x2*)(dst + nt * 16 + 4 * lg) = w; }
            }
        }
        __syncthreads();
    }
}

__device__ __forceinline__ void hgrn_sample_step_unit(const Params& p, char* lds, const int u) {
    int tid_ = threadIdx.x; asm volatile("" : "+v"(tid_));
    const int tid = tid_;
    float* part = (float*)lds;
    float* red = (float*)(lds + 8192);
    {
        const int i = u / B_HEADS, h = u % B_HEADS;
        const size_t r = R_PROMPT + i;
        const int v4 = (tid & 31) * 4, dp = tid >> 5;
        const float* S0 = p.state_hgrn + (size_t)u * 16384;
        float* S1 = p.out + OFF_HG_S + (size_t)u * 16384;
        const u32x2 vw = *(const u32x2*)(p.PBUF + r * IN_COLS_PAD + C_BI + h * 128 + v4);
        const float vv[4] = {bflo(vw[0]), bfhi(vw[0]), bflo(vw[1]), bfhi(vw[1])};
        float o[4] = {0.f, 0.f, 0.f, 0.f};
#pragma unroll
        for (int e = 0; e < 8; ++e) {
            const int d = dp * 8 + e;
            const float q = bf2f(p.PBUF[r * IN_COLS_PAD + C_BQ + h * 128 + d]);
            const float k = bf2f(p.PBUF[r * IN_COLS_PAD + C_BF + h * 128 + d]);
            const float f = expf(p.GLOG[r * 512 + h * 128 + d]);
            const f32x4 s0 = *(const f32x4*)(S0 + d * 128 + v4);
            f32x4 s1;
#pragma unroll
            for (int j = 0; j < 4; ++j) { s1[j] = f * s0[j] + k * vv[j]; o[j] += q * s1[j]; }
            *(f32x4*)(S1 + d * 128 + v4) = s1;
        }
#pragma unroll
        for (int j = 0; j < 4; ++j) part[dp * 128 + v4 + j] = o[j];
        __syncthreads();
        float osum = 0.f;
        if (tid < 128) {
#pragma unroll
            for (int q = 0; q < 16; ++q) osum += part[q * 128 + tid];
            float ss = wave_sum(osum * osum);
            if ((tid & 63) == 0) red[tid >> 6] = ss;
        }
        __syncthreads();
        if (tid < 128) {
            const float ss = red[0] + red[1];
            const float rs = 1.0f / sqrtf(ss * (1.0f / 128.0f) + EPSF);
            const float gb = bf2f(p.PBUF[r * IN_COLS_PAD + C_GB + h * 128 + tid]);
            p.AMB[(size_t)(NQ + i) * 512 + h * 128 + tid] = f2bf(osum * rs * p.g_bn[tid] * gb);
        }
        __syncthreads();
    }
}

#define Q_UF_ITEMS (3 * (R_PAD / 64))
#define Q_HA_ITEMS (BATCH * B_HEADS * NCHUNK)
#define Q_SS_ITEMS (DEC_BATCH * B_HEADS)
#define Q_F1_ITEMS ((R_ALL + 63) / 64)
#define QCTR_WORD 3584
__device__ __forceinline__ void phase2(const Params& p, char* lds) {
    volatile int* slot = (volatile int*)(lds + LDS_ITEM_OFF);
    const int total = Q_UF_ITEMS + Q_HA_ITEMS + Q_SS_ITEMS + Q_F1_ITEMS;
    int nxt = 0;
    if (threadIdx.x == 0) nxt = (int)atomicAdd(p.bar + QCTR_WORD, 1u);
    for (;;) {
        if (threadIdx.x == 0) *slot = nxt;
        __syncthreads();
        const int it = __builtin_amdgcn_readfirstlane(*slot);
        __syncthreads();
        if (it >= total) break;
        if (threadIdx.x == 0) nxt = (int)atomicAdd(p.bar + QCTR_WORD, 1u);
        if (it < Q_UF_ITEMS) upfused_item(p, lds, it);
        else if (it < Q_UF_ITEMS + Q_HA_ITEMS) hgrn_passA_unit(p, lds, it - Q_UF_ITEMS);
        else if (it < Q_UF_ITEMS + Q_HA_ITEMS + Q_SS_ITEMS) hgrn_sample_step_unit(p, lds, it - Q_UF_ITEMS - Q_HA_ITEMS);
        else fin1_chunk(p, it - Q_UF_ITEMS - Q_HA_ITEMS - Q_SS_ITEMS);
    }
}

__device__ __forceinline__ void hgrn_passB(const Params& p) {
    for (int g = blockIdx.x * NTHREADS + threadIdx.x; g < 32 * 128 * 32; g += gridDim.x * NTHREADS) {
        const int d4 = (g & 31) * 4, v = (g >> 5) & 127, bh = g >> 12;
        f32x4 S = {0.f, 0.f, 0.f, 0.f};
        for (int c = 0; c < NCHUNK; ++c) {
            const size_t u = (size_t)bh * NCHUNK + c;
            u32x2 w; w[0] = cvtpk(S[0], S[1]); w[1] = cvtpk(S[2], S[3]);
            *(u32x2*)(p.ST + u * 16384 + v * 128 + d4) = w;
            const f32x4 dec = *(const f32x4*)(p.DEC + u * 128 + d4);
            const u32x2 uw = *(const u32x2*)(p.UT + u * 16384 + v * 128 + d4);
            const f32x4 ut = {bflo(uw[0]), bfhi(uw[0]), bflo(uw[1]), bfhi(uw[1])};
#pragma unroll
            for (int j = 0; j < 4; ++j) S[j] = dec[j] * S[j] + ut[j];
        }
        float* o = p.out + OFF_HG_P + (size_t)bh * 16384;
#pragma unroll
        for (int j = 0; j < 4; ++j) o[(d4 + j) * 128 + v] = S[j];
    }
}

#define AK_LD 208
#define AV_LD 144
#define AP_LD 144
#define AK_BUF (64 * AK_LD)
#define AV_BUF (64 * AV_LD)

typedef float f32x16 __attribute__((ext_vector_type(16)));
#define A2K_LD 208
#define A2V_LD 144
#define A2K_BUF (64 * A2K_LD)
#define A2V_BUF (64 * A2V_LD)
__device__ __forceinline__ f32x16 mfma32(bf16x8 a, bf16x8 b, f32x16 c) { return __builtin_amdgcn_mfma_f32_32x32x16_bf16(a, b, c, 0, 0, 0); }
__device__ __forceinline__ void attn_unit2(const Params& p, char* lds, int b, int h, int qb) {
    const int tid = threadIdx.x, lane = tid & 63, wid = tid >> 6, r32 = lane & 31, hi = lane >> 5;
    char* Ks = lds;
    char* Vs = lds + 2 * A2K_BUF;
    const int tq0 = qb * 256;
    const int ntile = 4 * qb + 5;
    const float negMb = -p.SCAL[0] * LOG2E;
    const bf16_t* qsrc = p.QA + ((size_t)(b * 8 + h) * 2048 + tq0 + 32 * wid + r32) * 96 + hi * 8;
    bf16x8 qf[6];
#pragma unroll
    for (int s = 0; s < 6; ++s) qf[s] = *(const bf16x8*)(qsrc + 16 * s);
    const int wq_min = NMETA + tq0 + 32 * wid, wq_max = wq_min + 31, qpos = wq_min + r32;
    const bf16_t* kbase = p.KA + (size_t)(b * 8 + h) * LTOT * 96;
    const bf16_t* vbase = p.VTG + (size_t)(b * 8 + h) * 64 * 2112;
    const int kkey0 = tid / 12, kpart0 = tid % 12;
    const int kkey1 = (512 + tid) / 12, kpart1 = (512 + tid) % 12;
    const int vdv = tid >> 3, vpart = tid & 7;
    u32x4 kA0, kA1 = {0u, 0u, 0u, 0u}, vA, kB0, kB1 = {0u, 0u, 0u, 0u}, vB;
#define A2_LOAD(K0, K1, V, ti_) { const int key0 = (ti_) * 64; \
        int ka = key0 + kkey0; ka = ka < LTOT ? ka : LTOT - 1; K0 = *(const u32x4*)(kbase + (size_t)ka * 96 + kpart0 * 8); \
        if (tid < 256) { int kb = key0 + kkey1; kb = kb < LTOT ? kb : LTOT - 1; K1 = *(const u32x4*)(kbase + (size_t)kb * 96 + kpart1 * 8); } \
        V = *(const u32x4*)(vbase + (size_t)vdv * 2112 + key0 + vpart * 8); }
#define A2_STORE(K0, K1, V, buf_) { *(u32x4*)(Ks + (buf_) * A2K_BUF + kkey0 * A2K_LD + kpart0 * 16) = K0; \
        if (tid < 256) *(u32x4*)(Ks + (buf_) * A2K_BUF + kkey1 * A2K_LD + kpart1 * 16) = K1; \
        *(u32x4*)(Vs + (buf_) * A2V_BUF + vdv * A2V_LD + vpart * 16) = V; }
    f32x16 o0, o1;
#pragma unroll
    for (int i = 0; i < 16; ++i) { o0[i] = 0.f; o1[i] = 0.f; }
    float lsum = 0.f;
    A2_LOAD(kA0, kA1, vA, 0); A2_STORE(kA0, kA1, vA, 0);
    A2_LOAD(kB0, kB1, vB, 1);
    __syncthreads();
#pragma unroll 2
    for (int ti = 0; ti < ntile; ++ti) {
        const int cur = ti & 1;
        if (ti + 2 < ntile) { if (cur == 0) { A2_LOAD(kA0, kA1, vA, ti + 2); } else { A2_LOAD(kB0, kB1, vB, ti + 2); } }
        if (ti * 64 <= wq_max) {
            f32x16 s0, s1;
#pragma unroll
            for (int i = 0; i < 16; ++i) { s0[i] = negMb; s1[i] = negMb; }
            const char* ka = Ks + cur * A2K_BUF + r32 * A2K_LD + hi * 16;
#pragma unroll
            for (int s = 0; s < 6; ++s) {
                s0 = mfma32(*(const bf16x8*)(ka + s * 32), qf[s], s0);
                s1 = mfma32(*(const bf16x8*)(ka + 32 * A2K_LD + s * 32), qf[s], s1);
            }
            const bool diag = (ti * 64 + 63 > wq_min);
#pragma unroll
            for (int i = 0; i < 16; ++i) { s0[i] = __builtin_amdgcn_exp2f(s0[i]); s1[i] = __builtin_amdgcn_exp2f(s1[i]); }
            if (diag) {
                const int kb0 = ti * 64 + 4 * hi;
#pragma unroll
                for (int i = 0; i < 16; ++i) {
                    const int key = kb0 + (i & 3) + 8 * (i >> 2);
                    if (key > qpos) s0[i] = 0.f;
                    if (key + 32 > qpos) s1[i] = 0.f;
                }
            }
            float la = 0.f, lb = 0.f;
#pragma unroll
            for (int i = 0; i < 16; ++i) { la += s0[i]; lb += s1[i]; }
            lsum += la + lb;
            bf16x8 pb[2][2];
#pragma unroll
            for (int s = 0; s < 2; ++s) {
                u32x4 w0, w1;
#pragma unroll
                for (int e = 0; e < 4; ++e) { w0[e] = cvtpk(s0[8 * s + 2 * e], s0[8 * s + 2 * e + 1]); w1[e] = cvtpk(s1[8 * s + 2 * e], s1[8 * s + 2 * e + 1]); }
                pb[0][s] = __builtin_bit_cast(bf16x8, w0); pb[1][s] = __builtin_bit_cast(bf16x8, w1);
            }
            const char* va = Vs + cur * A2V_BUF + r32 * A2V_LD + hi * 16;
#pragma unroll
            for (int kt = 0; kt < 2; ++kt)
#pragma unroll
                for (int s = 0; s < 2; ++s) {
                    o0 = mfma32(*(const bf16x8*)(va + kt * 64 + s * 32), pb[kt][s], o0);
                    o1 = mfma32(*(const bf16x8*)(va + 32 * A2V_LD + kt * 64 + s * 32), pb[kt][s], o1);
                }
        }
        if (ti + 1 < ntile) { if (cur == 0) { A2_STORE(kB0, kB1, vB, 1); } else { A2_STORE(kA0, kA1, vA, 0); } }
        __syncthreads();
    }
#undef A2_LOAD
#undef A2_STORE
    lsum += __shfl_xor(lsum, 32);
    const float inv = 1.0f / lsum;
    const int tq = tq0 + 32 * wid + r32;
    const size_t r = (size_t)b * LTOT + NMETA + tq;
    const size_t mrow = (size_t)b * 2048 + tq;
#pragma unroll
    for (int vt = 0; vt < 2; ++vt)
#pragma unroll
        for (int g = 0; g < 4; ++g) {
            const int dv = 32 * vt + 8 * g + 4 * hi;
            const u32x2 gw = *(const u32x2*)(p.PBUF + r * IN_COLS_PAD + C_GA + h * 64 + dv);
            const float v0 = (vt ? o1[4 * g] : o0[4 * g]) * inv, v1 = (vt ? o1[4 * g + 1] : o0[4 * g + 1]) * inv;
            const float v2 = (vt ? o1[4 * g + 2] : o0[4 * g + 2]) * inv, v3 = (vt ? o1[4 * g + 3] : o0[4 * g + 3]) * inv;
            u32x2 w; w[0] = cvtpk(v0 * bflo(gw[0]), v1 * bfhi(gw[0])); w[1] = cvtpk(v2 * bflo(gw[1]), v3 * bfhi(gw[1]));
            *(u32x2*)(p.AMA + mrow * 512 + h * 64 + dv) = w;
        }
}

__device__ __forceinline__ void attn_phase(const Params& p, char* lds) {
    const int i = blockIdx.x;
    if (i < 256) {
        const int bh = i >> 2, pair = i & 3;
        attn_unit2(p, lds, bh >> 3, bh & 7, 7 - pair);
        attn_unit2(p, lds, bh >> 3, bh & 7, pair);
    }
}

__device__ __forceinline__ void hgrn_passC(const Params& p, char* lds) {
    const int tid = threadIdx.x, lane = tid & 63, wid = tid >> 6, lr = lane & 15, lg = lane >> 4;
    float* cumL = (float*)lds;
    float* tot = (float*)(lds + 32768);
    char* QT = lds + 34816;
    char* KN = QT + 64 * HC_LD;
    char* QH = KN + 64 * HC_LD;
    char* VT = QH + 64 * HC_LD;
    char* AT = VT + 128 * HA_LD;
    char* STl = AT + 64 * HA_LD;
    for (int uu = blockIdx.x; uu < 32 * 32; uu += gridDim.x) {
        const int c = 1 + (uu & 31), bh = uu >> 5, h = bh & 3, b = bh >> 2;
        const size_t u = (size_t)bh * NCHUNK + c;
        const int t0 = NMETA + 64 * (c - 1);
        const size_t rowbase = (size_t)b * LTOT + t0;
        const int d = tid & 127, part = tid >> 7;
#pragma unroll
        for (int i = 0; i < 4; ++i) {
            const int id = tid + 512 * i, row = id >> 5, c4 = id & 31;
            *(f32x4*)(cumL + row * 128 + c4 * 4) = *(const f32x4*)(p.GLOG + (rowbase + row) * 512 + h * 128 + c4 * 4);
        }
#pragma unroll
        for (int i = 0; i < 2; ++i) {
            const int id = tid + 512 * i, row = id >> 4, ch = id & 15;
            const bf16_t* src = p.PBUF + (rowbase + row) * IN_COLS_PAD + h * 128 + ch * 8;
            const u32x4 qw = *(const u32x4*)(src + C_BQ), kw = *(const u32x4*)(src + C_BF), w = *(const u32x4*)(src + C_BI);
            *(u32x4*)(QH + row * HC_LD + ch * 16) = qw;
            *(u32x4*)(KN + row * HC_LD + ch * 16) = kw;
#pragma unroll
            for (int e = 0; e < 4; ++e) {
                *(bf16_t*)(VT + (ch * 8 + 2 * e) * HA_LD + row * 2) = (bf16_t)(w[e] & 0xffffu);
                *(bf16_t*)(VT + (ch * 8 + 2 * e + 1) * HA_LD + row * 2) = (bf16_t)(w[e] >> 16);
            }
        }
#pragma unroll
        for (int i = 0; i < 4; ++i) {
            const int id = tid + 512 * i, v = id >> 4, dc = id & 15;
            *(u32x4*)(STl + v * HC_LD + dc * 16) = *(const u32x4*)(p.ST + u * 16384 + v * 128 + dc * 8);
        }
        __syncthreads();
        {
            float run = 0.f;
#pragma unroll
            for (int i = 0; i < 16; ++i) { const int s = part * 16 + i; run += cumL[s * 128 + d]; cumL[s * 128 + d] = run; }
            tot[part * 128 + d] = run;
        }
        __syncthreads();
        {
            float off = 0.f;
#pragma unroll
            for (int q = 0; q < 4; ++q) { const float tq = tot[q * 128 + d]; if (q < part) off += tq; }
            const float ref = tot[d] + tot[128 + d];
#pragma unroll
            for (int i = 0; i < 16; ++i) {
                const int s = part * 16 + i;
                const float cum = cumL[s * 128 + d] + off;
                const float qv = bf2f(*(const bf16_t*)(QH + s * HC_LD + d * 2));
                const float kv = bf2f(*(const bf16_t*)(KN + s * HC_LD + d * 2));
                *(bf16_t*)(QT + s * HC_LD + d * 2) = f2bf(qv * __expf(cum - ref));
                *(bf16_t*)(KN + s * HC_LD + d * 2) = f2bf(kv * __expf(ref - cum));
                *(bf16_t*)(QH + s * HC_LD + d * 2) = f2bf(qv * __expf(cum));
            }
        }
        __syncthreads();
        {
            const int mt = wid >> 1;
            const char* xs = QT + (mt * 16 + lr) * HC_LD + lg * 16;
            bf16x8 xf[4];
#pragma unroll
            for (int ks = 0; ks < 4; ++ks) xf[ks] = *(const bf16x8*)(xs + ks * 64);
#pragma unroll
            for (int q = 0; q < 2; ++q) {
                const int nt = 2 * (wid & 1) + q;
                const char* ws = KN + (nt * 16 + lr) * HC_LD + lg * 16;
                f32x4 a = {0.f, 0.f, 0.f, 0.f};
#pragma unroll
                for (int ks = 0; ks < 4; ++ks) a = mfma16(*(const bf16x8*)(ws + ks * 64), xf[ks], a);
                const int t = mt * 16 + lr, s0 = nt * 16 + 4 * lg;
                float m[4];
#pragma unroll
                for (int j = 0; j < 4; ++j) m[j] = (s0 + j <= t) ? a[j] : 0.f;
                u32x2 w; w[0] = cvtpk(m[0], m[1]); w[1] = cvtpk(m[2], m[3]);
                *(u32x2*)(AT + t * HA_LD + s0 * 2) = w;
            }
        }
        __syncthreads();
        {
            const int mt = wid >> 1;
            const char* xa = AT + (mt * 16 + lr) * HA_LD + lg * 16;
            const char* xq = QH + (mt * 16 + lr) * HC_LD + lg * 16;
            bf16x8 af[2], qf[4];
#pragma unroll
            for (int ks = 0; ks < 2; ++ks) af[ks] = *(const bf16x8*)(xa + ks * 64);
#pragma unroll
            for (int ks = 0; ks < 4; ++ks) qf[ks] = *(const bf16x8*)(xq + ks * 64);
#pragma unroll
            for (int q = 0; q < 4; ++q) {
                const int nt = 4 * (wid & 1) + q;
                const char* wv = VT + (nt * 16 + lr) * HA_LD + lg * 16;
                const char* wsx = STl + (nt * 16 + lr) * HC_LD + lg * 16;
                f32x4 a = {0.f, 0.f, 0.f, 0.f};
#pragma unroll
                for (int ks = 0; ks < 2; ++ks) a = mfma16(*(const bf16x8*)(wv + ks * 64), af[ks], a);
#pragma unroll
                for (int ks = 0; ks < 4; ++ks) a = mfma16(*(const bf16x8*)(wsx + ks * 64), qf[ks], a);
                *(f32x4*)(cumL + (mt * 16 + lr) * 128 + nt * 16 + 4 * lg) = a;
            }
        }
        __syncthreads();
        {
#pragma unroll
            for (int i = 0; i < 8; ++i) {
                const int t = wid * 8 + i;
                const f32x2 ov = *(const f32x2*)(cumL + t * 128 + 2 * lane);
                const float ss = wave_sum(ov[0] * ov[0] + ov[1] * ov[1]);
                const float rs = 1.0f / sqrtf(ss * (1.0f / 128.0f) + EPSF);
                const unsigned gw = *(const unsigned*)(p.PBUF + (rowbase + t) * IN_COLS_PAD + C_GB + h * 128 + 2 * lane);
                const f32x2 gbn = *(const f32x2*)(p.g_bn + 2 * lane);
                const size_t mrow = (size_t)b * 2048 + 64 * (c - 1) + t;
                *(unsigned*)(p.AMB + mrow * 512 + h * 128 + 2 * lane) = cvtpk(ov[0] * rs * gbn[0] * bflo(gw), ov[1] * rs * gbn[1] * bfhi(gw));
            }
        }
        __syncthreads();
    }
}

#define SC_LD 528
#define SP_LD 272
#define SC_BUF (128 * SC_LD)

#define SA_D 6
#define SA_STG (SA_D * 16384)
#define SA_RSTG (SA_D * 2048)
#define SA_CB_SLOT (16 * SC_LD)
#define SA_NG 128
typedef __attribute__((address_space(3))) unsigned las_u32;

#define SB_D 2
#define SB_STG (SB_D * 32768)
#define SB_RSTG (SB_D * 4096)
#define SB_CB_SLOT (32 * SC_LD)
#define SB_NG 64

#define SR_LD 80
typedef short v4i16_t __attribute__((ext_vector_type(4)));
__device__ __forceinline__ float xsum16_32(float v) {
    auto r = __builtin_amdgcn_permlane16_swap(__float_as_uint(v), __float_as_uint(v), false, false);
    v = __uint_as_float(r[0]) + __uint_as_float(r[1]);
    auto q = __builtin_amdgcn_permlane32_swap(__float_as_uint(v), __float_as_uint(v), false, false);
    return __uint_as_float(q[0]) + __uint_as_float(q[1]);
}
__device__ __forceinline__ void sample_attn4(const Params& p, char* lds) {
    const int tid = threadIdx.x, lane = tid & 63, lr = lane & 15, lg = lane >> 4;
    const int wid = __builtin_amdgcn_readfirstlane(tid >> 6);
    char* stg = lds;
    char* rstg = lds + SB_STG;
    char* cb = rstg + SB_RSTG;
    char* rb = cb + 3 * SB_CB_SLOT;
    char* pl = rb + 3 * 32 * SR_LD;
    for (int blk = blockIdx.x; blk < DEC_BATCH * 8; blk += gridDim.x) {
        const int b = blk >> 3, split = blk & 7, h = wid;
        ((unsigned*)pl)[tid] = 0u;
        bf16x8 wf[4][8];
        {
            const bf16_t* wb = p.WUKV_T + (size_t)(64 * h + lr) * 256 + 8 * lg;
#pragma unroll
            for (int nt = 0; nt < 4; ++nt) {
                asm volatile("" : "+v"(wb));
#pragma unroll
                for (int ks = 0; ks < 8; ++ks) wf[nt][ks] = *(const bf16x8*)(wb + 32 * ks);
                wb += 16 * 256;
            }
        }
        const float* qs = p.QS + (size_t)(b * 8 + h) * 96;
        f32x4 qg[4];
#pragma unroll
        for (int nt = 0; nt < 4; ++nt) qg[nt] = *(const f32x4*)(qs + 16 * nt + 4 * lg) * LOG2E;
        bf16x8 qrf;
        {
            u32x4 w = {0u, 0u, 0u, 0u};
            if (lr < 8) {
                const float* q = p.QS + (size_t)(b * 8 + lr) * 96 + 64 + 8 * lg;
                const f32x4 a0 = *(const f32x4*)q * LOG2E, a1 = *(const f32x4*)(q + 4) * LOG2E;
                w[0] = cvtpk(a0[0], a0[1]); w[1] = cvtpk(a0[2], a0[3]); w[2] = cvtpk(a1[0], a1[1]); w[3] = cvtpk(a1[2], a1[3]);
            }
            qrf = __builtin_bit_cast(bf16x8, w);
        }
        const int pgid = p.page_table[b * NPAGES + split * 16 + (lane & 15)];
        const float Mb = p.SCAL[0] * LOG2E;
        f32x4 accl[2] = {{0.f, 0.f, 0.f, 0.f}, {0.f, 0.f, 0.f, 0.f}};
        float lacc = 0.f;
        asm volatile("s_waitcnt vmcnt(0) lgkmcnt(0)" ::: "memory");
        __syncthreads();
        auto issue = [&](int gi, int slot) {
            const int pg = __builtin_amdgcn_readlane(pgid, gi >> 2);
            const size_t row0 = (size_t)pg * PAGE + 32 * (gi & 3) + 4 * wid;
            const float* src = p.cache_latent + row0 * KV_LORA + lane * 4;
            char __attribute__((address_space(3)))* d0 = (char __attribute__((address_space(3)))*)(stg + slot * 32768 + (4 * wid) * 1024);
            __builtin_amdgcn_global_load_lds((const unsigned*)src, (las_u32*)d0, 16, 0, 0);
            __builtin_amdgcn_global_load_lds((const unsigned*)(src + KV_LORA), (las_u32*)(d0 + 1024), 16, 0, 0);
            __builtin_amdgcn_global_load_lds((const unsigned*)(src + 2 * KV_LORA), (las_u32*)(d0 + 2048), 16, 0, 0);
            __builtin_amdgcn_global_load_lds((const unsigned*)(src + 3 * KV_LORA), (las_u32*)(d0 + 3072), 16, 0, 0);
            const float* rsrc = p.cache_krope + row0 * A_ROPE + lane;
            char __attribute__((address_space(3)))* r0 = (char __attribute__((address_space(3)))*)(rstg + slot * 4096 + wid * 512);
            __builtin_amdgcn_global_load_lds((const unsigned*)rsrc, (las_u32*)r0, 4, 0, 0);
            __builtin_amdgcn_global_load_lds((const unsigned*)(rsrc + 64), (las_u32*)(r0 + 256), 4, 0, 0);
        };
#pragma unroll 1
        for (int gi = 0; gi < SB_D; ++gi) issue(gi, gi);
        int c3_g = 2, d_g1 = 0;
        const int hsel = h & 3;
        const float fhg = (lg == (h >> 2)) ? 1.f : 0.f, fdg = (lg == (lr >> 2)) ? 1.f : 0.f;
#pragma unroll 1
        for (int g = -1; g <= SB_NG; ++g) {
            const int c3_g1 = (c3_g == 2) ? 0 : c3_g + 1;
            const int c3_gm1 = (c3_g == 0) ? 2 : c3_g - 1;
            if (g + 1 < SB_NG) {
                if (g + SB_D <= SB_NG - 1) asm volatile("s_waitcnt vmcnt(%0)" :: "n"(6 * (SB_D - 1)) : "memory");
                else asm volatile("s_waitcnt vmcnt(0)" ::: "memory");
            }
            asm volatile("s_waitcnt lgkmcnt(0)" ::: "memory");
            __builtin_amdgcn_s_barrier();
            asm volatile("" ::: "memory");
            if (g + 1 < SB_NG) {
#pragma unroll
                for (int i = 0; i < 4; ++i) {
                    const f32x4 v = *(const f32x4*)(stg + d_g1 * 32768 + (4 * wid + i) * 1024 + lane * 16);
                    u32x2 w; w[0] = cvtpk(v[0], v[1]); w[1] = cvtpk(v[2], v[3]);
                    *(u32x2*)(cb + c3_g1 * SB_CB_SLOT + (4 * wid + i) * SC_LD + lane * 8) = w;
                }
                {
                    const int rrow = 4 * wid + (lane >> 4), c2 = (lane & 15) * 2;
                    const f32x2 v = *(const f32x2*)(rstg + d_g1 * 4096 + rrow * 128 + c2 * 4);
                    *(unsigned*)(rb + c3_g1 * 32 * SR_LD + rrow * SR_LD + c2 * 2) = cvtpk(v[0], v[1]);
                }
                asm volatile("" ::: "memory");
                if (g + 1 + SB_D < SB_NG) issue(g + 1 + SB_D, d_g1);
            }
            if (g >= 0 && g < SB_NG) {
#pragma unroll
                for (int mt2 = 0; mt2 < 2; ++mt2) {
                    f32x4 a[4];
#pragma unroll
                    for (int nt = 0; nt < 4; ++nt) a[nt] = (f32x4){0.f, 0.f, 0.f, 0.f};
                    const char* xs = cb + c3_g * SB_CB_SLOT + (16 * mt2 + lr) * SC_LD + lg * 16;
                    const bf16x8 rf = *(const bf16x8*)(rb + c3_g * 32 * SR_LD + (16 * mt2 + lr) * SR_LD + lg * 16);
#pragma unroll
                    for (int ks = 0; ks < 8; ++ks) {
                        const bf16x8 xf = *(const bf16x8*)(xs + ks * 64);
#pragma unroll
                        for (int nt = 0; nt < 4; ++nt) a[nt] = mfma16(wf[nt][ks], xf, a[nt]);
                    }
                    const f32x4 z4 = {0.f, 0.f, 0.f, 0.f};
                    const f32x4 asr = mfma16(qrf, rf, z4);
                    const f32x4 arr = mfma16(rf, rf, z4);
                    const float srv = (hsel == 0) ? asr[0] : (hsel == 1) ? asr[1] : (hsel == 2) ? asr[2] : asr[3];
                    const int dj = lr & 3;
                    const float rrv = (dj == 0) ? arr[0] : (dj == 1) ? arr[1] : (dj == 2) ? arr[2] : arr[3];
                    float ss = rrv * fdg, sq = srv * fhg;
#pragma unroll
                    for (int nt = 0; nt < 4; ++nt)
#pragma unroll
                        for (int j = 0; j < 4; ++j) { ss += a[nt][j] * a[nt][j]; sq += a[nt][j] * qg[nt][j]; }
                    ss = xsum16_32(ss); sq = xsum16_32(sq);
                    const float sc = sq * __builtin_amdgcn_rsqf(ss * (1.0f / 96.0f) + EPSF);
                    const float pe = __builtin_amdgcn_exp2f(sc - Mb);
                    lacc += pe;
                    if (lg == 0) *(bf16_t*)(pl + (g & 1) * 1024 + h * 64 + (16 * mt2 + lr) * 2) = f2bf(pe);
                }
            }
            if (g >= 1) {
                const bf16x8 xf = *(const bf16x8*)(pl + ((g - 1) & 1) * 1024 + lr * 64 + lg * 16);
#pragma unroll
                for (int q = 0; q < 2; ++q) {
                    const char* cc = cb + c3_gm1 * SB_CB_SLOT + (8 * lg + (lr >> 2)) * SC_LD + (32 * wid + 16 * q + 4 * (lr & 3)) * 2;
                    const v4i16_t t0 = __builtin_amdgcn_ds_read_tr16_b64_v4i16((__attribute__((address_space(3))) v4i16_t*)(cc));
                    const v4i16_t t1 = __builtin_amdgcn_ds_read_tr16_b64_v4i16((__attribute__((address_space(3))) v4i16_t*)(cc + 4 * SC_LD));
                    const bf16x8 wfr = {t0[0], t0[1], t0[2], t0[3], t1[0], t1[1], t1[2], t1[3]};
                    accl[q] = mfma16(wfr, xf, accl[q]);
                }
            }
            c3_g = c3_g1;
            d_g1 = (d_g1 + 1 == SB_D) ? 0 : d_g1 + 1;
        }
        if (lr < 8) {
#pragma unroll
            for (int q = 0; q < 2; ++q) *(f32x4*)(p.PART + ((size_t)(b * 8 + split) * 8 + lr) * 256 + 32 * wid + 16 * q + 4 * lg) = accl[q];
        }
        lacc += __shfl_xor(lacc, 8); lacc += __shfl_xor(lacc, 4); lacc += __shfl_xor(lacc, 2); lacc += __shfl_xor(lacc, 1);
        if (lane == 0) p.PL[(b * 8 + split) * 8 + h] = lacc;
        __syncthreads();
    }
}

__device__ __forceinline__ void phase3(const Params& p, char* lds) {
    hgrn_passB(p);
    sample_attn4(p, lds);
}

__device__ __forceinline__ void sample_combine(const Params& p, char* lds) {
    const int tid = threadIdx.x;
    float* ol = (float*)lds;
    float* red = ol + 256;
    float* sc = red + 512;
    for (int u = blockIdx.x; u < DEC_BATCH * 8; u += gridDim.x) {
        const int b = u >> 3, h = u & 7;
        if (tid < 64) {
            const float* kraw = p.KSRAW + (size_t)(b * 8 + h) * 96;
            const float* qs = p.QS + (size_t)(b * 8 + h) * 96;
            float ss = 0.f, sq = 0.f;
            for (int d = tid; d < 96; d += 64) { const float k = kraw[d]; ss += k * k; sq += k * qs[d]; }
            ss = wave_sum(ss); sq = wave_sum(sq);
            if (tid == 0) {
                const float s = sq / sqrtf(ss * (1.0f / 96.0f) + EPSF);
                const float pn = __expf(s - p.SCAL[0]);
                float l = pn;
                for (int sp = 0; sp < 8; ++sp) l += p.PL[(b * 8 + sp) * 8 + h];
                sc[0] = pn; sc[1] = 1.0f / l;
            }
        }
        __syncthreads();
        if (tid < 256) {
            const int c = tid;
            float a = sc[0] * p.out[OFF_LAT_S + b * 256 + c];
#pragma unroll
            for (int sp = 0; sp < 8; ++sp) a += p.PART[((size_t)(b * 8 + sp) * 8 + h) * 256 + c];
            ol[c] = a * sc[1];
        }
        __syncthreads();
        {
            const int d = tid & 63, part = tid >> 6;
            const bf16_t* wrow = p.WUKV_T + (size_t)(512 + h * 64 + d) * 256 + part * 32;
            float a = 0.f;
#pragma unroll
            for (int c = 0; c < 32; c += 8) {
                const u32x4 w = *(const u32x4*)(wrow + c);
                const f32x4 o0 = *(const f32x4*)(ol + part * 32 + c), o1 = *(const f32x4*)(ol + part * 32 + c + 4);
                a += o0[0] * bflo(w[0]) + o0[1] * bfhi(w[0]) + o0[2] * bflo(w[1]) + o0[3] * bfhi(w[1]) + o1[0] * bflo(w[2]) + o1[1] * bfhi(w[2]) + o1[2] * bflo(w[3]) + o1[3] * bfhi(w[3]);
            }
            red[part * 64 + d] = a;
        }
        __syncthreads();
        if (tid < 64) {
            float a = 0.f;
#pragma unroll
            for (int q = 0; q < 8; ++q) a += red[q * 64 + tid];
            const float ga = bf2f(p.PBUF[(size_t)(R_PROMPT + b) * IN_COLS_PAD + C_GA + h * 64 + tid]);
            p.AMA[(size_t)(NQ + b) * 512 + h * 64 + tid] = f2bf(a * ga);
        }
        __syncthreads();
    }
}

__device__ __forceinline__ void merge_m_gemm(const Params& p, char* lds) {
    const int bx = blockIdx.x, vcu = (bx & 7) * 32 + (bx >> 3);
    OneTileOrder S{vcu, 1};
    {
        pg8::Gemm g{p.AMA, p.WOA_T, NQ, 1024, 512, p.AMA, p.WOA_T};
        EpiMerge<0> E{p.PBUF, p.TMP, p.MM};
        pg8::gemm_phase<EpiMerge<0>, OneTileOrder, false, true>((PG8_LAS unsigned char*)lds, g, S, E);
    }
    {
        pg8::Gemm g{p.AMB, p.WOB_T, NQ, 1024, 512, p.AMB, p.WOB_T};
        EpiMerge<1> E{p.PBUF, p.TMP, p.MM};
        pg8::gemm_phase<EpiMerge<1>, OneTileOrder, false, true>((PG8_LAS unsigned char*)lds, g, S, E);
    }
}


__device__ __forceinline__ float dot_bf16_row(const bf16_t* a, const bf16_t* w, int K) {
    float s = 0.f;
    for (int k = 0; k < K; k += 8) {
        const u32x4 x = *(const u32x4*)(a + k), y = *(const u32x4*)(w + k);
#pragma unroll
        for (int e = 0; e < 4; ++e) s += bflo(x[e]) * bflo(y[e]) + bfhi(x[e]) * bfhi(y[e]);
    }
    return s;
}
__device__ __forceinline__ void rows32_tile(f32x4 (&acc)[2], const bf16_t* __restrict__ X, int ldx, const bf16_t* __restrict__ W, int K, int nt) {
    const int lane = threadIdx.x & 63, lr = lane & 15, lg = lane >> 4;
    const bf16_t* x0 = X + (size_t)lr * ldx + lg * 8;
    const bf16_t* x1 = X + (size_t)(16 + lr) * ldx + lg * 8;
    const bf16_t* w = W + (size_t)(nt * 16 + lr) * K + lg * 8;
#pragma unroll 8
    for (int ks = 0; ks < (K >> 5); ++ks) {
        const bf16x8 wf = *(const bf16x8*)(w + ks * 32);
        acc[0] = mfma16(wf, *(const bf16x8*)(x0 + ks * 32), acc[0]);
        acc[1] = mfma16(wf, *(const bf16x8*)(x1 + ks * 32), acc[1]);
    }
}
template <int KSTEPS_PER_WAVE>
__device__ __forceinline__ void rows32_tile_ksplit(f32x4 (&acc)[2], const bf16_t* __restrict__ X, int ldx, const bf16_t* __restrict__ W, int K, int nt, int wid) {
    const int lane = threadIdx.x & 63, lr = lane & 15, lg = lane >> 4;
    const int ks0 = wid * KSTEPS_PER_WAVE;
    const bf16_t* x0 = X + (size_t)lr * ldx + lg * 8 + ks0 * 32;
    const bf16_t* x1 = X + (size_t)(16 + lr) * ldx + lg * 8 + ks0 * 32;
    const bf16_t* w = W + (size_t)(nt * 16 + lr) * K + lg * 8 + ks0 * 32;
    bf16x8 wf[KSTEPS_PER_WAVE], xa[KSTEPS_PER_WAVE], xb[KSTEPS_PER_WAVE];
#pragma unroll
    for (int ks = 0; ks < KSTEPS_PER_WAVE; ++ks) { wf[ks] = *(const bf16x8*)(w + ks * 32); xa[ks] = *(const bf16x8*)(x0 + ks * 32); xb[ks] = *(const bf16x8*)(x1 + ks * 32); }
#pragma unroll
    for (int ks = 0; ks < KSTEPS_PER_WAVE; ++ks) { acc[0] = mfma16(wf[ks], xa[ks], acc[0]); acc[1] = mfma16(wf[ks], xb[ks], acc[1]); }
}
__device__ __forceinline__ void sample_m(const Params& p, char* lds) {
    const int tid = threadIdx.x, lane = tid & 63, wid = tid >> 6, lr = lane & 15, lg = lane >> 4;
    f32x4* red = (f32x4*)lds;
    for (int nt = blockIdx.x; nt < 64; nt += gridDim.x) {
        f32x4 ya[2] = {{0.f, 0.f, 0.f, 0.f}, {0.f, 0.f, 0.f, 0.f}}, yb[2] = {{0.f, 0.f, 0.f, 0.f}, {0.f, 0.f, 0.f, 0.f}};
        rows32_tile_ksplit<2>(ya, p.AMA + (size_t)NQ * 512, 512, p.WOA_T, 512, nt, wid);
        rows32_tile_ksplit<2>(yb, p.AMB + (size_t)NQ * 512, 512, p.WOB_T, 512, nt, wid);
        red[(wid * 4 + 0) * 64 + lane] = ya[0]; red[(wid * 4 + 1) * 64 + lane] = ya[1];
        red[(wid * 4 + 2) * 64 + lane] = yb[0]; red[(wid * 4 + 3) * 64 + lane] = yb[1];
        __syncthreads();
        if (wid == 0) {
#pragma unroll
            for (int q = 1; q < 8; ++q) { ya[0] += red[(q * 4 + 0) * 64 + lane]; ya[1] += red[(q * 4 + 1) * 64 + lane]; yb[0] += red[(q * 4 + 2) * 64 + lane]; yb[1] += red[(q * 4 + 3) * 64 + lane]; }
#pragma unroll
            for (int mt = 0; mt < 2; ++mt) {
                const int i = 16 * mt + lr, n = 16 * nt + 4 * lg;
                const size_t r = R_PROMPT + i;
                const u32x2 ga = *(const u32x2*)(p.PBUF + r * IN_COLS_PAD + C_MA + n);
                const u32x2 gb = *(const u32x2*)(p.PBUF + r * IN_COLS_PAD + C_MB + n);
                u32x2 w;
                w[0] = cvtpk(bflo(ga[0]) * ya[mt][0] + bflo(gb[0]) * yb[mt][0], bfhi(ga[0]) * ya[mt][1] + bfhi(gb[0]) * yb[mt][1]);
                w[1] = cvtpk(bflo(ga[1]) * ya[mt][2] + bflo(gb[1]) * yb[mt][2], bfhi(ga[1]) * ya[mt][3] + bfhi(gb[1]) * yb[mt][3]);
                *(u32x2*)(p.MM + (size_t)(NQ + i) * 1024 + n) = w;
            }
        }
        __syncthreads();
    }
}
__device__ __forceinline__ void final_gemm(const Params& p, char* lds) {
    const int bx = blockIdx.x, vcu = (bx & 7) * 32 + (bx >> 3);
    pg8::Gemm g{p.MM, p.WO_T, NQ, 1024, 1024, p.MM, p.WO_T};
    OneTileOrder S{vcu, 1};
    EpiFinal E{p.x_prompt, p.out + OFF_Y_P};
    pg8::gemm_phase<EpiFinal, OneTileOrder, false, true>((PG8_LAS unsigned char*)lds, g, S, E);
}


__device__ __forceinline__ void sample_y(const Params& p, char* lds) {
    const int tid = threadIdx.x, lane = tid & 63, wid = tid >> 6, lr = lane & 15, lg = lane >> 4;
    f32x4* red = (f32x4*)lds;
    for (int nt = blockIdx.x; nt < 64; nt += gridDim.x) {
        f32x4 y[2] = {{0.f, 0.f, 0.f, 0.f}, {0.f, 0.f, 0.f, 0.f}};
        rows32_tile_ksplit<4>(y, p.MM + (size_t)NQ * 1024, 1024, p.WO_T, 1024, nt, wid);
        red[(wid * 2 + 0) * 64 + lane] = y[0]; red[(wid * 2 + 1) * 64 + lane] = y[1];
        __syncthreads();
        if (wid == 0) {
#pragma unroll
            for (int q = 1; q < 8; ++q) { y[0] += red[(q * 2 + 0) * 64 + lane]; y[1] += red[(q * 2 + 1) * 64 + lane]; }
#pragma unroll
            for (int mt = 0; mt < 2; ++mt) {
                const int i = 16 * mt + lr, n = 16 * nt + 4 * lg;
                const f32x4 x = *(const f32x4*)(p.x_sample + (size_t)i * 1024 + n);
                *(f32x4*)(p.out + OFF_Y_S + (size_t)i * 1024 + n) = x + y[mt];
            }
        }
        __syncthreads();
    }
}

__device__ __forceinline__ void phase4(const Params& p, char* lds) {
    sample_combine(p, lds);
    attn_phase(p, lds);
    hgrn_passC(p, lds);
}
__device__ __forceinline__ void phase5(const Params& p, char* lds) {
    sample_m(p, lds);
    merge_m_gemm(p, lds);
}
__device__ __forceinline__ void phase6(const Params& p, char* lds) {
    sample_y(p, lds);
    final_gemm(p, lds);
}

#define XB_TMO      128
#define XB_XCNT(j)  (256  + 64 * (j))
#define XB_XSUB(j)  (1280 + 64 * (j))
#define XB_XGEN(j)  (2304 + 64 * (j))
#define XB_TOP      3328
#define XB_TOPGEN   3392
#define XCD_BAR_WORDS 3456
#define XB_SPIN_CAP (1u << 22)
#define LAS __attribute__((address_space(3)))
__device__ __forceinline__ unsigned xb_ld(unsigned* p)              { return __hip_atomic_load(p, __ATOMIC_RELAXED, __HIP_MEMORY_SCOPE_AGENT); }
__device__ __forceinline__ unsigned xb_add(unsigned* p, unsigned v) { return __hip_atomic_fetch_add(p, v, __ATOMIC_RELAXED, __HIP_MEMORY_SCOPE_AGENT); }
__device__ __forceinline__ unsigned xb_xcc_id() { return (unsigned)__builtin_amdgcn_s_getreg((3 << 11) | 20) & 0xFu; }
#define XB_SPIN(cond, bar) do { unsigned _sp = 0; while (cond) { __builtin_amdgcn_s_sleep(1); \
    if ((++_sp & 255u) == 0u) { if (xb_ld(&(bar)[XB_TMO])) break; if (_sp > XB_SPIN_CAP) { atomicAdd(&(bar)[XB_TMO], 1u); break; } } } } while (0)
struct XcdBarrier { unsigned* bar; unsigned x; volatile LAS unsigned* st; };
__device__ __forceinline__ XcdBarrier xcd_barrier_post(unsigned* bar, volatile LAS unsigned* st) {
    XcdBarrier b; b.bar = bar; b.x = xb_xcc_id(); b.st = st;
    if (threadIdx.x == 0) (void)xb_add(&bar[XB_XCNT(b.x)], 1u);
    return b;
}
__device__ __forceinline__ void xcd_barrier_complete(unsigned* bar, unsigned x, unsigned& nloc, unsigned& nx) {
    const unsigned G = gridDim.x * gridDim.y * gridDim.z;
    unsigned sum, cnt, mine, sp = 0u;
    for (;;) {
        sum = 0u; cnt = 0u; mine = 0u;
#pragma unroll
        for (unsigned j = 0; j < 16; ++j) { const unsigned c = xb_ld(&bar[XB_XCNT(j)]); sum += c; cnt += (c > 0u) ? 1u : 0u; mine = (j == x) ? c : mine; }
        if (sum == G) break;
        __builtin_amdgcn_s_sleep(1);
        if ((++sp & 255u) == 0u) { if (xb_ld(&bar[XB_TMO])) break; if (sp > XB_SPIN_CAP) { atomicAdd(&bar[XB_TMO], 1u); break; } }
    }
    nloc = mine > 0u ? mine : 1u; nx = cnt > 0u ? cnt : 1u;
}
__device__ __forceinline__ void xcd_barrier(const XcdBarrier& b) {
    asm volatile("s_waitcnt vmcnt(0)" ::: "memory");
    __syncthreads();
    if (threadIdx.x == 0) {
        unsigned* bar = b.bar;
        __builtin_amdgcn_s_waitcnt(0);
        unsigned nloc = b.st[0], nx = b.st[1];
        if (nloc == 0u) { xcd_barrier_complete(bar, b.x, nloc, nx); b.st[0] = nloc; b.st[1] = nx; }
        const unsigned old = xb_add(&bar[XB_XSUB(b.x)], 1u);
        const unsigned gen = old / nloc;
        if (old + 1u == (gen + 1u) * nloc) {
            __builtin_amdgcn_fence(__ATOMIC_RELEASE, "agent");
            asm volatile("s_waitcnt vmcnt(0)" ::: "memory");
            const unsigned og = xb_add(&bar[XB_TOP], 1u);
            const unsigned tg = og / nx;
            if (og + 1u == (tg + 1u) * nx) xb_add(&bar[XB_TOPGEN], 1u);
            else XB_SPIN(xb_ld(&bar[XB_TOPGEN]) == tg, bar);
            __builtin_amdgcn_fence(__ATOMIC_ACQUIRE, "agent");
            xb_add(&bar[XB_XGEN(b.x)], 1u);
            asm volatile("s_waitcnt vmcnt(0)" ::: "memory");
        } else {
            XB_SPIN(xb_ld(&bar[XB_XGEN(b.x)]) == gen, bar);
            __builtin_amdgcn_fence(__ATOMIC_ACQUIRE, "agent");
            asm volatile("s_waitcnt vmcnt(0)" ::: "memory");
        }
    }
    __syncthreads();
}

extern __shared__ __attribute__((aligned(16))) char smem[];
#define NPHASES 7

#define XB_LDS_OFF (LDS_BYTES - 16)
__global__ void __launch_bounds__(NTHREADS) mega(Params p, int ph0, int ph1) {
    XcdBarrier xb;
    const bool multi = (ph1 - ph0) > 1;
    if (multi) {
        if (threadIdx.x == 0) *(u32x4*)(smem + XB_LDS_OFF) = (u32x4){0u, 0u, 0u, 0u};
        __syncthreads();
        xb = xcd_barrier_post(p.bar, (volatile LAS unsigned*)(smem + XB_LDS_OFF));
    }
#if defined(__HIP_DEVICE_COMPILE__)
    typedef const __attribute__((address_space(4))) Params* cparams_t;
    const cparams_t kp = (cparams_t)__builtin_amdgcn_kernarg_segment_ptr();
#define RUN_PHASE(k) if (ph0 <= k && k < ph1) { cparams_t q_ = kp; asm volatile("" : "+s"(q_)); const Params lp_ = *q_; phase##k(lp_, smem); if (k + 1 < ph1) xcd_barrier(xb); }
#else
#define RUN_PHASE(k) if (ph0 <= k && k < ph1) { phase##k(p, smem); if (k + 1 < ph1) xcd_barrier(xb); }
#endif
    RUN_PHASE(0)
    RUN_PHASE(1)
    RUN_PHASE(2)
    RUN_PHASE(3)
    RUN_PHASE(4)
    RUN_PHASE(5)
    RUN_PHASE(6)
}

static inline size_t align_up(size_t x, size_t a) { return (x + a - 1) / a * a; }

extern "C" void kernel_launch(void* const* d_in, const int* in_sizes, int n_in,
                              void* d_out, int out_size, void* d_ws, size_t ws_size,
                              hipStream_t stream) {
    Params p{};
    p.x_prompt = (const float*)d_in[0]; p.x_sample = (const float*)d_in[1]; p.cache_latent = (const float*)d_in[2]; p.cache_krope = (const float*)d_in[3];
    p.state_hgrn = (const float*)d_in[4]; p.page_table = (const int*)d_in[5]; p.meta = (const float*)d_in[6]; p.norm_g = (const float*)d_in[7];
    p.w_in = (const float*)d_in[8]; p.g_cq = (const float*)d_in[9]; p.w_uq = (const float*)d_in[10]; p.g_ckv = (const float*)d_in[11];
    p.w_uk = (const float*)d_in[12]; p.w_uv = (const float*)d_in[13]; p.g_qn = (const float*)d_in[14]; p.g_kn = (const float*)d_in[15];
    p.lb_logits = (const float*)d_in[16]; p.g_bn = (const float*)d_in[17]; p.w_oa = (const float*)d_in[18]; p.w_ob = (const float*)d_in[19]; p.w_o = (const float*)d_in[20];
    p.out = (float*)d_out;
    char* w = (char*)d_ws; size_t off = 0;
    auto take = [&](size_t bytes) { char* r = w + off; off = align_up(off + bytes, 256); return r; };
    p.bar    = (unsigned*)take(16384);
    p.XN     = (bf16_t*)take((size_t)R_PAD * 1024 * 2);
    p.WIN_T  = (bf16_t*)take((size_t)IN_COLS_PAD * 1024 * 2);
    p.PBUF   = (bf16_t*)take((size_t)R_PAD * IN_COLS_PAD * 2);
    p.F32A   = (float*)take((size_t)R_PAD * 672 * 4);
    p.GLOG   = (float*)take((size_t)R_PAD * 512 * 4);
    p.CQN    = (bf16_t*)take((size_t)R_PAD * 384 * 2);
    p.CKVN   = (bf16_t*)take((size_t)R_PAD * 256 * 2);
    p.KRR    = (float*)take((size_t)R_PAD * 32 * 4);
    p.WUQ_T  = (bf16_t*)take((size_t)768 * 384 * 2);
    p.WUKV_T = (bf16_t*)take((size_t)1024 * 256 * 2);
    p.WUKVG_T = (bf16_t*)take((size_t)1024 * 256 * 2);
    p.F32B   = (float*)take((size_t)R_PAD * 288 * 4);
    p.WOA_T  = (bf16_t*)take((size_t)1024 * 512 * 2);
    p.WOB_T  = (bf16_t*)take((size_t)1024 * 512 * 2);
    p.WO_T   = (bf16_t*)take((size_t)1024 * 1024 * 2);
    p.QRAW   = (bf16_t*)take((size_t)R_PAD * 768 * 2);
    p.KVRAW  = (bf16_t*)take((size_t)R_PAD * 1024 * 2);
    p.QA     = (bf16_t*)take((size_t)8 * 8 * 2048 * 96 * 2);
    p.KA     = (bf16_t*)take((size_t)8 * 8 * 2064 * 96 * 2 + 65536);
    p.VTG    = (bf16_t*)take((size_t)64 * 64 * 2112 * 2);
    p.QS     = (float*)take((size_t)32 * 8 * 96 * 4);
    p.KSRAW  = (float*)take((size_t)32 * 8 * 96 * 4);
    p.AMA    = (bf16_t*)take((size_t)MROWS_PAD * 512 * 2);
    p.AMB    = (bf16_t*)take((size_t)MROWS_PAD * 512 * 2);
    p.MM     = (bf16_t*)take((size_t)MROWS_PAD * 1024 * 2);
    p.TMP    = (float*)take((size_t)NQ * 1024 * 4);
    p.UT     = (bf16_t*)take((size_t)32 * NCHUNK * 16384 * 2);
    p.ST     = (bf16_t*)take((size_t)32 * NCHUNK * 16384 * 2);
    p.DEC    = (float*)take((size_t)32 * NCHUNK * 128 * 4);
    p.LB     = (float*)take(512 * 4);
    p.INV    = (float*)take(64);
    p.ROPE   = (float*)take((size_t)2065 * 32 * 4);
    p.SCAL   = (float*)take(64);
    p.PART   = (float*)take((size_t)32 * 8 * 8 * 256 * 4);
    p.PL     = (float*)take((size_t)32 * 8 * 8 * 4);
    p.OLAT   = (float*)take((size_t)32 * 8 * 256 * 4);
    (void)ws_size; (void)in_sizes; (void)n_in; (void)out_size;
    static int mode = -1;
    if (mode < 0) {
        (void)hipFuncSetAttribute((const void*)mega, hipFuncAttributeMaxDynamicSharedMemorySize, LDS_BYTES);
        int dev = 0, cus = 0, per_cu = 0;
        (void)hipGetDevice(&dev);
        (void)hipDeviceGetAttribute(&cus, hipDeviceAttributeMultiprocessorCount, dev);
        (void)hipOccupancyMaxActiveBlocksPerMultiprocessor(&per_cu, (const void*)mega, NTHREADS, LDS_BYTES);
        mode = (cus * per_cu >= 256) ? 1 : 0;
    }
    (void)hipMemsetAsync(p.bar, 0, 16384, stream);
    if (mode == 1) {
        mega<<<dim3(256), dim3(NTHREADS), LDS_BYTES, stream>>>(p, 0, NPHASES);
    } else {
        for (int ph = 0; ph < NPHASES; ++ph) mega<<<dim3(256), dim3(NTHREADS), LDS_BYTES, stream>>>(p, ph, ph + 1);
    }
}
```

```cpp
#include <hip/hip_runtime.h>
#include <stdint.h>

#define D_MODEL 1024
#define BATCH 8
#define SEQ 2048
#define NMETA 16
#define LTOT 2064
#define DEC_BATCH 32
#define PAST_LEN 16384
#define PAGE 128
#define NPAGES 128
#define A_HEADS 8
#define A_NOPE 64
#define A_ROPE 32
#define A_QK 96
#define A_V 64
#define Q_LORA 384
#define KV_LORA 256
#define B_HEADS 4
#define B_DK 128
#define B_DV 128
#define IN_COLS 5280
#define IN_COLS_PAD 5376
#define EPSF 1e-6f

#define C_CQ 0
#define C_CKV 384
#define C_KR 640
#define C_BQ 672
#define C_BF 1184
#define C_BI 1696
#define C_GA 2208
#define C_GB 2720
#define C_MA 3232
#define C_MB 4256
#define C_END 5280

#define R_PROMPT 16512
#define R_ALL 16544
#define R_PAD 16640
#define NQ 16384
#define MROWS 16416
#define MROWS_PAD 16512

#define OFF_Y_P 0
#define OFF_Y_S 16777216
#define OFF_LAT_P 16809984
#define OFF_KR_P 21037056
#define OFF_HG_P 21565440
#define OFF_LAT_S 22089728
#define OFF_KR_S 22097920
#define OFF_HG_S 22098944
#define OUT_TOTAL 24196096

#define NTHREADS 512
#define LDS_BYTES 155648
#define LDS_ITEM_OFF (LDS_BYTES - 32)
#define NCHUNK 33

typedef unsigned short bf16_t;
typedef short bf16x8 __attribute__((ext_vector_type(8)));
typedef float f32x4 __attribute__((ext_vector_type(4)));
typedef float f32x2 __attribute__((ext_vector_type(2)));
typedef unsigned u32x4 __attribute__((ext_vector_type(4)));
typedef unsigned u32x2 __attribute__((ext_vector_type(2)));
typedef __bf16 bf16x2_t __attribute__((ext_vector_type(2)));

__device__ __forceinline__ unsigned cvtpk(float lo, float hi) {
    f32x2 v = {lo, hi};
    bf16x2_t b = __builtin_convertvector(v, bf16x2_t);
    return __builtin_bit_cast(unsigned, b);
}
__device__ __forceinline__ bf16_t f2bf(float x) { return (bf16_t)(cvtpk(x, 0.f) & 0xffffu); }
__device__ __forceinline__ float bf2f(bf16_t u) { return __uint_as_float(((unsigned)u) << 16); }
__device__ __forceinline__ float bflo(unsigned w) { return __uint_as_float(w << 16); }
__device__ __forceinline__ float bfhi(unsigned w) { return __uint_as_float(w & 0xffff0000u); }
__device__ __forceinline__ float sigmoidf_(float x) { return __builtin_amdgcn_rcpf(1.0f + __expf(-x)); }
__device__ __forceinline__ float siluf_(float x) { return x * __builtin_amdgcn_rcpf(1.0f + __expf(-x)); }
__device__ __forceinline__ float wave_sum(float v) {
    v += __shfl_xor(v, 32); v += __shfl_xor(v, 16); v += __shfl_xor(v, 8);
    v += __shfl_xor(v, 4);  v += __shfl_xor(v, 2);  v += __shfl_xor(v, 1);
    return v;
}

struct Params {
    const float* x_prompt; const float* x_sample; const float* cache_latent; const float* cache_krope;
    const float* state_hgrn; const int* page_table; const float* meta; const float* norm_g;
    const float* w_in; const float* g_cq; const float* w_uq; const float* g_ckv; const float* w_uk; const float* w_uv;
    const float* g_qn; const float* g_kn; const float* lb_logits; const float* g_bn;
    const float* w_oa; const float* w_ob; const float* w_o;
    float* out;
    bf16_t* XN;
    bf16_t* WIN_T;
    bf16_t* PBUF;
    float*  F32A;
    float*  GLOG;
    bf16_t* CQN;
    bf16_t* CKVN;
    float*  KRR;
    bf16_t* WUQ_T;
    bf16_t* WUKV_T;
    bf16_t* WUKVG_T;
    float*  F32B;
    bf16_t* WOA_T;
    bf16_t* WOB_T;
    bf16_t* WO_T;
    bf16_t* QRAW;
    bf16_t* KVRAW;
    bf16_t* QA;
    bf16_t* KA;
    bf16_t* VTG;
    float*  QS;
    float*  KSRAW;
    bf16_t* AMA;
    bf16_t* AMB;
    bf16_t* MM;
    float*  TMP;
    bf16_t* UT;
    bf16_t* ST;
    float*  DEC;
    float*  LB;
    float*  INV;
    float*  ROPE;
    float*  SCAL;
    float*  PART;
    float*  PL;
    float*  OLAT;
    unsigned* bar;
};

__device__ __forceinline__ f32x4 mfma16(bf16x8 w, bf16x8 x, f32x4 acc) {
    return __builtin_amdgcn_mfma_f32_16x16x32_bf16(w, x, acc, 0, 0, 0);
}

#define GT_LD 144
#define GT_BUF (128 * GT_LD)
#define GT_LDS_BYTES (4 * GT_BUF)

__device__ __forceinline__ void gemm_tile_accum(f32x4 (&acc)[4][2], const bf16_t* __restrict__ X, int ldx, const bf16_t* __restrict__ W, int ldw,
                                                int K, char* lds) {
    const int tid = threadIdx.x, lane = tid & 63, wid = tid >> 6, wm = wid >> 2, wn = wid & 3;
    const int lr = lane & 15, lg = lane >> 4;
    const int r0 = tid >> 3, kc = tid & 7;
    const bf16_t* xp0 = X + (size_t)r0 * ldx + kc * 8;
    const bf16_t* xp1 = X + (size_t)(r0 + 64) * ldx + kc * 8;
    const bf16_t* wp0 = W + (size_t)r0 * ldw + kc * 8;
    const bf16_t* wp1 = W + (size_t)(r0 + 64) * ldw + kc * 8;
    const int so0 = r0 * GT_LD + kc * 16, so1 = (r0 + 64) * GT_LD + kc * 16;
    char* Xs = lds; char* Ws = lds + 2 * GT_BUF;
    const int nk = K >> 6;
    u32x4 a0 = *(const u32x4*)xp0, a1 = *(const u32x4*)xp1, b0 = *(const u32x4*)wp0, b1 = *(const u32x4*)wp1;
    *(u32x4*)(Xs + so0) = a0; *(u32x4*)(Xs + so1) = a1; *(u32x4*)(Ws + so0) = b0; *(u32x4*)(Ws + so1) = b1;
    __syncthreads();
    const int xoff = (wm * 64 + lr) * GT_LD + lg * 16;
    const int woff = (wn * 32 + lr) * GT_LD + lg * 16;
    for (int kt = 0; kt < nk; ++kt) {
        const int cur = kt & 1;
        if (kt + 1 < nk) {
            const int ko = (kt + 1) * 64;
            a0 = *(const u32x4*)(xp0 + ko); a1 = *(const u32x4*)(xp1 + ko); b0 = *(const u32x4*)(wp0 + ko); b1 = *(const u32x4*)(wp1 + ko);
        }
        const char* xs = Xs + cur * GT_BUF + xoff;
        const char* ws = Ws + cur * GT_BUF + woff;
#pragma unroll
        for (int ks = 0; ks < 2; ++ks) {
            bf16x8 xf[4], wf[2];
#pragma unroll
            for (int mt = 0; mt < 4; ++mt) xf[mt] = *(const bf16x8*)(xs + mt * 16 * GT_LD + ks * 64);
#pragma unroll
            for (int nt = 0; nt < 2; ++nt) wf[nt] = *(const bf16x8*)(ws + nt * 16 * GT_LD + ks * 64);
#pragma unroll
            for (int mt = 0; mt < 4; ++mt)
#pragma unroll
                for (int nt = 0; nt < 2; ++nt) acc[mt][nt] = mfma16(wf[nt], xf[mt], acc[mt][nt]);
        }
        if (kt + 1 < nk) {
            char* xd = Xs + (cur ^ 1) * GT_BUF; char* wd = Ws + (cur ^ 1) * GT_BUF;
            *(u32x4*)(xd + so0) = a0; *(u32x4*)(xd + so1) = a1; *(u32x4*)(wd + so0) = b0; *(u32x4*)(wd + so1) = b1;
        }
        __syncthreads();
    }
}

namespace pg8 {
#define PG8_LAS __attribute__((address_space(3)))
constexpr int BM = 256, BK = 64, HALF = 128, HTB = HALF * BK * 2  , STAGE_BYTES = 8 * HTB, NXCD = 8, WGM = 8;

__host__ __device__ __forceinline__ int lds_byte(int r, int c) { const int st = (r >> 4) * 2 + (c >> 5), rr = r & 15, cc = c & 31, ob = rr * 64 + cc * 2; return st * 1024 + (ob ^ (((ob >> 9) & 1) << 5)); }
__host__ __device__ __forceinline__ void stage_rc(int b, int& R, int& C) { const int st = b / 1024, sb = b % 1024, swz = sb ^ (((sb >> 9) & 1) << 5); R = (st >> 1) * 16 + swz / 64; C = (st & 1) * 32 + (swz % 64) / 2; }
__host__ __device__ __forceinline__ int perm32(int rho) { const int n = rho >> 4, i = rho & 15; return 8 * (i >> 2) + 4 * n + (i & 3); }

struct Unit { int pm, pn, sel; };
struct Gemm { const bf16_t* A; const bf16_t* Bt; int M, N, K; const bf16_t* A1; const bf16_t* Bt1; };

struct StaticOrder {
    int nM, nN, nwg, G, c;
    __host__ __device__ void init(int M, int N, int G_, int c_) { nM = M / BM; nN = N / BM; nwg = nM * nN; G = G_; c = c_; }
    __host__ __device__ bool next(int i, Unit& u) const {
        const long L = (long)i * G + c; if (L >= nwg) return false;
        int wgid = (int)L; { const int q = nwg / NXCD, r = nwg % NXCD, xcd = wgid % NXCD, off = wgid / NXCD; wgid = (xcd < r ? xcd * (q + 1) : r * (q + 1) + (xcd - r) * q) + off; }
        const int nig = WGM * nN, gid = wgid / nig, fm = gid * WGM, gsz = (nM - fm) < WGM ? (nM - fm) : WGM;
        u.pm = fm + ((wgid % nig) % gsz); u.pn = (wgid % nig) / gsz; u.sel = 0; return true;
    }
    __device__ __forceinline__ void a_ready(const Unit&) const {}
    __device__ __forceinline__ void done(const Unit&) const {}
};


template <class Epi, class Sched, bool ALIGN_EPI = false, bool SP2 = false>
__device__ __forceinline__ void gemm_phase(PG8_LAS unsigned char* lds, const Gemm g, const Sched& S, const Epi& E) {
    const int tid = threadIdx.x, wid = __builtin_amdgcn_readfirstlane(tid >> 6), lane = tid & 63, wr = wid >> 2, wc = wid & 3, fr = lane & 15, fq = lane >> 4;
    const int K = g.K, nt = K / BK;
    unsigned voffA[2], voffB[2];
#pragma unroll
    for (int i = 0; i < 2; ++i) { int R, C; stage_rc(tid * 16 + i * 8192, R, C); const int Rb = Epi::PERM ? ((R & ~31) + perm32(R & 31)) : R;
        voffA[i] = (unsigned)(R * K + C) * 2u; voffB[i] = (unsigned)(Rb * K + C) * 2u; }
    const size_t kstep = (size_t)(BK * 2);
    const size_t hstep = (size_t)HALF * K * 2;
    const size_t tstep = 2 * hstep;
    const unsigned ldsw = (unsigned)wid * 1024u;
    const int aoff = lds_byte(wr * 64 + fr, fq * 8), boff = lds_byte(wc * 32 + fr, fq * 8);
#define PG8_SA(b, h) (((b) * 2 + (h)) * HTB)
#define PG8_SB(b, h) ((4 + (b) * 2 + (h)) * HTB)
#define PG8_STAGE(bufoff, gbase, voff) do { _Pragma("unroll") for (int _i = 0; _i < 2; ++_i) \
        __builtin_amdgcn_global_load_lds((const unsigned*)((const char*)(gbase) + (voff)[_i]), (PG8_LAS unsigned*)(lds + (bufoff) + ldsw + _i * 8192), 16, 0, 0); } while (0)
#define PG8_LDA(dst, b, h) do { _Pragma("unroll") for (int m = 0; m < 4; ++m) _Pragma("unroll") for (int k = 0; k < 2; ++k) dst[m][k] = *(const PG8_LAS bf16x8*)(lds + PG8_SA(b, h) + aoff + m * 2048 + k * 1024); } while (0)
#define PG8_LDB(dst, b, h) do { _Pragma("unroll") for (int n = 0; n < 2; ++n) _Pragma("unroll") for (int k = 0; k < 2; ++k) dst[n][k] = *(const PG8_LAS bf16x8*)(lds + PG8_SB(b, h) + boff + n * 2048 + k * 1024); } while (0)
#define PG8_MMA(ai, bj, At, Bt) do { __builtin_amdgcn_s_setprio(1); _Pragma("unroll") for (int m = 0; m < 4; ++m) _Pragma("unroll") for (int n = 0; n < 2; ++n) _Pragma("unroll") for (int k = 0; k < 2; ++k) \
        acc[ai][bj][m][n] = __builtin_amdgcn_mfma_f32_16x16x32_bf16(Bt[n][k], At[m][k], acc[ai][bj][m][n], 0, 0, 0); __builtin_amdgcn_s_setprio(0); } while (0)
#define PG8_WAIT_V(n) asm volatile("s_waitcnt vmcnt(" #n ")" ::: "memory")
#define PG8_WAIT_L(n) asm volatile("s_waitcnt lgkmcnt(" #n ")" ::: "memory")
#define PG8_BAR __builtin_amdgcn_s_barrier()
#define PG8_SCHED __builtin_amdgcn_sched_barrier(0)
    Unit cur, nxt; int ui = 0;
    if (!S.next(0, cur)) return;
    f32x4 acc[2][2][4][2];
#pragma unroll
    for (int a = 0; a < 2; ++a)
#pragma unroll
        for (int b = 0; b < 2; ++b)
#pragma unroll
            for (int m = 0; m < 4; ++m)
#pragma unroll
                for (int n = 0; n < 2; ++n) acc[a][b][m][n] = (f32x4){0.f, 0.f, 0.f, 0.f};
    bf16x8 At[4][2], B0[2][2], B1[2][2];
    const char* cA = (const char*)(cur.sel ? g.A1 : g.A) + (size_t)cur.pm * tstep; const char* cB = (const char*)(cur.sel ? g.Bt1 : g.Bt) + (size_t)cur.pn * tstep;
    S.a_ready(cur);
    if constexpr (SP2) {
        PG8_STAGE(PG8_SB(0, 0), cB, voffB); PG8_STAGE(PG8_SB(0, 1), cB + hstep, voffB); PG8_STAGE(PG8_SA(0, 0), cA, voffA); PG8_STAGE(PG8_SA(0, 1), cA + hstep, voffA);
        if (wr == 1) PG8_BAR;
        PG8_WAIT_V(2); PG8_BAR;
        PG8_STAGE(PG8_SB(1, 0), cB + kstep, voffB); PG8_STAGE(PG8_SA(1, 0), cA + kstep, voffA); PG8_STAGE(PG8_SB(1, 1), cB + hstep + kstep, voffB);
        PG8_WAIT_V(6); PG8_BAR;
    } else {
        PG8_STAGE(PG8_SB(0, 0), cB, voffB); PG8_STAGE(PG8_SA(0, 0), cA, voffA); PG8_STAGE(PG8_SB(0, 1), cB + hstep, voffB); PG8_STAGE(PG8_SA(0, 1), cA + hstep, voffA);
        if (wr == 1) PG8_BAR;
        PG8_WAIT_V(4); PG8_BAR;
        PG8_STAGE(PG8_SB(1, 0), cB + kstep, voffB); PG8_STAGE(PG8_SA(1, 0), cA + kstep, voffA); PG8_STAGE(PG8_SB(1, 1), cB + hstep + kstep, voffB);
        PG8_WAIT_V(6); PG8_BAR;
    }
    for (;;) {
        const bool has_next = S.next(ui + 1, nxt);
        const char* nA = has_next ? (const char*)(nxt.sel ? g.A1 : g.A) + (size_t)nxt.pm * tstep : cA; const char* nB = has_next ? (const char*)(nxt.sel ? g.Bt1 : g.Bt) + (size_t)nxt.pn * tstep : cB;
        for (int t = 0; t < nt; t += 2) {
            const bool last = (t == nt - 2);
            const char* a1 = cA + (size_t)(t + 1) * kstep;
            const char* a2 = last ? nA : cA + (size_t)(t + 2) * kstep; const char* b2 = last ? nB : cB + (size_t)(t + 2) * kstep;
            const char* a3 = a2 + kstep; const char* b3 = b2 + kstep;
            if (last && has_next) S.a_ready(nxt);
            if constexpr (SP2) {
            PG8_LDB(B0, 0, 0); PG8_LDB(B1, 0, 1); PG8_SCHED; PG8_LDA(At, 0, 0); PG8_STAGE(PG8_SA(1, 1), a1 + hstep, voffA);
            PG8_WAIT_V(8); PG8_WAIT_L(0); PG8_BAR; PG8_MMA(0, 0, At, B0); PG8_MMA(0, 1, At, B1); PG8_BAR; PG8_SCHED;
            PG8_LDA(At, 0, 1); PG8_STAGE(PG8_SB(0, 0), b2, voffB); PG8_STAGE(PG8_SB(0, 1), b2 + hstep, voffB); PG8_STAGE(PG8_SA(0, 0), a2, voffA);
            PG8_WAIT_V(8); PG8_WAIT_L(0); PG8_BAR; PG8_MMA(1, 0, At, B0); PG8_MMA(1, 1, At, B1); PG8_BAR; PG8_SCHED;
            PG8_LDB(B0, 1, 0); PG8_LDB(B1, 1, 1); PG8_SCHED; PG8_LDA(At, 1, 0); PG8_STAGE(PG8_SA(0, 1), a2 + hstep, voffA);
            PG8_WAIT_V(8); PG8_WAIT_L(0); PG8_BAR; PG8_MMA(0, 0, At, B0); PG8_MMA(0, 1, At, B1); PG8_BAR; PG8_SCHED;
            PG8_LDA(At, 1, 1); PG8_STAGE(PG8_SB(1, 0), b3, voffB); PG8_STAGE(PG8_SB(1, 1), b3 + hstep, voffB); PG8_STAGE(PG8_SA(1, 0), a3, voffA);
            PG8_WAIT_V(8); PG8_WAIT_L(0); PG8_BAR; PG8_MMA(1, 0, At, B0); PG8_MMA(1, 1, At, B1); PG8_BAR; PG8_SCHED;
            } else {
            PG8_LDB(B0, 0, 0); PG8_SCHED; PG8_LDA(At, 0, 0); PG8_STAGE(PG8_SA(1, 1), a1 + hstep, voffA);
            PG8_WAIT_L(8); PG8_BAR; PG8_WAIT_L(0); PG8_MMA(0, 0, At, B0); PG8_BAR; PG8_SCHED;
            PG8_LDB(B1, 0, 1); PG8_STAGE(PG8_SB(0, 0), b2, voffB);
            PG8_BAR; PG8_WAIT_L(0); PG8_MMA(0, 1, At, B1); PG8_BAR;
            PG8_LDA(At, 0, 1); PG8_STAGE(PG8_SA(0, 0), a2, voffA);
            PG8_BAR; PG8_WAIT_L(0); PG8_MMA(1, 0, At, B0); PG8_BAR; PG8_SCHED;
            PG8_STAGE(PG8_SB(0, 1), b2 + hstep, voffB);
            PG8_WAIT_V(6); PG8_BAR; PG8_MMA(1, 1, At, B1); PG8_BAR;
            PG8_LDB(B0, 1, 0); PG8_SCHED; PG8_LDA(At, 1, 0); PG8_STAGE(PG8_SA(0, 1), a2 + hstep, voffA);
            PG8_WAIT_L(8); PG8_BAR; PG8_WAIT_L(0); PG8_MMA(0, 0, At, B0); PG8_BAR; PG8_SCHED;
            PG8_LDB(B1, 1, 1); PG8_STAGE(PG8_SB(1, 0), b3, voffB);
            PG8_BAR; PG8_WAIT_L(0); PG8_MMA(0, 1, At, B1); PG8_BAR;
            PG8_LDA(At, 1, 1); PG8_STAGE(PG8_SA(1, 0), a3, voffA);
            PG8_BAR; PG8_WAIT_L(0); PG8_MMA(1, 0, At, B0); PG8_BAR; PG8_SCHED;
            PG8_STAGE(PG8_SB(1, 1), b3 + hstep, voffB);
            PG8_WAIT_V(6); PG8_BAR; PG8_MMA(1, 1, At, B1); PG8_BAR;
            }
        }
        if constexpr (ALIGN_EPI) { if (wr == 0) PG8_BAR; }
        if constexpr (!Epi::AFTER_DRAIN) { E(acc, cur, wr, wc, fr, fq); S.done(cur); }
        if (!has_next) break;
        if (!Epi::keep(cur)) {
#pragma unroll
        for (int a = 0; a < 2; ++a)
#pragma unroll
            for (int b = 0; b < 2; ++b)
#pragma unroll
                for (int m = 0; m < 4; ++m)
#pragma unroll
                    for (int n = 0; n < 2; ++n) acc[a][b][m][n] = (f32x4){0.f, 0.f, 0.f, 0.f};
        }
        cur = nxt; cA = nA; cB = nB; ++ui;
        if constexpr (ALIGN_EPI) { if (wr == 1) PG8_BAR; }
    }
    PG8_WAIT_V(0);
    if constexpr (!ALIGN_EPI) { if (wr == 0) PG8_BAR; }
    PG8_BAR;
    if constexpr (Epi::AFTER_DRAIN) { E.fused(acc, cur, wr, wc, fr, fq, lds, wid, lane); S.done(cur); }
#undef PG8_SA
#undef PG8_SB
#undef PG8_STAGE
#undef PG8_LDA
#undef PG8_LDB
#undef PG8_MMA
#undef PG8_WAIT_V
#undef PG8_WAIT_L
#undef PG8_BAR
#undef PG8_SCHED
}
}

struct EpiInProj {
    static constexpr bool PERM = true, AFTER_DRAIN = false;
    static __device__ __forceinline__ bool keep(const pg8::Unit&) { return false; }
    float* F32B; float* GLOG; bf16_t* PBUF; const float* LB; bf16_t* CQN; bf16_t* CKVN;
    __device__ __forceinline__ void operator()(f32x4 (&acc)[2][2][4][2], const pg8::Unit& u, int wr, int wc, int fr, int fq) const {
#pragma unroll
        for (int bj = 0; bj < 2; ++bj) {
            const int nseg = u.pn * 256 + bj * 128 + wc * 32;
            if (nseg >= C_END) continue;
            const int c = nseg + 8 * fq;
#pragma unroll
            for (int ai = 0; ai < 2; ++ai)
#pragma unroll
                for (int m = 0; m < 4; ++m) {
                    const size_t r = (size_t)u.pm * 256 + ai * 128 + wr * 64 + m * 16 + fr;
                    const f32x4 v0 = acc[ai][bj][m][0], v1 = acc[ai][bj][m][1];
                    if (nseg < C_BQ) {
                        if (nseg >= C_CKV) { *(f32x4*)(F32B + r * 288 + (c - C_CKV)) = v0; *(f32x4*)(F32B + r * 288 + (c - C_CKV) + 4) = v1; }
                        if (nseg < C_KR) {
                            u32x4 w; w[0] = cvtpk(v0[0], v0[1]); w[1] = cvtpk(v0[2], v0[3]); w[2] = cvtpk(v1[0], v1[1]); w[3] = cvtpk(v1[2], v1[3]);
                            if (nseg < C_CKV) *(u32x4*)(CQN + r * 384 + c) = w; else *(u32x4*)(CKVN + r * 256 + (c - C_CKV)) = w;
                        }
                        continue;
                    }
                    f32x4 o0, o1;
                    if (nseg < C_BF) {
#pragma unroll
                        for (int e = 0; e < 4; ++e) { o0[e] = siluf_(v0[e]); o1[e] = siluf_(v1[e]); }
                    } else if (nseg < C_BI) {
                        const f32x4 lb0 = *(const f32x4*)(LB + (c - C_BF)), lb1 = *(const f32x4*)(LB + (c - C_BF) + 4);
                        f32x4 l0, l1;
#pragma unroll
                        for (int e = 0; e < 4; ++e) {
                            const float sg0 = sigmoidf_(v0[e]), sg1 = sigmoidf_(v1[e]);
                            l0[e] = __logf(lb0[e] + (1.0f - lb0[e]) * sg0); l1[e] = __logf(lb1[e] + (1.0f - lb1[e]) * sg1);
                            o0[e] = (1.0f - lb0[e]) * (1.0f - sg0); o1[e] = (1.0f - lb1[e]) * (1.0f - sg1);
                        }
                        *(f32x4*)(GLOG + r * 512 + (c - C_BF)) = l0; *(f32x4*)(GLOG + r * 512 + (c - C_BF) + 4) = l1;
                    } else if (nseg < C_GA) {
                        o0 = v0; o1 = v1;
                    } else if (nseg < C_MA) {
#pragma unroll
                        for (int e = 0; e < 4; ++e) { o0[e] = siluf_(v0[e]); o1[e] = siluf_(v1[e]); }
                    } else {
#pragma unroll
                        for (int e = 0; e < 4; ++e) { o0[e] = sigmoidf_(v0[e]); o1[e] = sigmoidf_(v1[e]); }
                    }
                    u32x4 w; w[0] = cvtpk(o0[0], o0[1]); w[1] = cvtpk(o0[2], o0[3]); w[2] = cvtpk(o1[0], o1[1]); w[3] = cvtpk(o1[2], o1[3]);
                    *(u32x4*)(PBUF + r * IN_COLS_PAD + c) = w;
                    asm volatile("" ::: "memory");
                }
        }
    }
};
template <int STAGE> struct EpiMerge {
    static constexpr bool PERM = true, AFTER_DRAIN = false;
    static __device__ __forceinline__ bool keep(const pg8::Unit&) { return false; }
    const bf16_t* PBUF; float* TMP; bf16_t* MM;
    __device__ __forceinline__ void operator()(f32x4 (&acc)[2][2][4][2], const pg8::Unit& u, int wr, int wc, int fr, int fq) const {
#pragma unroll
        for (int ai = 0; ai < 2; ++ai)
#pragma unroll
            for (int m = 0; m < 4; ++m) {
                const int mq = u.pm * 256 + ai * 128 + wr * 64 + m * 16 + fr;
                const size_t r = (size_t)(mq >> 11) * LTOT + NMETA + (mq & 2047);
#pragma unroll
                for (int bj = 0; bj < 2; ++bj) {
                    const int c = u.pn * 256 + bj * 128 + wc * 32 + 8 * fq;
                    const u32x4 g = *(const u32x4*)(PBUF + r * IN_COLS_PAD + (STAGE == 0 ? C_MA : C_MB) + c);
                    const f32x4 v0 = acc[ai][bj][m][0], v1 = acc[ai][bj][m][1];
                    f32x4 o0, o1;
                    o0[0] = v0[0] * bflo(g[0]); o0[1] = v0[1] * bfhi(g[0]); o0[2] = v0[2] * bflo(g[1]); o0[3] = v0[3] * bfhi(g[1]);
                    o1[0] = v1[0] * bflo(g[2]); o1[1] = v1[1] * bfhi(g[2]); o1[2] = v1[2] * bflo(g[3]); o1[3] = v1[3] * bfhi(g[3]);
                    if (STAGE == 0) {
                        u32x4 w; w[0] = cvtpk(o0[0], o0[1]); w[1] = cvtpk(o0[2], o0[3]); w[2] = cvtpk(o1[0], o1[1]); w[3] = cvtpk(o1[2], o1[3]);
                        *(u32x4*)(MM + (size_t)mq * 1024 + c) = w;
                    }
                    else {
                        const u32x4 tw = *(const u32x4*)(MM + (size_t)mq * 1024 + c);
                        f32x4 t0, t1;
                        t0[0] = bflo(tw[0]); t0[1] = bfhi(tw[0]); t0[2] = bflo(tw[1]); t0[3] = bfhi(tw[1]);
                        t1[0] = bflo(tw[2]); t1[1] = bfhi(tw[2]); t1[2] = bflo(tw[3]); t1[3] = bfhi(tw[3]);
                        u32x4 w; w[0] = cvtpk(o0[0] + t0[0], o0[1] + t0[1]); w[1] = cvtpk(o0[2] + t0[2], o0[3] + t0[3]);
                        w[2] = cvtpk(o1[0] + t1[0], o1[1] + t1[1]); w[3] = cvtpk(o1[2] + t1[2], o1[3] + t1[3]);
                        *(u32x4*)(MM + (size_t)mq * 1024 + c) = w;
                    }
                }
                asm volatile("" ::: "memory");
            }
    }
};
struct EpiFinal {
    static constexpr bool PERM = true, AFTER_DRAIN = false;
    static __device__ __forceinline__ bool keep(const pg8::Unit&) { return false; }
    const float* X; float* Y;
    __device__ __forceinline__ void operator()(f32x4 (&acc)[2][2][4][2], const pg8::Unit& u, int wr, int wc, int fr, int fq) const {
#pragma unroll
        for (int ai = 0; ai < 2; ++ai)
#pragma unroll
            for (int m = 0; m < 4; ++m) {
                const size_t mq = (size_t)u.pm * 256 + ai * 128 + wr * 64 + m * 16 + fr;
#pragma unroll
                for (int bj = 0; bj < 2; ++bj) {
                    const int c = u.pn * 256 + bj * 128 + wc * 32 + 8 * fq;
                    const f32x4 x0 = __builtin_nontemporal_load((const f32x4*)(X + mq * 1024 + c)), x1 = __builtin_nontemporal_load((const f32x4*)(X + mq * 1024 + c + 4));
                    __builtin_nontemporal_store(x0 + acc[ai][bj][m][0], (f32x4*)(Y + mq * 1024 + c));
                    __builtin_nontemporal_store(x1 + acc[ai][bj][m][1], (f32x4*)(Y + mq * 1024 + c + 4));
                }
            }
    }
};
struct OneTileOrder {
    int tile, nsel;
    __device__ __forceinline__ bool next(int i, pg8::Unit& u) const { if (i >= nsel) return false; u.pm = tile >> 2; u.pn = tile & 3; u.sel = i; return true; }
    __device__ __forceinline__ void a_ready(const pg8::Unit&) const {}
    __device__ __forceinline__ void done(const pg8::Unit&) const {}
};

__device__ __forceinline__ void transpose_tile(const float* __restrict__ src, int src_ld, int nvalid, int k0, int n0,
                                               bf16_t* __restrict__ dst, int dst_ld, float* tile  , const float* __restrict__ kscale, bool fragmajor = false) {
    const int tid = threadIdx.x;
#pragma unroll
    for (int i = 0; i < 2; ++i) {
        const int kk = (tid >> 4) + 32 * i, nn = (tid & 15) * 4;
        f32x4 v = {0.f, 0.f, 0.f, 0.f};
        if (n0 + nn < nvalid) v = *(const f32x4*)(src + (size_t)(k0 + kk) * src_ld + n0 + nn);
        if (kscale) v = v * kscale[k0 + kk];
        tile[kk * 65 + nn + 0] = v[0]; tile[kk * 65 + nn + 1] = v[1]; tile[kk * 65 + nn + 2] = v[2]; tile[kk * 65 + nn + 3] = v[3];
    }
    __syncthreads();
    {
        const int n = tid >> 3, kq = (tid & 7) * 8;
        u32x4 w;
        w[0] = cvtpk(tile[(kq + 0) * 65 + n], tile[(kq + 1) * 65 + n]);
        w[1] = cvtpk(tile[(kq + 2) * 65 + n], tile[(kq + 3) * 65 + n]);
        w[2] = cvtpk(tile[(kq + 4) * 65 + n], tile[(kq + 5) * 65 + n]);
        w[3] = cvtpk(tile[(kq + 6) * 65 + n], tile[(kq + 7) * 65 + n]);
        if (!fragmajor) *(u32x4*)(dst + (size_t)(n0 + n) * dst_ld + k0 + kq) = w;
        else {
            const int nn_ = n0 + n, kk_ = k0 + kq;
            const size_t f = (size_t)(nn_ >> 4) * (dst_ld >> 5) + (kk_ >> 5);
            *(u32x4*)(dst + f * 512 + ((((kk_ >> 3) & 3) << 4) + (nn_ & 15)) * 8) = w;
        }
    }
    __syncthreads();
}

#define TJ_C0 (16 * 84)
#define TJ_C8 (TJ_C0 + 6 * 12 + 4 * 8 + 4 * 8 + 8 * 16 + 8 * 16 + 16 * 16 + 4 * 8 + 4 * 8)
__device__ __forceinline__ void transpose_jobs(const Params& p, char* lds, int jbeg, int jend, int jstart, int jstride) {
    float* tile = (float*)lds;
    const int c0 = TJ_C0;
    const int c1 = c0 + 6 * 12;
    const int c2 = c1 + 4 * 8;
    const int c3 = c2 + 4 * 8;
    const int c4 = c3 + 8 * 16;
    const int c5 = c4 + 8 * 16;
    const int c6 = c5 + 16 * 16;
    const int c7 = c6 + 4 * 8;
    for (int j = jbeg + jstart; j < jend; j += jstride) {
        const float* src; int sld, nval, ntn, loc; bf16_t* dst; int dld; const float* ksc = nullptr; bool fm = false;
        if (j < c0)      { loc = j;      src = p.w_in; sld = IN_COLS; nval = IN_COLS; ntn = 84; dst = p.WIN_T; dld = 1024; }
        else if (j < c1) { loc = j - c0; src = p.w_uq; sld = 768;  nval = 768;  ntn = 12; dst = p.WUQ_T; dld = 384; ksc = p.g_cq; fm = true; }
        else if (j < c2) { loc = j - c1; src = p.w_uk; sld = 512;  nval = 512;  ntn = 8;  dst = p.WUKV_T; dld = 256; }
        else if (j < c3) { loc = j - c2; src = p.w_uv; sld = 512;  nval = 512;  ntn = 8;  dst = p.WUKV_T + (size_t)512 * 256; dld = 256; }
        else if (j < c4) { loc = j - c3; src = p.w_oa; sld = 1024; nval = 1024; ntn = 16; dst = p.WOA_T; dld = 512; }
        else if (j < c5) { loc = j - c4; src = p.w_ob; sld = 1024; nval = 1024; ntn = 16; dst = p.WOB_T; dld = 512; }
        else if (j < c6) { loc = j - c5; src = p.w_o;  sld = 1024; nval = 1024; ntn = 16; dst = p.WO_T; dld = 1024; }
        else if (j < c7) { loc = j - c6; src = p.w_uk; sld = 512;  nval = 512;  ntn = 8;  dst = p.WUKVG_T; dld = 256; ksc = p.g_ckv; fm = true; }
        else             { loc = j - c7; src = p.w_uv; sld = 512;  nval = 512;  ntn = 8;  dst = p.WUKVG_T + (size_t)512 * 256; dld = 256; ksc = p.g_ckv; fm = true; }
        const int kt = loc / ntn, nt = loc % ntn;
        transpose_tile(src, sld, nval, kt * 64, nt * 64, dst, dld, tile, ksc, fm);
    }
}

__device__ __forceinline__ void phase0(const Params& p, char* lds) {
    const int tid = threadIdx.x, lane = tid & 63, wid = tid >> 6;
    const int nb = gridDim.x, bid = blockIdx.x;
    transpose_jobs(p, lds, 0, TJ_C0, bid, nb);
    for (int i = bid * NTHREADS + tid; i < 64 * 64 * 48; i += nb * NTHREADS) {
        const int row = i / 48, c = i - row * 48;
        p.VTG[(size_t)row * 2112 + LTOT + c] = 0;
    }
    for (int r = bid * 8 + wid; r < R_PAD; r += nb * 8) {
        bf16_t* dst = p.XN + (size_t)r * 1024;
        if (r >= R_ALL) {
#pragma unroll
            for (int i = 0; i < 4; ++i) *(u32x2*)(dst + lane * 4 + 256 * i) = (u32x2){0u, 0u};
            continue;
        }
        const float* src;
        if (r < R_PROMPT) { const int b = r / LTOT, t = r - b * LTOT; src = (t < NMETA) ? p.meta + (size_t)t * 1024 : p.x_prompt + ((size_t)b * SEQ + (t - NMETA)) * 1024; }
        else src = p.x_sample + (size_t)(r - R_PROMPT) * 1024;
        f32x4 v[4]; float ss = 0.f;
#pragma unroll
        for (int i = 0; i < 4; ++i) { v[i] = *(const f32x4*)(src + lane * 4 + 256 * i); ss += v[i][0] * v[i][0] + v[i][1] * v[i][1] + v[i][2] * v[i][2] + v[i][3] * v[i][3]; }
        ss = wave_sum(ss);
        const float rs = 1.0f / sqrtf(ss * (1.0f / 1024.0f) + EPSF);
#pragma unroll
        for (int i = 0; i < 4; ++i) {
            const f32x4 g = *(const f32x4*)(p.norm_g + lane * 4 + 256 * i);
            u32x2 w; w[0] = cvtpk(v[i][0] * rs * g[0], v[i][1] * rs * g[1]); w[1] = cvtpk(v[i][2] * rs * g[2], v[i][3] * rs * g[3]);
            *(u32x2*)(dst + lane * 4 + 256 * i) = w;
        }
    }
    for (int i = bid * NTHREADS + tid; i < 2065 * 16; i += nb * NTHREADS) {
        const int pi = i >> 4, k = i & 15;
        const float pos = (pi < LTOT) ? (float)pi : (float)PAST_LEN;
        const float inv = (float)exp(-(double)k / 16.0 * log(10000.0));
        const float ang = pos * inv;
        p.ROPE[pi * 32 + k] = cosf(ang); p.ROPE[pi * 32 + 16 + k] = sinf(ang);
    }
    if (bid == 0) {
        if (tid < 512) { const float l0 = p.lb_logits[tid], l1 = p.lb_logits[512 + tid]; p.LB[tid] = 1.0f / (1.0f + expf(l1 - l0)); }
        if (tid < 16) p.INV[tid] = (float)exp(-(double)tid / 16.0 * log(10000.0));
        if (wid == 0) {
            float gq = 0.f, gk = 0.f;
            for (int i = lane; i < A_QK; i += 64) { gq = fmaxf(gq, fabsf(p.g_qn[i])); gk = fmaxf(gk, fabsf(p.g_kn[i])); }
#pragma unroll
            for (int o = 32; o >= 1; o >>= 1) { gq = fmaxf(gq, __shfl_xor(gq, o)); gk = fmaxf(gk, __shfl_xor(gk, o)); }
            if (lane == 0) p.SCAL[0] = sqrtf((float)A_QK) * gq * gk;
        }
    }
}

__device__ __forceinline__ void phase1(const Params& p, char* lds) {
    pg8::Gemm g{p.XN, p.WIN_T, R_PAD, IN_COLS_PAD, 1024, p.XN, p.WIN_T};
    pg8::StaticOrder S; S.init(R_PAD, IN_COLS_PAD, (int)gridDim.x, (int)blockIdx.x);
    EpiInProj E{p.F32B, p.GLOG, p.PBUF, p.LB, p.CQN, p.CKVN};
    pg8::gemm_phase<EpiInProj, pg8::StaticOrder, true, true>((PG8_LAS unsigned char*)lds, g, S, E);
    const int nidle = (int)gridDim.x - 85;
    if ((int)blockIdx.x >= 85 && nidle > 0) transpose_jobs(p, lds, TJ_C0, TJ_C8, (int)blockIdx.x - 85, nidle);
    else if (nidle <= 0) transpose_jobs(p, lds, TJ_C0, TJ_C8, (int)blockIdx.x, (int)gridDim.x);
}

#define LOG2E 1.4426950408889634f
__device__ __forceinline__ void fin1_chunk(const Params& p, const int c) {
    int tid_ = threadIdx.x; asm volatile("" : "+v"(tid_));
    const int tid = tid_, lane = tid & 63, wid = tid >> 6;
#pragma unroll 1
    for (int i = 0; i < 8; ++i) {
        const int r = c * 64 + wid * 8 + i;
        if (r >= R_ALL) break;
        const float* src = p.F32B + (size_t)r * 288;
        int pidx; float* o_lat; float* o_kr;
        if (r < R_PROMPT) { pidx = r % LTOT; o_lat = p.out + OFF_LAT_P + (size_t)r * 256; o_kr = p.out + OFF_KR_P + (size_t)r * 32; }
        else { const int j = r - R_PROMPT; pidx = LTOT; o_lat = p.out + OFF_LAT_S + (size_t)j * 256; o_kr = p.out + OFF_KR_S + (size_t)j * 32; }
        const f32x4 v = *(const f32x4*)(src + lane * 4);
        float ss = v[0] * v[0] + v[1] * v[1] + v[2] * v[2] + v[3] * v[3];
        ss = wave_sum(ss);
        const float rs = 1.0f / sqrtf(ss * (1.0f / 256.0f) + EPSF);
        const f32x4 g = *(const f32x4*)(p.g_ckv + lane * 4);
        f32x4 o; o[0] = v[0] * rs * g[0]; o[1] = v[1] * rs * g[1]; o[2] = v[2] * rs * g[2]; o[3] = v[3] * rs * g[3];
        *(f32x4*)(o_lat + lane * 4) = o;
        if (lane < 16) {
            const float x1 = src[256 + lane], x2 = src[256 + 16 + lane];
            const float cs = p.ROPE[pidx * 32 + lane], sn = p.ROPE[pidx * 32 + 16 + lane];
            o_kr[lane] = x1 * cs - x2 * sn; o_kr[16 + lane] = x1 * sn + x2 * cs;
        }
    }
}

#define UF_XQ_LD 784
#define UF_XK_LD 528
__device__ __forceinline__ float diag_pick(const f32x4 a, int lr, int lg) {
    const int j = lr & 3;
    float v = (j == 0) ? a[0] : (j == 1) ? a[1] : (j == 2) ? a[2] : a[3];
    v = (lg == (lr >> 2)) ? v : 0.f;
    v += __shfl_xor(v, 16); v += __shfl_xor(v, 32);
    return v;
}
__device__ __forceinline__ void upfused_item(const Params& p, char* lds, const int item) {
    int tid_ = threadIdx.x; asm volatile("" : "+v"(tid_));
    const int tid = tid_, lane = tid & 63, h = tid >> 6, lr = lane & 15, lg = lane >> 4;
    const int rt = item / 3, part = item - rt * 3, row0 = rt * 64;
    const float qk_scale = 0.10206207261596577f;
    if (part == 0) {
        char* X = lds;
#pragma unroll
        for (int i = 0; i < 6; ++i) {
            const int id = tid + 512 * i, row = id / 48, ch = id - row * 48;
            *(u32x4*)(X + row * UF_XQ_LD + ch * 16) = *(const u32x4*)(p.CQN + (size_t)(row0 + row) * 384 + ch * 8);
        }
        __syncthreads();
        f32x4 acc[4][6], accs[4];
#pragma unroll
        for (int mt = 0; mt < 4; ++mt) { accs[mt] = (f32x4){0.f, 0.f, 0.f, 0.f};
#pragma unroll
            for (int nt = 0; nt < 6; ++nt) acc[mt][nt] = (f32x4){0.f, 0.f, 0.f, 0.f}; }
        const bf16_t* wb = p.WUQ_T + (size_t)(h * 6) * 12 * 512 + lane * 8;
        f32x4 gq[6], rc[4], rsn[4];
#pragma unroll
        for (int nt = 0; nt < 6; ++nt) gq[nt] = *(const f32x4*)(p.g_qn + 16 * nt + 4 * lg);
#pragma unroll
        for (int mt = 0; mt < 4; ++mt) {
            const int r = row0 + 16 * mt + lr;
            const int pidx = (r >= R_PROMPT) ? LTOT : (r % LTOT);
            rc[mt] = *(const f32x4*)(p.ROPE + pidx * 32 + 4 * lg); rsn[mt] = *(const f32x4*)(p.ROPE + pidx * 32 + 16 + 4 * lg);
        }
#pragma unroll 1
        for (int ks = 0; ks < 12; ++ks) {
            bf16x8 xf[4], wf[6];
#pragma unroll
            for (int nt = 0; nt < 6; ++nt) wf[nt] = *(const bf16x8*)(wb + (size_t)(nt * 12 + ks) * 512);
#pragma unroll
            for (int mt = 0; mt < 4; ++mt) xf[mt] = *(const bf16x8*)(X + (16 * mt + lr) * UF_XQ_LD + ks * 64 + lg * 16);
#pragma unroll
            for (int mt = 0; mt < 4; ++mt) {
                accs[mt] = mfma16(xf[mt], xf[mt], accs[mt]);
#pragma unroll
                for (int nt = 0; nt < 6; ++nt) acc[mt][nt] = mfma16(wf[nt], xf[mt], acc[mt][nt]);
            }
        }
#pragma unroll
        for (int mt = 0; mt < 4; ++mt) {
            const int r = row0 + 16 * mt + lr;
            const float rs_cq = 1.0f / sqrtf(diag_pick(accs[mt], lr, lg) * (1.0f / 384.0f) + EPSF);
            const bool is_s = r >= R_PROMPT;
            const int b = r / LTOT, t = r - b * LTOT;
            const int pidx = is_s ? LTOT : t;
            f32x4 q[6];
#pragma unroll
            for (int nt = 0; nt < 6; ++nt) q[nt] = acc[mt][nt] * rs_cq;
            {
                const f32x4 c4 = rc[mt], s4 = rsn[mt];
#pragma unroll
                for (int j = 0; j < 4; ++j) { const float x1 = q[4][j], x2 = q[5][j]; q[4][j] = x1 * c4[j] - x2 * s4[j]; q[5][j] = x1 * s4[j] + x2 * c4[j]; }
            }
            float ss = 0.f;
#pragma unroll
            for (int nt = 0; nt < 6; ++nt)
#pragma unroll
                for (int j = 0; j < 4; ++j) ss += q[nt][j] * q[nt][j];
            ss += __shfl_xor(ss, 16); ss += __shfl_xor(ss, 32);
            const float rs = 1.0f / sqrtf(ss * (1.0f / 96.0f) + EPSF);
            if (!is_s) {
                if (t >= NMETA && r < R_PROMPT) {
                    bf16_t* dst = p.QA + ((size_t)(b * 8 + h) * 2048 + (t - NMETA)) * 96 + 4 * lg;
                    const float sc = rs * qk_scale * LOG2E;
#pragma unroll
                    for (int nt = 0; nt < 6; ++nt) {
                        const f32x4 g = gq[nt];
                        u32x2 w; w[0] = cvtpk(q[nt][0] * sc * g[0], q[nt][1] * sc * g[1]); w[1] = cvtpk(q[nt][2] * sc * g[2], q[nt][3] * sc * g[3]);
                        *(u32x2*)(dst + 16 * nt) = w;
                    }
                }
            } else if (r < R_ALL) {
                float* dst = p.QS + ((size_t)(r - R_PROMPT) * 8 + h) * 96 + 4 * lg;
                const float sc = rs * qk_scale;
#pragma unroll
                for (int nt = 0; nt < 6; ++nt) {
                    const f32x4 g = gq[nt], gk = *(const f32x4*)(p.g_kn + 16 * nt + 4 * lg);
                    f32x4 o; o[0] = q[nt][0] * sc * g[0] * gk[0]; o[1] = q[nt][1] * sc * g[1] * gk[1]; o[2] = q[nt][2] * sc * g[2] * gk[2]; o[3] = q[nt][3] * sc * g[3] * gk[3];
                    *(f32x4*)(dst + 16 * nt) = o;
                }
            }
        }
    } else {
        char* X = lds;
        float* KR = (float*)(lds + 64 * UF_XK_LD);
#pragma unroll
        for (int i = 0; i < 4; ++i) {
            const int id = tid + 512 * i, row = id >> 5, ch = id & 31;
            *(u32x4*)(X + row * UF_XK_LD + ch * 16) = *(const u32x4*)(p.CKVN + (size_t)(row0 + row) * 256 + ch * 8);
        }
        if (part == 1) { const int row = tid >> 3, c4 = tid & 7; *(f32x4*)(KR + row * 36 + c4 * 4) = *(const f32x4*)(p.F32B + (size_t)(row0 + row) * 288 + 256 + c4 * 4); }
        __syncthreads();
        f32x4 ak[4][4], accs[4];
#pragma unroll
        for (int mt = 0; mt < 4; ++mt) { accs[mt] = (f32x4){0.f, 0.f, 0.f, 0.f};
#pragma unroll
            for (int nt = 0; nt < 4; ++nt) ak[mt][nt] = (f32x4){0.f, 0.f, 0.f, 0.f}; }
        const bf16_t* wk = p.WUKVG_T + (size_t)((part == 1 ? 0 : 32) + h * 4) * 8 * 512 + lane * 8;
        f32x4 gk[6], rc[4], rsn[4];
        if (part == 1) {
#pragma unroll
            for (int nt = 0; nt < 6; ++nt) gk[nt] = *(const f32x4*)(p.g_kn + 16 * nt + 4 * lg);
#pragma unroll
            for (int mt = 0; mt < 4; ++mt) {
                const int r = row0 + 16 * mt + lr;
                const int pidx = (r >= R_PROMPT) ? LTOT : (r % LTOT);
                rc[mt] = *(const f32x4*)(p.ROPE + pidx * 32 + 4 * lg); rsn[mt] = *(const f32x4*)(p.ROPE + pidx * 32 + 16 + 4 * lg);
            }
        }
#pragma unroll 1
        for (int ks = 0; ks < 8; ++ks) {
            bf16x8 xf[4], wfk[4];
#pragma unroll
            for (int nt = 0; nt < 4; ++nt) wfk[nt] = *(const bf16x8*)(wk + (size_t)(nt * 8 + ks) * 512);
#pragma unroll
            for (int mt = 0; mt < 4; ++mt) xf[mt] = *(const bf16x8*)(X + (16 * mt + lr) * UF_XK_LD + ks * 64 + lg * 16);
#pragma unroll
            for (int mt = 0; mt < 4; ++mt) {
                accs[mt] = mfma16(xf[mt], xf[mt], accs[mt]);
#pragma unroll
                for (int nt = 0; nt < 4; ++nt) ak[mt][nt] = mfma16(wfk[nt], xf[mt], ak[mt][nt]);
            }
        }
#pragma unroll
        for (int mt = 0; mt < 4; ++mt) {
            const int r = row0 + 16 * mt + lr;
            const float rs_ckv = 1.0f / sqrtf(diag_pick(accs[mt], lr, lg) * (1.0f / 256.0f) + EPSF);
            const bool is_s = r >= R_PROMPT;
            const int b = r / LTOT, t = r - b * LTOT;
            if (part == 2) {
                if (!is_s) {
                    const int x = t & 15, slot = (t & ~15) | (x & 3) | ((x & 4) << 1) | ((x & 8) >> 1);
                    bf16_t* vd = p.VTG + (size_t)(b * 8 + h) * 64 * 2112 + slot;
#pragma unroll
                    for (int nt = 0; nt < 4; ++nt)
#pragma unroll
                        for (int j = 0; j < 4; ++j) vd[(size_t)(16 * nt + 4 * lg + j) * 2112] = f2bf(ak[mt][nt][j] * rs_ckv);
                }
                continue;
            }
            const int pidx = is_s ? LTOT : t;
            const f32x4 x1 = *(const f32x4*)(KR + (16 * mt + lr) * 36 + 4 * lg), x2 = *(const f32x4*)(KR + (16 * mt + lr) * 36 + 16 + 4 * lg);
            float ss = 0.f;
#pragma unroll
            for (int j = 0; j < 4; ++j) ss += x1[j] * x1[j] + x2[j] * x2[j];
            f32x4 kn[4];
#pragma unroll
            for (int nt = 0; nt < 4; ++nt) { kn[nt] = ak[mt][nt] * rs_ckv;
#pragma unroll
                for (int j = 0; j < 4; ++j) ss += kn[nt][j] * kn[nt][j]; }
            ss += __shfl_xor(ss, 16); ss += __shfl_xor(ss, 32);
            const float rs = 1.0f / sqrtf(ss * (1.0f / 96.0f) + EPSF);
            const f32x4 c4 = rc[mt], s4 = rsn[mt];
            f32x4 y1, y2;
#pragma unroll
            for (int j = 0; j < 4; ++j) { y1[j] = x1[j] * c4[j] - x2[j] * s4[j]; y2[j] = x1[j] * s4[j] + x2[j] * c4[j]; }
            if (!is_s) {
                bf16_t* dst = p.KA + ((size_t)(b * 8 + h) * LTOT + t) * 96 + 4 * lg;
#pragma unroll
                for (int nt = 0; nt < 4; ++nt) {
                    const f32x4 g = gk[nt];
                    u32x2 w; w[0] = cvtpk(kn[nt][0] * rs * g[0], kn[nt][1] * rs * g[1]); w[1] = cvtpk(kn[nt][2] * rs * g[2], kn[nt][3] * rs * g[3]);
                    *(u32x2*)(dst + 16 * nt) = w;
                }
                {
                    const f32x4 g1 = gk[4], g2 = gk[5];
                    u32x2 w1, w2;
                    w1[0] = cvtpk(y1[0] * rs * g1[0], y1[1] * rs * g1[1]); w1[1] = cvtpk(y1[2] * rs * g1[2], y1[3] * rs * g1[3]);
                    w2[0] = cvtpk(y2[0] * rs * g2[0], y2[1] * rs * g2[1]); w2[1] = cvtpk(y2[2] * rs * g2[2], y2[3] * rs * g2[3]);
                    *(u32x2*)(dst + 64) = w1; *(u32x2*)(dst + 80) = w2;
                }
            } else if (r < R_ALL) {
                float* dst = p.KSRAW + ((size_t)(r - R_PROMPT) * 8 + h) * 96 + 4 * lg;
#pragma unroll
                for (int nt = 0; nt < 4; ++nt) *(f32x4*)(dst + 16 * nt) = kn[nt];
                *(f32x4*)(dst + 64) = y1; *(f32x4*)(dst + 80) = y2;
            }
        }
    }
    __syncthreads();
}

#define HA_LD 144
#define HC_LD 272
__device__ __forceinline__ void hgrn_passA_unit(const Params& p, char* lds, const int u) {
    int tid_ = threadIdx.x; asm volatile("" : "+v"(tid_));
    const int tid = tid_, lane = tid & 63, wid = tid >> 6, lr = lane & 15, lg = lane >> 4;
    float* cumL = (float*)lds;
    float* tot = (float*)(lds + 32768);
    char* KT = lds + 32768 + 2048;
    char* VT = KT + 128 * HA_LD;
    {
        const int c = u % NCHUNK, bh = u / NCHUNK, h = bh % B_HEADS, b = bh / B_HEADS;
        const int nvalid = (c == 0) ? NMETA : 64;
        const int t0 = (c == 0) ? 0 : NMETA + 64 * (c - 1);
        const size_t rowbase = (size_t)b * LTOT + t0;
        const int d = tid & 127, part = tid >> 7;
        char* KR = VT + 128 * HA_LD;
#pragma unroll
        for (int i = 0; i < 4; ++i) {
            const int id = tid + 512 * i, row = id >> 5, c4 = id & 31;
            f32x4 g = {0.f, 0.f, 0.f, 0.f};
            if (row < nvalid) g = *(const f32x4*)(p.GLOG + (rowbase + row) * 512 + h * 128 + c4 * 4);
            *(f32x4*)(cumL + row * 128 + c4 * 4) = g;
        }
#pragma unroll
        for (int i = 0; i < 2; ++i) {
            const int id = tid + 512 * i, row = id >> 4, ch = id & 15;
            u32x4 kw = {0u, 0u, 0u, 0u}, w = {0u, 0u, 0u, 0u};
            if (row < nvalid) {
                kw = *(const u32x4*)(p.PBUF + (rowbase + row) * IN_COLS_PAD + C_BF + h * 128 + ch * 8);
                w = *(const u32x4*)(p.PBUF + (rowbase + row) * IN_COLS_PAD + C_BI + h * 128 + ch * 8);
            }
            *(u32x4*)(KR + row * HC_LD + ch * 16) = kw;
#pragma unroll
            for (int e = 0; e < 4; ++e) {
                *(bf16_t*)(VT + (ch * 8 + 2 * e) * HA_LD + row * 2) = (bf16_t)(w[e] & 0xffffu);
                *(bf16_t*)(VT + (ch * 8 + 2 * e + 1) * HA_LD + row * 2) = (bf16_t)(w[e] >> 16);
            }
        }
        __syncthreads();
        {
            float run = 0.f;
#pragma unroll
            for (int i = 0; i < 16; ++i) { const int s = part * 16 + i; run += cumL[s * 128 + d]; cumL[s * 128 + d] = run; }
            tot[part * 128 + d] = run;
        }
        __syncthreads();
        {
            float off = 0.f, last = 0.f;
#pragma unroll
            for (int q = 0; q < 4; ++q) { const float tq = tot[q * 128 + d]; last += tq; if (q < part) off += tq; }
            if (part == 0) p.DEC[(size_t)u * 128 + d] = expf(last);
#pragma unroll
            for (int i = 0; i < 16; ++i) {
                const int s = part * 16 + i;
                const float cum = cumL[s * 128 + d] + off;
                const float kv = bf2f(*(const bf16_t*)(KR + s * HC_LD + d * 2));
                *(bf16_t*)(KT + d * HA_LD + s * 2) = f2bf(kv * __expf(last - cum));
            }
        }
        __syncthreads();
        {
            const char* xs = VT + (wid * 16 + lr) * HA_LD + lg * 16;
            bf16x8 xf0 = *(const bf16x8*)(xs), xf1 = *(const bf16x8*)(xs + 64);
            bf16_t* dst = p.UT + (size_t)u * 16384 + (size_t)(wid * 16 + lr) * 128;
#pragma unroll
            for (int nt = 0; nt < 8; ++nt) {
                const char* ws = KT + (nt * 16 + lr) * HA_LD + lg * 16;
                f32x4 acc = {0.f, 0.f, 0.f, 0.f};
                acc = mfma16(*(const bf16x8*)(ws), xf0, acc);
                acc = mfma16(*(const bf16x8*)(ws + 64), xf1, acc);
                { u32x2 w; w[0] = cvtpk(acc[0], acc[1]); w[1] = cvtpk(acc[2], acc[3]); *(u32x2*)(dst + nt * 16 + 4 * lg) = w; }
            }
        }
        __syncthreads();
    }
}

__device__ __forceinline__ void hgrn_sample_step_unit(const Params& p, char* lds, const int u) {
    int tid_ = threadIdx.x; asm volatile("" : "+v"(tid_));
    const int tid = tid_;
    float* part = (float*)lds;
    float* red = (float*)(lds + 8192);
    {
        const int i = u / B_HEADS, h = u % B_HEADS;
        const size_t r = R_PROMPT + i;
        const int v4 = (tid & 31) * 4, dp = tid >> 5;
        const float* S0 = p.state_hgrn + (size_t)u * 16384;
        float* S1 = p.out + OFF_HG_S + (size_t)u * 16384;
        const u32x2 vw = *(const u32x2*)(p.PBUF + r * IN_COLS_PAD + C_BI + h * 128 + v4);
        const float vv[4] = {bflo(vw[0]), bfhi(vw[0]), bflo(vw[1]), bfhi(vw[1])};
        float o[4] = {0.f, 0.f, 0.f, 0.f};
#pragma unroll
        for (int e = 0; e < 8; ++e) {
            const int d = dp * 8 + e;
            const float q = bf2f(p.PBUF[r * IN_COLS_PAD + C_BQ + h * 128 + d]);
            const float k = bf2f(p.PBUF[r * IN_COLS_PAD + C_BF + h * 128 + d]);
            const float f = expf(p.GLOG[r * 512 + h * 128 + d]);
            const f32x4 s0 = *(const f32x4*)(S0 + d * 128 + v4);
            f32x4 s1;
#pragma unroll
            for (int j = 0; j < 4; ++j) { s1[j] = f * s0[j] + k * vv[j]; o[j] += q * s1[j]; }
            *(f32x4*)(S1 + d * 128 + v4) = s1;
        }
#pragma unroll
        for (int j = 0; j < 4; ++j) part[dp * 128 + v4 + j] = o[j];
        __syncthreads();
        float osum = 0.f;
        if (tid < 128) {
#pragma unroll
            for (int q = 0; q < 16; ++q) osum += part[q * 128 + tid];
            float ss = wave_sum(osum * osum);
            if ((tid & 63) == 0) red[tid >> 6] = ss;
        }
        __syncthreads();
        if (tid < 128) {
            const float ss = red[0] + red[1];
            const float rs = 1.0f / sqrtf(ss * (1.0f / 128.0f) + EPSF);
            const float gb = bf2f(p.PBUF[r * IN_COLS_PAD + C_GB + h * 128 + tid]);
            p.AMB[(size_t)(NQ + i) * 512 + h * 128 + tid] = f2bf(osum * rs * p.g_bn[tid] * gb);
        }
        __syncthreads();
    }
}

#define Q_UF_ITEMS (3 * (R_PAD / 64))
#define Q_HA_ITEMS (BATCH * B_HEADS * NCHUNK)
#define Q_SS_ITEMS (DEC_BATCH * B_HEADS)
#define Q_F1_ITEMS ((R_ALL + 63) / 64)
#define QCTR_WORD 3584
__device__ __forceinline__ void phase2(const Params& p, char* lds) {
    volatile int* slot = (volatile int*)(lds + LDS_ITEM_OFF);
    const int total = Q_UF_ITEMS + Q_HA_ITEMS + Q_SS_ITEMS + Q_F1_ITEMS;
    int nxt = 0;
    if (threadIdx.x == 0) nxt = (int)atomicAdd(p.bar + QCTR_WORD, 1u);
    for (;;) {
        if (threadIdx.x == 0) *slot = nxt;
        __syncthreads();
        const int it = __builtin_amdgcn_readfirstlane(*slot);
        __syncthreads();
        if (it >= total) break;
        if (threadIdx.x == 0) nxt = (int)atomicAdd(p.bar + QCTR_WORD, 1u);
        if (it < Q_UF_ITEMS) upfused_item(p, lds, it);
        else if (it < Q_UF_ITEMS + Q_HA_ITEMS) hgrn_passA_unit(p, lds, it - Q_UF_ITEMS);
        else if (it < Q_UF_ITEMS + Q_HA_ITEMS + Q_SS_ITEMS) hgrn_sample_step_unit(p, lds, it - Q_UF_ITEMS - Q_HA_ITEMS);
        else fin1_chunk(p, it - Q_UF_ITEMS - Q_HA_ITEMS - Q_SS_ITEMS);
    }
}

__device__ __forceinline__ void hgrn_passB(const Params& p) {
    for (int g = blockIdx.x * NTHREADS + threadIdx.x; g < 32 * 128 * 32; g += gridDim.x * NTHREADS) {
        const int d4 = (g & 31) * 4, v = (g >> 5) & 127, bh = g >> 12;
        f32x4 S = {0.f, 0.f, 0.f, 0.f};
        for (int c = 0; c < NCHUNK; ++c) {
            const size_t u = (size_t)bh * NCHUNK + c;
            u32x2 w; w[0] = cvtpk(S[0], S[1]); w[1] = cvtpk(S[2], S[3]);
            *(u32x2*)(p.ST + u * 16384 + v * 128 + d4) = w;
            const f32x4 dec = *(const f32x4*)(p.DEC + u * 128 + d4);
            const u32x2 uw = *(const u32x2*)(p.UT + u * 16384 + v * 128 + d4);
            const f32x4 ut = {bflo(uw[0]), bfhi(uw[0]), bflo(uw[1]), bfhi(uw[1])};
#pragma unroll
            for (int j = 0; j < 4; ++j) S[j] = dec[j] * S[j] + ut[j];
        }
        float* o = p.out + OFF_HG_P + (size_t)bh * 16384;
#pragma unroll
        for (int j = 0; j < 4; ++j) o[(d4 + j) * 128 + v] = S[j];
    }
}

#define AK_LD 208
#define AV_LD 144
#define AP_LD 144
#define AK_BUF (64 * AK_LD)
#define AV_BUF (64 * AV_LD)

typedef float f32x16 __attribute__((ext_vector_type(16)));
#define A2K_LD 208
#define A2V_LD 144
#define A2K_BUF (64 * A2K_LD)
#define A2V_BUF (64 * A2V_LD)
__device__ __forceinline__ f32x16 mfma32(bf16x8 a, bf16x8 b, f32x16 c) { return __builtin_amdgcn_mfma_f32_32x32x16_bf16(a, b, c, 0, 0, 0); }
__device__ __forceinline__ void attn_unit2(const Params& p, char* lds, int b, int h, int qb) {
    const int tid = threadIdx.x, lane = tid & 63, wid = tid >> 6, r32 = lane & 31, hi = lane >> 5;
    char* Ks = lds;
    char* Vs = lds + 2 * A2K_BUF;
    const int tq0 = qb * 256;
    const int ntile = 4 * qb + 5;
    const float negMb = -p.SCAL[0] * LOG2E;
    const bf16_t* qsrc = p.QA + ((size_t)(b * 8 + h) * 2048 + tq0 + 32 * wid + r32) * 96 + hi * 8;
    bf16x8 qf[6];
#pragma unroll
    for (int s = 0; s < 6; ++s) qf[s] = *(const bf16x8*)(qsrc + 16 * s);
    const int wq_min = NMETA + tq0 + 32 * wid, wq_max = wq_min + 31, qpos = wq_min + r32;
    const bf16_t* kbase = p.KA + (size_t)(b * 8 + h) * LTOT * 96;
    const bf16_t* vbase = p.VTG + (size_t)(b * 8 + h) * 64 * 2112;
    const int kkey0 = tid / 12, kpart0 = tid % 12;
    const int kkey1 = (512 + tid) / 12, kpart1 = (512 + tid) % 12;
    const int vdv = tid >> 3, vpart = tid & 7;
    u32x4 kA0, kA1 = {0u, 0u, 0u, 0u}, vA, kB0, kB1 = {0u, 0u, 0u, 0u}, vB;
#define A2_LOAD(K0, K1, V, ti_) { const int key0 = (ti_) * 64; \
        int ka = key0 + kkey0; ka = ka < LTOT ? ka : LTOT - 1; K0 = *(const u32x4*)(kbase + (size_t)ka * 96 + kpart0 * 8); \
        if (tid < 256) { int kb = key0 + kkey1; kb = kb < LTOT ? kb : LTOT - 1; K1 = *(const u32x4*)(kbase + (size_t)kb * 96 + kpart1 * 8); } \
        V = *(const u32x4*)(vbase + (size_t)vdv * 2112 + key0 + vpart * 8); }
#define A2_STORE(K0, K1, V, buf_) { *(u32x4*)(Ks + (buf_) * A2K_BUF + kkey0 * A2K_LD + kpart0 * 16) = K0; \
        if (tid < 256) *(u32x4*)(Ks + (buf_) * A2K_BUF + kkey1 * A2K_LD + kpart1 * 16) = K1; \
        *(u32x4*)(Vs + (buf_) * A2V_BUF + vdv * A2V_LD + vpart * 16) = V; }
    f32x16 o0, o1;
#pragma unroll
    for (int i = 0; i < 16; ++i) { o0[i] = 0.f; o1[i] = 0.f; }
    float lsum = 0.f;
    A2_LOAD(kA0, kA1, vA, 0); A2_STORE(kA0, kA1, vA, 0);
    A2_LOAD(kB0, kB1, vB, 1);
    __syncthreads();
#pragma unroll 2
    for (int ti = 0; ti < ntile; ++ti) {
        const int cur = ti & 1;
        if (ti + 2 < ntile) { if (cur == 0) { A2_LOAD(kA0, kA1, vA, ti + 2); } else { A2_LOAD(kB0, kB1, vB, ti + 2); } }
        if (ti * 64 <= wq_max) {
            f32x16 s0, s1;
#pragma unroll
            for (int i = 0; i < 16; ++i) { s0[i] = negMb; s1[i] = negMb; }
            const char* ka = Ks + cur * A2K_BUF + r32 * A2K_LD + hi * 16;
#pragma unroll
            for (int s = 0; s < 6; ++s) {
                s0 = mfma32(*(const bf16x8*)(ka + s * 32), qf[s], s0);
                s1 = mfma32(*(const bf16x8*)(ka + 32 * A2K_LD + s * 32), qf[s], s1);
            }
            const bool diag = (ti * 64 + 63 > wq_min);
#pragma unroll
            for (int i = 0; i < 16; ++i) { s0[i] = __builtin_amdgcn_exp2f(s0[i]); s1[i] = __builtin_amdgcn_exp2f(s1[i]); }
            if (diag) {
                const int kb0 = ti * 64 + 4 * hi;
#pragma unroll
                for (int i = 0; i < 16; ++i) {
                    const int key = kb0 + (i & 3) + 8 * (i >> 2);
                    if (key > qpos) s0[i] = 0.f;
                    if (key + 32 > qpos) s1[i] = 0.f;
                }
            }
            float la = 0.f, lb = 0.f;
#pragma unroll
            for (int i = 0; i < 16; ++i) { la += s0[i]; lb += s1[i]; }
            lsum += la + lb;
            bf16x8 pb[2][2];
#pragma unroll
            for (int s = 0; s < 2; ++s) {
                u32x4 w0, w1;
#pragma unroll
                for (int e = 0; e < 4; ++e) { w0[e] = cvtpk(s0[8 * s + 2 * e], s0[8 * s + 2 * e + 1]); w1[e] = cvtpk(s1[8 * s + 2 * e], s1[8 * s + 2 * e + 1]); }
                pb[0][s] = __builtin_bit_cast(bf16x8, w0); pb[1][s] = __builtin_bit_cast(bf16x8, w1);
            }
            const char* va = Vs + cur * A2V_BUF + r32 * A2V_LD + hi * 16;
#pragma unroll
            for (int kt = 0; kt < 2; ++kt)
#pragma unroll
                for (int s = 0; s < 2; ++s) {
                    o0 = mfma32(*(const bf16x8*)(va + kt * 64 + s * 32), pb[kt][s], o0);
                    o1 = mfma32(*(const bf16x8*)(va + 32 * A2V_LD + kt * 64 + s * 32), pb[kt][s], o1);
                }
        }
        if (ti + 1 < ntile) { if (cur == 0) { A2_STORE(kB0, kB1, vB, 1); } else { A2_STORE(kA0, kA1, vA, 0); } }
        __syncthreads();
    }
#undef A2_LOAD
#undef A2_STORE
    lsum += __shfl_xor(lsum, 32);
    const float inv = 1.0f / lsum;
    const int tq = tq0 + 32 * wid + r32;
    const size_t r = (size_t)b * LTOT + NMETA + tq;
    const size_t mrow = (size_t)b * 2048 + tq;
#pragma unroll
    for (int vt = 0; vt < 2; ++vt)
#pragma unroll
        for (int g = 0; g < 4; ++g) {
            const int dv = 32 * vt + 8 * g + 4 * hi;
            const u32x2 gw = *(const u32x2*)(p.PBUF + r * IN_COLS_PAD + C_GA + h * 64 + dv);
            const float v0 = (vt ? o1[4 * g] : o0[4 * g]) * inv, v1 = (vt ? o1[4 * g + 1] : o0[4 * g + 1]) * inv;
            const float v2 = (vt ? o1[4 * g + 2] : o0[4 * g + 2]) * inv, v3 = (vt ? o1[4 * g + 3] : o0[4 * g + 3]) * inv;
            u32x2 w; w[0] = cvtpk(v0 * bflo(gw[0]), v1 * bfhi(gw[0])); w[1] = cvtpk(v2 * bflo(gw[1]), v3 * bfhi(gw[1]));
            *(u32x2*)(p.AMA + mrow * 512 + h * 64 + dv) = w;
        }
}

__device__ __forceinline__ void attn_phase(const Params& p, char* lds) {
    const int i = blockIdx.x;
    if (i < 256) {
        const int bh = i >> 2, pair = i & 3;
        attn_unit2(p, lds, bh >> 3, bh & 7, 7 - pair);
        attn_unit2(p, lds, bh >> 3, bh & 7, pair);
    }
}

__device__ __forceinline__ void hgrn_passC(const Params& p, char* lds) {
    const int tid = threadIdx.x, lane = tid & 63, wid = tid >> 6, lr = lane & 15, lg = lane >> 4;
    float* cumL = (float*)lds;
    float* tot = (float*)(lds + 32768);
    char* QT = lds + 34816;
    char* KN = QT + 64 * HC_LD;
    char* QH = KN + 64 * HC_LD;
    char* VT = QH + 64 * HC_LD;
    char* AT = VT + 128 * HA_LD;
    char* STl = AT + 64 * HA_LD;
    for (int uu = blockIdx.x; uu < 32 * 32; uu += gridDim.x) {
        const int c = 1 + (uu & 31), bh = uu >> 5, h = bh & 3, b = bh >> 2;
        const size_t u = (size_t)bh * NCHUNK + c;
        const int t0 = NMETA + 64 * (c - 1);
        const size_t rowbase = (size_t)b * LTOT + t0;
        const int d = tid & 127, part = tid >> 7;
#pragma unroll
        for (int i = 0; i < 4; ++i) {
            const int id = tid + 512 * i, row = id >> 5, c4 = id & 31;
            *(f32x4*)(cumL + row * 128 + c4 * 4) = *(const f32x4*)(p.GLOG + (rowbase + row) * 512 + h * 128 + c4 * 4);
        }
#pragma unroll
        for (int i = 0; i < 2; ++i) {
            const int id = tid + 512 * i, row = id >> 4, ch = id & 15;
            const bf16_t* src = p.PBUF + (rowbase + row) * IN_COLS_PAD + h * 128 + ch * 8;
            const u32x4 qw = *(const u32x4*)(src + C_BQ), kw = *(const u32x4*)(src + C_BF), w = *(const u32x4*)(src + C_BI);
            *(u32x4*)(QH + row * HC_LD + ch * 16) = qw;
            *(u32x4*)(KN + row * HC_LD + ch * 16) = kw;
#pragma unroll
            for (int e = 0; e < 4; ++e) {
                *(bf16_t*)(VT + (ch * 8 + 2 * e) * HA_LD + row * 2) = (bf16_t)(w[e] & 0xffffu);
                *(bf16_t*)(VT + (ch * 8 + 2 * e + 1) * HA_LD + row * 2) = (bf16_t)(w[e] >> 16);
            }
        }
#pragma unroll
        for (int i = 0; i < 4; ++i) {
            const int id = tid + 512 * i, v = id >> 4, dc = id & 15;
            *(u32x4*)(STl + v * HC_LD + dc * 16) = *(const u32x4*)(p.ST + u * 16384 + v * 128 + dc * 8);
        }
        __syncthreads();
        {
            float run = 0.f;
#pragma unroll
            for (int i = 0; i < 16; ++i) { const int s = part * 16 + i; run += cumL[s * 128 + d]; cumL[s * 128 + d] = run; }
            tot[part * 128 + d] = run;
        }
        __syncthreads();
        {
            float off = 0.f;
#pragma unroll
            for (int q = 0; q < 4; ++q) { const float tq = tot[q * 128 + d]; if (q < part) off += tq; }
            const float ref = tot[d] + tot[128 + d];
#pragma unroll
            for (int i = 0; i < 16; ++i) {
                const int s = part * 16 + i;
                const float cum = cumL[s * 128 + d] + off;
                const float qv = bf2f(*(const bf16_t*)(QH + s * HC_LD + d * 2));
                const float kv = bf2f(*(const bf16_t*)(KN + s * HC_LD + d * 2));
                *(bf16_t*)(QT + s * HC_LD + d * 2) = f2bf(qv * __expf(cum - ref));
                *(bf16_t*)(KN + s * HC_LD + d * 2) = f2bf(kv * __expf(ref - cum));
                *(bf16_t*)(QH + s * HC_LD + d * 2) = f2bf(qv * __expf(cum));
            }
        }
        __syncthreads();
        {
            const int mt = wid >> 1;
            const char* xs = QT + (mt * 16 + lr) * HC_LD + lg * 16;
            bf16x8 xf[4];
#pragma unroll
            for (int ks = 0; ks < 4; ++ks) xf[ks] = *(const bf16x8*)(xs + ks * 64);
#pragma unroll
            for (int q = 0; q < 2; ++q) {
                const int nt = 2 * (wid & 1) + q;
                const char* ws = KN + (nt * 16 + lr) * HC_LD + lg * 16;
                f32x4 a = {0.f, 0.f, 0.f, 0.f};
#pragma unroll
                for (int ks = 0; ks < 4; ++ks) a = mfma16(*(const bf16x8*)(ws + ks * 64), xf[ks], a);
                const int t = mt * 16 + lr, s0 = nt * 16 + 4 * lg;
                float m[4];
#pragma unroll
                for (int j = 0; j < 4; ++j) m[j] = (s0 + j <= t) ? a[j] : 0.f;
                u32x2 w; w[0] = cvtpk(m[0], m[1]); w[1] = cvtpk(m[2], m[3]);
                *(u32x2*)(AT + t * HA_LD + s0 * 2) = w;
            }
        }
        __syncthreads();
        {
            const int mt = wid >> 1;
            const char* xa = AT + (mt * 16 + lr) * HA_LD + lg * 16;
            const char* xq = QH + (mt * 16 + lr) * HC_LD + lg * 16;
            bf16x8 af[2], qf[4];
#pragma unroll
            for (int ks = 0; ks < 2; ++ks) af[ks] = *(const bf16x8*)(xa + ks * 64);
#pragma unroll
            for (int ks = 0; ks < 4; ++ks) qf[ks] = *(const bf16x8*)(xq + ks * 64);
#pragma unroll
            for (int q = 0; q < 4; ++q) {
                const int nt = 4 * (wid & 1) + q;
                const char* wv = VT + (nt * 16 + lr) * HA_LD + lg * 16;
                const char* wsx = STl + (nt * 16 + lr) * HC_LD + lg * 16;
                f32x4 a = {0.f, 0.f, 0.f, 0.f};
#pragma unroll
                for (int ks = 0; ks < 2; ++ks) a = mfma16(*(const bf16x8*)(wv + ks * 64), af[ks], a);
#pragma unroll
                for (int ks = 0; ks < 4; ++ks) a = mfma16(*(const bf16x8*)(wsx + ks * 64), qf[ks], a);
                *(f32x4*)(cumL + (mt * 16 + lr) * 128 + nt * 16 + 4 * lg) = a;
            }
        }
        __syncthreads();
        {
#pragma unroll
            for (int i = 0; i < 8; ++i) {
                const int t = wid * 8 + i;
                const f32x2 ov = *(const f32x2*)(cumL + t * 128 + 2 * lane);
                const float ss = wave_sum(ov[0] * ov[0] + ov[1] * ov[1]);
                const float rs = 1.0f / sqrtf(ss * (1.0f / 128.0f) + EPSF);
                const unsigned gw = *(const unsigned*)(p.PBUF + (rowbase + t) * IN_COLS_PAD + C_GB + h * 128 + 2 * lane);
                const f32x2 gbn = *(const f32x2*)(p.g_bn + 2 * lane);
                const size_t mrow = (size_t)b * 2048 + 64 * (c - 1) + t;
                *(unsigned*)(p.AMB + mrow * 512 + h * 128 + 2 * lane) = cvtpk(ov[0] * rs * gbn[0] * bflo(gw), ov[1] * rs * gbn[1] * bfhi(gw));
            }
        }
        __syncthreads();
    }
}

#define SC_LD 528
#define SP_LD 272
#define SC_BUF (128 * SC_LD)

#define SA_D 6
#define SA_STG (SA_D * 16384)
#define SA_RSTG (SA_D * 2048)
#define SA_CB_SLOT (16 * SC_LD)
#define SA_NG 128
typedef __attribute__((address_space(3))) unsigned las_u32;

#define SB_D 2
#define SB_STG (SB_D * 32768)
#define SB_RSTG (SB_D * 4096)
#define SB_CB_SLOT (32 * SC_LD)
#define SB_NG 64

#define SR_LD 80
typedef short v4i16_t __attribute__((ext_vector_type(4)));
__device__ __forceinline__ float xsum16_32(float v) {
    auto r = __builtin_amdgcn_permlane16_swap(__float_as_uint(v), __float_as_uint(v), false, false);
    v = __uint_as_float(r[0]) + __uint_as_float(r[1]);
    auto q = __builtin_amdgcn_permlane32_swap(__float_as_uint(v), __float_as_uint(v), false, false);
    return __uint_as_float(q[0]) + __uint_as_float(q[1]);
}
__device__ __forceinline__ void sample_attn4(const Params& p, char* lds) {
    const int tid = threadIdx.x, lane = tid & 63, lr = lane & 15, lg = lane >> 4;
    const int wid = __builtin_amdgcn_readfirstlane(tid >> 6);
    char* stg = lds;
    char* rstg = lds + SB_STG;
    char* cb = rstg + SB_RSTG;
    char* rb = cb + 3 * SB_CB_SLOT;
    char* pl = rb + 3 * 32 * SR_LD;
    for (int blk = blockIdx.x; blk < DEC_BATCH * 8; blk += gridDim.x) {
        const int b = blk >> 3, split = blk & 7, h = wid;
        ((unsigned*)pl)[tid] = 0u;
        bf16x8 wf[4][8];
        {
            const bf16_t* wb = p.WUKV_T + (size_t)(64 * h + lr) * 256 + 8 * lg;
#pragma unroll
            for (int nt = 0; nt < 4; ++nt) {
                asm volatile("" : "+v"(wb));
#pragma unroll
                for (int ks = 0; ks < 8; ++ks) wf[nt][ks] = *(const bf16x8*)(wb + 32 * ks);
                wb += 16 * 256;
            }
        }
        const float* qs = p.QS + (size_t)(b * 8 + h) * 96;
        f32x4 qg[4];
#pragma unroll
        for (int nt = 0; nt < 4; ++nt) qg[nt] = *(const f32x4*)(qs + 16 * nt + 4 * lg) * LOG2E;
        bf16x8 qrf;
        {
            u32x4 w = {0u, 0u, 0u, 0u};
            if (lr < 8) {
                const float* q = p.QS + (size_t)(b * 8 + lr) * 96 + 64 + 8 * lg;
                const f32x4 a0 = *(const f32x4*)q * LOG2E, a1 = *(const f32x4*)(q + 4) * LOG2E;
                w[0] = cvtpk(a0[0], a0[1]); w[1] = cvtpk(a0[2], a0[3]); w[2] = cvtpk(a1[0], a1[1]); w[3] = cvtpk(a1[2], a1[3]);
            }
            qrf = __builtin_bit_cast(bf16x8, w);
        }
        const int pgid = p.page_table[b * NPAGES + split * 16 + (lane & 15)];
        const float Mb = p.SCAL[0] * LOG2E;
        f32x4 accl[2] = {{0.f, 0.f, 0.f, 0.f}, {0.f, 0.f, 0.f, 0.f}};
        float lacc = 0.f;
        asm volatile("s_waitcnt vmcnt(0) lgkmcnt(0)" ::: "memory");
        __syncthreads();
        auto issue = [&](int gi, int slot) {
            const int pg = __builtin_amdgcn_readlane(pgid, gi >> 2);
            const size_t row0 = (size_t)pg * PAGE + 32 * (gi & 3) + 4 * wid;
            const float* src = p.cache_latent + row0 * KV_LORA + lane * 4;
            char __attribute__((address_space(3)))* d0 = (char __attribute__((address_space(3)))*)(stg + slot * 32768 + (4 * wid) * 1024);
            __builtin_amdgcn_global_load_lds((const unsigned*)src, (las_u32*)d0, 16, 0, 0);
            __builtin_amdgcn_global_load_lds((const unsigned*)(src + KV_LORA), (las_u32*)(d0 + 1024), 16, 0, 0);
            __builtin_amdgcn_global_load_lds((const unsigned*)(src + 2 * KV_LORA), (las_u32*)(d0 + 2048), 16, 0, 0);
            __builtin_amdgcn_global_load_lds((const unsigned*)(src + 3 * KV_LORA), (las_u32*)(d0 + 3072), 16, 0, 0);
            const float* rsrc = p.cache_krope + row0 * A_ROPE + lane;
            char __attribute__((address_space(3)))* r0 = (char __attribute__((address_space(3)))*)(rstg + slot * 4096 + wid * 512);
            __builtin_amdgcn_global_load_lds((const unsigned*)rsrc, (las_u32*)r0, 4, 0, 0);
            __builtin_amdgcn_global_load_lds((const unsigned*)(rsrc + 64), (las_u32*)(r0 + 256), 4, 0, 0);
        };
#pragma unroll 1
        for (int gi = 0; gi < SB_D; ++gi) issue(gi, gi);
        int c3_g = 2, d_g1 = 0;
        const int hsel = h & 3;
        const float fhg = (lg == (h >> 2)) ? 1.f : 0.f, fdg = (lg == (lr >> 2)) ? 1.f : 0.f;
#pragma unroll 1
        for (int g = -1; g <= SB_NG; ++g) {
            const int c3_g1 = (c3_g == 2) ? 0 : c3_g + 1;
            const int c3_gm1 = (c3_g == 0) ? 2 : c3_g - 1;
            if (g + 1 < SB_NG) {
                if (g + SB_D <= SB_NG - 1) asm volatile("s_waitcnt vmcnt(%0)" :: "n"(6 * (SB_D - 1)) : "memory");
                else asm volatile("s_waitcnt vmcnt(0)" ::: "memory");
            }
            asm volatile("s_waitcnt lgkmcnt(0)" ::: "memory");
            __builtin_amdgcn_s_barrier();
            asm volatile("" ::: "memory");
            if (g + 1 < SB_NG) {
#pragma unroll
                for (int i = 0; i < 4; ++i) {
                    const f32x4 v = *(const f32x4*)(stg + d_g1 * 32768 + (4 * wid + i) * 1024 + lane * 16);
                    u32x2 w; w[0] = cvtpk(v[0], v[1]); w[1] = cvtpk(v[2], v[3]);
                    *(u32x2*)(cb + c3_g1 * SB_CB_SLOT + (4 * wid + i) * SC_LD + lane * 8) = w;
                }
                {
                    const int rrow = 4 * wid + (lane >> 4), c2 = (lane & 15) * 2;
                    const f32x2 v = *(const f32x2*)(rstg + d_g1 * 4096 + rrow * 128 + c2 * 4);
                    *(unsigned*)(rb + c3_g1 * 32 * SR_LD + rrow * SR_LD + c2 * 2) = cvtpk(v[0], v[1]);
                }
                asm volatile("" ::: "memory");
                if (g + 1 + SB_D < SB_NG) issue(g + 1 + SB_D, d_g1);
            }
            if (g >= 0 && g < SB_NG) {
#pragma unroll
                for (int mt2 = 0; mt2 < 2; ++mt2) {
                    f32x4 a[4];
#pragma unroll
                    for (int nt = 0; nt < 4; ++nt) a[nt] = (f32x4){0.f, 0.f, 0.f, 0.f};
                    const char* xs = cb + c3_g * SB_CB_SLOT + (16 * mt2 + lr) * SC_LD + lg * 16;
                    const bf16x8 rf = *(const bf16x8*)(rb + c3_g * 32 * SR_LD + (16 * mt2 + lr) * SR_LD + lg * 16);
#pragma unroll
                    for (int ks = 0; ks < 8; ++ks) {
                        const bf16x8 xf = *(const bf16x8*)(xs + ks * 64);
#pragma unroll
                        for (int nt = 0; nt < 4; ++nt) a[nt] = mfma16(wf[nt][ks], xf, a[nt]);
                    }
                    const f32x4 z4 = {0.f, 0.f, 0.f, 0.f};
                    const f32x4 asr = mfma16(qrf, rf, z4);
                    const f32x4 arr = mfma16(rf, rf, z4);
                    const float srv = (hsel == 0) ? asr[0] : (hsel == 1) ? asr[1] : (hsel == 2) ? asr[2] : asr[3];
                    const int dj = lr & 3;
                    const float rrv = (dj == 0) ? arr[0] : (dj == 1) ? arr[1] : (dj == 2) ? arr[2] : arr[3];
                    float ss = rrv * fdg, sq = srv * fhg;
#pragma unroll
                    for (int nt = 0; nt < 4; ++nt)
#pragma unroll
                        for (int j = 0; j < 4; ++j) { ss += a[nt][j] * a[nt][j]; sq += a[nt][j] * qg[nt][j]; }
                    ss = xsum16_32(ss); sq = xsum16_32(sq);
                    const float sc = sq * __builtin_amdgcn_rsqf(ss * (1.0f / 96.0f) + EPSF);
                    const float pe = __builtin_amdgcn_exp2f(sc - Mb);
                    lacc += pe;
                    if (lg == 0) *(bf16_t*)(pl + (g & 1) * 1024 + h * 64 + (16 * mt2 + lr) * 2) = f2bf(pe);
                }
            }
            if (g >= 1) {
                const bf16x8 xf = *(const bf16x8*)(pl + ((g - 1) & 1) * 1024 + lr * 64 + lg * 16);
#pragma unroll
                for (int q = 0; q < 2; ++q) {
                    const char* cc = cb + c3_gm1 * SB_CB_SLOT + (8 * lg + (lr >> 2)) * SC_LD + (32 * wid + 16 * q + 4 * (lr & 3)) * 2;
                    const v4i16_t t0 = __builtin_amdgcn_ds_read_tr16_b64_v4i16((__attribute__((address_space(3))) v4i16_t*)(cc));
                    const v4i16_t t1 = __builtin_amdgcn_ds_read_tr16_b64_v4i16((__attribute__((address_space(3))) v4i16_t*)(cc + 4 * SC_LD));
                    const bf16x8 wfr = {t0[0], t0[1], t0[2], t0[3], t1[0], t1[1], t1[2], t1[3]};
                    accl[q] = mfma16(wfr, xf, accl[q]);
                }
            }
            c3_g = c3_g1;
            d_g1 = (d_g1 + 1 == SB_D) ? 0 : d_g1 + 1;
        }
        if (lr < 8) {
#pragma unroll
            for (int q = 0; q < 2; ++q) *(f32x4*)(p.PART + ((size_t)(b * 8 + split) * 8 + lr) * 256 + 32 * wid + 16 * q + 4 * lg) = accl[q];
        }
        lacc += __shfl_xor(lacc, 8); lacc += __shfl_xor(lacc, 4); lacc += __shfl_xor(lacc, 2); lacc += __shfl_xor(lacc, 1);
        if (lane == 0) p.PL[(b * 8 + split) * 8 + h] = lacc;
        __syncthreads();
    }
}

__device__ __forceinline__ void phase3(const Params& p, char* lds) {
    hgrn_passB(p);
    sample_attn4(p, lds);
}

__device__ __forceinline__ void sample_combine(const Params& p, char* lds) {
    const int tid = threadIdx.x;
    float* ol = (float*)lds;
    float* red = ol + 256;
    float* sc = red + 512;
    for (int u = blockIdx.x; u < DEC_BATCH * 8; u += gridDim.x) {
        const int b = u >> 3, h = u & 7;
        if (tid < 64) {
            const float* kraw = p.KSRAW + (size_t)(b * 8 + h) * 96;
            const float* qs = p.QS + (size_t)(b * 8 + h) * 96;
            float ss = 0.f, sq = 0.f;
            for (int d = tid; d < 96; d += 64) { const float k = kraw[d]; ss += k * k; sq += k * qs[d]; }
            ss = wave_sum(ss); sq = wave_sum(sq);
            if (tid == 0) {
                const float s = sq / sqrtf(ss * (1.0f / 96.0f) + EPSF);
                const float pn = __expf(s - p.SCAL[0]);
                float l = pn;
                for (int sp = 0; sp < 8; ++sp) l += p.PL[(b * 8 + sp) * 8 + h];
                sc[0] = pn; sc[1] = 1.0f / l;
            }
        }
        __syncthreads();
        if (tid < 256) {
            const int c = tid;
            float a = sc[0] * p.out[OFF_LAT_S + b * 256 + c];
#pragma unroll
            for (int sp = 0; sp < 8; ++sp) a += p.PART[((size_t)(b * 8 + sp) * 8 + h) * 256 + c];
            ol[c] = a * sc[1];
        }
        __syncthreads();
        {
            const int d = tid & 63, part = tid >> 6;
            const bf16_t* wrow = p.WUKV_T + (size_t)(512 + h * 64 + d) * 256 + part * 32;
            float a = 0.f;
#pragma unroll
            for (int c = 0; c < 32; c += 8) {
                const u32x4 w = *(const u32x4*)(wrow + c);
                const f32x4 o0 = *(const f32x4*)(ol + part * 32 + c), o1 = *(const f32x4*)(ol + part * 32 + c + 4);
                a += o0[0] * bflo(w[0]) + o0[1] * bfhi(w[0]) + o0[2] * bflo(w[1]) + o0[3] * bfhi(w[1]) + o1[0] * bflo(w[2]) + o1[1] * bfhi(w[2]) + o1[2] * bflo(w[3]) + o1[3] * bfhi(w[3]);
            }
            red[part * 64 + d] = a;
        }
        __syncthreads();
        if (tid < 64) {
            float a = 0.f;
#pragma unroll
            for (int q = 0; q < 8; ++q) a += red[q * 64 + tid];
            const float ga = bf2f(p.PBUF[(size_t)(R_PROMPT + b) * IN_COLS_PAD + C_GA + h * 64 + tid]);
            p.AMA[(size_t)(NQ + b) * 512 + h * 64 + tid] = f2bf(a * ga);
        }
        __syncthreads();
    }
}

__device__ __forceinline__ void merge_m_gemm(const Params& p, char* lds) {
    const int bx = blockIdx.x, vcu = (bx & 7) * 32 + (bx >> 3);
    OneTileOrder S{vcu, 1};
    {
        pg8::Gemm g{p.AMA, p.WOA_T, NQ, 1024, 512, p.AMA, p.WOA_T};
        EpiMerge<0> E{p.PBUF, p.TMP, p.MM};
        pg8::gemm_phase<EpiMerge<0>, OneTileOrder, false, true>((PG8_LAS unsigned char*)lds, g, S, E);
    }
    {
        pg8::Gemm g{p.AMB, p.WOB_T, NQ, 1024, 512, p.AMB, p.WOB_T};
        EpiMerge<1> E{p.PBUF, p.TMP, p.MM};
        pg8::gemm_phase<EpiMerge<1>, OneTileOrder, false, true>((PG8_LAS unsigned char*)lds, g, S, E);
    }
}


__device__ __forceinline__ float dot_bf16_row(const bf16_t* a, const bf16_t* w, int K) {
    float s = 0.f;
    for (int k = 0; k < K; k += 8) {
        const u32x4 x = *(const u32x4*)(a + k), y = *(const u32x4*)(w + k);
#pragma unroll
        for (int e = 0; e < 4; ++e) s += bflo(x[e]) * bflo(y[e]) + bfhi(x[e]) * bfhi(y[e]);
    }
    return s;
}
__device__ __forceinline__ void rows32_tile(f32x4 (&acc)[2], const bf16_t* __restrict__ X, int ldx, const bf16_t* __restrict__ W, int K, int nt) {
    const int lane = threadIdx.x & 63, lr = lane & 15, lg = lane >> 4;
    const bf16_t* x0 = X + (size_t)lr * ldx + lg * 8;
    const bf16_t* x1 = X + (size_t)(16 + lr) * ldx + lg * 8;
    const bf16_t* w = W + (size_t)(nt * 16 + lr) * K + lg * 8;
#pragma unroll 8
    for (int ks = 0; ks < (K >> 5); ++ks) {
        const bf16x8 wf = *(const bf16x8*)(w + ks * 32);
        acc[0] = mfma16(wf, *(const bf16x8*)(x0 + ks * 32), acc[0]);
        acc[1] = mfma16(wf, *(const bf16x8*)(x1 + ks * 32), acc[1]);
    }
}
template <int KSTEPS_PER_WAVE>
__device__ __forceinline__ void rows32_tile_ksplit(f32x4 (&acc)[2], const bf16_t* __restrict__ X, int ldx, const bf16_t* __restrict__ W, int K, int nt, int wid) {
    const int lane = threadIdx.x & 63, lr = lane & 15, lg = lane >> 4;
    const int ks0 = wid * KSTEPS_PER_WAVE;
    const bf16_t* x0 = X + (size_t)lr * ldx + lg * 8 + ks0 * 32;
    const bf16_t* x1 = X + (size_t)(16 + lr) * ldx + lg * 8 + ks0 * 32;
    const bf16_t* w = W + (size_t)(nt * 16 + lr) * K + lg * 8 + ks0 * 32;
    bf16x8 wf[KSTEPS_PER_WAVE], xa[KSTEPS_PER_WAVE], xb[KSTEPS_PER_WAVE];
#pragma unroll
    for (int ks = 0; ks < KSTEPS_PER_WAVE; ++ks) { wf[ks] = *(const bf16x8*)(w + ks * 32); xa[ks] = *(const bf16x8*)(x0 + ks * 32); xb[ks] = *(const bf16x8*)(x1 + ks * 32); }
#pragma unroll
    for (int ks = 0; ks < KSTEPS_PER_WAVE; ++ks) { acc[0] = mfma16(wf[ks], xa[ks], acc[0]); acc[1] = mfma16(wf[ks], xb[ks], acc[1]); }
}
__device__ __forceinline__ void sample_m(const Params& p, char* lds) {
    const int tid = threadIdx.x, lane = tid & 63, wid = tid >> 6, lr = lane & 15, lg = lane >> 4;
    f32x4* red = (f32x4*)lds;
    for (int nt = blockIdx.x; nt < 64; nt += gridDim.x) {
        f32x4 ya[2] = {{0.f, 0.f, 0.f, 0.f}, {0.f, 0.f, 0.f, 0.f}}, yb[2] = {{0.f, 0.f, 0.f, 0.f}, {0.f, 0.f, 0.f, 0.f}};
        rows32_tile_ksplit<2>(ya, p.AMA + (size_t)NQ * 512, 512, p.WOA_T, 512, nt, wid);
        rows32_tile_ksplit<2>(yb, p.AMB + (size_t)NQ * 512, 512, p.WOB_T, 512, nt, wid);
        red[(wid * 4 + 0) * 64 + lane] = ya[0]; red[(wid * 4 + 1) * 64 + lane] = ya[1];
        red[(wid * 4 + 2) * 64 + lane] = yb[0]; red[(wid * 4 + 3) * 64 + lane] = yb[1];
        __syncthreads();
        if (wid == 0) {
#pragma unroll
            for (int q = 1; q < 8; ++q) { ya[0] += red[(q * 4 + 0) * 64 + lane]; ya[1] += red[(q * 4 + 1) * 64 + lane]; yb[0] += red[(q * 4 + 2) * 64 + lane]; yb[1] += red[(q * 4 + 3) * 64 + lane]; }
#pragma unroll
            for (int mt = 0; mt < 2; ++mt) {
                const int i = 16 * mt + lr, n = 16 * nt + 4 * lg;
                const size_t r = R_PROMPT + i;
                const u32x2 ga = *(const u32x2*)(p.PBUF + r * IN_COLS_PAD + C_MA + n);
                const u32x2 gb = *(const u32x2*)(p.PBUF + r * IN_COLS_PAD + C_MB + n);
                u32x2 w;
                w[0] = cvtpk(bflo(ga[0]) * ya[mt][0] + bflo(gb[0]) * yb[mt][0], bfhi(ga[0]) * ya[mt][1] + bfhi(gb[0]) * yb[mt][1]);
                w[1] = cvtpk(bflo(ga[1]) * ya[mt][2] + bflo(gb[1]) * yb[mt][2], bfhi(ga[1]) * ya[mt][3] + bfhi(gb[1]) * yb[mt][3]);
                *(u32x2*)(p.MM + (size_t)(NQ + i) * 1024 + n) = w;
            }
        }
        __syncthreads();
    }
}
__device__ __forceinline__ void final_gemm(const Params& p, char* lds) {
    const int bx = blockIdx.x, vcu = (bx & 7) * 32 + (bx >> 3);
    pg8::Gemm g{p.MM, p.WO_T, NQ, 1024, 1024, p.MM, p.WO_T};
    OneTileOrder S{vcu, 1};
    EpiFinal E{p.x_prompt, p.out + OFF_Y_P};
    pg8::gemm_phase<EpiFinal, OneTileOrder, false, true>((PG8_LAS unsigned char*)lds, g, S, E);
}


__device__ __forceinline__ void sample_y(const Params& p, char* lds) {
    const int tid = threadIdx.x, lane = tid & 63, wid = tid >> 6, lr = lane & 15, lg = lane >> 4;
    f32x4* red = (f32x4*)lds;
    for (int nt = blockIdx.x; nt < 64; nt += gridDim.x) {
        f32x4 y[2] = {{0.f, 0.f, 0.f, 0.f}, {0.f, 0.f, 0.f, 0.f}};
        rows32_tile_ksplit<4>(y, p.MM + (size_t)NQ * 1024, 1024, p.WO_T, 1024, nt, wid);
        red[(wid * 2 + 0) * 64 + lane] = y[0]; red[(wid * 2 + 1) * 64 + lane] = y[1];
        __syncthreads();
        if (wid == 0) {
#pragma unroll
            for (int q = 1; q < 8; ++q) { y[0] += red[(q * 2 + 0) * 64 + lane]; y[1] += red[(q * 2 + 1) * 64 + lane]; }
#pragma unroll
            for (int mt = 0; mt < 2; ++mt) {
                const int i = 16 * mt + lr, n = 16 * nt + 4 * lg;
                const f32x4 x = *(const f32x4*)(p.x_sample + (size_t)i * 1024 + n);
                *(f32x4*)(p.out + OFF_Y_S + (size_t)i * 1024 + n) = x + y[mt];
            }
        }
        __syncthreads();
    }
}

__device__ __forceinline__ void phase4(const Params& p, char* lds) {
    sample_combine(p, lds);
    attn_phase(p, lds);
    hgrn_passC(p, lds);
}
__device__ __forceinline__ void phase5(const Params& p, char* lds) {
    sample_m(p, lds);
    merge_m_gemm(p, lds);
}
__device__ __forceinline__ void phase6(const Params& p, char* lds) {
    sample_y(p, lds);
    final_gemm(p, lds);
}

#define XB_TMO      128
#define XB_XCNT(j)  (256  + 64 * (j))
#define XB_XSUB(j)  (1280 + 64 * (j))
#define XB_XGEN(j)  (2304 + 64 * (j))
#define XB_TOP      3328
#define XB_TOPGEN   3392
#define XCD_BAR_WORDS 3456
#define XB_SPIN_CAP (1u << 22)
#define LAS __attribute__((address_space(3)))
__device__ __forceinline__ unsigned xb_ld(unsigned* p)              { return __hip_atomic_load(p, __ATOMIC_RELAXED, __HIP_MEMORY_SCOPE_AGENT); }
__device__ __forceinline__ unsigned xb_add(unsigned* p, unsigned v) { return __hip_atomic_fetch_add(p, v, __ATOMIC_RELAXED, __HIP_MEMORY_SCOPE_AGENT); }
__device__ __forceinline__ unsigned xb_xcc_id() { return (unsigned)__builtin_amdgcn_s_getreg((3 << 11) | 20) & 0xFu; }
#define XB_SPIN(cond, bar) do { unsigned _sp = 0; while (cond) { __builtin_amdgcn_s_sleep(1); \
    if ((++_sp & 255u) == 0u) { if (xb_ld(&(bar)[XB_TMO])) break; if (_sp > XB_SPIN_CAP) { atomicAdd(&(bar)[XB_TMO], 1u); break; } } } } while (0)
struct XcdBarrier { unsigned* bar; unsigned x; volatile LAS unsigned* st; };
__device__ __forceinline__ XcdBarrier xcd_barrier_post(unsigned* bar, volatile LAS unsigned* st) {
    XcdBarrier b; b.bar = bar; b.x = xb_xcc_id(); b.st = st;
    if (threadIdx.x == 0) (void)xb_add(&bar[XB_XCNT(b.x)], 1u);
    return b;
}
__device__ __forceinline__ void xcd_barrier_complete(unsigned* bar, unsigned x, unsigned& nloc, unsigned& nx) {
    const unsigned G = gridDim.x * gridDim.y * gridDim.z;
    unsigned sum, cnt, mine, sp = 0u;
    for (;;) {
        sum = 0u; cnt = 0u; mine = 0u;
#pragma unroll
        for (unsigned j = 0; j < 16; ++j) { const unsigned c = xb_ld(&bar[XB_XCNT(j)]); sum += c; cnt += (c > 0u) ? 1u : 0u; mine = (j == x) ? c : mine; }
        if (sum == G) break;
        __builtin_amdgcn_s_sleep(1);
        if ((++sp & 255u) == 0u) { if (xb_ld(&bar[XB_TMO])) break; if (sp > XB_SPIN_CAP) { atomicAdd(&bar[XB_TMO], 1u); break; } }
    }
    nloc = mine > 0u ? mine : 1u; nx = cnt > 0u ? cnt : 1u;
}
__device__ __forceinline__ void xcd_barrier(const XcdBarrier& b) {
    asm volatile("s_waitcnt vmcnt(0)" ::: "memory");
    __syncthreads();
    if (threadIdx.x == 0) {
        unsigned* bar = b.bar;
        __builtin_amdgcn_s_waitcnt(0);
        unsigned nloc = b.st[0], nx = b.st[1];
        if (nloc == 0u) { xcd_barrier_complete(bar, b.x, nloc, nx); b.st[0] = nloc; b.st[1] = nx; }
        const unsigned old = xb_add(&bar[XB_XSUB(b.x)], 1u);
        const unsigned gen = old / nloc;
        if (old + 1u == (gen + 1u) * nloc) {
            __builtin_amdgcn_fence(__ATOMIC_RELEASE, "agent");
            asm volatile("s_waitcnt vmcnt(0)" ::: "memory");
            const unsigned og = xb_add(&bar[XB_TOP], 1u);
            const unsigned tg = og / nx;
            if (og + 1u == (tg + 1u) * nx) xb_add(&bar[XB_TOPGEN], 1u);
            else XB_SPIN(xb_ld(&bar[XB_TOPGEN]) == tg, bar);
            __builtin_amdgcn_fence(__ATOMIC_ACQUIRE, "agent");
            xb_add(&bar[XB_XGEN(b.x)], 1u);
            asm volatile("s_waitcnt vmcnt(0)" ::: "memory");
        } else {
            XB_SPIN(xb_ld(&bar[XB_XGEN(b.x)]) == gen, bar);
            __builtin_amdgcn_fence(__ATOMIC_ACQUIRE, "agent");
            asm volatile("s_waitcnt vmcnt(0)" ::: "memory");
        }
    }
    __syncthreads();
}

extern __shared__ __attribute__((aligned(16))) char smem[];
#define NPHASES 7

#define XB_LDS_OFF (LDS_BYTES - 16)
__global__ void __launch_bounds__(NTHREADS) mega(Params p, int ph0, int ph1) {
    XcdBarrier xb;
    const bool multi = (ph1 - ph0) > 1;
    if (multi) {
        if (threadIdx.x == 0) *(u32x4*)(smem + XB_LDS_OFF) = (u32x4){0u, 0u, 0u, 0u};
        __syncthreads();
        xb = xcd_barrier_post(p.bar, (volatile LAS unsigned*)(smem + XB_LDS_OFF));
    }
#if defined(__HIP_DEVICE_COMPILE__)
    typedef const __attribute__((address_space(4))) Params* cparams_t;
    const cparams_t kp = (cparams_t)__builtin_amdgcn_kernarg_segment_ptr();
#define RUN_PHASE(k) if (ph0 <= k && k < ph1) { cparams_t q_ = kp; asm volatile("" : "+s"(q_)); const Params lp_ = *q_; phase##k(lp_, smem); if (k + 1 < ph1) xcd_barrier(xb); }
#else
#define RUN_PHASE(k) if (ph0 <= k && k < ph1) { phase##k(p, smem); if (k + 1 < ph1) xcd_barrier(xb); }
#endif
    RUN_PHASE(0)
    RUN_PHASE(1)
    RUN_PHASE(2)
    RUN_PHASE(3)
    RUN_PHASE(4)
    RUN_PHASE(5)
    RUN_PHASE(6)
}

static inline size_t align_up(size_t x, size_t a) { return (x + a - 1) / a * a; }

extern "C" void kernel_launch(void* const* d_in, const int* in_sizes, int n_in,
                              void* d_out, int out_size, void* d_ws, size_t ws_size,
                              hipStream_t stream) {
    Params p{};
    p.x_prompt = (const float*)d_in[0]; p.x_sample = (const float*)d_in[1]; p.cache_latent = (const float*)d_in[2]; p.cache_krope = (const float*)d_in[3];
    p.state_hgrn = (const float*)d_in[4]; p.page_table = (const int*)d_in[5]; p.meta = (const float*)d_in[6]; p.norm_g = (const float*)d_in[7];
    p.w_in = (const float*)d_in[8]; p.g_cq = (const float*)d_in[9]; p.w_uq = (const float*)d_in[10]; p.g_ckv = (const float*)d_in[11];
    p.w_uk = (const float*)d_in[12]; p.w_uv = (const float*)d_in[13]; p.g_qn = (const float*)d_in[14]; p.g_kn = (const float*)d_in[15];
    p.lb_logits = (const float*)d_in[16]; p.g_bn = (const float*)d_in[17]; p.w_oa = (const float*)d_in[18]; p.w_ob = (const float*)d_in[19]; p.w_o = (const float*)d_in[20];
    p.out = (float*)d_out;
    char* w = (char*)d_ws; size_t off = 0;
    auto take = [&](size_t bytes) { char* r = w + off; off = align_up(off + bytes, 256); return r; };
    p.bar    = (unsigned*)take(16384);
    p.XN     = (bf16_t*)take((size_t)R_PAD * 1024 * 2);
    p.WIN_T  = (bf16_t*)take((size_t)IN_COLS_PAD * 1024 * 2);
    p.PBUF   = (bf16_t*)take((size_t)R_PAD * IN_COLS_PAD * 2);
    p.F32A   = (float*)take((size_t)R_PAD * 672 * 4);
    p.GLOG   = (float*)take((size_t)R_PAD * 512 * 4);
    p.CQN    = (bf16_t*)take((size_t)R_PAD * 384 * 2);
    p.CKVN   = (bf16_t*)take((size_t)R_PAD * 256 * 2);
    p.KRR    = (float*)take((size_t)R_PAD * 32 * 4);
    p.WUQ_T  = (bf16_t*)take((size_t)768 * 384 * 2);
    p.WUKV_T = (bf16_t*)take((size_t)1024 * 256 * 2);
    p.WUKVG_T = (bf16_t*)take((size_t)1024 * 256 * 2);
    p.F32B   = (float*)take((size_t)R_PAD * 288 * 4);
    p.WOA_T  = (bf16_t*)take((size_t)1024 * 512 * 2);
    p.WOB_T  = (bf16_t*)take((size_t)1024 * 512 * 2);
    p.WO_T   = (bf16_t*)take((size_t)1024 * 1024 * 2);
    p.QRAW   = (bf16_t*)take((size_t)R_PAD * 768 * 2);
    p.KVRAW  = (bf16_t*)take((size_t)R_PAD * 1024 * 2);
    p.QA     = (bf16_t*)take((size_t)8 * 8 * 2048 * 96 * 2);
    p.KA     = (bf16_t*)take((size_t)8 * 8 * 2064 * 96 * 2 + 65536);
    p.VTG    = (bf16_t*)take((size_t)64 * 64 * 2112 * 2);
    p.QS     = (float*)take((size_t)32 * 8 * 96 * 4);
    p.KSRAW  = (float*)take((size_t)32 * 8 * 96 * 4);
    p.AMA    = (bf16_t*)take((size_t)MROWS_PAD * 512 * 2);
    p.AMB    = (bf16_t*)take((size_t)MROWS_PAD * 512 * 2);
    p.MM     = (bf16_t*)take((size_t)MROWS_PAD * 1024 * 2);
    p.TMP    = (float*)take((size_t)NQ * 1024 * 4);
    p.UT     = (bf16_t*)take((size_t)32 * NCHUNK * 16384 * 2);
    p.ST     = (bf16_t*)take((size_t)32 * NCHUNK * 16384 * 2);
    p.DEC    = (float*)take((size_t)32 * NCHUNK * 128 * 4);
    p.LB     = (float*)take(512 * 4);
    p.INV    = (float*)take(64);
    p.ROPE   = (float*)take((size_t)2065 * 32 * 4);
    p.SCAL   = (float*)take(64);
    p.PART   = (float*)take((size_t)32 * 8 * 8 * 256 * 4);
    p.PL     = (float*)take((size_t)32 * 8 * 8 * 4);
    p.OLAT   = (float*)take((size_t)32 * 8 * 256 * 4);
    (void)ws_size; (void)in_sizes; (void)n_in; (void)out_size;
    static int mode = -1;
    if (mode < 0) {
        (void)hipFuncSetAttribute((const void*)mega, hipFuncAttributeMaxDynamicSharedMemorySize, LDS_BYTES);
        int dev = 0, cus = 0, per_cu = 0;
        (void)hipGetDevice(&dev);
        (void)hipDeviceGetAttribute(&cus, hipDeviceAttributeMultiprocessorCount, dev);
        (void)hipOccupancyMaxActiveBlocksPerMultiprocessor(&per_cu, (const void*)mega, NTHREADS, LDS_BYTES);
        mode = (cus * per_cu >= 256) ? 1 : 0;
    }
    (void)hipMemsetAsync(p.bar, 0, 16384, stream);
    if (mode == 1) {
        mega<<<dim3(256), dim3(NTHREADS), LDS_BYTES, stream>>>(p, 0, NPHASES);
    } else {
        for (int ph = 0; ph < NPHASES; ++ph) mega<<<dim3(256), dim3(NTHREADS), LDS_BYTES, stream>>>(p, ph, ph + 1);
    }
}
```

```cpp
#include <hip/hip_runtime.h>
#include <stdint.h>

#define D_MODEL 1024
#define BATCH 8
#define SEQ 2048
#define NMETA 16
#define LTOT 2064
#define DEC_BATCH 32
#define PAST_LEN 16384
#define PAGE 128
#define NPAGES 128
#define A_HEADS 8
#define A_NOPE 64
#define A_ROPE 32
#define A_QK 96
#define A_V 64
#define Q_LORA 384
#define KV_LORA 256
#define B_HEADS 4
#define B_DK 128
#define B_DV 128
#define IN_COLS 5280
#define IN_COLS_PAD 5376
#define EPSF 1e-6f

#define C_CQ 0
#define C_CKV 384
#define C_KR 640
#define C_BQ 672
#define C_BF 1184
#define C_BI 1696
#define C_GA 2208
#define C_GB 2720
#define C_MA 3232
#define C_MB 4256
#define C_END 5280

#define R_PROMPT 16512
#define R_ALL 16544
#define R_PAD 16640
#define NQ 16384
#define MROWS 16416
#define MROWS_PAD 16512

#define OFF_Y_P 0
#define OFF_Y_S 16777216
#define OFF_LAT_P 16809984
#define OFF_KR_P 21037056
#define OFF_HG_P 21565440
#define OFF_LAT_S 22089728
#define OFF_KR_S 22097920
#define OFF_HG_S 22098944
#define OUT_TOTAL 24196096

#define NTHREADS 512
#define LDS_BYTES 155648
#define LDS_ITEM_OFF (LDS_BYTES - 32)
#define NCHUNK 33

typedef unsigned short bf16_t;
typedef short bf16x8 __attribute__((ext_vector_type(8)));
typedef float f32x4 __attribute__((ext_vector_type(4)));
typedef float f32x2 __attribute__((ext_vector_type(2)));
typedef unsigned u32x4 __attribute__((ext_vector_type(4)));
typedef unsigned u32x2 __attribute__((ext_vector_type(2)));
typedef __bf16 bf16x2_t __attribute__((ext_vector_type(2)));

__device__ __forceinline__ unsigned cvtpk(float lo, float hi) {
    f32x2 v = {lo, hi};
    bf16x2_t b = __builtin_convertvector(v, bf16x2_t);
    return __builtin_bit_cast(unsigned, b);
}
__device__ __forceinline__ bf16_t f2bf(float x) { return (bf16_t)(cvtpk(x, 0.f) & 0xffffu); }
__device__ __forceinline__ float bf2f(bf16_t u) { return __uint_as_float(((unsigned)u) << 16); }
__device__ __forceinline__ float bflo(unsigned w) { return __uint_as_float(w << 16); }
__device__ __forceinline__ float bfhi(unsigned w) { return __uint_as_float(w & 0xffff0000u); }
__device__ __forceinline__ float sigmoidf_(float x) { return __builtin_amdgcn_rcpf(1.0f + __expf(-x)); }
__device__ __forceinline__ float siluf_(float x) { return x * __builtin_amdgcn_rcpf(1.0f + __expf(-x)); }
__device__ __forceinline__ float wave_sum(float v) {
    v += __shfl_xor(v, 32); v += __shfl_xor(v, 16); v += __shfl_xor(v, 8);
    v += __shfl_xor(v, 4);  v += __shfl_xor(v, 2);  v += __shfl_xor(v, 1);
    return v;
}

struct Params {
    const float* x_prompt; const float* x_sample; const float* cache_latent; const float* cache_krope;
    const float* state_hgrn; const int* page_table; const float* meta; const float* norm_g;
    const float* w_in; const float* g_cq; const float* w_uq; const float* g_ckv; const float* w_uk; const float* w_uv;
    const float* g_qn; const float* g_kn; const float* lb_logits; const float* g_bn;
    const float* w_oa; const float* w_ob; const float* w_o;
    float* out;
    bf16_t* XN;
    bf16_t* WIN_T;
    bf16_t* PBUF;
    float*  F32A;
    float*  GLOG;
    bf16_t* CQN;
    bf16_t* CKVN;
    float*  KRR;
    bf16_t* WUQ_T;
    bf16_t* WUKV_T;
    bf16_t* WUKVG_T;
    float*  F32B;
    bf16_t* WOA_T;
    bf16_t* WOB_T;
    bf16_t* WO_T;
    bf16_t* QRAW;
    bf16_t* KVRAW;
    bf16_t* QA;
    bf16_t* KA;
    bf16_t* VTG;
    float*  QS;
    float*  KSRAW;
    bf16_t* AMA;
    bf16_t* AMB;
    bf16_t* MM;
    float*  TMP;
    bf16_t* UT;
    bf16_t* ST;
    float*  DEC;
    float*  LB;
    float*  INV;
    float*  ROPE;
    float*  SCAL;
    float*  PART;
    float*  PL;
    float*  OLAT;
    unsigned* bar;
};

__device__ __forceinline__ f32x4 mfma16(bf16x8 w, bf16x8 x, f32x4 acc) {
    return __builtin_amdgcn_mfma_f32_16x16x32_bf16(w, x, acc, 0, 0, 0);
}

#define GT_LD 144
#define GT_BUF (128 * GT_LD)
#define GT_LDS_BYTES (4 * GT_BUF)

__device__ __forceinline__ void gemm_tile_accum(f32x4 (&acc)[4][2], const bf16_t* __restrict__ X, int ldx, const bf16_t* __restrict__ W, int ldw,
                                                int K, char* lds) {
    const int tid = threadIdx.x, lane = tid & 63, wid = tid >> 6, wm = wid >> 2, wn = wid & 3;
    const int lr = lane & 15, lg = lane >> 4;
    const int r0 = tid >> 3, kc = tid & 7;
    const bf16_t* xp0 = X + (size_t)r0 * ldx + kc * 8;
    const bf16_t* xp1 = X + (size_t)(r0 + 64) * ldx + kc * 8;
    const bf16_t* wp0 = W + (size_t)r0 * ldw + kc * 8;
    const bf16_t* wp1 = W + (size_t)(r0 + 64) * ldw + kc * 8;
    const int so0 = r0 * GT_LD + kc * 16, so1 = (r0 + 64) * GT_LD + kc * 16;
    char* Xs = lds; char* Ws = lds + 2 * GT_BUF;
    const int nk = K >> 6;
    u32x4 a0 = *(const u32x4*)xp0, a1 = *(const u32x4*)xp1, b0 = *(const u32x4*)wp0, b1 = *(const u32x4*)wp1;
    *(u32x4*)(Xs + so0) = a0; *(u32x4*)(Xs + so1) = a1; *(u32x4*)(Ws + so0) = b0; *(u32x4*)(Ws + so1) = b1;
    __syncthreads();
    const int xoff = (wm * 64 + lr) * GT_LD + lg * 16;
    const int woff = (wn * 32 + lr) * GT_LD + lg * 16;
    for (int kt = 0; kt < nk; ++kt) {
        const int cur = kt & 1;
        if (kt + 1 < nk) {
            const int ko = (kt + 1) * 64;
            a0 = *(const u32x4*)(xp0 + ko); a1 = *(const u32x4*)(xp1 + ko); b0 = *(const u32x4*)(wp0 + ko); b1 = *(const u32x4*)(wp1 + ko);
        }
        const char* xs = Xs + cur * GT_BUF + xoff;
        const char* ws = Ws + cur * GT_BUF + woff;
#pragma unroll
        for (int ks = 0; ks < 2; ++ks) {
            bf16x8 xf[4], wf[2];
#pragma unroll
            for (int mt = 0; mt < 4; ++mt) xf[mt] = *(const bf16x8*)(xs + mt * 16 * GT_LD + ks * 64);
#pragma unroll
            for (int nt = 0; nt < 2; ++nt) wf[nt] = *(const bf16x8*)(ws + nt * 16 * GT_LD + ks * 64);
#pragma unroll
            for (int mt = 0; mt < 4; ++mt)
#pragma unroll
                for (int nt = 0; nt < 2; ++nt) acc[mt][nt] = mfma16(wf[nt], xf[mt], acc[mt][nt]);
        }
        if (kt + 1 < nk) {
            char* xd = Xs + (cur ^ 1) * GT_BUF; char* wd = Ws + (cur ^ 1) * GT_BUF;
            *(u32x4*)(xd + so0) = a0; *(u32x4*)(xd + so1) = a1; *(u32x4*)(wd + so0) = b0; *(u32x4*)(wd + so1) = b1;
        }
        __syncthreads();
    }
}

namespace pg8 {
#define PG8_LAS __attribute__((address_space(3)))
constexpr int BM = 256, BK = 64, HALF = 128, HTB = HALF * BK * 2  , STAGE_BYTES = 8 * HTB, NXCD = 8, WGM = 8;

__host__ __device__ __forceinline__ int lds_byte(int r, int c) { const int st = (r >> 4) * 2 + (c >> 5), rr = r & 15, cc = c & 31, ob = rr * 64 + cc * 2; return st * 1024 + (ob ^ (((ob >> 9) & 1) << 5)); }
__host__ __device__ __forceinline__ void stage_rc(int b, int& R, int& C) { const int st = b / 1024, sb = b % 1024, swz = sb ^ (((sb >> 9) & 1) << 5); R = (st >> 1) * 16 + swz / 64; C = (st & 1) * 32 + (swz % 64) / 2; }
__host__ __device__ __forceinline__ int perm32(int rho) { const int n = rho >> 4, i = rho & 15; return 8 * (i >> 2) + 4 * n + (i & 3); }

struct Unit { int pm, pn, sel; };
struct Gemm { const bf16_t* A; const bf16_t* Bt; int M, N, K; const bf16_t* A1; const bf16_t* Bt1; };

struct StaticOrder {
    int nM, nN, nwg, G, c;
    __host__ __device__ void init(int M, int N, int G_, int c_) { nM = M / BM; nN = N / BM; nwg = nM * nN; G = G_; c = c_; }
    __host__ __device__ bool next(int i, Unit& u) const {
        const long L = (long)i * G + c; if (L >= nwg) return false;
        int wgid = (int)L; { const int q = nwg / NXCD, r = nwg % NXCD, xcd = wgid % NXCD, off = wgid / NXCD; wgid = (xcd < r ? xcd * (q + 1) : r * (q + 1) + (xcd - r) * q) + off; }
        const int nig = WGM * nN, gid = wgid / nig, fm = gid * WGM, gsz = (nM - fm) < WGM ? (nM - fm) : WGM;
        u.pm = fm + ((wgid % nig) % gsz); u.pn = (wgid % nig) / gsz; u.sel = 0; return true;
    }
    __device__ __forceinline__ void a_ready(const Unit&) const {}
    __device__ __forceinline__ void done(const Unit&) const {}
};


template <class Epi, class Sched, bool ALIGN_EPI = false, bool SP2 = false>
__device__ __forceinline__ void gemm_phase(PG8_LAS unsigned char* lds, const Gemm g, const Sched& S, const Epi& E) {
    const int tid = threadIdx.x, wid = __builtin_amdgcn_readfirstlane(tid >> 6), lane = tid & 63, wr = wid >> 2, wc = wid & 3, fr = lane & 15, fq = lane >> 4;
    const int K = g.K, nt = K / BK;
    unsigned voffA[2], voffB[2];
#pragma unroll
    for (int i = 0; i < 2; ++i) { int R, C; stage_rc(tid * 16 + i * 8192, R, C); const int Rb = Epi::PERM ? ((R & ~31) + perm32(R & 31)) : R;
        voffA[i] = (unsigned)(R * K + C) * 2u; voffB[i] = (unsigned)(Rb * K + C) * 2u; }
    const size_t kstep = (size_t)(BK * 2);
    const size_t hstep = (size_t)HALF * K * 2;
    const size_t tstep = 2 * hstep;
    const unsigned ldsw = (unsigned)wid * 1024u;
    const int aoff = lds_byte(wr * 64 + fr, fq * 8), boff = lds_byte(wc * 32 + fr, fq * 8);
#define PG8_SA(b, h) (((b) * 2 + (h)) * HTB)
#define PG8_SB(b, h) ((4 + (b) * 2 + (h)) * HTB)
#define PG8_STAGE(bufoff, gbase, voff) do { _Pragma("unroll") for (int _i = 0; _i < 2; ++_i) \
        __builtin_amdgcn_global_load_lds((const unsigned*)((const char*)(gbase) + (voff)[_i]), (PG8_LAS unsigned*)(lds + (bufoff) + ldsw + _i * 8192), 16, 0, 0); } while (0)
#define PG8_LDA(dst, b, h) do { _Pragma("unroll") for (int m = 0; m < 4; ++m) _Pragma("unroll") for (int k = 0; k < 2; ++k) dst[m][k] = *(const PG8_LAS bf16x8*)(lds + PG8_SA(b, h) + aoff + m * 2048 + k * 1024); } while (0)
#define PG8_LDB(dst, b, h) do { _Pragma("unroll") for (int n = 0; n < 2; ++n) _Pragma("unroll") for (int k = 0; k < 2; ++k) dst[n][k] = *(const PG8_LAS bf16x8*)(lds + PG8_SB(b, h) + boff + n * 2048 + k * 1024); } while (0)
#define PG8_MMA(ai, bj, At, Bt) do { __builtin_amdgcn_s_setprio(1); _Pragma("unroll") for (int m = 0; m < 4; ++m) _Pragma("unroll") for (int n = 0; n < 2; ++n) _Pragma("unroll") for (int k = 0; k < 2; ++k) \
        acc[ai][bj][m][n] = __builtin_amdgcn_mfma_f32_16x16x32_bf16(Bt[n][k], At[m][k], acc[ai][bj][m][n], 0, 0, 0); __builtin_amdgcn_s_setprio(0); } while (0)
#define PG8_WAIT_V(n) asm volatile("s_waitcnt vmcnt(" #n ")" ::: "memory")
#define PG8_WAIT_L(n) asm volatile("s_waitcnt lgkmcnt(" #n ")" ::: "memory")
#define PG8_BAR __builtin_amdgcn_s_barrier()
#define PG8_SCHED __builtin_amdgcn_sched_barrier(0)
    Unit cur, nxt; int ui = 0;
    if (!S.next(0, cur)) return;
    f32x4 acc[2][2][4][2];
#pragma unroll
    for (int a = 0; a < 2; ++a)
#pragma unroll
        for (int b = 0; b < 2; ++b)
#pragma unroll
            for (int m = 0; m < 4; ++m)
#pragma unroll
                for (int n = 0; n < 2; ++n) acc[a][b][m][n] = (f32x4){0.f, 0.f, 0.f, 0.f};
    bf16x8 At[4][2], B0[2][2], B1[2][2];
    const char* cA = (const char*)(cur.sel ? g.A1 : g.A) + (size_t)cur.pm * tstep; const char* cB = (const char*)(cur.sel ? g.Bt1 : g.Bt) + (size_t)cur.pn * tstep;
    S.a_ready(cur);
    if constexpr (SP2) {
        PG8_STAGE(PG8_SB(0, 0), cB, voffB); PG8_STAGE(PG8_SB(0, 1), cB + hstep, voffB); PG8_STAGE(PG8_SA(0, 0), cA, voffA); PG8_STAGE(PG8_SA(0, 1), cA + hstep, voffA);
        if (wr == 1) PG8_BAR;
        PG8_WAIT_V(2); PG8_BAR;
        PG8_STAGE(PG8_SB(1, 0), cB + kstep, voffB); PG8_STAGE(PG8_SA(1, 0), cA + kstep, voffA); PG8_STAGE(PG8_SB(1, 1), cB + hstep + kstep, voffB);
        PG8_WAIT_V(6); PG8_BAR;
    } else {
        PG8_STAGE(PG8_SB(0, 0), cB, voffB); PG8_STAGE(PG8_SA(0, 0), cA, voffA); PG8_STAGE(PG8_SB(0, 1), cB + hstep, voffB); PG8_STAGE(PG8_SA(0, 1), cA + hstep, voffA);
        if (wr == 1) PG8_BAR;
        PG8_WAIT_V(4); PG8_BAR;
        PG8_STAGE(PG8_SB(1, 0), cB + kstep, voffB); PG8_STAGE(PG8_SA(1, 0), cA + kstep, voffA); PG8_STAGE(PG8_SB(1, 1), cB + hstep + kstep, voffB);
        PG8_WAIT_V(6); PG8_BAR;
    }
    for (;;) {
        const bool has_next = S.next(ui + 1, nxt);
        const char* nA = has_next ? (const char*)(nxt.sel ? g.A1 : g.A) + (size_t)nxt.pm * tstep : cA; const char* nB = has_next ? (const char*)(nxt.sel ? g.Bt1 : g.Bt) + (size_t)nxt.pn * tstep : cB;
        for (int t = 0; t < nt; t += 2) {
            const bool last = (t == nt - 2);
            const char* a1 = cA + (size_t)(t + 1) * kstep;
            const char* a2 = last ? nA : cA + (size_t)(t + 2) * kstep; const char* b2 = last ? nB : cB + (size_t)(t + 2) * kstep;
            const char* a3 = a2 + kstep; const char* b3 = b2 + kstep;
            if (last && has_next) S.a_ready(nxt);
            if constexpr (SP2) {
            PG8_LDB(B0, 0, 0); PG8_LDB(B1, 0, 1); PG8_SCHED; PG8_LDA(At, 0, 0); PG8_STAGE(PG8_SA(1, 1), a1 + hstep, voffA);
            PG8_WAIT_V(8); PG8_WAIT_L(0); PG8_BAR; PG8_MMA(0, 0, At, B0); PG8_MMA(0, 1, At, B1); PG8_BAR; PG8_SCHED;
            PG8_LDA(At, 0, 1); PG8_STAGE(PG8_SB(0, 0), b2, voffB); PG8_STAGE(PG8_SB(0, 1), b2 + hstep, voffB); PG8_STAGE(PG8_SA(0, 0), a2, voffA);
            PG8_WAIT_V(8); PG8_WAIT_L(0); PG8_BAR; PG8_MMA(1, 0, At, B0); PG8_MMA(1, 1, At, B1); PG8_BAR; PG8_SCHED;
            PG8_LDB(B0, 1, 0); PG8_LDB(B1, 1, 1); PG8_SCHED; PG8_LDA(At, 1, 0); PG8_STAGE(PG8_SA(0, 1), a2 + hstep, voffA);
            PG8_WAIT_V(8); PG8_WAIT_L(0); PG8_BAR; PG8_MMA(0, 0, At, B0); PG8_MMA(0, 1, At, B1); PG8_BAR; PG8_SCHED;
            PG8_LDA(At, 1, 1); PG8_STAGE(PG8_SB(1, 0), b3, voffB); PG8_STAGE(PG8_SB(1, 1), b3 + hstep, voffB); PG8_STAGE(PG8_SA(1, 0), a3, voffA);
            PG8_WAIT_V(8); PG8_WAIT_L(0); PG8_BAR; PG8_MMA(1, 0, At, B0); PG8_MMA(1, 1, At, B1); PG8_BAR; PG8_SCHED;
            } else {
            PG8_LDB(B0, 0, 0); PG8_SCHED; PG8_LDA(At, 0, 0); PG8_STAGE(PG8_SA(1, 1), a1 + hstep, voffA);
            PG8_WAIT_L(8); PG8_BAR; PG8_WAIT_L(0); PG8_MMA(0, 0, At, B0); PG8_BAR; PG8_SCHED;
            PG8_LDB(B1, 0, 1); PG8_STAGE(PG8_SB(0, 0), b2, voffB);
            PG8_BAR; PG8_WAIT_L(0); PG8_MMA(0, 1, At, B1); PG8_BAR;
            PG8_LDA(At, 0, 1); PG8_STAGE(PG8_SA(0, 0), a2, voffA);
            PG8_BAR; PG8_WAIT_L(0); PG8_MMA(1, 0, At, B0); PG8_BAR; PG8_SCHED;
            PG8_STAGE(PG8_SB(0, 1), b2 + hstep, voffB);
            PG8_WAIT_V(6); PG8_BAR; PG8_MMA(1, 1, At, B1); PG8_BAR;
            PG8_LDB(B0, 1, 0); PG8_SCHED; PG8_LDA(At, 1, 0); PG8_STAGE(PG8_SA(0, 1), a2 + hstep, voffA);
            PG8_WAIT_L(8); PG8_BAR; PG8_WAIT_L(0); PG8_MMA(0, 0, At, B0); PG8_BAR; PG8_SCHED;
            PG8_LDB(B1, 1, 1); PG8_STAGE(PG8_SB(1, 0), b3, voffB);
            PG8_BAR; PG8_WAIT_L(0); PG8_MMA(0, 1, At, B1); PG8_BAR;
            PG8_LDA(At, 1, 1); PG8_STAGE(PG8_SA(1, 0), a3, voffA);
            PG8_BAR; PG8_WAIT_L(0); PG8_MMA(1, 0, At, B0); PG8_BAR; PG8_SCHED;
            PG8_STAGE(PG8_SB(1, 1), b3 + hstep, voffB);
            PG8_WAIT_V(6); PG8_BAR; PG8_MMA(1, 1, At, B1); PG8_BAR;
            }
        }
        if constexpr (ALIGN_EPI) { if (wr == 0) PG8_BAR; }
        if constexpr (!Epi::AFTER_DRAIN) { E(acc, cur, wr, wc, fr, fq); S.done(cur); }
        if (!has_next) break;
        if (!Epi::keep(cur)) {
#pragma unroll
        for (int a = 0; a < 2; ++a)
#pragma unroll
            for (int b = 0; b < 2; ++b)
#pragma unroll
                for (int m = 0; m < 4; ++m)
#pragma unroll
                    for (int n = 0; n < 2; ++n) acc[a][b][m][n] = (f32x4){0.f, 0.f, 0.f, 0.f};
        }
        cur = nxt; cA = nA; cB = nB; ++ui;
        if constexpr (ALIGN_EPI) { if (wr == 1) PG8_BAR; }
    }
    PG8_WAIT_V(0);
    if constexpr (!ALIGN_EPI) { if (wr == 0) PG8_BAR; }
    PG8_BAR;
    if constexpr (Epi::AFTER_DRAIN) { E.fused(acc, cur, wr, wc, fr, fq, lds, wid, lane); S.done(cur); }
#undef PG8_SA
#undef PG8_SB
#undef PG8_STAGE
#undef PG8_LDA
#undef PG8_LDB
#undef PG8_MMA
#undef PG8_WAIT_V
#undef PG8_WAIT_L
#undef PG8_BAR
#undef PG8_SCHED
}
}

struct EpiInProj {
    static constexpr bool PERM = true, AFTER_DRAIN = false;
    static __device__ __forceinline__ bool keep(const pg8::Unit&) { return false; }
    float* F32B; float* GLOG; bf16_t* PBUF; const float* LB; bf16_t* CQN; bf16_t* CKVN;
    __device__ __forceinline__ void operator()(f32x4 (&acc)[2][2][4][2], const pg8::Unit& u, int wr, int wc, int fr, int fq) const {
#pragma unroll
        for (int bj = 0; bj < 2; ++bj) {
            const int nseg = u.pn * 256 + bj * 128 + wc * 32;
            if (nseg >= C_END) continue;
            const int c = nseg + 8 * fq;
#pragma unroll
            for (int ai = 0; ai < 2; ++ai)
#pragma unroll
                for (int m = 0; m < 4; ++m) {
                    const size_t r = (size_t)u.pm * 256 + ai * 128 + wr * 64 + m * 16 + fr;
                    const f32x4 v0 = acc[ai][bj][m][0], v1 = acc[ai][bj][m][1];
                    if (nseg < C_BQ) {
                        if (nseg >= C_CKV) { *(f32x4*)(F32B + r * 288 + (c - C_CKV)) = v0; *(f32x4*)(F32B + r * 288 + (c - C_CKV) + 4) = v1; }
                        if (nseg < C_KR) {
                            u32x4 w; w[0] = cvtpk(v0[0], v0[1]); w[1] = cvtpk(v0[2], v0[3]); w[2] = cvtpk(v1[0], v1[1]); w[3] = cvtpk(v1[2], v1[3]);
                            if (nseg < C_CKV) *(u32x4*)(CQN + r * 384 + c) = w; else *(u32x4*)(CKVN + r * 256 + (c - C_CKV)) = w;
                        }
                        continue;
                    }
                    f32x4 o0, o1;
                    if (nseg < C_BF) {
#pragma unroll
                        for (int e = 0; e < 4; ++e) { o0[e] = siluf_(v0[e]); o1[e] = siluf_(v1[e]); }
                    } else if (nseg < C_BI) {
                        const f32x4 lb0 = *(const f32x4*)(LB + (c - C_BF)), lb1 = *(const f32x4*)(LB + (c - C_BF) + 4);
                        f32x4 l0, l1;
#pragma unroll
                        for (int e = 0; e < 4; ++e) {
                            const float sg0 = sigmoidf_(v0[e]), sg1 = sigmoidf_(v1[e]);
                            l0[e] = __logf(lb0[e] + (1.0f - lb0[e]) * sg0); l1[e] = __logf(lb1[e] + (1.0f - lb1[e]) * sg1);
                            o0[e] = (1.0f - lb0[e]) * (1.0f - sg0); o1[e] = (1.0f - lb1[e]) * (1.0f - sg1);
                        }
                        *(f32x4*)(GLOG + r * 512 + (c - C_BF)) = l0; *(f32x4*)(GLOG + r * 512 + (c - C_BF) + 4) = l1;
                    } else if (nseg < C_GA) {
                        o0 = v0; o1 = v1;
                    } else if (nseg < C_MA) {
#pragma unroll
                        for (int e = 0; e < 4; ++e) { o0[e] = siluf_(v0[e]); o1[e] = siluf_(v1[e]); }
                    } else {
#pragma unroll
                        for (int e = 0; e < 4; ++e) { o0[e] = sigmoidf_(v0[e]); o1[e] = sigmoidf_(v1[e]); }
                    }
                    u32x4 w; w[0] = cvtpk(o0[0], o0[1]); w[1] = cvtpk(o0[2], o0[3]); w[2] = cvtpk(o1[0], o1[1]); w[3] = cvtpk(o1[2], o1[3]);
                    *(u32x4*)(PBUF + r * IN_COLS_PAD + c) = w;
                    asm volatile("" ::: "memory");
                }
        }
    }
};
template <int STAGE> struct EpiMerge {
    static constexpr bool PERM = true, AFTER_DRAIN = false;
    static __device__ __forceinline__ bool keep(const pg8::Unit&) { return false; }
    const bf16_t* PBUF; float* TMP; bf16_t* MM;
    __device__ __forceinline__ void operator()(f32x4 (&acc)[2][2][4][2], const pg8::Unit& u, int wr, int wc, int fr, int fq) const {
#pragma unroll
        for (int ai = 0; ai < 2; ++ai)
#pragma unroll
            for (int m = 0; m < 4; ++m) {
                const int mq = u.pm * 256 + ai * 128 + wr * 64 + m * 16 + fr;
                const size_t r = (size_t)(mq >> 11) * LTOT + NMETA + (mq & 2047);
#pragma unroll
                for (int bj = 0; bj < 2; ++bj) {
                    const int c = u.pn * 256 + bj * 128 + wc * 32 + 8 * fq;
                    const u32x4 g = *(const u32x4*)(PBUF + r * IN_COLS_PAD + (STAGE == 0 ? C_MA : C_MB) + c);
                    const f32x4 v0 = acc[ai][bj][m][0], v1 = acc[ai][bj][m][1];
                    f32x4 o0, o1;
                    o0[0] = v0[0] * bflo(g[0]); o0[1] = v0[1] * bfhi(g[0]); o0[2] = v0[2] * bflo(g[1]); o0[3] = v0[3] * bfhi(g[1]);
                    o1[0] = v1[0] * bflo(g[2]); o1[1] = v1[1] * bfhi(g[2]); o1[2] = v1[2] * bflo(g[3]); o1[3] = v1[3] * bfhi(g[3]);
                    if (STAGE == 0) {
                        u32x4 w; w[0] = cvtpk(o0[0], o0[1]); w[1] = cvtpk(o0[2], o0[3]); w[2] = cvtpk(o1[0], o1[1]); w[3] = cvtpk(o1[2], o1[3]);
                        *(u32x4*)(MM + (size_t)mq * 1024 + c) = w;
                    }
                    else {
                        const u32x4 tw = *(const u32x4*)(MM + (size_t)mq * 1024 + c);
                        f32x4 t0, t1;
                        t0[0] = bflo(tw[0]); t0[1] = bfhi(tw[0]); t0[2] = bflo(tw[1]); t0[3] = bfhi(tw[1]);
                        t1[0] = bflo(tw[2]); t1[1] = bfhi(tw[2]); t1[2] = bflo(tw[3]); t1[3] = bfhi(tw[3]);
                        u32x4 w; w[0] = cvtpk(o0[0] + t0[0], o0[1] + t0[1]); w[1] = cvtpk(o0[2] + t0[2], o0[3] + t0[3]);
                        w[2] = cvtpk(o1[0] + t1[0], o1[1] + t1[1]); w[3] = cvtpk(o1[2] + t1[2], o1[3] + t1[3]);
                        *(u32x4*)(MM + (size_t)mq * 1024 + c) = w;
                    }
                }
                asm volatile("" ::: "memory");
            }
    }
};
struct EpiFinal {
    static constexpr bool PERM = true, AFTER_DRAIN = false;
    static __device__ __forceinline__ bool keep(const pg8::Unit&) { return false; }
    const float* X; float* Y;
    __device__ __forceinline__ void operator()(f32x4 (&acc)[2][2][4][2], const pg8::Unit& u, int wr, int wc, int fr, int fq) const {
#pragma unroll
        for (int ai = 0; ai < 2; ++ai)
#pragma unroll
            for (int m = 0; m < 4; ++m) {
                const size_t mq = (size_t)u.pm * 256 + ai * 128 + wr * 64 + m * 16 + fr;
#pragma unroll
                for (int bj = 0; bj < 2; ++bj) {
                    const int c = u.pn * 256 + bj * 128 + wc * 32 + 8 * fq;
                    const f32x4 x0 = __builtin_nontemporal_load((const f32x4*)(X + mq * 1024 + c)), x1 = __builtin_nontemporal_load((const f32x4*)(X + mq * 1024 + c + 4));
                    __builtin_nontemporal_store(x0 + acc[ai][bj][m][0], (f32x4*)(Y + mq * 1024 + c));
                    __builtin_nontemporal_store(x1 + acc[ai][bj][m][1], (f32x4*)(Y + mq * 1024 + c + 4));
                }
            }
    }
};
struct OneTileOrder {
    int tile, nsel;
    __device__ __forceinline__ bool next(int i, pg8::Unit& u) const { if (i >= nsel) return false; u.pm = tile >> 2; u.pn = tile & 3; u.sel = i; return true; }
    __device__ __forceinline__ void a_ready(const pg8::Unit&) const {}
    __device__ __forceinline__ void done(const pg8::Unit&) const {}
};

__device__ __forceinline__ void transpose_tile(const float* __restrict__ src, int src_ld, int nvalid, int k0, int n0,
                                               bf16_t* __restrict__ dst, int dst_ld, float* tile  , const float* __restrict__ kscale, bool fragmajor = false) {
    const int tid = threadIdx.x;
#pragma unroll
    for (int i = 0; i < 2; ++i) {
        const int kk = (tid >> 4) + 32 * i, nn = (tid & 15) * 4;
        f32x4 v = {0.f, 0.f, 0.f, 0.f};
        if (n0 + nn < nvalid) v = *(const f32x4*)(src + (size_t)(k0 + kk) * src_ld + n0 + nn);
        if (kscale) v = v * kscale[k0 + kk];
        tile[kk * 65 + nn + 0] = v[0]; tile[kk * 65 + nn + 1] = v[1]; tile[kk * 65 + nn + 2] = v[2]; tile[kk * 65 + nn + 3] = v[3];
    }
    __syncthreads();
    {
        const int n = tid >> 3, kq = (tid & 7) * 8;
        u32x4 w;
        w[0] = cvtpk(tile[(kq + 0) * 65 + n], tile[(kq + 1) * 65 + n]);
        w[1] = cvtpk(tile[(kq + 2) * 65 + n], tile[(kq + 3) * 65 + n]);
        w[2] = cvtpk(tile[(kq + 4) * 65 + n], tile[(kq + 5) * 65 + n]);
        w[3] = cvtpk(tile[(kq + 6) * 65 + n], tile[(kq + 7) * 65 + n]);
        if (!fragmajor) *(u32x4*)(dst + (size_t)(n0 + n) * dst_ld + k0 + kq) = w;
        else {
            const int nn_ = n0 + n, kk_ = k0 + kq;
            const size_t f = (size_t)(nn_ >> 4) * (dst_ld >> 5) + (kk_ >> 5);
            *(u32x4*)(dst + f * 512 + ((((kk_ >> 3) & 3) << 4) + (nn_ & 15)) * 8) = w;
        }
    }
    __syncthreads();
}

#define TJ_C0 (16 * 84)
#define TJ_C8 (TJ_C0 + 6 * 12 + 4 * 8 + 4 * 8 + 8 * 16 + 8 * 16 + 16 * 16 + 4 * 8 + 4 * 8)
__device__ __forceinline__ void transpose_jobs(const Params& p, char* lds, int jbeg, int jend, int jstart, int jstride) {
    float* tile = (float*)lds;
    const int c0 = TJ_C0;
    const int c1 = c0 + 6 * 12;
    const int c2 = c1 + 4 * 8;
    const int c3 = c2 + 4 * 8;
    const int c4 = c3 + 8 * 16;
    const int c5 = c4 + 8 * 16;
    const int c6 = c5 + 16 * 16;
    const int c7 = c6 + 4 * 8;
    for (int j = jbeg + jstart; j < jend; j += jstride) {
        const float* src; int sld, nval, ntn, loc; bf16_t* dst; int dld; const float* ksc = nullptr; bool fm = false;
        if (j < c0)      { loc = j;      src = p.w_in; sld = IN_COLS; nval = IN_COLS; ntn = 84; dst = p.WIN_T; dld = 1024; }
        else if (j < c1) { loc = j - c0; src = p.w_uq; sld = 768;  nval = 768;  ntn = 12; dst = p.WUQ_T; dld = 384; ksc = p.g_cq; fm = true; }
        else if (j < c2) { loc = j - c1; src = p.w_uk; sld = 512;  nval = 512;  ntn = 8;  dst = p.WUKV_T; dld = 256; }
        else if (j < c3) { loc = j - c2; src = p.w_uv; sld = 512;  nval = 512;  ntn = 8;  dst = p.WUKV_T + (size_t)512 * 256; dld = 256; }
        else if (j < c4) { loc = j - c3; src = p.w_oa; sld = 1024; nval = 1024; ntn = 16; dst = p.WOA_T; dld = 512; }
        else if (j < c5) { loc = j - c4; src = p.w_ob; sld = 1024; nval = 1024; ntn = 16; dst = p.WOB_T; dld = 512; }
        else if (j < c6) { loc = j - c5; src = p.w_o;  sld = 1024; nval = 1024; ntn = 16; dst = p.WO_T; dld = 1024; }
        else if (j < c7) { loc = j - c6; src = p.w_uk; sld = 512;  nval = 512;  ntn = 8;  dst = p.WUKVG_T; dld = 256; ksc = p.g_ckv; fm = true; }
        else             { loc = j - c7; src = p.w_uv; sld = 512;  nval = 512;  ntn = 8;  dst = p.WUKVG_T + (size_t)512 * 256; dld = 256; ksc = p.g_ckv; fm = true; }
        const int kt = loc / ntn, nt = loc % ntn;
        transpose_tile(src, sld, nval, kt * 64, nt * 64, dst, dld, tile, ksc, fm);
    }
}

__device__ __forceinline__ void phase0(const Params& p, char* lds) {
    const int tid = threadIdx.x, lane = tid & 63, wid = tid >> 6;
    const int nb = gridDim.x, bid = blockIdx.x;
    transpose_jobs(p, lds, 0, TJ_C0, bid, nb);
    for (int i = bid * NTHREADS + tid; i < 64 * 64 * 48; i += nb * NTHREADS) {
        const int row = i / 48, c = i - row * 48;
        p.VTG[(size_t)row * 2112 + LTOT + c] = 0;
    }
    for (int r = bid * 8 + wid; r < R_PAD; r += nb * 8) {
        bf16_t* dst = p.XN + (size_t)r * 1024;
        if (r >= R_ALL) {
#pragma unroll
            for (int i = 0; i < 4; ++i) *(u32x2*)(dst + lane * 4 + 256 * i) = (u32x2){0u, 0u};
            continue;
        }
        const float* src;
        if (r < R_PROMPT) { const int b = r / LTOT, t = r - b * LTOT; src = (t < NMETA) ? p.meta + (size_t)t * 1024 : p.x_prompt + ((size_t)b * SEQ + (t - NMETA)) * 1024; }
        else src = p.x_sample + (size_t)(r - R_PROMPT) * 1024;
        f32x4 v[4]; float ss = 0.f;
#pragma unroll
        for (int i = 0; i < 4; ++i) { v[i] = *(const f32x4*)(src + lane * 4 + 256 * i); ss += v[i][0] * v[i][0] + v[i][1] * v[i][1] + v[i][2] * v[i][2] + v[i][3] * v[i][3]; }
        ss = wave_sum(ss);
        const float rs = 1.0f / sqrtf(ss * (1.0f / 1024.0f) + EPSF);
#pragma unroll
        for (int i = 0; i < 4; ++i) {
            const f32x4 g = *(const f32x4*)(p.norm_g + lane * 4 + 256 * i);
            u32x2 w; w[0] = cvtpk(v[i][0] * rs * g[0], v[i][1] * rs * g[1]); w[1] = cvtpk(v[i][2] * rs * g[2], v[i][3] * rs * g[3]);
            *(u32x2*)(dst + lane * 4 + 256 * i) = w;
        }
    }
    for (int i = bid * NTHREADS + tid; i < 2065 * 16; i += nb * NTHREADS) {
        const int pi = i >> 4, k = i & 15;
        const float pos = (pi < LTOT) ? (float)pi : (float)PAST_LEN;
        const float inv = (float)exp(-(double)k / 16.0 * log(10000.0));
        const float ang = pos * inv;
        p.ROPE[pi * 32 + k] = cosf(ang); p.ROPE[pi * 32 + 16 + k] = sinf(ang);
    }
    if (bid == 0) {
        if (tid < 512) { const float l0 = p.lb_logits[tid], l1 = p.lb_logits[512 + tid]; p.LB[tid] = 1.0f / (1.0f + expf(l1 - l0)); }
        if (tid < 16) p.INV[tid] = (float)exp(-(double)tid / 16.0 * log(10000.0));
        if (wid == 0) {
            float gq = 0.f, gk = 0.f;
            for (int i = lane; i < A_QK; i += 64) { gq = fmaxf(gq, fabsf(p.g_qn[i])); gk = fmaxf(gk, fabsf(p.g_kn[i])); }
#pragma unroll
            for (int o = 32; o >= 1; o >>= 1) { gq = fmaxf(gq, __shfl_xor(gq, o)); gk = fmaxf(gk, __shfl_xor(gk, o)); }
            if (lane == 0) p.SCAL[0] = sqrtf((float)A_QK) * gq * gk;
        }
    }
}

__device__ __forceinline__ void phase1(const Params& p, char* lds) {
    pg8::Gemm g{p.XN, p.WIN_T, R_PAD, IN_COLS_PAD, 1024, p.XN, p.WIN_T};
    pg8::StaticOrder S; S.init(R_PAD, IN_COLS_PAD, (int)gridDim.x, (int)blockIdx.x);
    EpiInProj E{p.F32B, p.GLOG, p.PBUF, p.LB, p.CQN, p.CKVN};
    pg8::gemm_phase<EpiInProj, pg8::StaticOrder, true, true>((PG8_LAS unsigned char*)lds, g, S, E);
    const int nidle = (int)gridDim.x - 85;
    if ((int)blockIdx.x >= 85 && nidle > 0) transpose_jobs(p, lds, TJ_C0, TJ_C8, (int)blockIdx.x - 85, nidle);
    else if (nidle <= 0) transpose_jobs(p, lds, TJ_C0, TJ_C8, (int)blockIdx.x, (int)gridDim.x);
}

#define LOG2E 1.4426950408889634f
__device__ __forceinline__ void fin1_chunk(const Params& p, const int c) {
    int tid_ = threadIdx.x; asm volatile("" : "+v"(tid_));
    const int tid = tid_, lane = tid & 63, wid = tid >> 6;
#pragma unroll 1
    for (int i = 0; i < 8; ++i) {
        const int r = c * 64 + wid * 8 + i;
        if (r >= R_ALL) break;
        const float* src = p.F32B + (size_t)r * 288;
        int pidx; float* o_lat; float* o_kr;
        if (r < R_PROMPT) { pidx = r % LTOT; o_lat = p.out + OFF_LAT_P + (size_t)r * 256; o_kr = p.out + OFF_KR_P + (size_t)r * 32; }
        else { const int j = r - R_PROMPT; pidx = LTOT; o_lat = p.out + OFF_LAT_S + (size_t)j * 256; o_kr = p.out + OFF_KR_S + (size_t)j * 32; }
        const f32x4 v = *(const f32x4*)(src + lane * 4);
        float ss = v[0] * v[0] + v[1] * v[1] + v[2] * v[2] + v[3] * v[3];
        ss = wave_sum(ss);
        const float rs = 1.0f / sqrtf(ss * (1.0f / 256.0f) + EPSF);
        const f32x4 g = *(const f32x4*)(p.g_ckv + lane * 4);
        f32x4 o; o[0] = v[0] * rs * g[0]; o[1] = v[1] * rs * g[1]; o[2] = v[2] * rs * g[2]; o[3] = v[3] * rs * g[3];
        *(f32x4*)(o_lat + lane * 4) = o;
        if (lane < 16) {
            const float x1 = src[256 + lane], x2 = src[256 + 16 + lane];
            const float cs = p.ROPE[pidx * 32 + lane], sn = p.ROPE[pidx * 32 + 16 + lane];
            o_kr[lane] = x1 * cs - x2 * sn; o_kr[16 + lane] = x1 * sn + x2 * cs;
        }
    }
}

#define UF_XQ_LD 784
#define UF_XK_LD 528
__device__ __forceinline__ float diag_pick(const f32x4 a, int lr, int lg) {
    const int j = lr & 3;
    float v = (j == 0) ? a[0] : (j == 1) ? a[1] : (j == 2) ? a[2] : a[3];
    v = (lg == (lr >> 2)) ? v : 0.f;
    v += __shfl_xor(v, 16); v += __shfl_xor(v, 32);
    return v;
}
__device__ __forceinline__ void upfused_item(const Params& p, char* lds, const int item) {
    int tid_ = threadIdx.x; asm volatile("" : "+v"(tid_));
    const int tid = tid_, lane = tid & 63, h = tid >> 6, lr = lane & 15, lg = lane >> 4;
    const int rt = item / 3, part = item - rt * 3, row0 = rt * 64;
    const float qk_scale = 0.10206207261596577f;
    if (part == 0) {
        char* X = lds;
#pragma unroll
        for (int i = 0; i < 6; ++i) {
            const int id = tid + 512 * i, row = id / 48, ch = id - row * 48;
            *(u32x4*)(X + row * UF_XQ_LD + ch * 16) = *(const u32x4*)(p.CQN + (size_t)(row0 + row) * 384 + ch * 8);
        }
        __syncthreads();
        f32x4 acc[4][6], accs[4];
#pragma unroll
        for (int mt = 0; mt < 4; ++mt) { accs[mt] = (f32x4){0.f, 0.f, 0.f, 0.f};
#pragma unroll
            for (int nt = 0; nt < 6; ++nt) acc[mt][nt] = (f32x4){0.f, 0.f, 0.f, 0.f}; }
        const bf16_t* wb = p.WUQ_T + (size_t)(h * 6) * 12 * 512 + lane * 8;
        f32x4 gq[6], rc[4], rsn[4];
#pragma unroll
        for (int nt = 0; nt < 6; ++nt) gq[nt] = *(const f32x4*)(p.g_qn + 16 * nt + 4 * lg);
#pragma unroll
        for (int mt = 0; mt < 4; ++mt) {
            const int r = row0 + 16 * mt + lr;
            const int pidx = (r >= R_PROMPT) ? LTOT : (r % LTOT);
            rc[mt] = *(const f32x4*)(p.ROPE + pidx * 32 + 4 * lg); rsn[mt] = *(const f32x4*)(p.ROPE + pidx * 32 + 16 + 4 * lg);
        }
#pragma unroll 1
        for (int ks = 0; ks < 12; ++ks) {
            bf16x8 xf[4], wf[6];
#pragma unroll
            for (int nt = 0; nt < 6; ++nt) wf[nt] = *(const bf16x8*)(wb + (size_t)(nt * 12 + ks) * 512);
#pragma unroll
            for (int mt = 0; mt < 4; ++mt) xf[mt] = *(const bf16x8*)(X + (16 * mt + lr) * UF_XQ_LD + ks * 64 + lg * 16);
#pragma unroll
            for (int mt = 0; mt < 4; ++mt) {
                accs[mt] = mfma16(xf[mt], xf[mt], accs[mt]);
#pragma unroll
                for (int nt = 0; nt < 6; ++nt) acc[mt][nt] = mfma16(wf[nt], xf[mt], acc[mt][nt]);
            }
        }
#pragma unroll
        for (int mt = 0; mt < 4; ++mt) {
            const int r = row0 + 16 * mt + lr;
            const float rs_cq = 1.0f / sqrtf(diag_pick(accs[mt], lr, lg) * (1.0f / 384.0f) + EPSF);
            const bool is_s = r >= R_PROMPT;
            const int b = r / LTOT, t = r - b * LTOT;
            const int pidx = is_s ? LTOT : t;
            f32x4 q[6];
#pragma unroll
            for (int nt = 0; nt < 6; ++nt) q[nt] = acc[mt][nt] * rs_cq;
            {
                const f32x4 c4 = rc[mt], s4 = rsn[mt];
#pragma unroll
                for (int j = 0; j < 4; ++j) { const float x1 = q[4][j], x2 = q[5][j]; q[4][j] = x1 * c4[j] - x2 * s4[j]; q[5][j] = x1 * s4[j] + x2 * c4[j]; }
            }
            float ss = 0.f;
#pragma unroll
            for (int nt = 0; nt < 6; ++nt)
#pragma unroll
                for (int j = 0; j < 4; ++j) ss += q[nt][j] * q[nt][j];
            ss += __shfl_xor(ss, 16); ss += __shfl_xor(ss, 32);
            const float rs = 1.0f / sqrtf(ss * (1.0f / 96.0f) + EPSF);
            if (!is_s) {
                if (t >= NMETA && r < R_PROMPT) {
                    bf16_t* dst = p.QA + ((size_t)(b * 8 + h) * 2048 + (t - NMETA)) * 96 + 4 * lg;
                    const float sc = rs * qk_scale * LOG2E;
#pragma unroll
                    for (int nt = 0; nt < 6; ++nt) {
                        const f32x4 g = gq[nt];
                        u32x2 w; w[0] = cvtpk(q[nt][0] * sc * g[0], q[nt][1] * sc * g[1]); w[1] = cvtpk(q[nt][2] * sc * g[2], q[nt][3] * sc * g[3]);
                        *(u32x2*)(dst + 16 * nt) = w;
                    }
                }
            } else if (r < R_ALL) {
                float* dst = p.QS + ((size_t)(r - R_PROMPT) * 8 + h) * 96 + 4 * lg;
                const float sc = rs * qk_scale;
#pragma unroll
                for (int nt = 0; nt < 6; ++nt) {
                    const f32x4 g = gq[nt], gk = *(const f32x4*)(p.g_kn + 16 * nt + 4 * lg);
                    f32x4 o; o[0] = q[nt][0] * sc * g[0] * gk[0]; o[1] = q[nt][1] * sc * g[1] * gk[1]; o[2] = q[nt][2] * sc * g[2] * gk[2]; o[3] = q[nt][3] * sc * g[3] * gk[3];
                    *(f32x4*)(dst + 16 * nt) = o;
                }
            }
        }
    } else {
        char* X = lds;
        float* KR = (float*)(lds + 64 * UF_XK_LD);
#pragma unroll
        for (int i = 0; i < 4; ++i) {
            const int id = tid + 512 * i, row = id >> 5, ch = id & 31;
            *(u32x4*)(X + row * UF_XK_LD + ch * 16) = *(const u32x4*)(p.CKVN + (size_t)(row0 + row) * 256 + ch * 8);
        }
        if (part == 1) { const int row = tid >> 3, c4 = tid & 7; *(f32x4*)(KR + row * 36 + c4 * 4) = *(const f32x4*)(p.F32B + (size_t)(row0 + row) * 288 + 256 + c4 * 4); }
        __syncthreads();
        f32x4 ak[4][4], accs[4];
#pragma unroll
        for (int mt = 0; mt < 4; ++mt) { accs[mt] = (f32x4){0.f, 0.f, 0.f, 0.f};
#pragma unroll
            for (int nt = 0; nt < 4; ++nt) ak[mt][nt] = (f32x4){0.f, 0.f, 0.f, 0.f}; }
        const bf16_t* wk = p.WUKVG_T + (size_t)((part == 1 ? 0 : 32) + h * 4) * 8 * 512 + lane * 8;
        f32x4 gk[6], rc[4], rsn[4];
        if (part == 1) {
#pragma unroll
            for (int nt = 0; nt < 6; ++nt) gk[nt] = *(const f32x4*)(p.g_kn + 16 * nt + 4 * lg);
#pragma unroll
            for (int mt = 0; mt < 4; ++mt) {
                const int r = row0 + 16 * mt + lr;
                const int pidx = (r >= R_PROMPT) ? LTOT : (r % LTOT);
                rc[mt] = *(const f32x4*)(p.ROPE + pidx * 32 + 4 * lg); rsn[mt] = *(const f32x4*)(p.ROPE + pidx * 32 + 16 + 4 * lg);
            }
        }
#pragma unroll 1
        for (int ks = 0; ks < 8; ++ks) {
            bf16x8 xf[4], wfk[4];
#pragma unroll
            for (int nt = 0; nt < 4; ++nt) wfk[nt] = *(const bf16x8*)(wk + (size_t)(nt * 8 + ks) * 512);
#pragma unroll
            for (int mt = 0; mt < 4; ++mt) xf[mt] = *(const bf16x8*)(X + (16 * mt + lr) * UF_XK_LD + ks * 64 + lg * 16);
#pragma unroll
            for (int mt = 0; mt < 4; ++mt) {
                accs[mt] = mfma16(xf[mt], xf[mt], accs[mt]);
#pragma unroll
                for (int nt = 0; nt < 4; ++nt) ak[mt][nt] = mfma16(wfk[nt], xf[mt], ak[mt][nt]);
            }
        }
#pragma unroll
        for (int mt = 0; mt < 4; ++mt) {
            const int r = row0 + 16 * mt + lr;
            const float rs_ckv = 1.0f / sqrtf(diag_pick(accs[mt], lr, lg) * (1.0f / 256.0f) + EPSF);
            const bool is_s = r >= R_PROMPT;
            const int b = r / LTOT, t = r - b * LTOT;
            if (part == 2) {
                if (!is_s) {
                    const int x = t & 15, slot = (t & ~15) | (x & 3) | ((x & 4) << 1) | ((x & 8) >> 1);
                    bf16_t* vd = p.VTG + (size_t)(b * 8 + h) * 64 * 2112 + slot;
#pragma unroll
                    for (int nt = 0; nt < 4; ++nt)
#pragma unroll
                        for (int j = 0; j < 4; ++j) vd[(size_t)(16 * nt + 4 * lg + j) * 2112] = f2bf(ak[mt][nt][j] * rs_ckv);
                }
                continue;
            }
            const int pidx = is_s ? LTOT : t;
            const f32x4 x1 = *(const f32x4*)(KR + (16 * mt + lr) * 36 + 4 * lg), x2 = *(const f32x4*)(KR + (16 * mt + lr) * 36 + 16 + 4 * lg);
            float ss = 0.f;
#pragma unroll
            for (int j = 0; j < 4; ++j) ss += x1[j] * x1[j] + x2[j] * x2[j];
            f32x4 kn[4];
#pragma unroll
            for (int nt = 0; nt < 4; ++nt) { kn[nt] = ak[mt][nt] * rs_ckv;
#pragma unroll
                for (int j = 0; j < 4; ++j) ss += kn[nt][j] * kn[nt][j]; }
            ss += __shfl_xor(ss, 16); ss += __shfl_xor(ss, 32);
            const float rs = 1.0f / sqrtf(ss * (1.0f / 96.0f) + EPSF);
            const f32x4 c4 = rc[mt], s4 = rsn[mt];
            f32x4 y1, y2;
#pragma unroll
            for (int j = 0; j < 4; ++j) { y1[j] = x1[j] * c4[j] - x2[j] * s4[j]; y2[j] = x1[j] * s4[j] + x2[j] * c4[j]; }
            if (!is_s) {
                bf16_t* dst = p.KA + ((size_t)(b * 8 + h) * LTOT + t) * 96 + 4 * lg;
#pragma unroll
                for (int nt = 0; nt < 4; ++nt) {
                    const f32x4 g = gk[nt];
                    u32x2 w; w[0] = cvtpk(kn[nt][0] * rs * g[0], kn[nt][1] * rs * g[1]); w[1] = cvtpk(kn[nt][2] * rs * g[2], kn[nt][3] * rs * g[3]);
                    *(u32x2*)(dst + 16 * nt) = w;
                }
                {
                    const f32x4 g1 = gk[4], g2 = gk[5];
                    u32x2 w1, w2;
                    w1[0] = cvtpk(y1[0] * rs * g1[0], y1[1] * rs * g1[1]); w1[1] = cvtpk(y1[2] * rs * g1[2], y1[3] * rs * g1[3]);
                    w2[0] = cvtpk(y2[0] * rs * g2[0], y2[1] * rs * g2[1]); w2[1] = cvtpk(y2[2] * rs * g2[2], y2[3] * rs * g2[3]);
                    *(u32x2*)(dst + 64) = w1; *(u32x2*)(dst + 80) = w2;
                }
            } else if (r < R_ALL) {
                float* dst = p.KSRAW + ((size_t)(r - R_PROMPT) * 8 + h) * 96 + 4 * lg;
#pragma unroll
                for (int nt = 0; nt < 4; ++nt) *(f32x4*)(dst + 16 * nt) = kn[nt];
                *(f32x4*)(dst + 64) = y1; *(f32x4*)(dst + 80) = y2;
            }
        }
    }
    __syncthreads();
}

#define HA_LD 144
#define HC_LD 272
__device__ __forceinline__ void hgrn_passA_unit(const Params& p, char* lds, const int u) {
    int tid_ = threadIdx.x; asm volatile("" : "+v"(tid_));
    const int tid = tid_, lane = tid & 63, wid = tid >> 6, lr = lane & 15, lg = lane >> 4;
    float* cumL = (float*)lds;
    float* tot = (float*)(lds + 32768);
    char* KT = lds + 32768 + 2048;
    char* VT = KT + 128 * HA_LD;
    {
        const int c = u % NCHUNK, bh = u / NCHUNK, h = bh % B_HEADS, b = bh / B_HEADS;
        const int nvalid = (c == 0) ? NMETA : 64;
        const int t0 = (c == 0) ? 0 : NMETA + 64 * (c - 1);
        const size_t rowbase = (size_t)b * LTOT + t0;
        const int d = tid & 127, part = tid >> 7;
        char* KR = VT + 128 * HA_LD;
#pragma unroll
        for (int i = 0; i < 4; ++i) {
            const int id = tid + 512 * i, row = id >> 5, c4 = id & 31;
            f32x4 g = {0.f, 0.f, 0.f, 0.f};
            if (row < nvalid) g = *(const f32x4*)(p.GLOG + (rowbase + row) * 512 + h * 128 + c4 * 4);
            *(f32x4*)(cumL + row * 128 + c4 * 4) = g;
        }
#pragma unroll
        for (int i = 0; i < 2; ++i) {
            const int id = tid + 512 * i, row = id >> 4, ch = id & 15;
            u32x4 kw = {0u, 0u, 0u, 0u}, w = {0u, 0u, 0u, 0u};
            if (row < nvalid) {
                kw = *(const u32x4*)(p.PBUF + (rowbase + row) * IN_COLS_PAD + C_BF + h * 128 + ch * 8);
                w = *(const u32x4*)(p.PBUF + (rowbase + row) * IN_COLS_PAD + C_BI + h * 128 + ch * 8);
            }
            *(u32x4*)(KR + row * HC_LD + ch * 16) = kw;
#pragma unroll
            for (int e = 0; e < 4; ++e) {
                *(bf16_t*)(VT + (ch * 8 + 2 * e) * HA_LD + row * 2) = (bf16_t)(w[e] & 0xffffu);
                *(bf16_t*)(VT + (ch * 8 + 2 * e + 1) * HA_LD + row * 2) = (bf16_t)(w[e] >> 16);
            }
        }
        __syncthreads();
        {
            float run = 0.f;
#pragma unroll
            for (int i = 0; i < 16; ++i) { const int s = part * 16 + i; run += cumL[s * 128 + d]; cumL[s * 128 + d] = run; }
            tot[part * 128 + d] = run;
        }
        __syncthreads();
        {
            float off = 0.f, last = 0.f;
#pragma unroll
            for (int q = 0; q < 4; ++q) { const float tq = tot[q * 128 + d]; last += tq; if (q < part) off += tq; }
            if (part == 0) p.DEC[(size_t)u * 128 + d] = expf(last);
#pragma unroll
            for (int i = 0; i < 16; ++i) {
                const int s = part * 16 + i;
                const float cum = cumL[s * 128 + d] + off;
                const float kv = bf2f(*(const bf16_t*)(KR + s * HC_LD + d * 2));
                *(bf16_t*)(KT + d * HA_LD + s * 2) = f2bf(kv * __expf(last - cum));
            }
        }
        __syncthreads();
        {
            const char* xs = VT + (wid * 16 + lr) * HA_LD + lg * 16;
            bf16x8 xf0 = *(const bf16x8*)(xs), xf1 = *(const bf16x8*)(xs + 64);
            bf16_t* dst = p.UT + (size_t)u * 16384 + (size_t)(wid * 16 + lr) * 128;
#pragma unroll
            for (int nt = 0; nt < 8; ++nt) {
                const char* ws = KT + (nt * 16 + lr) * HA_LD + lg * 16;
                f32x4 acc = {0.f, 0.f, 0.f, 0.f};
                acc = mfma16(*(const bf16x8*)(ws), xf0, acc);
                acc = mfma16(*(const bf16x8*)(ws + 64), xf1, acc);
                { u32x2 w; w[0] = cvtpk(acc[0], acc[1]); w[1] = cvtpk(acc[2], acc[3]); *(u32x2*)(dst + nt * 16 + 4 * lg) = w; }
            }
        }
        __syncthreads();
    }
}

__device__ __forceinline__ void hgrn_sample_step_unit(const Params& p, char* lds, const int u) {
    int tid_ = threadIdx.x; asm volatile("" : "+v"(tid_));
    const int tid = tid_;
    float* part = (float*)lds;
    float* red = (float*)(lds + 8192);
    {
        const int i = u / B_HEADS, h = u % B_HEADS;
        const size_t r = R_PROMPT + i;
        const int v4 = (tid & 31) * 4, dp = tid >> 5;
        const float* S0 = p.state_hgrn + (size_t)u * 16384;
        float* S1 = p.out + OFF_HG_S + (size_t)u * 16384;
        const u32x2 vw = *(const u32x2*)(p.PBUF + r * IN_COLS_PAD + C_BI + h * 128 + v4);
        const float vv[4] = {bflo(vw[0]), bfhi(vw[0]), bflo(vw[1]), bfhi(vw[1])};
        float o[4] = {0.f, 0.f, 0.f, 0.f};
#pragma unroll
        for (int e = 0; e < 8; ++e) {
            const int d = dp * 8 + e;
            const float q = bf2f(p.PBUF[r * IN_COLS_PAD + C_BQ + h * 128 + d]);
            const float k = bf2f(p.PBUF[r * IN_COLS_PAD + C_BF + h * 128 + d]);
            const float f = expf(p.GLOG[r * 512 + h * 128 + d]);
            const f32x4 s0 = *(const f32x4*)(S0 + d * 128 + v4);
            f32x4 s1;
#pragma unroll
            for (int j = 0; j < 4; ++j) { s1[j] = f * s0[j] + k * vv[j]; o[j] += q * s1[j]; }
            *(f32x4*)(S1 + d * 128 + v4) = s1;
        }
#pragma unroll
        for (int j = 0; j < 4; ++j) part[dp * 128 + v4 + j] = o[j];
        __syncthreads();
        float osum = 0.f;
        if (tid < 128) {
#pragma unroll
            for (int q = 0; q < 16; ++q) osum += part[q * 128 + tid];
            float ss = wave_sum(osum * osum);
            if ((tid & 63) == 0) red[tid >> 6] = ss;
        }
        __syncthreads();
        if (tid < 128) {
            const float ss = red[0] + red[1];
            const float rs = 1.0f / sqrtf(ss * (1.0f / 128.0f) + EPSF);
            const float gb = bf2f(p.PBUF[r * IN_COLS_PAD + C_GB + h * 128 + tid]);
            p.AMB[(size_t)(NQ + i) * 512 + h * 128 + tid] = f2bf(osum * rs * p.g_bn[tid] * gb);
        }
        __syncthreads();
    }
}

#define Q_UF_ITEMS (3 * (R_PAD / 64))
#define Q_HA_ITEMS (BATCH * B_HEADS * NCHUNK)
#define Q_SS_ITEMS (DEC_BATCH * B_HEADS)
#define Q_F1_ITEMS ((R_ALL + 63) / 64)
#define QCTR_WORD 3584
__device__ __forceinline__ void phase2(const Params& p, char* lds) {
    volatile int* slot = (volatile int*)(lds + LDS_ITEM_OFF);
    const int total = Q_UF_ITEMS + Q_HA_ITEMS + Q_SS_ITEMS + Q_F1_ITEMS;
    int nxt = 0;
    if (threadIdx.x == 0) nxt = (int)atomicAdd(p.bar + QCTR_WORD, 1u);
    for (;;) {
        if (threadIdx.x == 0) *slot = nxt;
        __syncthreads();
        const int it = __builtin_amdgcn_readfirstlane(*slot);
        __syncthreads();
        if (it >= total) break;
        if (threadIdx.x == 0) nxt = (int)atomicAdd(p.bar + QCTR_WORD, 1u);
        if (it < Q_UF_ITEMS) upfused_item(p, lds, it);
        else if (it < Q_UF_ITEMS + Q_HA_ITEMS) hgrn_passA_unit(p, lds, it - Q_UF_ITEMS);
        else if (it < Q_UF_ITEMS + Q_HA_ITEMS + Q_SS_ITEMS) hgrn_sample_step_unit(p, lds, it - Q_UF_ITEMS - Q_HA_ITEMS);
        else fin1_chunk(p, it - Q_UF_ITEMS - Q_HA_ITEMS - Q_SS_ITEMS);
    }
}

__device__ __forceinline__ void hgrn_passB(const Params& p) {
    for (int g = blockIdx.x * NTHREADS + threadIdx.x; g < 32 * 128 * 32; g += gridDim.x * NTHREADS) {
        const int d4 = (g & 31) * 4, v = (g >> 5) & 127, bh = g >> 12;
        f32x4 S = {0.f, 0.f, 0.f, 0.f};
        for (int c = 0; c < NCHUNK; ++c) {
            const size_t u = (size_t)bh * NCHUNK + c;
            u32x2 w; w[0] = cvtpk(S[0], S[1]); w[1] = cvtpk(S[2], S[3]);
            *(u32x2*)(p.ST + u * 16384 + v * 128 + d4) = w;
            const f32x4 dec = *(const f32x4*)(p.DEC + u * 128 + d4);
            const u32x2 uw = *(const u32x2*)(p.UT + u * 16384 + v * 128 + d4);
            const f32x4 ut = {bflo(uw[0]), bfhi(uw[0]), bflo(uw[1]), bfhi(uw[1])};
#pragma unroll
            for (int j = 0; j < 4; ++j) S[j] = dec[j] * S[j] + ut[j];
        }
        float* o = p.out + OFF_HG_P + (size_t)bh * 16384;
#pragma unroll
        for (int j = 0; j < 4; ++j) o[(d4 + j) * 128 + v] = S[j];
    }
}

#define AK_LD 208
#define AV_LD 144
#define AP_LD 144
#define AK_BUF (64 * AK_LD)
#define AV_BUF (64 * AV_LD)

typedef float f32x16 __attribute__((ext_vector_type(16)));
#define A2K_LD 208
#define A2V_LD 144
#define A2K_BUF (64 * A2K_LD)
#define A2V_BUF (64 * A2V_LD)
__device__ __forceinline__ f32x16 mfma32(bf16x8 a, bf16x8 b, f32x16 c) { return __builtin_amdgcn_mfma_f32_32x32x16_bf16(a, b, c, 0, 0, 0); }
__device__ __forceinline__ void attn_unit2(const Params& p, char* lds, int b, int h, int qb) {
    const int tid = threadIdx.x, lane = tid & 63, wid = tid >> 6, r32 = lane & 31, hi = lane >> 5;
    char* Ks = lds;
    char* Vs = lds + 2 * A2K_BUF;
    const int tq0 = qb * 256;
    const int ntile = 4 * qb + 5;
    const float negMb = -p.SCAL[0] * LOG2E;
    const bf16_t* qsrc = p.QA + ((size_t)(b * 8 + h) * 2048 + tq0 + 32 * wid + r32) * 96 + hi * 8;
    bf16x8 qf[6];
#pragma unroll
    for (int s = 0; s < 6; ++s) qf[s] = *(const bf16x8*)(qsrc + 16 * s);
    const int wq_min = NMETA + tq0 + 32 * wid, wq_max = wq_min + 31, qpos = wq_min + r32;
    const bf16_t* kbase = p.KA + (size_t)(b * 8 + h) * LTOT * 96;
    const bf16_t* vbase = p.VTG + (size_t)(b * 8 + h) * 64 * 2112;
    const int kkey0 = tid / 12, kpart0 = tid % 12;
    const int kkey1 = (512 + tid) / 12, kpart1 = (512 + tid) % 12;
    const int vdv = tid >> 3, vpart = tid & 7;
    u32x4 kA0, kA1 = {0u, 0u, 0u, 0u}, vA, kB0, kB1 = {0u, 0u, 0u, 0u}, vB;
#define A2_LOAD(K0, K1, V, ti_) { const int key0 = (ti_) * 64; \
        int ka = key0 + kkey0; ka = ka < LTOT ? ka : LTOT - 1; K0 = *(const u32x4*)(kbase + (size_t)ka * 96 + kpart0 * 8); \
        if (tid < 256) { int kb = key0 + kkey1; kb = kb < LTOT ? kb : LTOT - 1; K1 = *(const u32x4*)(kbase + (size_t)kb * 96 + kpart1 * 8); } \
        V = *(const u32x4*)(vbase + (size_t)vdv * 2112 + key0 + vpart * 8); }
#define A2_STORE(K0, K1, V, buf_) { *(u32x4*)(Ks + (buf_) * A2K_BUF + kkey0 * A2K_LD + kpart0 * 16) = K0; \
        if (tid < 256) *(u32x4*)(Ks + (buf_) * A2K_BUF + kkey1 * A2K_LD + kpart1 * 16) = K1; \
        *(u32x4*)(Vs + (buf_) * A2V_BUF + vdv * A2V_LD + vpart * 16) = V; }
    f32x16 o0, o1;
#pragma unroll
    for (int i = 0; i < 16; ++i) { o0[i] = 0.f; o1[i] = 0.f; }
    float lsum = 0.f;
    A2_LOAD(kA0, kA1, vA, 0); A2_STORE(kA0, kA1, vA, 0);
    A2_LOAD(kB0, kB1, vB, 1);
    __syncthreads();
#pragma unroll 2
    for (int ti = 0; ti < ntile; ++ti) {
        const int cur = ti & 1;
        if (ti + 2 < ntile) { if (cur == 0) { A2_LOAD(kA0, kA1, vA, ti + 2); } else { A2_LOAD(kB0, kB1, vB, ti + 2); } }
        if (ti * 64 <= wq_max) {
            f32x16 s0, s1;
#pragma unroll
            for (int i = 0; i < 16; ++i) { s0[i] = negMb; s1[i] = negMb; }
            const char* ka = Ks + cur * A2K_BUF + r32 * A2K_LD + hi * 16;
#pragma unroll
            for (int s = 0; s < 6; ++s) {
                s0 = mfma32(*(const bf16x8*)(ka + s * 32), qf[s], s0);
                s1 = mfma32(*(const bf16x8*)(ka + 32 * A2K_LD + s * 32), qf[s], s1);
            }
            const bool diag = (ti * 64 + 63 > wq_min);
#pragma unroll
            for (int i = 0; i < 16; ++i) { s0[i] = __builtin_amdgcn_exp2f(s0[i]); s1[i] = __builtin_amdgcn_exp2f(s1[i]); }
            if (diag) {
                const int kb0 = ti * 64 + 4 * hi;
#pragma unroll
                for (int i = 0; i < 16; ++i) {
                    const int key = kb0 + (i & 3) + 8 * (i >> 2);
                    if (key > qpos) s0[i] = 0.f;
                    if (key + 32 > qpos) s1[i] = 0.f;
                }
            }
            float la = 0.f, lb = 0.f;
#pragma unroll
            for (int i = 0; i < 16; ++i) { la += s0[i]; lb += s1[i]; }
            lsum += la + lb;
            bf16x8 pb[2][2];
#pragma unroll
            for (int s = 0; s < 2; ++s) {
                u32x4 w0, w1;
#pragma unroll
                for (int e = 0; e < 4; ++e) { w0[e] = cvtpk(s0[8 * s + 2 * e], s0[8 * s + 2 * e + 1]); w1[e] = cvtpk(s1[8 * s + 2 * e], s1[8 * s + 2 * e + 1]); }
                pb[0][s] = __builtin_bit_cast(bf16x8, w0); pb[1][s] = __builtin_bit_cast(bf16x8, w1);
            }
            const char* va = Vs + cur * A2V_BUF + r32 * A2V_LD + hi * 16;
#pragma unroll
            for (int kt = 0; kt < 2; ++kt)
#pragma unroll
                for (int s = 0; s < 2; ++s) {
                    o0 = mfma32(*(const bf16x8*)(va + kt * 64 + s * 32), pb[kt][s], o0);
                    o1 = mfma32(*(const bf16x8*)(va + 32 * A2V_LD + kt * 64 + s * 32), pb[kt][s], o1);
                }
        }
        if (ti + 1 < ntile) { if (cur == 0) { A2_STORE(kB0, kB1, vB, 1); } else { A2_STORE(kA0, kA1, vA, 0); } }
        __syncthreads();
    }
#undef A2_LOAD
#undef A2_STORE
    lsum += __shfl_xor(lsum, 32);
    const float inv = 1.0f / lsum;
    const int tq = tq0 + 32 * wid + r32;
    const size_t r = (size_t)b * LTOT + NMETA + tq;
    const size_t mrow = (size_t)b * 2048 + tq;
#pragma unroll
    for (int vt = 0; vt < 2; ++vt)
#pragma unroll
        for (int g = 0; g < 4; ++g) {
            const int dv = 32 * vt + 8 * g + 4 * hi;
            const u32x2 gw = *(const u32x2*)(p.PBUF + r * IN_COLS_PAD + C_GA + h * 64 + dv);
            const float v0 = (vt ? o1[4 * g] : o0[4 * g]) * inv, v1 = (vt ? o1[4 * g + 1] : o0[4 * g + 1]) * inv;
            const float v2 = (vt ? o1[4 * g + 2] : o0[4 * g + 2]) * inv, v3 = (vt ? o1[4 * g + 3] : o0[4 * g + 3]) * inv;
            u32x2 w; w[0] = cvtpk(v0 * bflo(gw[0]), v1 * bfhi(gw[0])); w[1] = cvtpk(v2 * bflo(gw[1]), v3 * bfhi(gw[1]));
            *(u32x2*)(p.AMA + mrow * 512 + h * 64 + dv) = w;
        }
}

__device__ __forceinline__ void attn_phase(const Params& p, char* lds) {
    const int i = blockIdx.x;
    if (i < 256) {
        const int bh = i >> 2, pair = i & 3;
        attn_unit2(p, lds, bh >> 3, bh & 7, 7 - pair);
        attn_unit2(p, lds, bh >> 3, bh & 7, pair);
    }
}

__device__ __forceinline__ void hgrn_passC(const Params& p, char* lds) {
    const int tid = threadIdx.x, lane = tid & 63, wid = tid >> 6, lr = lane & 15, lg = lane >> 4;
    float* cumL = (float*)lds;
    float* tot = (float*)(lds + 32768);
    char* QT = lds + 34816;
    char* KN = QT + 64 * HC_LD;
    char* QH = KN + 64 * HC_LD;
    char* VT = QH + 64 * HC_LD;
    char* AT = VT + 128 * HA_LD;
    char* STl = AT + 64 * HA_LD;
    for (int uu = blockIdx.x; uu < 32 * 32; uu += gridDim.x) {
        const int c = 1 + (uu & 31), bh = uu >> 5, h = bh & 3, b = bh >> 2;
        const size_t u = (size_t)bh * NCHUNK + c;
        const int t0 = NMETA + 64 * (c - 1);
        const size_t rowbase = (size_t)b * LTOT + t0;
        const int d = tid & 127, part = tid >> 7;
#pragma unroll
        for (int i = 0; i < 4; ++i) {
            const int id = tid + 512 * i, row = id >> 5, c4 = id & 31;
            *(f32x4*)(cumL + row * 128 + c4 * 4) = *(const f32x4*)(p.GLOG + (rowbase + row) * 512 + h * 128 + c4 * 4);
        }
#pragma unroll
        for (int i = 0; i < 2; ++i) {
            const int id = tid + 512 * i, row = id >> 4, ch = id & 15;
            const bf16_t* src = p.PBUF + (rowbase + row) * IN_COLS_PAD + h * 128 + ch * 8;
            const u32x4 qw = *(const u32x4*)(src + C_BQ), kw = *(const u32x4*)(src + C_BF), w = *(const u32x4*)(src + C_BI);
            *(u32x4*)(QH + row * HC_LD + ch * 16) = qw;
            *(u32x4*)(KN + row * HC_LD + ch * 16) = kw;
#pragma unroll
            for (int e = 0; e < 4; ++e) {
                *(bf16_t*)(VT + (ch * 8 + 2 * e) * HA_LD + row * 2) = (bf16_t)(w[e] & 0xffffu);
                *(bf16_t*)(VT + (ch * 8 + 2 * e + 1) * HA_LD + row * 2) = (bf16_t)(w[e] >> 16);
            }
        }
#pragma unroll
        for (int i = 0; i < 4; ++i) {
            const int id = tid + 512 * i, v = id >> 4, dc = id & 15;
            *(u32x4*)(STl + v * HC_LD + dc * 16) = *(const u32x4*)(p.ST + u * 16384 + v * 128 + dc * 8);
        }
        __syncthreads();
        {
            float run = 0.f;
#pragma unroll
            for (int i = 0; i < 16; ++i) { const int s = part * 16 + i; run += cumL[s * 128 + d]; cumL[s * 128 + d] = run; }
            tot[part * 128 + d] = run;
        }
        __syncthreads();
        {
            float off = 0.f;
#pragma unroll
            for (int q = 0; q < 4; ++q) { const float tq = tot[q * 128 + d]; if (q < part) off += tq; }
            const float ref = tot[d] + tot[128 + d];
#pragma unroll
            for (int i = 0; i < 16; ++i) {
                const int s = part * 16 + i;
                const float cum = cumL[s * 128 + d] + off;
                const float qv = bf2f(*(const bf16_t*)(QH + s * HC_LD + d * 2));
                const float kv = bf2f(*(const bf16_t*)(KN + s * HC_LD + d * 2));
                *(bf16_t*)(QT + s * HC_LD + d * 2) = f2bf(qv * __expf(cum - ref));
                *(bf16_t*)(KN + s * HC_LD + d * 2) = f2bf(kv * __expf(ref - cum));
                *(bf16_t*)(QH + s * HC_LD + d * 2) = f2bf(qv * __expf(cum));
            }
        }
        __syncthreads();
        {
            const int mt = wid >> 1;
            const char* xs = QT + (mt * 16 + lr) * HC_LD + lg * 16;
            bf16x8 xf[4];
#pragma unroll
            for (int ks = 0; ks < 4; ++ks) xf[ks] = *(const bf16x8*)(xs + ks * 64);
#pragma unroll
            for (int q = 0; q < 2; ++q) {
                const int nt = 2 * (wid & 1) + q;
                const char* ws = KN + (nt * 16 + lr) * HC_LD + lg * 16;
                f32x4 a = {0.f, 0.f, 0.f, 0.f};
#pragma unroll
                for (int ks = 0; ks < 4; ++ks) a = mfma16(*(const bf16x8*)(ws + ks * 64), xf[ks], a);
                const int t = mt * 16 + lr, s0 = nt * 16 + 4 * lg;
                float m[4];
#pragma unroll
                for (int j = 0; j < 4; ++j) m[j] = (s0 + j <= t) ? a[j] : 0.f;
                u32x2 w; w[0] = cvtpk(m[0], m[1]); w[1] = cvtpk(m[2], m[3]);
                *(u32x2*)(AT + t * HA_LD + s0 * 2) = w;
            }
        }
        __syncthreads();
        {
            const int mt = wid >> 1;
            const char* xa = AT + (mt * 16 + lr) * HA_LD + lg * 16;
            const char* xq = QH + (mt * 16 + lr) * HC_LD + lg * 16;
            bf16x8 af[2], qf[4];
#pragma unroll
            for (int ks = 0; ks < 2; ++ks) af[ks] = *(const bf16x8*)(xa + ks * 64);
#pragma unroll
            for (int ks = 0; ks < 4; ++ks) qf[ks] = *(const bf16x8*)(xq + ks * 64);
#pragma unroll
            for (int q = 0; q < 4; ++q) {
                const int nt = 4 * (wid & 1) + q;
                const char* wv = VT + (nt * 16 + lr) * HA_LD + lg * 16;
                const char* wsx = STl + (nt * 16 + lr) * HC_LD + lg * 16;
                f32x4 a = {0.f, 0.f, 0.f, 0.f};
#pragma unroll
                for (int ks = 0; ks < 2; ++ks) a = mfma16(*(const bf16x8*)(wv + ks * 64), af[ks], a);
#pragma unroll
                for (int ks = 0; ks < 4; ++ks) a = mfma16(*(const bf16x8*)(wsx + ks * 64), qf[ks], a);
                *(f32x4*)(cumL + (mt * 16 + lr) * 128 + nt * 16 + 4 * lg) = a;
            }
        }
        __syncthreads();
        {
#pragma unroll
            for (int i = 0; i < 8; ++i) {
                const int t = wid * 8 + i;
                const f32x2 ov = *(const f32x2*)(cumL + t * 128 + 2 * lane);
                const float ss = wave_sum(ov[0] * ov[0] + ov[1] * ov[1]);
                const float rs = 1.0f / sqrtf(ss * (1.0f / 128.0f) + EPSF);
                const unsigned gw = *(const unsigned*)(p.PBUF + (rowbase + t) * IN_COLS_PAD + C_GB + h * 128 + 2 * lane);
                const f32x2 gbn = *(const f32x2*)(p.g_bn + 2 * lane);
                const size_t mrow = (size_t)b * 2048 + 64 * (c - 1) + t;
                *(unsigned*)(p.AMB + mrow * 512 + h * 128 + 2 * lane) = cvtpk(ov[0] * rs * gbn[0] * bflo(gw), ov[1] * rs * gbn[1] * bfhi(gw));
            }
        }
        __syncthreads();
    }
}

#define SC_LD 528
#define SP_LD 272
#define SC_BUF (128 * SC_LD)

#define SA_D 6
#define SA_STG (SA_D * 16384)
#define SA_RSTG (SA_D * 2048)
#define SA_CB_SLOT (16 * SC_LD)
#define SA_NG 128
typedef __attribute__((address_space(3))) unsigned las_u32;

#define SB_D 2
#define SB_STG (SB_D * 32768)
#define SB_RSTG (SB_D * 4096)
#define SB_CB_SLOT (32 * SC_LD)
#define SB_NG 64

#define SR_LD 80
typedef short v4i16_t __attribute__((ext_vector_type(4)));
__device__ __forceinline__ float xsum16_32(float v) {
    auto r = __builtin_amdgcn_permlane16_swap(__float_as_uint(v), __float_as_uint(v), false, false);
    v = __uint_as_float(r[0]) + __uint_as_float(r[1]);
    auto q = __builtin_amdgcn_permlane32_swap(__float_as_uint(v), __float_as_uint(v), false, false);
    return __uint_as_float(q[0]) + __uint_as_float(q[1]);
}
__device__ __forceinline__ void tr_read2(v4i16_t& t0, v4i16_t& t1, const char* cc) {
    const unsigned la = (unsigned)(unsigned long)(__attribute__((address_space(3))) const char*)cc;
    asm volatile("ds_read_b64_tr_b16 %0, %2\n\tds_read_b64_tr_b16 %1, %2 offset:2112\n\ts_waitcnt lgkmcnt(0)" : "=&v"(t0), "=&v"(t1) : "v"(la) : "memory");
}
__device__ __forceinline__ void sample_attn4(const Params& p, char* lds) {
    const int tid = threadIdx.x, lane = tid & 63, lr = lane & 15, lg = lane >> 4;
    const int wid = __builtin_amdgcn_readfirstlane(tid >> 6);
    char* stg = lds;
    char* rstg = lds + SB_STG;
    char* cb = rstg + SB_RSTG;
    char* rb = cb + 3 * SB_CB_SLOT;
    char* pl = rb + 3 * 32 * SR_LD;
    for (int blk = blockIdx.x; blk < DEC_BATCH * 8; blk += gridDim.x) {
        const int b = blk >> 3, split = blk & 7, h = wid;
        ((unsigned*)pl)[tid] = 0u;
        bf16x8 wf[4][8];
        {
            const bf16_t* wb = p.WUKV_T + (size_t)(64 * h + lr) * 256 + 8 * lg;
#pragma unroll
            for (int nt = 0; nt < 4; ++nt) {
                asm volatile("" : "+v"(wb));
#pragma unroll
                for (int ks = 0; ks < 8; ++ks) wf[nt][ks] = *(const bf16x8*)(wb + 32 * ks);
                wb += 16 * 256;
            }
        }
        const float* qs = p.QS + (size_t)(b * 8 + h) * 96;
        f32x4 qg[4];
#pragma unroll
        for (int nt = 0; nt < 4; ++nt) qg[nt] = *(const f32x4*)(qs + 16 * nt + 4 * lg) * LOG2E;
        bf16x8 qrf;
        {
            u32x4 w = {0u, 0u, 0u, 0u};
            if (lr < 8) {
                const float* q = p.QS + (size_t)(b * 8 + lr) * 96 + 64 + 8 * lg;
                const f32x4 a0 = *(const f32x4*)q * LOG2E, a1 = *(const f32x4*)(q + 4) * LOG2E;
                w[0] = cvtpk(a0[0], a0[1]); w[1] = cvtpk(a0[2], a0[3]); w[2] = cvtpk(a1[0], a1[1]); w[3] = cvtpk(a1[2], a1[3]);
            }
            qrf = __builtin_bit_cast(bf16x8, w);
        }
        const int pgid = p.page_table[b * NPAGES + split * 16 + (lane & 15)];
        const float Mb = p.SCAL[0] * LOG2E;
        f32x4 accl[2] = {{0.f, 0.f, 0.f, 0.f}, {0.f, 0.f, 0.f, 0.f}};
        float lacc = 0.f;
        asm volatile("s_waitcnt vmcnt(0) lgkmcnt(0)" ::: "memory");
        __syncthreads();
        auto issue = [&](int gi, int slot) {
            const int pg = __builtin_amdgcn_readlane(pgid, gi >> 2);
            const size_t row0 = (size_t)pg * PAGE + 32 * (gi & 3) + 4 * wid;
            const float* src = p.cache_latent + row0 * KV_LORA + lane * 4;
            char __attribute__((address_space(3)))* d0 = (char __attribute__((address_space(3)))*)(stg + slot * 32768 + (4 * wid) * 1024);
            __builtin_amdgcn_global_load_lds((const unsigned*)src, (las_u32*)d0, 16, 0, 0);
            __builtin_amdgcn_global_load_lds((const unsigned*)(src + KV_LORA), (las_u32*)(d0 + 1024), 16, 0, 0);
            __builtin_amdgcn_global_load_lds((const unsigned*)(src + 2 * KV_LORA), (las_u32*)(d0 + 2048), 16, 0, 0);
            __builtin_amdgcn_global_load_lds((const unsigned*)(src + 3 * KV_LORA), (las_u32*)(d0 + 3072), 16, 0, 0);
            const float* rsrc = p.cache_krope + row0 * A_ROPE + lane;
            char __attribute__((address_space(3)))* r0 = (char __attribute__((address_space(3)))*)(rstg + slot * 4096 + wid * 512);
            __builtin_amdgcn_global_load_lds((const unsigned*)rsrc, (las_u32*)r0, 4, 0, 0);
            __builtin_amdgcn_global_load_lds((const unsigned*)(rsrc + 64), (las_u32*)(r0 + 256), 4, 0, 0);
        };
#pragma unroll 1
        for (int gi = 0; gi < SB_D; ++gi) issue(gi, gi);
        int c3_g = 2, d_g1 = 0;
        const int hsel = h & 3;
        const float fhg = (lg == (h >> 2)) ? 1.f : 0.f, fdg = (lg == (lr >> 2)) ? 1.f : 0.f;
#pragma unroll 1
        for (int g = -1; g <= SB_NG; ++g) {
            const int c3_g1 = (c3_g == 2) ? 0 : c3_g + 1;
            const int c3_gm1 = (c3_g == 0) ? 2 : c3_g - 1;
            if (g + 1 < SB_NG) {
                if (g + SB_D <= SB_NG - 1) asm volatile("s_waitcnt vmcnt(%0)" :: "n"(6 * (SB_D - 1)) : "memory");
                else asm volatile("s_waitcnt vmcnt(0)" ::: "memory");
            }
            asm volatile("s_waitcnt lgkmcnt(0)" ::: "memory");
            __builtin_amdgcn_s_barrier();
            asm volatile("" ::: "memory");
            if (g + 1 < SB_NG) {
#pragma unroll
                for (int i = 0; i < 4; ++i) {
                    const f32x4 v = *(const f32x4*)(stg + d_g1 * 32768 + (4 * wid + i) * 1024 + lane * 16);
                    u32x2 w; w[0] = cvtpk(v[0], v[1]); w[1] = cvtpk(v[2], v[3]);
                    *(u32x2*)(cb + c3_g1 * SB_CB_SLOT + (4 * wid + i) * SC_LD + lane * 8) = w;
                }
                {
                    const int rrow = 4 * wid + (lane >> 4), c2 = (lane & 15) * 2;
                    const f32x2 v = *(const f32x2*)(rstg + d_g1 * 4096 + rrow * 128 + c2 * 4);
                    *(unsigned*)(rb + c3_g1 * 32 * SR_LD + rrow * SR_LD + c2 * 2) = cvtpk(v[0], v[1]);
                }
                asm volatile("" ::: "memory");
                if (g + 1 + SB_D < SB_NG) issue(g + 1 + SB_D, d_g1);
            }
            if (g >= 0 && g < SB_NG) {
#pragma unroll
                for (int mt2 = 0; mt2 < 2; ++mt2) {
                    f32x4 a[4];
#pragma unroll
                    for (int nt = 0; nt < 4; ++nt) a[nt] = (f32x4){0.f, 0.f, 0.f, 0.f};
                    const char* xs = cb + c3_g * SB_CB_SLOT + (16 * mt2 + lr) * SC_LD + lg * 16;
                    const bf16x8 rf = *(const bf16x8*)(rb + c3_g * 32 * SR_LD + (16 * mt2 + lr) * SR_LD + lg * 16);
#pragma unroll
                    for (int ks = 0; ks < 8; ++ks) {
                        const bf16x8 xf = *(const bf16x8*)(xs + ks * 64);
#pragma unroll
                        for (int nt = 0; nt < 4; ++nt) a[nt] = mfma16(wf[nt][ks], xf, a[nt]);
                    }
                    const f32x4 z4 = {0.f, 0.f, 0.f, 0.f};
                    const f32x4 asr = mfma16(qrf, rf, z4);
                    const f32x4 arr = mfma16(rf, rf, z4);
                    const float srv = (hsel == 0) ? asr[0] : (hsel == 1) ? asr[1] : (hsel == 2) ? asr[2] : asr[3];
                    const int dj = lr & 3;
                    const float rrv = (dj == 0) ? arr[0] : (dj == 1) ? arr[1] : (dj == 2) ? arr[2] : arr[3];
                    float ss = rrv * fdg, sq = srv * fhg;
#pragma unroll
                    for (int nt = 0; nt < 4; ++nt)
#pragma unroll
                        for (int j = 0; j < 4; ++j) { ss += a[nt][j] * a[nt][j]; sq += a[nt][j] * qg[nt][j]; }
                    ss = xsum16_32(ss); sq = xsum16_32(sq);
                    const float sc = sq * __builtin_amdgcn_rsqf(ss * (1.0f / 96.0f) + EPSF);
                    const float pe = __builtin_amdgcn_exp2f(sc - Mb);
                    lacc += pe;
                    if (lg == 0) *(bf16_t*)(pl + (g & 1) * 1024 + h * 64 + (16 * mt2 + lr) * 2) = f2bf(pe);
                }
            }
            if (g >= 1) {
                const bf16x8 xf = *(const bf16x8*)(pl + ((g - 1) & 1) * 1024 + lr * 64 + lg * 16);
#pragma unroll
                for (int q = 0; q < 2; ++q) {
                    const char* cc = cb + c3_gm1 * SB_CB_SLOT + (8 * lg + (lr >> 2)) * SC_LD + (32 * wid + 16 * q + 4 * (lr & 3)) * 2;
                    const v4i16_t t0 = __builtin_amdgcn_ds_read_tr16_b64_v4i16((__attribute__((address_space(3))) v4i16_t*)(cc));
                    const v4i16_t t1 = __builtin_amdgcn_ds_read_tr16_b64_v4i16((__attribute__((address_space(3))) v4i16_t*)(cc + 4 * SC_LD));
                    const bf16x8 wfr = {t0[0], t0[1], t0[2], t0[3], t1[0], t1[1], t1[2], t1[3]};
                    accl[q] = mfma16(wfr, xf, accl[q]);
                }
            }
            c3_g = c3_g1;
            d_g1 = (d_g1 + 1 == SB_D) ? 0 : d_g1 + 1;
        }
        if (lr < 8) {
#pragma unroll
            for (int q = 0; q < 2; ++q) *(f32x4*)(p.PART + ((size_t)(b * 8 + split) * 8 + lr) * 256 + 32 * wid + 16 * q + 4 * lg) = accl[q];
        }
        lacc += __shfl_xor(lacc, 8); lacc += __shfl_xor(lacc, 4); lacc += __shfl_xor(lacc, 2); lacc += __shfl_xor(lacc, 1);
        if (lane == 0) p.PL[(b * 8 + split) * 8 + h] = lacc;
        __syncthreads();
    }
}

#define SA8_SB __builtin_amdgcn_sched_barrier(0)
template <int K> struct SA8IC { static constexpr int value = K; };
template <bool CONV, bool ISSUE, bool MAIN, bool PXC, int VMW>
__device__ __forceinline__ void sa8_iter(const Params& p, char* lds, const bf16x8 (&wf)[4][8], const f32x4 (&qg)[4], const bf16x8 qrf, const int pgid,
                                         const float Mb, f32x4 (&accl)[2], float& lacc, const int g, const int c3_g, const int c3_g1, const int c3_gm1, const int d_g1,
                                         const int wid, const int lane, const int hsel) {
    const int lr = lane & 15, lg = lane >> 4, h = wid;
    const bool bhg = (lg == (h >> 2)), bdg = (lg == (lr >> 2));
    char* stg = lds;
    char* rstg = lds + SB_STG;
    char* cb = rstg + SB_RSTG;
    char* rb = cb + 3 * SB_CB_SLOT;
    char* pl = rb + 3 * 32 * SR_LD;
    if constexpr (VMW >= 0) asm volatile("s_waitcnt vmcnt(%0)" :: "n"(VMW) : "memory");
    asm volatile("s_waitcnt lgkmcnt(0)" ::: "memory");
    __builtin_amdgcn_s_barrier();
    asm volatile("" ::: "memory");
    const f32x4 z4 = {0.f, 0.f, 0.f, 0.f};
    f32x4 a0[4], a1[4], asr = z4, arr = z4;
    bf16x8 xr[3], rf0, rf1, xfp;
    f32x4 cv = z4; f32x2 crv = {0.f, 0.f};
    f32x2 ss2 = {0.f, 0.f}, sq2 = {0.f, 0.f};
    float ss = 0.f, sq = 0.f, srv0 = 0.f, rrv0 = 0.f;
    v4i16_t pt0, pt1;
    const char* xs0 = cb + c3_g * SB_CB_SLOT + lr * SC_LD + lg * 16;
    const char* rs0 = rb + c3_g * 32 * SR_LD + lr * SR_LD + lg * 16;
    const char* cvsrc = stg + d_g1 * 32768 + (4 * wid) * 1024 + lane * 16;
    char* cvdst = cb + c3_g1 * SB_CB_SLOT + (4 * wid) * SC_LD + lane * 8;
    int lane_o = lane; asm volatile("" : "+v"(lane_o));
    const int rrow = 4 * wid + (lane_o >> 4), c2 = (lane_o & 15) * 2, lr_o = lane_o & 15, lg_o = lane_o >> 4;
    const char* isrc = nullptr; const char* irsrc = nullptr;
    const unsigned lo16 = (unsigned)lane_o * 16u, lo4 = (unsigned)lane_o * 4u;
    const char* pcc = cb + c3_gm1 * SB_CB_SLOT + (8 * lg + (lr >> 2)) * SC_LD + (32 * wid + 4 * (lr & 3)) * 2;
    const int dj = lr & 3;
    if constexpr (MAIN) { xr[0] = *(const bf16x8*)(xs0); xr[1] = *(const bf16x8*)(xs0 + 64); rf0 = *(const bf16x8*)(rs0); }
    if constexpr (CONV) cv = *(const f32x4*)(cvsrc);
    SA8_SB;
#define SA8_EPI_ACC(A, NT) do { const f32x2 lo_ = {A[NT][0], A[NT][1]}, hi_ = {A[NT][2], A[NT][3]}; const f32x2 ql_ = {qg[NT][0], qg[NT][1]}, qh_ = {qg[NT][2], qg[NT][3]}; \
        ss2 += lo_ * lo_; sq2 += lo_ * ql_; ss2 += hi_ * hi_; sq2 += hi_ * qh_; } while (0)
#define SA8_EPI_SEL() do { srv0 = (hsel == 0) ? asr[0] : (hsel == 1) ? asr[1] : (hsel == 2) ? asr[2] : asr[3]; rrv0 = (dj == 0) ? arr[0] : (dj == 1) ? arr[1] : (dj == 2) ? arr[2] : arr[3]; } while (0)
#define SA8_EPI_H() do { ss = ss2[0] + ss2[1] + (bdg ? rrv0 : 0.f); sq = sq2[0] + sq2[1] + (bhg ? srv0 : 0.f); ss2 = (f32x2){0.f, 0.f}; sq2 = (f32x2){0.f, 0.f}; } while (0)
#define SA8_EPI_FIN(T) do { const float sc_ = sq * __builtin_amdgcn_rsqf(ss * (1.0f / 96.0f) + EPSF); const float pe_ = __builtin_amdgcn_exp2f(sc_ - Mb); lacc += pe_; \
        *(bf16_t*)(pl + (g & 1) * 1024 + h * 64 + (16 * (T) + lr_o) * 2) = f2bf(pe_); } while (0)
    auto slot = [&](auto kc) __attribute__((always_inline)) {
        constexpr int k = decltype(kc)::value;
        constexpr int t = k >> 5, ks = (k >> 2) & 7, nt = k & 3, step = k >> 2;
        if constexpr (MAIN) {
            if constexpr (nt == 0 && step + 2 < 16) xr[(step + 2) % 3] = *(const bf16x8*)(xs0 + ((step + 2) >> 3) * 16 * SC_LD + ((step + 2) & 7) * 64);
            if constexpr (k == 26) rf1 = *(const bf16x8*)(rs0 + 16 * SR_LD);
            if constexpr (t == 0) { if constexpr (ks == 0) a0[nt] = mfma16(wf[nt][ks], xr[step % 3], z4); else a0[nt] = mfma16(wf[nt][ks], xr[step % 3], a0[nt]); }
            else { if constexpr (ks == 0) a1[nt] = mfma16(wf[nt][ks], xr[step % 3], z4); else a1[nt] = mfma16(wf[nt][ks], xr[step % 3], a1[nt]); }
            if constexpr (k == 29) { asr = mfma16(qrf, rf0, z4); }
            if constexpr (k == 30) { arr = mfma16(rf0, rf0, z4); }
            if constexpr (k == 33) { SA8_EPI_SEL(); }
            if constexpr (k == 34) { SA8_EPI_ACC(a0, 0); }
            if constexpr (k == 36) { SA8_EPI_ACC(a0, 1); }
            if constexpr (k == 38) { SA8_EPI_ACC(a0, 2); }
            if constexpr (k == 40) { SA8_EPI_ACC(a0, 3); }
            if constexpr (k == 42) { SA8_EPI_H(); }
            if constexpr (k == 44) { ss = xsum16_32(ss); }
            if constexpr (k == 46) { sq = xsum16_32(sq); }
            if constexpr (k == 48) { SA8_EPI_FIN(0); }
            if constexpr (k == 60) { asr = mfma16(qrf, rf1, z4); }
            if constexpr (k == 61) { arr = mfma16(rf1, rf1, z4); }
        }
        if constexpr (CONV) {
            if constexpr (k == 2 || k == 5 || k == 8 || k == 11) {
                constexpr int i = (k - 2) / 3;
                u32x2 w; w[0] = cvtpk(cv[0], cv[1]); w[1] = cvtpk(cv[2], cv[3]);
                *(u32x2*)(cvdst + i * SC_LD) = w;
                if constexpr (i < 3) cv = *(const f32x4*)(cvsrc + (i + 1) * 1024);
                else crv = *(const f32x2*)(rstg + d_g1 * 4096 + rrow * 128 + c2 * 4);
            }
            if constexpr (k == 14) *(unsigned*)(rb + c3_g1 * 32 * SR_LD + rrow * SR_LD + c2 * 2) = cvtpk(crv[0], crv[1]);
        }
        if constexpr (ISSUE) {
            if constexpr (k == 16) {
                asm volatile("" ::: "memory");
                const int gi = g + 1 + SB_D;
                const int pg = __builtin_amdgcn_readlane(pgid, gi >> 2);
                const size_t row0 = (size_t)pg * PAGE + 32 * (gi & 3) + 4 * wid;
                isrc = (const char*)p.cache_latent + row0 * (KV_LORA * 4);
                irsrc = (const char*)p.cache_krope + row0 * (A_ROPE * 4);
            }
            if constexpr (k >= 17 && k <= 20) {
                char __attribute__((address_space(3)))* d0 = (char __attribute__((address_space(3)))*)(stg + d_g1 * 32768 + (4 * wid) * 1024);
                __builtin_amdgcn_global_load_lds((const unsigned*)(isrc + (k - 17) * (KV_LORA * 4) + lo16), (las_u32*)(d0 + (k - 17) * 1024), 16, 0, 0);
            }
            if constexpr (k == 21 || k == 22) {
                char __attribute__((address_space(3)))* r0 = (char __attribute__((address_space(3)))*)(rstg + d_g1 * 4096 + wid * 512);
                __builtin_amdgcn_global_load_lds((const unsigned*)(irsrc + (k - 21) * 256 + lo4), (las_u32*)(r0 + (k - 21) * 256), 4, 0, 0);
            }
        }
        if constexpr (PXC) {
            if constexpr (k == 18) xfp = *(const bf16x8*)(pl + ((g - 1) & 1) * 1024 + lr_o * 64 + lg_o * 16);
            if constexpr (k == 19 || k == 24) {
                const char* cc = pcc + (k == 19 ? 0 : 32);
                static_assert(4 * SC_LD == 2112, "tr_read2 offset");
                tr_read2(pt0, pt1, cc);
            }
            if constexpr (k == 23 || k == 28) {
                const bf16x8 wfr = {pt0[0], pt0[1], pt0[2], pt0[3], pt1[0], pt1[1], pt1[2], pt1[3]};
                accl[k == 23 ? 0 : 1] = mfma16(wfr, xfp, accl[k == 23 ? 0 : 1]);
            }
        }
        SA8_SB;
    };
#define SA8_S1(K) slot(SA8IC<(K)>{});
#define SA8_S4(K) SA8_S1(K) SA8_S1((K) + 1) SA8_S1((K) + 2) SA8_S1((K) + 3)
#define SA8_S16(K) SA8_S4(K) SA8_S4((K) + 4) SA8_S4((K) + 8) SA8_S4((K) + 12)
    SA8_S16(0) SA8_S16(16) SA8_S16(32) SA8_S16(48)
#undef SA8_S1
#undef SA8_S4
#undef SA8_S16
    if constexpr (MAIN) {
        SA8_EPI_SEL();
        SA8_EPI_ACC(a1, 0); SA8_EPI_ACC(a1, 1); SA8_EPI_ACC(a1, 2); SA8_EPI_ACC(a1, 3);
        SA8_EPI_H();
        ss = xsum16_32(ss); sq = xsum16_32(sq);
        SA8_EPI_FIN(1);
    }
#undef SA8_EPI_ACC
#undef SA8_EPI_SEL
#undef SA8_EPI_H
#undef SA8_EPI_FIN
}
__device__ __forceinline__ void sample_attn8(const Params& p, char* lds) {
    const int tid = threadIdx.x, lane = tid & 63, lr = lane & 15, lg = lane >> 4;
    const int wid = __builtin_amdgcn_readfirstlane(tid >> 6);
    char* stg = lds;
    char* rstg = lds + SB_STG;
    char* cb = rstg + SB_RSTG;
    char* rb = cb + 3 * SB_CB_SLOT;
    char* pl = rb + 3 * 32 * SR_LD;
    static_assert(SB_D == 2 && SB_NG == 64, "iteration schedule below assumes a 2-deep ring over 64 granules");
    for (int blk = blockIdx.x; blk < DEC_BATCH * 8; blk += gridDim.x) {
        const int b = blk >> 3, split = blk & 7, h = wid;
        ((unsigned*)pl)[tid] = 0u;
        bf16x8 wf[4][8];
        {
            const bf16_t* wb = p.WUKV_T + (size_t)(64 * h + lr) * 256 + 8 * lg;
#pragma unroll
            for (int nt = 0; nt < 4; ++nt) {
                asm volatile("" : "+v"(wb));
#pragma unroll
                for (int ks = 0; ks < 8; ++ks) wf[nt][ks] = *(const bf16x8*)(wb + 32 * ks);
                wb += 16 * 256;
            }
        }
        const float* qs = p.QS + (size_t)(b * 8 + h) * 96;
        f32x4 qg[4];
#pragma unroll
        for (int nt = 0; nt < 4; ++nt) qg[nt] = *(const f32x4*)(qs + 16 * nt + 4 * lg) * LOG2E;
        bf16x8 qrf;
        {
            u32x4 w = {0u, 0u, 0u, 0u};
            if (lr < 8) {
                const float* q = p.QS + (size_t)(b * 8 + lr) * 96 + 64 + 8 * lg;
                const f32x4 a0 = *(const f32x4*)q * LOG2E, a1 = *(const f32x4*)(q + 4) * LOG2E;
                w[0] = cvtpk(a0[0], a0[1]); w[1] = cvtpk(a0[2], a0[3]); w[2] = cvtpk(a1[0], a1[1]); w[3] = cvtpk(a1[2], a1[3]);
            }
            qrf = __builtin_bit_cast(bf16x8, w);
        }
        const int pgid = p.page_table[b * NPAGES + split * 16 + (lane & 15)];
        const float Mb = __uint_as_float(__builtin_amdgcn_readfirstlane(__float_as_uint(p.SCAL[0] * LOG2E)));
        f32x4 accl[2] = {{0.f, 0.f, 0.f, 0.f}, {0.f, 0.f, 0.f, 0.f}};
        float lacc = 0.f;
        asm volatile("s_waitcnt vmcnt(0) lgkmcnt(0)" ::: "memory");
        __syncthreads();
        auto issue = [&](int gi, int slot) {
            const int pg = __builtin_amdgcn_readlane(pgid, gi >> 2);
            const size_t row0 = (size_t)pg * PAGE + 32 * (gi & 3) + 4 * wid;
            const float* src = p.cache_latent + row0 * KV_LORA + lane * 4;
            char __attribute__((address_space(3)))* d0 = (char __attribute__((address_space(3)))*)(stg + slot * 32768 + (4 * wid) * 1024);
            __builtin_amdgcn_global_load_lds((const unsigned*)src, (las_u32*)d0, 16, 0, 0);
            __builtin_amdgcn_global_load_lds((const unsigned*)(src + KV_LORA), (las_u32*)(d0 + 1024), 16, 0, 0);
            __builtin_amdgcn_global_load_lds((const unsigned*)(src + 2 * KV_LORA), (las_u32*)(d0 + 2048), 16, 0, 0);
            __builtin_amdgcn_global_load_lds((const unsigned*)(src + 3 * KV_LORA), (las_u32*)(d0 + 3072), 16, 0, 0);
            const float* rsrc = p.cache_krope + row0 * A_ROPE + lane;
            char __attribute__((address_space(3)))* r0 = (char __attribute__((address_space(3)))*)(rstg + slot * 4096 + wid * 512);
            __builtin_amdgcn_global_load_lds((const unsigned*)rsrc, (las_u32*)r0, 4, 0, 0);
            __builtin_amdgcn_global_load_lds((const unsigned*)(rsrc + 64), (las_u32*)(r0 + 256), 4, 0, 0);
        };
        issue(0, 0); issue(1, 1);
        int c3_g = 2, d_g1 = 0, g = -1;
        const int hsel = h & 3;
#define SA8_RUN(CONV, ISSUE, MAIN, PXC, VMW) do { const int c3_g1 = (c3_g == 2) ? 0 : c3_g + 1, c3_gm1 = (c3_g == 0) ? 2 : c3_g - 1; \
        sa8_iter<CONV, ISSUE, MAIN, PXC, VMW>(p, lds, wf, qg, qrf, pgid, Mb, accl, lacc, g, c3_g, c3_g1, c3_gm1, d_g1, wid, lane, hsel); \
        c3_g = c3_g1; d_g1 ^= 1; ++g; } while (0)
        SA8_RUN(true, true, false, false, 6);
        SA8_RUN(true, true, true, false, 6);
#pragma unroll 1
        for (int it = 1; it <= SB_NG - SB_D - 2; ++it) { asm volatile("" : "+s"(c3_g), "+s"(d_g1)); SA8_RUN(true, true, true, true, 6); }
        SA8_RUN(true, false, true, true, 6);
        SA8_RUN(true, false, true, true, 0);
        SA8_RUN(false, false, true, true, -1);
        SA8_RUN(false, false, false, true, -1);
#undef SA8_RUN
        if (lr < 8) {
#pragma unroll
            for (int q = 0; q < 2; ++q) *(f32x4*)(p.PART + ((size_t)(b * 8 + split) * 8 + lr) * 256 + 32 * wid + 16 * q + 4 * lg) = accl[q];
        }
        lacc += __shfl_xor(lacc, 8); lacc += __shfl_xor(lacc, 4); lacc += __shfl_xor(lacc, 2); lacc += __shfl_xor(lacc, 1);
        if (lane == 0) p.PL[(b * 8 + split) * 8 + h] = lacc;
        __syncthreads();
    }
}

__device__ __forceinline__ void phase3(const Params& p, char* lds) {
    hgrn_passB(p);
    sample_attn8(p, lds);
}

__device__ __forceinline__ void sample_combine(const Params& p, char* lds) {
    const int tid = threadIdx.x;
    float* ol = (float*)lds;
    float* red = ol + 256;
    float* sc = red + 512;
    for (int u = blockIdx.x; u < DEC_BATCH * 8; u += gridDim.x) {
        const int b = u >> 3, h = u & 7;
        if (tid < 64) {
            const float* kraw = p.KSRAW + (size_t)(b * 8 + h) * 96;
            const float* qs = p.QS + (size_t)(b * 8 + h) * 96;
            float ss = 0.f, sq = 0.f;
            for (int d = tid; d < 96; d += 64) { const float k = kraw[d]; ss += k * k; sq += k * qs[d]; }
            ss = wave_sum(ss); sq = wave_sum(sq);
            if (tid == 0) {
                const float s = sq / sqrtf(ss * (1.0f / 96.0f) + EPSF);
                const float pn = __expf(s - p.SCAL[0]);
                float l = pn;
                for (int sp = 0; sp < 8; ++sp) l += p.PL[(b * 8 + sp) * 8 + h];
                sc[0] = pn; sc[1] = 1.0f / l;
            }
        }
        __syncthreads();
        if (tid < 256) {
            const int c = tid;
            float a = sc[0] * p.out[OFF_LAT_S + b * 256 + c];
#pragma unroll
            for (int sp = 0; sp < 8; ++sp) a += p.PART[((size_t)(b * 8 + sp) * 8 + h) * 256 + c];
            ol[c] = a * sc[1];
        }
        __syncthreads();
        {
            const int d = tid & 63, part = tid >> 6;
            const bf16_t* wrow = p.WUKV_T + (size_t)(512 + h * 64 + d) * 256 + part * 32;
            float a = 0.f;
#pragma unroll
            for (int c = 0; c < 32; c += 8) {
                const u32x4 w = *(const u32x4*)(wrow + c);
                const f32x4 o0 = *(const f32x4*)(ol + part * 32 + c), o1 = *(const f32x4*)(ol + part * 32 + c + 4);
                a += o0[0] * bflo(w[0]) + o0[1] * bfhi(w[0]) + o0[2] * bflo(w[1]) + o0[3] * bfhi(w[1]) + o1[0] * bflo(w[2]) + o1[1] * bfhi(w[2]) + o1[2] * bflo(w[3]) + o1[3] * bfhi(w[3]);
            }
            red[part * 64 + d] = a;
        }
        __syncthreads();
        if (tid < 64) {
            float a = 0.f;
#pragma unroll
            for (int q = 0; q < 8; ++q) a += red[q * 64 + tid];
            const float ga = bf2f(p.PBUF[(size_t)(R_PROMPT + b) * IN_COLS_PAD + C_GA + h * 64 + tid]);
            p.AMA[(size_t)(NQ + b) * 512 + h * 64 + tid] = f2bf(a * ga);
        }
        __syncthreads();
    }
}

__device__ __forceinline__ void merge_m_gemm(const Params& p, char* lds) {
    const int bx = blockIdx.x, vcu = (bx & 7) * 32 + (bx >> 3);
    OneTileOrder S{vcu, 1};
    {
        pg8::Gemm g{p.AMA, p.WOA_T, NQ, 1024, 512, p.AMA, p.WOA_T};
        EpiMerge<0> E{p.PBUF, p.TMP, p.MM};
        pg8::gemm_phase<EpiMerge<0>, OneTileOrder, false, true>((PG8_LAS unsigned char*)lds, g, S, E);
    }
    {
        pg8::Gemm g{p.AMB, p.WOB_T, NQ, 1024, 512, p.AMB, p.WOB_T};
        EpiMerge<1> E{p.PBUF, p.TMP, p.MM};
        pg8::gemm_phase<EpiMerge<1>, OneTileOrder, false, true>((PG8_LAS unsigned char*)lds, g, S, E);
    }
}


__device__ __forceinline__ float dot_bf16_row(const bf16_t* a, const bf16_t* w, int K) {
    float s = 0.f;
    for (int k = 0; k < K; k += 8) {
        const u32x4 x = *(const u32x4*)(a + k), y = *(const u32x4*)(w + k);
#pragma unroll
        for (int e = 0; e < 4; ++e) s += bflo(x[e]) * bflo(y[e]) + bfhi(x[e]) * bfhi(y[e]);
    }
    return s;
}
__device__ __forceinline__ void rows32_tile(f32x4 (&acc)[2], const bf16_t* __restrict__ X, int ldx, const bf16_t* __restrict__ W, int K, int nt) {
    const int lane = threadIdx.x & 63, lr = lane & 15, lg = lane >> 4;
    const bf16_t* x0 = X + (size_t)lr * ldx + lg * 8;
    const bf16_t* x1 = X + (size_t)(16 + lr) * ldx + lg * 8;
    const bf16_t* w = W + (size_t)(nt * 16 + lr) * K + lg * 8;
#pragma unroll 8
    for (int ks = 0; ks < (K >> 5); ++ks) {
        const bf16x8 wf = *(const bf16x8*)(w + ks * 32);
        acc[0] = mfma16(wf, *(const bf16x8*)(x0 + ks * 32), acc[0]);
        acc[1] = mfma16(wf, *(const bf16x8*)(x1 + ks * 32), acc[1]);
    }
}
template <int KSTEPS_PER_WAVE>
__device__ __forceinline__ void rows32_tile_ksplit(f32x4 (&acc)[2], const bf16_t* __restrict__ X, int ldx, const bf16_t* __restrict__ W, int K, int nt, int wid) {
    const int lane = threadIdx.x & 63, lr = lane & 15, lg = lane >> 4;
    const int ks0 = wid * KSTEPS_PER_WAVE;
    const bf16_t* x0 = X + (size_t)lr * ldx + lg * 8 + ks0 * 32;
    const bf16_t* x1 = X + (size_t)(16 + lr) * ldx + lg * 8 + ks0 * 32;
    const bf16_t* w = W + (size_t)(nt * 16 + lr) * K + lg * 8 + ks0 * 32;
    bf16x8 wf[KSTEPS_PER_WAVE], xa[KSTEPS_PER_WAVE], xb[KSTEPS_PER_WAVE];
#pragma unroll
    for (int ks = 0; ks < KSTEPS_PER_WAVE; ++ks) { wf[ks] = *(const bf16x8*)(w + ks * 32); xa[ks] = *(const bf16x8*)(x0 + ks * 32); xb[ks] = *(const bf16x8*)(x1 + ks * 32); }
#pragma unroll
    for (int ks = 0; ks < KSTEPS_PER_WAVE; ++ks) { acc[0] = mfma16(wf[ks], xa[ks], acc[0]); acc[1] = mfma16(wf[ks], xb[ks], acc[1]); }
}
__device__ __forceinline__ void sample_m(const Params& p, char* lds) {
    const int tid = threadIdx.x, lane = tid & 63, wid = tid >> 6, lr = lane & 15, lg = lane >> 4;
    f32x4* red = (f32x4*)lds;
    for (int nt = blockIdx.x; nt < 64; nt += gridDim.x) {
        f32x4 ya[2] = {{0.f, 0.f, 0.f, 0.f}, {0.f, 0.f, 0.f, 0.f}}, yb[2] = {{0.f, 0.f, 0.f, 0.f}, {0.f, 0.f, 0.f, 0.f}};
        rows32_tile_ksplit<2>(ya, p.AMA + (size_t)NQ * 512, 512, p.WOA_T, 512, nt, wid);
        rows32_tile_ksplit<2>(yb, p.AMB + (size_t)NQ * 512, 512, p.WOB_T, 512, nt, wid);
        red[(wid * 4 + 0) * 64 + lane] = ya[0]; red[(wid * 4 + 1) * 64 + lane] = ya[1];
        red[(wid * 4 + 2) * 64 + lane] = yb[0]; red[(wid * 4 + 3) * 64 + lane] = yb[1];
        __syncthreads();
        if (wid == 0) {
#pragma unroll
            for (int q = 1; q < 8; ++q) { ya[0] += red[(q * 4 + 0) * 64 + lane]; ya[1] += red[(q * 4 + 1) * 64 + lane]; yb[0] += red[(q * 4 + 2) * 64 + lane]; yb[1] += red[(q * 4 + 3) * 64 + lane]; }
#pragma unroll
            for (int mt = 0; mt < 2; ++mt) {
                const int i = 16 * mt + lr, n = 16 * nt + 4 * lg;
                const size_t r = R_PROMPT + i;
                const u32x2 ga = *(const u32x2*)(p.PBUF + r * IN_COLS_PAD + C_MA + n);
                const u32x2 gb = *(const u32x2*)(p.PBUF + r * IN_COLS_PAD + C_MB + n);
                u32x2 w;
                w[0] = cvtpk(bflo(ga[0]) * ya[mt][0] + bflo(gb[0]) * yb[mt][0], bfhi(ga[0]) * ya[mt][1] + bfhi(gb[0]) * yb[mt][1]);
                w[1] = cvtpk(bflo(ga[1]) * ya[mt][2] + bflo(gb[1]) * yb[mt][2], bfhi(ga[1]) * ya[mt][3] + bfhi(gb[1]) * yb[mt][3]);
                *(u32x2*)(p.MM + (size_t)(NQ + i) * 1024 + n) = w;
            }
        }
        __syncthreads();
    }
}
__device__ __forceinline__ void final_gemm(const Params& p, char* lds) {
    const int bx = blockIdx.x, vcu = (bx & 7) * 32 + (bx >> 3);
    pg8::Gemm g{p.MM, p.WO_T, NQ, 1024, 1024, p.MM, p.WO_T};
    OneTileOrder S{vcu, 1};
    EpiFinal E{p.x_prompt, p.out + OFF_Y_P};
    pg8::gemm_phase<EpiFinal, OneTileOrder, false, true>((PG8_LAS unsigned char*)lds, g, S, E);
}


__device__ __forceinline__ void sample_y(const Params& p, char* lds) {
    const int tid = threadIdx.x, lane = tid & 63, wid = tid >> 6, lr = lane & 15, lg = lane >> 4;
    f32x4* red = (f32x4*)lds;
    for (int nt = blockIdx.x; nt < 64; nt += gridDim.x) {
        f32x4 y[2] = {{0.f, 0.f, 0.f, 0.f}, {0.f, 0.f, 0.f, 0.f}};
        rows32_tile_ksplit<4>(y, p.MM + (size_t)NQ * 1024, 1024, p.WO_T, 1024, nt, wid);
        red[(wid * 2 + 0) * 64 + lane] = y[0]; red[(wid * 2 + 1) * 64 + lane] = y[1];
        __syncthreads();
        if (wid == 0) {
#pragma unroll
            for (int q = 1; q < 8; ++q) { y[0] += red[(q * 2 + 0) * 64 + lane]; y[1] += red[(q * 2 + 1) * 64 + lane]; }
#pragma unroll
            for (int mt = 0; mt < 2; ++mt) {
                const int i = 16 * mt + lr, n = 16 * nt + 4 * lg;
                const f32x4 x = *(const f32x4*)(p.x_sample + (size_t)i * 1024 + n);
                *(f32x4*)(p.out + OFF_Y_S + (size_t)i * 1024 + n) = x + y[mt];
            }
        }
        __syncthreads();
    }
}

__device__ __forceinline__ void phase4(const Params& p, char* lds) {
    sample_combine(p, lds);
    attn_phase(p, lds);
    hgrn_passC(p, lds);
}
__device__ __forceinline__ void phase5(const Params& p, char* lds) {
    sample_m(p, lds);
    merge_m_gemm(p, lds);
}
__device__ __forceinline__ void phase6(const Params& p, char* lds) {
    sample_y(p, lds);
    final_gemm(p, lds);
}

#define XB_TMO      128
#define XB_XCNT(j)  (256  + 64 * (j))
#define XB_XSUB(j)  (1280 + 64 * (j))
#define XB_XGEN(j)  (2304 + 64 * (j))
#define XB_TOP      3328
#define XB_TOPGEN   3392
#define XCD_BAR_WORDS 3456
#define XB_SPIN_CAP (1u << 22)
#define LAS __attribute__((address_space(3)))
__device__ __forceinline__ unsigned xb_ld(unsigned* p)              { return __hip_atomic_load(p, __ATOMIC_RELAXED, __HIP_MEMORY_SCOPE_AGENT); }
__device__ __forceinline__ unsigned xb_add(unsigned* p, unsigned v) { return __hip_atomic_fetch_add(p, v, __ATOMIC_RELAXED, __HIP_MEMORY_SCOPE_AGENT); }
__device__ __forceinline__ unsigned xb_xcc_id() { return (unsigned)__builtin_amdgcn_s_getreg((3 << 11) | 20) & 0xFu; }
#define XB_SPIN(cond, bar) do { unsigned _sp = 0; while (cond) { __builtin_amdgcn_s_sleep(1); \
    if ((++_sp & 255u) == 0u) { if (xb_ld(&(bar)[XB_TMO])) break; if (_sp > XB_SPIN_CAP) { atomicAdd(&(bar)[XB_TMO], 1u); break; } } } } while (0)
struct XcdBarrier { unsigned* bar; unsigned x; volatile LAS unsigned* st; };
__device__ __forceinline__ XcdBarrier xcd_barrier_post(unsigned* bar, volatile LAS unsigned* st) {
    XcdBarrier b; b.bar = bar; b.x = xb_xcc_id(); b.st = st;
    if (threadIdx.x == 0) (void)xb_add(&bar[XB_XCNT(b.x)], 1u);
    return b;
}
__device__ __forceinline__ void xcd_barrier_complete(unsigned* bar, unsigned x, unsigned& nloc, unsigned& nx) {
    const unsigned G = gridDim.x * gridDim.y * gridDim.z;
    unsigned sum, cnt, mine, sp = 0u;
    for (;;) {
        sum = 0u; cnt = 0u; mine = 0u;
#pragma unroll
        for (unsigned j = 0; j < 16; ++j) { const unsigned c = xb_ld(&bar[XB_XCNT(j)]); sum += c; cnt += (c > 0u) ? 1u : 0u; mine = (j == x) ? c : mine; }
        if (sum == G) break;
        __builtin_amdgcn_s_sleep(1);
        if ((++sp & 255u) == 0u) { if (xb_ld(&bar[XB_TMO])) break; if (sp > XB_SPIN_CAP) { atomicAdd(&bar[XB_TMO], 1u); break; } }
    }
    nloc = mine > 0u ? mine : 1u; nx = cnt > 0u ? cnt : 1u;
}
__device__ __forceinline__ void xcd_barrier(const XcdBarrier& b, unsigned* bar_in) {
    asm volatile("s_waitcnt vmcnt(0)" ::: "memory");
    __syncthreads();
    if (threadIdx.x == 0) {
        unsigned* bar = bar_in;
        __builtin_amdgcn_s_waitcnt(0);
        unsigned nloc = b.st[0], nx = b.st[1];
        if (nloc == 0u) { xcd_barrier_complete(bar, b.x, nloc, nx); b.st[0] = nloc; b.st[1] = nx; }
        const unsigned old = xb_add(&bar[XB_XSUB(b.x)], 1u);
        const unsigned gen = old / nloc;
        if (old + 1u == (gen + 1u) * nloc) {
            __builtin_amdgcn_fence(__ATOMIC_RELEASE, "agent");
            asm volatile("s_waitcnt vmcnt(0)" ::: "memory");
            const unsigned og = xb_add(&bar[XB_TOP], 1u);
            const unsigned tg = og / nx;
            if (og + 1u == (tg + 1u) * nx) xb_add(&bar[XB_TOPGEN], 1u);
            else XB_SPIN(xb_ld(&bar[XB_TOPGEN]) == tg, bar);
            __builtin_amdgcn_fence(__ATOMIC_ACQUIRE, "agent");
            xb_add(&bar[XB_XGEN(b.x)], 1u);
            asm volatile("s_waitcnt vmcnt(0)" ::: "memory");
        } else {
            XB_SPIN(xb_ld(&bar[XB_XGEN(b.x)]) == gen, bar);
            __builtin_amdgcn_fence(__ATOMIC_ACQUIRE, "agent");
            asm volatile("s_waitcnt vmcnt(0)" ::: "memory");
        }
    }
    __syncthreads();
}

extern __shared__ __attribute__((aligned(16))) char smem[];
#define NPHASES 7

#define XB_LDS_OFF (LDS_BYTES - 16)
__global__ void __launch_bounds__(NTHREADS) mega(Params p, int ph0, int ph1) {
    XcdBarrier xb;
    const bool multi = (ph1 - ph0) > 1;
    if (multi) {
        if (threadIdx.x == 0) *(u32x4*)(smem + XB_LDS_OFF) = (u32x4){0u, 0u, 0u, 0u};
        __syncthreads();
        xb = xcd_barrier_post(p.bar, (volatile LAS unsigned*)(smem + XB_LDS_OFF));
    }
#if defined(__HIP_DEVICE_COMPILE__)
    typedef const __attribute__((address_space(4))) Params* cparams_t;
    const cparams_t kp = (cparams_t)__builtin_amdgcn_kernarg_segment_ptr();
#define RUN_PHASE(k) if (ph0 <= k && k < ph1) { cparams_t q_ = kp; asm volatile("" : "+s"(q_)); const Params lp_ = *q_; phase##k(lp_, smem); if (k + 1 < ph1) { cparams_t r_ = kp; asm volatile("" : "+s"(r_)); xcd_barrier(xb, r_->bar); } }
#else
#define RUN_PHASE(k) if (ph0 <= k && k < ph1) { phase##k(p, smem); if (k + 1 < ph1) xcd_barrier(xb, p.bar); }
#endif
    RUN_PHASE(0)
    RUN_PHASE(1)
    RUN_PHASE(2)
    RUN_PHASE(3)
    RUN_PHASE(4)
    RUN_PHASE(5)
    RUN_PHASE(6)
}

static inline size_t align_up(size_t x, size_t a) { return (x + a - 1) / a * a; }

extern "C" void kernel_launch(void* const* d_in, const int* in_sizes, int n_in,
                              void* d_out, int out_size, void* d_ws, size_t ws_size,
                              hipStream_t stream) {
    Params p{};
    p.x_prompt = (const float*)d_in[0]; p.x_sample = (const float*)d_in[1]; p.cache_latent = (const float*)d_in[2]; p.cache_krope = (const float*)d_in[3];
    p.state_hgrn = (const float*)d_in[4]; p.page_table = (const int*)d_in[5]; p.meta = (const float*)d_in[6]; p.norm_g = (const float*)d_in[7];
    p.w_in = (const float*)d_in[8]; p.g_cq = (const float*)d_in[9]; p.w_uq = (const float*)d_in[10]; p.g_ckv = (const float*)d_in[11];
    p.w_uk = (const float*)d_in[12]; p.w_uv = (const float*)d_in[13]; p.g_qn = (const float*)d_in[14]; p.g_kn = (const float*)d_in[15];
    p.lb_logits = (const float*)d_in[16]; p.g_bn = (const float*)d_in[17]; p.w_oa = (const float*)d_in[18]; p.w_ob = (const float*)d_in[19]; p.w_o = (const float*)d_in[20];
    p.out = (float*)d_out;
    char* w = (char*)d_ws; size_t off = 0;
    auto take = [&](size_t bytes) { char* r = w + off; off = align_up(off + bytes, 256); return r; };
    p.bar    = (unsigned*)take(16384);
    p.XN     = (bf16_t*)take((size_t)R_PAD * 1024 * 2);
    p.WIN_T  = (bf16_t*)take((size_t)IN_COLS_PAD * 1024 * 2);
    p.PBUF   = (bf16_t*)take((size_t)R_PAD * IN_COLS_PAD * 2);
    p.F32A   = (float*)take((size_t)R_PAD * 672 * 4);
    p.GLOG   = (float*)take((size_t)R_PAD * 512 * 4);
    p.CQN    = (bf16_t*)take((size_t)R_PAD * 384 * 2);
    p.CKVN   = (bf16_t*)take((size_t)R_PAD * 256 * 2);
    p.KRR    = (float*)take((size_t)R_PAD * 32 * 4);
    p.WUQ_T  = (bf16_t*)take((size_t)768 * 384 * 2);
    p.WUKV_T = (bf16_t*)take((size_t)1024 * 256 * 2);
    p.WUKVG_T = (bf16_t*)take((size_t)1024 * 256 * 2);
    p.F32B   = (float*)take((size_t)R_PAD * 288 * 4);
    p.WOA_T  = (bf16_t*)take((size_t)1024 * 512 * 2);
    p.WOB_T  = (bf16_t*)take((size_t)1024 * 512 * 2);
    p.WO_T   = (bf16_t*)take((size_t)1024 * 1024 * 2);
    p.QRAW   = (bf16_t*)take((size_t)R_PAD * 768 * 2);
    p.KVRAW  = (bf16_t*)take((size_t)R_PAD * 1024 * 2);
    p.QA     = (bf16_t*)take((size_t)8 * 8 * 2048 * 96 * 2);
    p.KA     = (bf16_t*)take((size_t)8 * 8 * 2064 * 96 * 2 + 65536);
    p.VTG    = (bf16_t*)take((size_t)64 * 64 * 2112 * 2);
    p.QS     = (float*)take((size_t)32 * 8 * 96 * 4);
    p.KSRAW  = (float*)take((size_t)32 * 8 * 96 * 4);
    p.AMA    = (bf16_t*)take((size_t)MROWS_PAD * 512 * 2);
    p.AMB    = (bf16_t*)take((size_t)MROWS_PAD * 512 * 2);
    p.MM     = (bf16_t*)take((size_t)MROWS_PAD * 1024 * 2);
    p.TMP    = (float*)take((size_t)NQ * 1024 * 4);
    p.UT     = (bf16_t*)take((size_t)32 * NCHUNK * 16384 * 2);
    p.ST     = (bf16_t*)take((size_t)32 * NCHUNK * 16384 * 2);
    p.DEC    = (float*)take((size_t)32 * NCHUNK * 128 * 4);
    p.LB     = (float*)take(512 * 4);
    p.INV    = (float*)take(64);
    p.ROPE   = (float*)take((size_t)2065 * 32 * 4);
    p.SCAL   = (float*)take(64);
    p.PART   = (float*)take((size_t)32 * 8 * 8 * 256 * 4);
    p.PL     = (float*)take((size_t)32 * 8 * 8 * 4);
    p.OLAT   = (float*)take((size_t)32 * 8 * 256 * 4);
    (void)ws_size; (void)in_sizes; (void)n_in; (void)out_size;
    static int mode = -1;
    if (mode < 0) {
        (void)hipFuncSetAttribute((const void*)mega, hipFuncAttributeMaxDynamicSharedMemorySize, LDS_BYTES);
        int dev = 0, cus = 0, per_cu = 0;
        (void)hipGetDevice(&dev);
        (void)hipDeviceGetAttribute(&cus, hipDeviceAttributeMultiprocessorCount, dev);
        (void)hipOccupancyMaxActiveBlocksPerMultiprocessor(&per_cu, (const void*)mega, NTHREADS, LDS_BYTES);
        mode = (cus * per_cu >= 256) ? 1 : 0;
    }
    (void)hipMemsetAsync(p.bar, 0, 16384, stream);
    if (mode == 1) {
        mega<<<dim3(256), dim3(NTHREADS), LDS_BYTES, stream>>>(p, 0, NPHASES);
    } else {
        for (int ph = 0; ph < NPHASES; ++ph) mega<<<dim3(256), dim3(NTHREADS), LDS_BYTES, stream>>>(p, ph, ph + 1);
    }
}
```
